# Optimizing an MI355X kernel written in HIP

```python
import jax, jax.numpy as jnp
from jax import lax
import numpy as np

D_MODEL = 1024
BATCH = 1
SEQ = 16384
DEPTH = 1

GRID_W = 64
CTX_LEN = 256
RWKV_HEADS = 8
RWKV_HEAD_DIM = 64
D_RWKV = RWKV_HEADS * RWKV_HEAD_DIM
W_RANK = 64
A_RANK = 64
G_RANK = 128
GN_EPS = 64e-5
CHUNK = 128
SG_GROUPS = 4
SG_GROUP_DIM = 128
D_SG = SG_GROUPS * SG_GROUP_DIM
P_A = 3 * D_RWKV + 2 * W_RANK + 2 * A_RANK + G_RANK
W_IN_COLS = P_A + 2 * D_SG + 2 * D_MODEL
RWKV_SPLITS = (D_RWKV, 2 * D_RWKV, 3 * D_RWKV, 3 * D_RWKV + 2 * W_RANK, 3 * D_RWKV + 2 * W_RANK + 2 * A_RANK)
N_GROUPS = 4
EXPERTS_PER_GROUP = 8
N_EXPERTS = N_GROUPS * EXPERTS_PER_GROUP
TOP_K_IN_GROUP = 2
D_EXPERT = 512
MOE_BLOCK = 128
NORM_EPS = 1e-6

kernel_name = "hybrid_rwkv7_chunkgmlp_hmoe_dit"


def rms_norm(x, g):
    xf = x.astype(jnp.float32)
    y = xf * lax.rsqrt(jnp.mean(xf * xf, axis=-1, keepdims=True) + NORM_EPS)
    return (y * g).astype(x.dtype)


def layer_norm(x, w, b):
    xf = x.astype(jnp.float32)
    mu = jnp.mean(xf, axis=-1, keepdims=True)
    var = jnp.mean((xf - mu) ** 2, axis=-1, keepdims=True)
    return ((xf - mu) * lax.rsqrt(var + 1e-5) * w + b).astype(x.dtype)


def modulate(h, shift, scale):
    return h * (1.0 + scale[:, None, :]) + shift[:, None, :]


def grid_shift(z, rows):
    B, L, C = z.shape
    zq = z.reshape(B, rows, GRID_W, C // 4, 4)
    left = jnp.pad(zq[:, :, :-1, :, 0], ((0, 0), (0, 0), (1, 0), (0, 0)))
    right = jnp.pad(zq[:, :, 1:, :, 1], ((0, 0), (0, 0), (0, 1), (0, 0)))
    up = jnp.pad(zq[:, :-1, :, :, 2], ((0, 0), (1, 0), (0, 0), (0, 0)))
    down = jnp.pad(zq[:, 1:, :, :, 3], ((0, 0), (0, 1), (0, 0), (0, 0)))
    return jnp.stack([left, right, up, down], axis=-1).reshape(B, L, C)


def seq_shift(z):
    B, L, C = z.shape
    zq = z.reshape(B, L, C // 2, 2)
    prev = jnp.pad(zq[:, :-1, :, 0], ((0, 0), (1, 0), (0, 0)))
    nxt = jnp.pad(zq[:, 1:, :, 1], ((0, 0), (0, 1), (0, 0)))
    return jnp.stack([prev, nxt], axis=-1).reshape(B, L, C)


def dir_major(t_fwd, t_bwd):
    B, L, _ = t_fwd.shape
    t = jnp.stack([t_fwd, jnp.flip(t_bwd, axis=1)], axis=0).astype(jnp.float32)
    return jnp.transpose(t.reshape(2, B, L, RWKV_HEADS, RWKV_HEAD_DIM), (2, 0, 1, 3, 4))


def rwkv_prepare(zA, w0, w_up, a0, a_up, g_up, k_k, k_a):
    B, L, _ = zA.shape
    r, k, v, wd, ad, gd = jnp.split(zA, RWKV_SPLITS, axis=-1)
    wd = jnp.tanh(wd).reshape(B, L, 2, W_RANK)
    ad = ad.reshape(B, L, 2, A_RANK)
    w = -jax.nn.softplus(-(w0 + jnp.einsum('bldr,drc->bldc', wd, w_up))) - 0.5
    decay = jnp.exp(-jnp.exp(w.astype(jnp.float32)))
    a = jax.nn.sigmoid(a0 + jnp.einsum('bldr,drc->bldc', ad, a_up))
    g = jax.nn.sigmoid(gd) @ g_up
    kk = (k * k_k).astype(jnp.float32).reshape(B, L, RWKV_HEADS, RWKV_HEAD_DIM)
    kk = kk / jnp.maximum(jnp.sqrt(jnp.sum(kk * kk, axis=-1, keepdims=True)), 1e-12)
    kk = kk.reshape(B, L, D_RWKV)
    k_dir = k[:, :, None, :] * (1.0 + (a - 1.0) * k_a)
    a32 = a.astype(jnp.float32)
    scan_in = (dir_major(r, r),
               dir_major(decay[:, :, 0], decay[:, :, 1]),
               dir_major(k_dir[:, :, 0], k_dir[:, :, 1]),
               dir_major(v, v),
               dir_major(kk, kk),
               dir_major(kk * a32[:, :, 0], kk * a32[:, :, 1]))
    return scan_in, r, k, v, g


def rwkv_step(S, inp):
    r, w, k, v, kk, kka = inp
    sa = jnp.einsum('dbhvk,dbhk->dbhv', S, kk)
    S = S * w[..., None, :] - sa[..., :, None] * kka[..., None, :] + v[..., :, None] * k[..., None, :]
    y = jnp.einsum('dbhvk,dbhk->dbhv', S, r)
    return S, y


def rwkv_scan(scan_in, S0):
    S_fin, ys = lax.scan(rwkv_step, S0, scan_in)
    y = ys[:, 0] + jnp.flip(ys[:, 1], axis=0)
    return S_fin, jnp.transpose(y, (1, 0, 2, 3))


def rwkv_output(y, r, k, v, g, r_k, ln_w, ln_b):
    B, L, H, N = y.shape
    mu = jnp.mean(y, axis=-1, keepdims=True)
    var = jnp.mean((y - mu) ** 2, axis=-1, keepdims=True)
    yn = ((y - mu) * lax.rsqrt(var + GN_EPS)).reshape(B, L, D_RWKV) * ln_w + ln_b
    rh = r.reshape(B, L, H, N)
    kh = k.reshape(B, L, H, N)
    vh = v.reshape(B, L, H, N)
    bonus = (jnp.sum(rh * kh * r_k, axis=-1, keepdims=True) * vh).reshape(B, L, D_RWKV)
    return (yn.astype(r.dtype) + bonus) * g


def chunk_gating(zB, ln_w, ln_b, sg_w, sg_b):
    B, L, _ = zB.shape
    u, v = jnp.split(jax.nn.gelu(zB), 2, axis=-1)
    v = layer_norm(v, ln_w, ln_b).reshape(B, L // CHUNK, CHUNK, SG_GROUPS, SG_GROUP_DIM)
    s = jnp.einsum('gpq,bnqgc->bnpgc', sg_w, v) + jnp.transpose(sg_b)[:, :, None]
    return u * s.reshape(B, L, D_SG)


def mixer_stream(h, shift_fn, S0, need_output, params):
    (w_in, mu, w0, w_up, a0, a_up, g_up, k_k, k_a, r_k, ln_w, ln_b,
     w_branch_a, sg_ln_w, sg_ln_b, sg_w, sg_b, w_branch_b, w_out) = params
    z = h @ (w_in if need_output else w_in[:, :P_A])
    zA = z[..., :P_A]
    zA = zA + mu * (shift_fn(zA) - zA)
    scan_in, r, k, v, g = rwkv_prepare(zA, w0, w_up, a0, a_up, g_up, k_k, k_a)
    S_fin, y = rwkv_scan(scan_in, S0)
    if not need_output:
        return None, S_fin
    zB = z[..., P_A:P_A + 2 * D_SG]
    gate_a, gate_b = jnp.split(jax.nn.sigmoid(z[..., P_A + 2 * D_SG:]), 2, axis=-1)
    y_a = rwkv_output(y, r, k, v, g, r_k, ln_w, ln_b) @ w_branch_a
    y_b = chunk_gating(zB, sg_ln_w, sg_ln_b, sg_w, sg_b) @ w_branch_b
    return (gate_a * y_a + gate_b * y_b) @ w_out, S_fin


def hier_moe(h, grp_w, grp_b, exp_w, exp_b, w_gate, w_up, w_down):
    B, L, D = h.shape
    T = B * L
    xt = h.reshape(T, D)
    tok = jnp.arange(T)
    grp_logits = (xt @ grp_w + grp_b).astype(jnp.float32)
    grp = jnp.argmax(grp_logits, axis=-1)
    p_grp = jax.nn.softmax(grp_logits, axis=-1)[tok, grp]
    exp_logits = (xt @ exp_w + exp_b).astype(jnp.float32).reshape(T, N_GROUPS, EXPERTS_PER_GROUP)
    top_val, top_idx = lax.top_k(exp_logits[tok, grp], TOP_K_IN_GROUP)
    top_w = jax.nn.softmax(top_val, axis=-1) * p_grp[:, None]
    expert = grp[:, None] * EXPERTS_PER_GROUP + top_idx
    A = T * TOP_K_IN_GROUP
    flat_e = expert.reshape(A).astype(jnp.int32)
    flat_tok = jnp.repeat(tok, TOP_K_IN_GROUP).astype(jnp.int32)
    flat_w = top_w.reshape(A)
    order = jnp.argsort(flat_e)
    e_s, tok_s, w_s = flat_e[order], flat_tok[order], flat_w[order]
    counts = jax.ops.segment_sum(jnp.ones((A,), jnp.int32), flat_e, num_segments=N_EXPERTS)
    start = jnp.cumsum(counts) - counts
    padded = ((counts + MOE_BLOCK - 1) // MOE_BLOCK) * MOE_BLOCK
    pend = jnp.cumsum(padded)
    pstart = pend - padded
    dest = pstart[e_s] + (jnp.arange(A, dtype=jnp.int32) - start[e_s])
    P = ((A + MOE_BLOCK - 1) // MOE_BLOCK) * MOE_BLOCK + N_EXPERTS * MOE_BLOCK
    n_blocks = P // MOE_BLOCK
    row_tok = jnp.full((P,), T, jnp.int32).at[dest].set(tok_s)
    row_w = jnp.zeros((P,), jnp.float32).at[dest].set(w_s)
    block_expert = jnp.minimum(jnp.searchsorted(pend, jnp.arange(n_blocks) * MOE_BLOCK, side='right'),
                               N_EXPERTS - 1)
    x_pad = jnp.concatenate([xt, jnp.zeros((1, D), xt.dtype)], axis=0)
    rows = x_pad[row_tok].reshape(n_blocks, MOE_BLOCK, D)

    def expert_block(args):
        xb, e = args
        hb = jax.nn.silu(xb @ w_gate[e]) * (xb @ w_up[e])
        return hb @ w_down[e]

    out = lax.map(expert_block, (rows, block_expert)).reshape(P, D)
    out = out * row_w[:, None].astype(out.dtype)
    y = jax.ops.segment_sum(out, row_tok, num_segments=T + 1)[:T]
    return y.reshape(B, L, D)


def setup_inputs(seed: int = 0) -> dict:
    key = jax.random.key(seed)
    ks = jax.random.split(key, 40)
    f32 = jnp.float32

    def nrm(k, shape, scale):
        return scale * jax.random.normal(k, shape, f32)

    Dp = DEPTH
    return {
        "x": nrm(ks[0], (BATCH, SEQ, D_MODEL), 1.0),
        "c": nrm(ks[1], (BATCH, D_MODEL), 1.0),
        "ctx": nrm(ks[2], (BATCH, CTX_LEN, D_MODEL), 1.0),
        "c_ctx": nrm(ks[3], (D_MODEL,), 1.0),
        "ada_w": nrm(ks[4], (Dp, D_MODEL, 6 * D_MODEL), 0.5 * D_MODEL ** -0.5),
        "ada_b": nrm(ks[5], (Dp, 6 * D_MODEL), 0.01),
        "norm1_g": 1.0 + nrm(ks[6], (Dp, D_MODEL), 0.02),
        "norm2_g": 1.0 + nrm(ks[7], (Dp, D_MODEL), 0.02),
        "w_in": nrm(ks[8], (Dp, D_MODEL, W_IN_COLS), D_MODEL ** -0.5),
        "shift_mu": jax.random.uniform(ks[9], (Dp, P_A), f32, 0.2, 0.8),
        "rwkv_w0": jax.random.uniform(ks[10], (Dp, 2, D_RWKV), f32, -6.5, -1.5),
        "rwkv_w_up": nrm(ks[11], (Dp, 2, W_RANK, D_RWKV), 0.1),
        "rwkv_a0": nrm(ks[12], (Dp, 2, D_RWKV), 0.1),
        "rwkv_a_up": nrm(ks[13], (Dp, 2, A_RANK, D_RWKV), 0.1),
        "rwkv_g_up": nrm(ks[14], (Dp, G_RANK, D_RWKV), G_RANK ** -0.5),
        "rwkv_k_k": 0.85 + nrm(ks[15], (Dp, D_RWKV), 0.02),
        "rwkv_k_a": 1.0 + nrm(ks[16], (Dp, D_RWKV), 0.02),
        "rwkv_r_k": nrm(ks[17], (Dp, RWKV_HEADS, RWKV_HEAD_DIM), 0.1),
        "rwkv_ln_w": 1.0 + nrm(ks[18], (Dp, D_RWKV), 0.02),
        "rwkv_ln_b": nrm(ks[19], (Dp, D_RWKV), 0.01),
        "w_branch_a": nrm(ks[20], (Dp, D_RWKV, D_MODEL), D_RWKV ** -0.5),
        "sg_ln_w": 1.0 + nrm(ks[21], (Dp, D_SG), 0.02),
        "sg_ln_b": nrm(ks[22], (Dp, D_SG), 0.01),
        "sg_w": nrm(ks[23], (Dp, SG_GROUPS, CHUNK, CHUNK), CHUNK ** -0.5),
        "sg_b": 1.0 + nrm(ks[24], (Dp, SG_GROUPS, CHUNK), 0.02),
        "w_branch_b": nrm(ks[25], (Dp, D_SG, D_MODEL), D_SG ** -0.5),
        "w_out": nrm(ks[26], (Dp, D_MODEL, D_MODEL), D_MODEL ** -0.5),
        "moe_grp_w": nrm(ks[27], (Dp, D_MODEL, N_GROUPS), D_MODEL ** -0.5),
        "moe_grp_b": nrm(ks[28], (Dp, N_GROUPS), 0.01),
        "moe_exp_w": nrm(ks[29], (Dp, D_MODEL, N_EXPERTS), D_MODEL ** -0.5),
        "moe_exp_b": nrm(ks[30], (Dp, N_EXPERTS), 0.01),
        "moe_w_gate": nrm(ks[31], (Dp, N_EXPERTS, D_MODEL, D_EXPERT), D_MODEL ** -0.5),
        "moe_w_up": nrm(ks[32], (Dp, N_EXPERTS, D_MODEL, D_EXPERT), D_MODEL ** -0.5),
        "moe_w_down": nrm(ks[33], (Dp, N_EXPERTS, D_EXPERT, D_MODEL), D_EXPERT ** -0.5),
        "final_norm_g": 1.0 + nrm(ks[34], (D_MODEL,), 0.02),
    }


def reference(x, c, ctx, c_ctx, ada_w, ada_b, norm1_g, norm2_g, w_in, shift_mu,
              rwkv_w0, rwkv_w_up, rwkv_a0, rwkv_a_up, rwkv_g_up, rwkv_k_k, rwkv_k_a, rwkv_r_k,
              rwkv_ln_w, rwkv_ln_b, w_branch_a, sg_ln_w, sg_ln_b, sg_w, sg_b, w_branch_b, w_out,
              moe_grp_w, moe_grp_b, moe_exp_w, moe_exp_b, moe_w_gate, moe_w_up, moe_w_down,
              final_norm_g):
    rows = x.shape[1] // GRID_W
    lat_shift = lambda z: grid_shift(z, rows)
    xc = ctx
    for layer in range(DEPTH):
        need_ctx = layer + 1 < DEPTH
        params = (w_in[layer], shift_mu[layer], rwkv_w0[layer], rwkv_w_up[layer], rwkv_a0[layer],
                  rwkv_a_up[layer], rwkv_g_up[layer], rwkv_k_k[layer], rwkv_k_a[layer], rwkv_r_k[layer],
                  rwkv_ln_w[layer], rwkv_ln_b[layer], w_branch_a[layer], sg_ln_w[layer], sg_ln_b[layer],
                  sg_w[layer], sg_b[layer], w_branch_b[layer], w_out[layer])
        moe_params = (moe_grp_w[layer], moe_grp_b[layer], moe_exp_w[layer], moe_exp_b[layer],
                      moe_w_gate[layer], moe_w_up[layer], moe_w_down[layer])
        mod = jax.nn.silu(c) @ ada_w[layer] + ada_b[layer]
        mod_c = jax.nn.silu(c_ctx)[None] @ ada_w[layer] + ada_b[layer]
        sh1, sc1, gt1, sh2, sc2, gt2 = jnp.split(mod, 6, axis=-1)
        csh1, csc1, cgt1, csh2, csc2, cgt2 = jnp.split(mod_c, 6, axis=-1)
        h_c = modulate(rms_norm(xc, norm1_g[layer]), csh1, csc1)
        s0 = jnp.zeros((2, xc.shape[0], RWKV_HEADS, RWKV_HEAD_DIM, RWKV_HEAD_DIM), jnp.float32)
        out_c, s_ctx = mixer_stream(h_c, seq_shift, s0, need_ctx, params)
        h = modulate(rms_norm(x, norm1_g[layer]), sh1, sc1)
        out, _ = mixer_stream(h, lat_shift, s_ctx, True, params)
        x = x + gt1[:, None, :] * out
        h = modulate(rms_norm(x, norm2_g[layer]), sh2, sc2)
        x = x + gt2[:, None, :] * hier_moe(h, *moe_params)
        if need_ctx:
            xc = xc + cgt1[:, None, :] * out_c
            hc = modulate(rms_norm(xc, norm2_g[layer]), csh2, csc2)
            xc = xc + cgt2[:, None, :] * hier_moe(hc, *moe_params)
    return rms_norm(x, final_norm_g)
```

```cpp
#include <hip/hip_runtime.h>
#include <cstdio>
#include <cstdint>
namespace pg8 {
#define PG8_LAS __attribute__((address_space(3)))
typedef unsigned short bf16_t;
typedef short bf16x8 __attribute__((ext_vector_type(8)));
typedef float f32x4 __attribute__((ext_vector_type(4)));
typedef unsigned u32x4 __attribute__((ext_vector_type(4)));
constexpr int BM = 256, BK = 64, HALF = 128, HTB = HALF * BK * 2  , STAGE_BYTES = 8 * HTB, NXCD = 8, WGM = 8;

__host__ __device__ __forceinline__ int lds_byte(int r, int c) { const int st = (r >> 4) * 2 + (c >> 5), rr = r & 15, cc = c & 31, ob = rr * 64 + cc * 2; return st * 1024 + (ob ^ (((ob >> 9) & 1) << 5)); }
__host__ __device__ __forceinline__ void stage_rc(int b, int& R, int& C) { const int st = b / 1024, sb = b % 1024, swz = sb ^ (((sb >> 9) & 1) << 5); R = (st >> 1) * 16 + swz / 64; C = (st & 1) * 32 + (swz % 64) / 2; }
__host__ __device__ __forceinline__ int perm32(int rho) { const int n = rho >> 4, i = rho & 15; return 8 * (i >> 2) + 4 * n + (i & 3); }

struct Unit { int pm, pn; };
struct Gemm { const bf16_t* A; const bf16_t* Bt; int M, N, K; };

struct StaticOrder {
    int nM, nN, nwg, G, c;
    __host__ __device__ void init(int M, int N, int G_, int c_) { nM = M / BM; nN = N / BM; nwg = nM * nN; G = G_; c = c_; }
    __host__ __device__ bool next(int i, Unit& u) const {
        const long L = (long)i * G + c; if (L >= nwg) return false;
        int wgid = (int)L; { const int q = nwg / NXCD, r = nwg % NXCD, xcd = wgid % NXCD, off = wgid / NXCD; wgid = (xcd < r ? xcd * (q + 1) : r * (q + 1) + (xcd - r) * q) + off; }
        const int nig = WGM * nN, gid = wgid / nig, fm = gid * WGM, gsz = (nM - fm) < WGM ? (nM - fm) : WGM;
        u.pm = fm + ((wgid % nig) % gsz); u.pn = (wgid % nig) / gsz; return true;
    }
    __device__ __forceinline__ void a_ready(const Unit&) const {}
    __device__ __forceinline__ void done(const Unit&) const {}
};

__device__ __forceinline__ unsigned cvt_pk_bf16(float lo, float hi) { unsigned r; asm volatile("v_cvt_pk_bf16_f32 %0, %1, %2" : "=v"(r) : "v"(lo), "v"(hi)); return r; }
template <class Epi, class Sched, bool ALIGN_EPI = false, bool SP2 = false>
__device__ __forceinline__ void gemm_phase(PG8_LAS unsigned char* lds, const Gemm g, const Sched& S, const Epi& E) {
    int tid_ = threadIdx.x; asm volatile("" : "+v"(tid_));
    const int tid = tid_, wid = __builtin_amdgcn_readfirstlane(tid >> 6), lane = tid & 63, wr = wid >> 2, wc = wid & 3, fr = lane & 15, fq = lane >> 4;
    const int K = g.K, nt = K / BK;
    unsigned voffA[2], voffB[2];
#pragma unroll
    for (int i = 0; i < 2; ++i) { int R, C; stage_rc(tid * 16 + i * 8192, R, C); const int Rb = Epi::PERM ? ((R & ~31) + perm32(R & 31)) : R;
        voffA[i] = (unsigned)(R * K + C) * 2u; voffB[i] = (unsigned)(Rb * K + C) * 2u; }
    const size_t kstep = (size_t)(BK * 2);
    const size_t hstep = (size_t)HALF * K * 2;
    const size_t tstep = 2 * hstep;
    const unsigned ldsw = (unsigned)wid * 1024u;
    const int aoff = lds_byte(wr * 64 + fr, fq * 8), boff = lds_byte(wc * 32 + fr, fq * 8);
#define PG8_SA(b, h) (((b) * 2 + (h)) * HTB)
#define PG8_SB(b, h) ((4 + (b) * 2 + (h)) * HTB)
#define PG8_STAGE(bufoff, gbase, voff) do { _Pragma("unroll") for (int _i = 0; _i < 2; ++_i) \
        __builtin_amdgcn_global_load_lds((const unsigned*)((const char*)(gbase) + (voff)[_i]), (PG8_LAS unsigned*)(lds + (bufoff) + ldsw + _i * 8192), 16, 0, 0); } while (0)
#define PG8_LDA(dst, b, h) do { _Pragma("unroll") for (int m = 0; m < 4; ++m) _Pragma("unroll") for (int k = 0; k < 2; ++k) dst[m][k] = *(const PG8_LAS bf16x8*)(lds + PG8_SA(b, h) + aoff + m * 2048 + k * 1024); } while (0)
#define PG8_LDB(dst, b, h) do { _Pragma("unroll") for (int n = 0; n < 2; ++n) _Pragma("unroll") for (int k = 0; k < 2; ++k) dst[n][k] = *(const PG8_LAS bf16x8*)(lds + PG8_SB(b, h) + boff + n * 2048 + k * 1024); } while (0)
#define PG8_MMA(ai, bj, At, Bt) do { __builtin_amdgcn_s_setprio(1); _Pragma("unroll") for (int m = 0; m < 4; ++m) _Pragma("unroll") for (int n = 0; n < 2; ++n) _Pragma("unroll") for (int k = 0; k < 2; ++k) \
        acc[ai][bj][m][n] = __builtin_amdgcn_mfma_f32_16x16x32_bf16(Bt[n][k], At[m][k], acc[ai][bj][m][n], 0, 0, 0); __builtin_amdgcn_s_setprio(0); } while (0)
#define PG8_WAIT_V(n) asm volatile("s_waitcnt vmcnt(" #n ")" ::: "memory")
#define PG8_WAIT_L(n) asm volatile("s_waitcnt lgkmcnt(" #n ")" ::: "memory")
#define PG8_BAR __builtin_amdgcn_s_barrier()
#define PG8_SCHED __builtin_amdgcn_sched_barrier(0)
    Unit cur, nxt; int ui = 0;
    if (!S.next(0, cur)) return;
    f32x4 acc[2][2][4][2];
#pragma unroll
    for (int a = 0; a < 2; ++a)
#pragma unroll
        for (int b = 0; b < 2; ++b)
#pragma unroll
            for (int m = 0; m < 4; ++m)
#pragma unroll
                for (int n = 0; n < 2; ++n) acc[a][b][m][n] = (f32x4){0.f, 0.f, 0.f, 0.f};
    bf16x8 At[4][2], B0[2][2], B1[2][2];
    const char* cA = (const char*)g.A + (size_t)cur.pm * tstep; const char* cB = (const char*)g.Bt + (size_t)cur.pn * tstep;
    S.a_ready(cur);
    if constexpr (SP2) {
        PG8_STAGE(PG8_SB(0, 0), cB, voffB); PG8_STAGE(PG8_SB(0, 1), cB + hstep, voffB); PG8_STAGE(PG8_SA(0, 0), cA, voffA); PG8_STAGE(PG8_SA(0, 1), cA + hstep, voffA);
        if (wr == 1) PG8_BAR;
        PG8_WAIT_V(2); PG8_BAR;
        PG8_STAGE(PG8_SB(1, 0), cB + kstep, voffB); PG8_STAGE(PG8_SA(1, 0), cA + kstep, voffA); PG8_STAGE(PG8_SB(1, 1), cB + hstep + kstep, voffB);
        PG8_WAIT_V(6); PG8_BAR;
    } else {
        PG8_STAGE(PG8_SB(0, 0), cB, voffB); PG8_STAGE(PG8_SA(0, 0), cA, voffA); PG8_STAGE(PG8_SB(0, 1), cB + hstep, voffB); PG8_STAGE(PG8_SA(0, 1), cA + hstep, voffA);
        if (wr == 1) PG8_BAR;
        PG8_WAIT_V(4); PG8_BAR;
        PG8_STAGE(PG8_SB(1, 0), cB + kstep, voffB); PG8_STAGE(PG8_SA(1, 0), cA + kstep, voffA); PG8_STAGE(PG8_SB(1, 1), cB + hstep + kstep, voffB);
        PG8_WAIT_V(6); PG8_BAR;
    }
    for (;;) {
        const bool has_next = S.next(ui + 1, nxt);
        const char* nA = has_next ? (const char*)g.A + (size_t)nxt.pm * tstep : cA; const char* nB = has_next ? (const char*)g.Bt + (size_t)nxt.pn * tstep : cB;
        for (int t = 0; t < nt; t += 2) {
            const bool last = (t == nt - 2);
            const char* a1 = cA + (size_t)(t + 1) * kstep;
            const char* a2 = last ? nA : cA + (size_t)(t + 2) * kstep; const char* b2 = last ? nB : cB + (size_t)(t + 2) * kstep;
            const char* a3 = a2 + kstep; const char* b3 = b2 + kstep;
            if (last && has_next) S.a_ready(nxt);
            if constexpr (SP2) {
            PG8_LDB(B0, 0, 0); PG8_LDB(B1, 0, 1); PG8_SCHED; PG8_LDA(At, 0, 0); PG8_STAGE(PG8_SA(1, 1), a1 + hstep, voffA);
            PG8_WAIT_V(8); PG8_WAIT_L(0); PG8_BAR; PG8_MMA(0, 0, At, B0); PG8_MMA(0, 1, At, B1); PG8_BAR; PG8_SCHED;
            PG8_LDA(At, 0, 1); PG8_STAGE(PG8_SB(0, 0), b2, voffB); PG8_STAGE(PG8_SB(0, 1), b2 + hstep, voffB); PG8_STAGE(PG8_SA(0, 0), a2, voffA);
            PG8_WAIT_V(8); PG8_WAIT_L(0); PG8_BAR; PG8_MMA(1, 0, At, B0); PG8_MMA(1, 1, At, B1); PG8_BAR; PG8_SCHED;
            PG8_LDB(B0, 1, 0); PG8_LDB(B1, 1, 1); PG8_SCHED; PG8_LDA(At, 1, 0); PG8_STAGE(PG8_SA(0, 1), a2 + hstep, voffA);
            PG8_WAIT_V(8); PG8_WAIT_L(0); PG8_BAR; PG8_MMA(0, 0, At, B0); PG8_MMA(0, 1, At, B1); PG8_BAR; PG8_SCHED;
            PG8_LDA(At, 1, 1); PG8_STAGE(PG8_SB(1, 0), b3, voffB); PG8_STAGE(PG8_SB(1, 1), b3 + hstep, voffB); PG8_STAGE(PG8_SA(1, 0), a3, voffA);
            PG8_WAIT_V(8); PG8_WAIT_L(0); PG8_BAR; PG8_MMA(1, 0, At, B0); PG8_MMA(1, 1, At, B1); PG8_BAR; PG8_SCHED;
            } else {
            PG8_LDB(B0, 0, 0); PG8_SCHED; PG8_LDA(At, 0, 0); PG8_STAGE(PG8_SA(1, 1), a1 + hstep, voffA);
            PG8_WAIT_L(8); PG8_BAR; PG8_WAIT_L(0); PG8_MMA(0, 0, At, B0); PG8_BAR; PG8_SCHED;
            PG8_LDB(B1, 0, 1); PG8_STAGE(PG8_SB(0, 0), b2, voffB);
            PG8_BAR; PG8_WAIT_L(0); PG8_MMA(0, 1, At, B1); PG8_BAR;
            PG8_LDA(At, 0, 1); PG8_STAGE(PG8_SA(0, 0), a2, voffA);
            PG8_BAR; PG8_WAIT_L(0); PG8_MMA(1, 0, At, B0); PG8_BAR; PG8_SCHED;
            PG8_STAGE(PG8_SB(0, 1), b2 + hstep, voffB);
            PG8_WAIT_V(6); PG8_BAR; PG8_MMA(1, 1, At, B1); PG8_BAR;
            PG8_LDB(B0, 1, 0); PG8_SCHED; PG8_LDA(At, 1, 0); PG8_STAGE(PG8_SA(0, 1), a2 + hstep, voffA);
            PG8_WAIT_L(8); PG8_BAR; PG8_WAIT_L(0); PG8_MMA(0, 0, At, B0); PG8_BAR; PG8_SCHED;
            PG8_LDB(B1, 1, 1); PG8_STAGE(PG8_SB(1, 0), b3, voffB);
            PG8_BAR; PG8_WAIT_L(0); PG8_MMA(0, 1, At, B1); PG8_BAR;
            PG8_LDA(At, 1, 1); PG8_STAGE(PG8_SA(1, 0), a3, voffA);
            PG8_BAR; PG8_WAIT_L(0); PG8_MMA(1, 0, At, B0); PG8_BAR; PG8_SCHED;
            PG8_STAGE(PG8_SB(1, 1), b3 + hstep, voffB);
            PG8_WAIT_V(6); PG8_BAR; PG8_MMA(1, 1, At, B1); PG8_BAR;
            }
        }
        if constexpr (ALIGN_EPI) { if (wr == 0) PG8_BAR; }
        if constexpr (!Epi::AFTER_DRAIN) { E(acc, cur, wr, wc, fr, fq); S.done(cur); }
        if (!has_next) break;
#pragma unroll
        for (int a = 0; a < 2; ++a)
#pragma unroll
            for (int b = 0; b < 2; ++b)
#pragma unroll
                for (int m = 0; m < 4; ++m)
#pragma unroll
                    for (int n = 0; n < 2; ++n) acc[a][b][m][n] = (f32x4){0.f, 0.f, 0.f, 0.f};
        cur = nxt; cA = nA; cB = nB; ++ui;
        if constexpr (ALIGN_EPI) { if (wr == 1) PG8_BAR; }
    }
    PG8_WAIT_V(0);
    if constexpr (!ALIGN_EPI) { if (wr == 0) PG8_BAR; }
    PG8_BAR;
    if constexpr (Epi::AFTER_DRAIN) { E.fused(acc, cur, wr, wc, fr, fq, lds, wid, lane); S.done(cur); }
#undef PG8_SA
#undef PG8_SB
#undef PG8_STAGE
#undef PG8_LDA
#undef PG8_LDB
#undef PG8_MMA
#undef PG8_WAIT_V
#undef PG8_WAIT_L
#undef PG8_BAR
#undef PG8_SCHED
}
}

#ifndef MK_LAUNCH_PER_PHASE
#define MK_LAUNCH_PER_PHASE 0
#endif
constexpr int D = 1024, SEQ = 16384, CTXL = 256, MTOT = SEQ + CTXL, GW = 64, GROWS = SEQ / GW;
constexpr int DR = 512, NH = 8, HD = 64, PA = 1920, WINC = 4992, NPAD = 5120;
constexpr int NEXP = 32, DEXP = 512;
constexpr float NORM_EPS = 1e-6f, GN_EPS = 64e-5f;
constexpr int NPHASE = 12;

constexpr size_t MiB = 1u << 20;
constexpr size_t WS_CTL = 0, CTL_ZERO_BYTES = 1 * MiB;
constexpr size_t WS_MOD = 1 * MiB;
constexpr size_t WS_ROWINFO = WS_MOD + 64 * 1024;
constexpr size_t WS_ROWW = WS_MOD + 256 * 1024;
constexpr size_t WS_ROUTE = WS_MOD + 512 * 1024;
constexpr size_t WS_WIN = 2 * MiB;
constexpr size_t WS_WA = 12 * MiB, WS_WB = 13 * MiB, WS_WOUT = 14 * MiB;
constexpr size_t WS_H = 16 * MiB;
constexpr size_t WS_ZA = 49 * MiB;
constexpr size_t WS_ZB = 114 * MiB;
constexpr size_t WS_ZG = 146 * MiB;
constexpr size_t WS_YB = 210 * MiB;
constexpr size_t WS_YA = 226 * MiB;
constexpr size_t WS_Y = 242 * MiB;
constexpr size_t WS_END = 306 * MiB;
constexpr size_t WS_WGU = 49 * MiB;
constexpr size_t WS_WD = 113 * MiB;
constexpr size_t WS_XG = 145 * MiB;
constexpr size_t WS_HMID = 225 * MiB;
constexpr int MAXTILES = 160;
constexpr int CW_TMO = 0, CW_BAR = 4096, CW_CNT = 8192;

constexpr int RING_BYTES = 131072, MISC_OFF = RING_BYTES, TAB_OFF = MISC_OFF + 256, LDS_BYTES = 147456;

#define GAS __attribute__((address_space(1)))
#define LAS __attribute__((address_space(3)))
typedef unsigned short bf16;
typedef float f32x4 __attribute__((ext_vector_type(4)));
typedef unsigned u32x4 __attribute__((ext_vector_type(4)));
typedef unsigned u32x2 __attribute__((ext_vector_type(2)));
typedef short bf16x8 __attribute__((ext_vector_type(8)));
#define LDS_WAIT() asm volatile("s_waitcnt lgkmcnt(0)" ::: "memory")
#define VM_WAIT() asm volatile("s_waitcnt vmcnt(0)" ::: "memory")

__device__ __forceinline__ unsigned f2bf(float f) { unsigned u = __builtin_bit_cast(unsigned, f); return (u + 0x7fffu + ((u >> 16) & 1u)) >> 16; }
__device__ __forceinline__ unsigned pk2(float lo, float hi) { return f2bf(lo) | (f2bf(hi) << 16); }
__device__ __forceinline__ float bf2f(unsigned b) { return __builtin_bit_cast(float, b << 16); }
__device__ __forceinline__ float bflo(unsigned w) { return __builtin_bit_cast(float, w << 16); }
__device__ __forceinline__ float bfhi(unsigned w) { return __builtin_bit_cast(float, w & 0xffff0000u); }
__device__ __forceinline__ float sigmoidf_(float x) { return 1.0f / (1.0f + __expf(-x)); }
__device__ __forceinline__ float siluf_(float x) { return x / (1.0f + __expf(-x)); }
__device__ __forceinline__ float softplusf_(float x) { return fmaxf(x, 0.f) + log1pf(__expf(-fabsf(x))); }
__device__ __forceinline__ float gelu_tanh(float x) { const float u = 0.7978845608028654f * (x + 0.044715f * x * x * x); return 0.5f * x * (1.0f + tanhf(u)); }
__device__ __forceinline__ float wave_sum(float v) {
#pragma unroll
    for (int o = 1; o < 64; o <<= 1) v += __shfl_xor(v, o);
    return v;
}

#define XB_TMO      128
#define XB_XCNT(j)  (256  + 64 * (j))
#define XB_XSUB(j)  (1280 + 64 * (j))
#define XB_XGEN(j)  (2304 + 64 * (j))
#define XB_TOP      3328
#define XB_TOPGEN   3392
#define XCD_BAR_WORDS 3456
#define XB_SPIN_CAP (1u << 26)
#define LAS __attribute__((address_space(3)))

__device__ __forceinline__ unsigned xb_ld(unsigned* p)              { return __hip_atomic_load(p, __ATOMIC_RELAXED, __HIP_MEMORY_SCOPE_AGENT); }
__device__ __forceinline__ unsigned xb_add(unsigned* p, unsigned v) { return __hip_atomic_fetch_add(p, v, __ATOMIC_RELAXED, __HIP_MEMORY_SCOPE_AGENT); }
__device__ __forceinline__ unsigned xb_xcc_id() { return (unsigned)__builtin_amdgcn_s_getreg((3 << 11) | 20) & 0xFu; }
#define XB_SPIN(cond, bar) do { unsigned _sp = 0; while (cond) { __builtin_amdgcn_s_sleep(1); \
    if ((++_sp & 255u) == 0u) { if (xb_ld(&(bar)[XB_TMO])) break; if (_sp > XB_SPIN_CAP) { atomicAdd(&(bar)[XB_TMO], 1u); break; } } } } while (0)

struct XcdBarrier {
    unsigned* bar; unsigned x;
    volatile LAS unsigned* st;
};

__device__ __forceinline__ XcdBarrier xcd_barrier_post(unsigned* bar, volatile LAS unsigned* st) {
    XcdBarrier b; b.bar = bar; b.x = xb_xcc_id(); b.st = st;
    if (threadIdx.x == 0) (void)xb_add(&bar[XB_XCNT(b.x)], 1u);
    return b;
}
__device__ __forceinline__ void xcd_barrier_complete(unsigned* bar, unsigned x, unsigned& nloc, unsigned& nx) {
    const unsigned G = gridDim.x * gridDim.y * gridDim.z;
    unsigned sum, cnt, mine, sp = 0u;
    for (;;) {
        sum = 0u; cnt = 0u; mine = 0u;
#pragma unroll
        for (unsigned j = 0; j < 16; ++j) { const unsigned c = xb_ld(&bar[XB_XCNT(j)]); sum += c; cnt += (c > 0u) ? 1u : 0u; mine = (j == x) ? c : mine; }
        if (sum == G) break;
        __builtin_amdgcn_s_sleep(1);
        if ((++sp & 255u) == 0u) { if (xb_ld(&bar[XB_TMO])) break; if (sp > XB_SPIN_CAP) { atomicAdd(&bar[XB_TMO], 1u); break; } }
    }
    nloc = mine > 0u ? mine : 1u; nx = cnt > 0u ? cnt : 1u;
}

__device__ __forceinline__ void xcd_barrier(const XcdBarrier& b) {
    asm volatile("s_waitcnt vmcnt(0)" ::: "memory");
    __syncthreads();
    if (threadIdx.x == 0) {
        unsigned* bar = b.bar;
        __builtin_amdgcn_s_waitcnt(0);
        unsigned nloc = b.st[0], nx = b.st[1];
        if (nloc == 0u) { xcd_barrier_complete(bar, b.x, nloc, nx); b.st[0] = nloc; b.st[1] = nx; }
        const unsigned old = xb_add(&bar[XB_XSUB(b.x)], 1u);
        const unsigned gen = old / nloc;
        if (old + 1u == (gen + 1u) * nloc) {
            __builtin_amdgcn_fence(__ATOMIC_RELEASE, "agent");
            asm volatile("s_waitcnt vmcnt(0)" ::: "memory");
            const unsigned og = xb_add(&bar[XB_TOP], 1u);
            const unsigned tg = og / nx;
            if (og + 1u == (tg + 1u) * nx) xb_add(&bar[XB_TOPGEN], 1u);
            else XB_SPIN(xb_ld(&bar[XB_TOPGEN]) == tg, bar);
            __builtin_amdgcn_fence(__ATOMIC_ACQUIRE, "agent");
            xb_add(&bar[XB_XGEN(b.x)], 1u);
            asm volatile("s_waitcnt vmcnt(0)" ::: "memory");
        } else {
            XB_SPIN(xb_ld(&bar[XB_XGEN(b.x)]) == gen, bar);
            __builtin_amdgcn_fence(__ATOMIC_ACQUIRE, "agent");
            asm volatile("s_waitcnt vmcnt(0)" ::: "memory");
        }
    }
    __syncthreads();
}

struct Args { const float* in[35]; float* out; unsigned char* ws; int ph_lo, ph_hi; };

typedef const __attribute__((address_space(4))) unsigned char* kptr_t;
struct KArgs {
    kptr_t p;
    __device__ __forceinline__ const float* in(int i) const { return *(const float* const __attribute__((address_space(4)))*)(p + 8 * i); }
    __device__ __forceinline__ float* out() const { return *(float* const __attribute__((address_space(4)))*)(p + 280); }
    __device__ __forceinline__ unsigned char* ws() const { return *(unsigned char* const __attribute__((address_space(4)))*)(p + 288); }
};
#define FRESH_KA(name) KArgs name; { kptr_t q_ = (kptr_t)__builtin_amdgcn_kernarg_segment_ptr(); asm volatile("" : "+s"(q_)); name.p = q_; }
#define F_x (A.in(0))
#define F_c (A.in(1))
#define F_ctx (A.in(2))
#define F_cctx (A.in(3))
#define F_ada_w (A.in(4))
#define F_ada_b (A.in(5))
#define F_norm1_g (A.in(6))
#define F_norm2_g (A.in(7))
#define F_w_in (A.in(8))
#define F_mu (A.in(9))
#define F_w0 (A.in(10))
#define F_w_up (A.in(11))
#define F_a0 (A.in(12))
#define F_a_up (A.in(13))
#define F_g_up (A.in(14))
#define F_k_k (A.in(15))
#define F_k_a (A.in(16))
#define F_r_k (A.in(17))
#define F_ln_w (A.in(18))
#define F_ln_b (A.in(19))
#define F_w_ba (A.in(20))
#define F_sg_ln_w (A.in(21))
#define F_sg_ln_b (A.in(22))
#define F_sg_w (A.in(23))
#define F_sg_b (A.in(24))
#define F_w_bb (A.in(25))
#define F_w_out (A.in(26))
#define F_grp_w (A.in(27))
#define F_grp_b (A.in(28))
#define F_exp_w (A.in(29))
#define F_exp_b (A.in(30))
#define F_wg (A.in(31))
#define F_wu (A.in(32))
#define F_wd (A.in(33))
#define F_fin_g (A.in(34))
#define F_MOD ((float*)(A.ws() + WS_MOD))
#define F_rowinfo ((int*)(A.ws() + WS_ROWINFO))
#define F_roww ((float*)(A.ws() + WS_ROWW))
#define F_route ((unsigned*)(A.ws() + WS_ROUTE))
#define F_WinT ((bf16*)(A.ws() + WS_WIN))
#define F_WaT ((bf16*)(A.ws() + WS_WA))
#define F_WbT ((bf16*)(A.ws() + WS_WB))
#define F_WoutT ((bf16*)(A.ws() + WS_WOUT))
#define F_H ((bf16*)(A.ws() + WS_H))
#define F_ZA ((bf16*)(A.ws() + WS_ZA))
#define F_ZB ((bf16*)(A.ws() + WS_ZB))
#define F_ZG ((bf16*)(A.ws() + WS_ZG))
#define F_YB ((bf16*)(A.ws() + WS_YB))
#define F_YA ((bf16*)(A.ws() + WS_YA))
#define F_WguT ((bf16*)(A.ws() + WS_WGU))
#define F_WdT ((bf16*)(A.ws() + WS_WD))
#define F_XG ((bf16*)(A.ws() + WS_XG))
#define F_HMID ((bf16*)(A.ws() + WS_HMID))
#define F_YBUF ((bf16*)(A.ws() + WS_XG))
#define F_MG ((bf16*)(A.ws() + WS_ZB))
#define F_Y ((float*)(A.ws() + WS_Y))
#define F_out (A.out())
struct Frame {
    LAS unsigned char* lds;
    unsigned* ctl;
    unsigned char* ws;
    const float* const* in;
    int tid, lane, wave, G;
};


__device__ __forceinline__ void static_tile(int wgid, int nM, int nN, pg8::Unit& u) {
    const int nwg = nM * nN;
    { const int q = nwg / 8, r = nwg % 8, xcd = wgid % 8, off = wgid / 8; wgid = (xcd < r ? xcd * (q + 1) : r * (q + 1) + (xcd - r) * q) + off; }
    const int nig = 8 * nN, gid = wgid / nig, fm = gid * 8, gsz = (nM - fm) < 8 ? (nM - fm) : 8;
    u.pm = fm + ((wgid % nig) % gsz); u.pn = (wgid % nig) / gsz;
}

__device__ __forceinline__ void transpose_item(const float* W, int K, int N, int k0, int n0, bf16* WT, int dst_row0, LAS float* scr, int lane) {
#pragma unroll 8
    for (int i = 0; i < 32; ++i) { const int kk = 2 * i + (lane >> 5); scr[kk * 33 + (lane & 31)] = W[(size_t)(k0 + kk) * N + n0 + (lane & 31)]; }
    LDS_WAIT(); asm volatile("" ::: "memory");
    const int c = lane & 7;
#pragma unroll
    for (int j = 0; j < 4; ++j) { const int n = (lane >> 3) + 8 * j; const LAS float* s = scr + (8 * c) * 33 + n;
        u32x4 o; o.x = pk2(s[0 * 33], s[1 * 33]); o.y = pk2(s[2 * 33], s[3 * 33]); o.z = pk2(s[4 * 33], s[5 * 33]); o.w = pk2(s[6 * 33], s[7 * 33]);
        *(u32x4*)(WT + (size_t)(dst_row0 + n) * K + k0 + 8 * c) = o; }
    LDS_WAIT(); asm volatile("" ::: "memory");
}

__device__ __forceinline__ void p0_prologue(Frame& F, const KArgs& A) {
    {
        LAS float* red = (LAS float*)F.lds;
        const int cl = F.tid & 31, kg = F.tid >> 5;
        for (int cb = blockIdx.x; cb < 256; cb += F.G) {
            const int col = cb * 24 + cl; float a0 = 0.f, a1 = 0.f;
            if (cl < 24) for (int k = kg; k < D; k += 16) { const float w = F_ada_w[(size_t)k * 6144 + col]; a0 += siluf_(F_c[k]) * w; a1 += siluf_(F_cctx[k]) * w; }
            red[(kg * 32 + cl) * 2] = a0; red[(kg * 32 + cl) * 2 + 1] = a1;
            __syncthreads();
            if (F.tid < 48) { const int cc = F.tid % 24, i = F.tid / 24; float s = 0.f; for (int g = 0; g < 16; ++g) s += red[(g * 32 + cc) * 2 + i]; F_MOD[i * 6144 + cb * 24 + cc] = s + F_ada_b[cb * 24 + cc]; }
            __syncthreads();
        }
    }
    LAS float* scr = (LAS float*)(F.lds + F.wave * 16384);
    const int gw = blockIdx.x * 8 + F.wave, NGW = F.G * 8;
    constexpr int I_IN = 16 * 156, I_A = 8 * 32, I_B = 8 * 32, I_O = 16 * 32, NIT = I_IN + I_A + I_B + I_O;
    for (int it = gw; it < NIT; it += NGW) {
        int r = it;
        if (r < I_IN) { const int kb = r / 156, nb = r % 156, n0 = 32 * nb; transpose_item(F_w_in, D, WINC, 64 * kb, n0, F_WinT, n0 + (n0 >= PA ? 128 : 0), scr, F.lane); continue; } r -= I_IN;
        if (r < I_A) { const int kb = r / 32, nb = r % 32; transpose_item(F_w_ba, DR, D, 64 * kb, 32 * nb, F_WaT, 32 * nb, scr, F.lane); continue; } r -= I_A;
        if (r < I_B) { const int kb = r / 32, nb = r % 32; transpose_item(F_w_bb, DR, D, 64 * kb, 32 * nb, F_WbT, 32 * nb, scr, F.lane); continue; } r -= I_B;
        { const int kb = r / 32, nb = r % 32; transpose_item(F_w_out, D, D, 64 * kb, 32 * nb, F_WoutT, 32 * nb, scr, F.lane); }
    }
    for (int i = blockIdx.x * 512 + F.tid; i < 16384; i += F.G * 512) ((u32x4*)(F_WinT + (size_t)PA * D))[i] = (u32x4){0u, 0u, 0u, 0u};
}

__device__ __forceinline__ void norm_row_bf16(const float* src, const float* g, const float* sh, const float* sc, bf16* dst, int lane) {
    f32x4 v[4]; float ss = 0.f;
#pragma unroll
    for (int j = 0; j < 4; ++j) { v[j] = ((const f32x4*)src)[lane + 64 * j]; ss += (v[j].x * v[j].x + v[j].y * v[j].y) + (v[j].z * v[j].z + v[j].w * v[j].w); }
    const float rinv = rsqrtf(wave_sum(ss) * (1.0f / D) + NORM_EPS);
#pragma unroll
    for (int j = 0; j < 4; ++j) {
        const f32x4 gg = ((const f32x4*)g)[lane + 64 * j], s1 = ((const f32x4*)sc)[lane + 64 * j], s0 = ((const f32x4*)sh)[lane + 64 * j];
        const f32x4 hv = (v[j] * rinv * gg) * (1.0f + s1) + s0;
        u32x2 o; o.x = pk2(hv.x, hv.y); o.y = pk2(hv.z, hv.w);
        ((u32x2*)dst)[lane + 64 * j] = o;
    }
}
__device__ __forceinline__ void p1_norm1(Frame& F, const KArgs& A) {
    const int gw = blockIdx.x * 8 + F.wave, NGW = F.G * 8;
    for (int row = gw; row < MTOT; row += NGW) {
        const bool isctx = row >= SEQ;
        const float* src = isctx ? F_ctx + (size_t)(row - SEQ) * D : F_x + (size_t)row * D;
        const float* mod = F_MOD + (isctx ? 6144 : 0);
        norm_row_bf16(src, F_norm1_g, mod, mod + 1024, F_H + (size_t)row * D, F.lane);
    }
}

struct Sched1 {
    int G, c;
    __device__ __forceinline__ bool next(int i, pg8::Unit& u) const {
        long L = (long)i * G + c; if (L < 8) { u.pm = 64; u.pn = (int)L; return true; }
        L -= 8; if (L >= 1280) return false; static_tile((int)L, 64, 20, u); return true;
    }
    __device__ __forceinline__ void a_ready(const pg8::Unit&) const {}
    __device__ __forceinline__ void done(const pg8::Unit&) const {}
};
struct EpiZ {
    static constexpr bool PERM = true, AFTER_DRAIN = false;
    bf16 *ZA, *ZB, *ZG;
    __device__ __forceinline__ void operator()(const pg8::f32x4 (&acc)[2][2][4][2], const pg8::Unit& u, int wr, int wc, int fr, int fq) const {
        const int row0 = u.pm * 256 + wr * 64 + fr;
        bf16* base; int ld, colt;
        if (u.pn < 8) { base = ZA; ld = 2048; colt = u.pn * 256; } else if (u.pn < 12) { base = ZB; ld = 1024; colt = (u.pn - 8) * 256; } else { base = ZG; ld = 2048; colt = (u.pn - 12) * 256; }
        const int col0 = colt + wc * 32 + 8 * fq;
#pragma unroll
        for (int ai = 0; ai < 2; ++ai)
#pragma unroll
            for (int m = 0; m < 4; ++m) { bf16* rowp = base + (size_t)(row0 + ai * 128 + m * 16) * ld + col0;
#pragma unroll
                for (int bj = 0; bj < 2; ++bj) { const pg8::f32x4 v0 = acc[ai][bj][m][0], v1 = acc[ai][bj][m][1];
                    u32x4 w; w.x = pg8::cvt_pk_bf16(v0[0], v0[1]); w.y = pg8::cvt_pk_bf16(v0[2], v0[3]); w.z = pg8::cvt_pk_bf16(v1[0], v1[1]); w.w = pg8::cvt_pk_bf16(v1[2], v1[3]);
                    *(u32x4*)(rowp + bj * 128) = w; } }
    }
};

__device__ __forceinline__ float mixed_val(const bf16* ZA, bool isctx, int t, int col, float mu) {
    const int row = isctx ? SEQ + t : t;
    const bf16* Z = ZA + (size_t)row * 2048;
    int dr; bool ok;
    if (isctx) { const bool ev = (col & 1) == 0; dr = ev ? -1 : 1; ok = ev ? (t > 0) : (t < CTXL - 1); }
    else { const int s = col & 3, gx = t & 63, gy = t >> 6;
        dr = (s == 0) ? -1 : (s == 1) ? 1 : (s == 2) ? -64 : 64;
        ok = (s == 0) ? (gx > 0) : (s == 1) ? (gx < 63) : (s == 2) ? (gy > 0) : (gy < GROWS - 1); }
    const int dsafe = ok ? dr : 0;
    const float z = bf2f(Z[col]);
    const float nbv = bf2f(Z[col + dsafe * 2048]);
    const float nb = ok ? nbv : 0.f;
    return z + mu * (nb - z);
}
__device__ __forceinline__ void mixed8(const bf16* ZA, int t, int col0, const float* mu, float (&o)[8]) {
    const bf16* Z = ZA + (size_t)t * 2048 + col0;
    const int gx = t & 63, gy = t >> 6;
    const u32x4 z = *(const u32x4*)Z;
    const u32x4 zero = (u32x4){0u, 0u, 0u, 0u};
    const u32x4 l = gx > 0 ? *(const u32x4*)(Z - 2048) : zero, r = gx < 63 ? *(const u32x4*)(Z + 2048) : zero;
    const u32x4 up = gy > 0 ? *(const u32x4*)(Z - 64 * 2048) : zero, dn = gy < GROWS - 1 ? *(const u32x4*)(Z + 64 * 2048) : zero;
    const f32x4 m0 = *(const f32x4*)(mu + col0), m1 = *(const f32x4*)(mu + col0 + 4);
    float zz[8], nn[8];
    zz[0] = bflo(z.x); zz[1] = bfhi(z.x); zz[2] = bflo(z.y); zz[3] = bfhi(z.y); zz[4] = bflo(z.z); zz[5] = bfhi(z.z); zz[6] = bflo(z.w); zz[7] = bfhi(z.w);
    nn[0] = bflo(l.x); nn[1] = bfhi(r.x); nn[2] = bflo(up.y); nn[3] = bfhi(dn.y); nn[4] = bflo(l.z); nn[5] = bfhi(r.z); nn[6] = bflo(up.w); nn[7] = bfhi(dn.w);
    const float mm[8] = {m0.x, m0.y, m0.z, m0.w, m1.x, m1.y, m1.z, m1.w};
#pragma unroll
    for (int i = 0; i < 8; ++i) o[i] = zz[i] + mm[i] * (nn[i] - zz[i]);
}

__device__ __forceinline__ void p3_scan_naive(Frame& F, const KArgs& A, int chain) {
    const int d = chain >> 3, h = chain & 7, j = F.lane, c = h * 64 + j, w = F.wave;
    float wup[64], aup[64];
#pragma unroll
    for (int r = 0; r < 64; ++r) { wup[r] = F_w_up[(size_t)(d * 64 + r) * DR + c]; aup[r] = F_a_up[(size_t)(d * 64 + r) * DR + c]; }
    const float w0 = F_w0[d * DR + c], a0 = F_a0[d * DR + c], kkc = F_k_k[c], kac = F_k_a[c];
    const int col_w = 1536 + d * 64 + j, col_a = 1664 + d * 64 + j;
    const float mu_r = F_mu[c], mu_k = F_mu[512 + c], mu_v = F_mu[1024 + c], mu_w = F_mu[col_w], mu_a = F_mu[col_a];
    float S[8];
#pragma unroll
    for (int i = 0; i < 8; ++i) S[i] = 0.f;
    float* Yd = F_Y + (size_t)d * SEQ * DR;
    const int NSTEP = CTXL + SEQ;
    float nr, nk, nv, nwd, nad;
    { const bool ic = true; const int t = d ? CTXL - 1 : 0;
      nr = mixed_val(F_ZA, ic, t, c, mu_r); nk = mixed_val(F_ZA, ic, t, 512 + c, mu_k); nv = mixed_val(F_ZA, ic, t, 1024 + c, mu_v); nwd = mixed_val(F_ZA, ic, t, col_w, mu_w); nad = mixed_val(F_ZA, ic, t, col_a, mu_a); }
    for (int step = 0; step < NSTEP; ++step) {
        const bool isctx = step < CTXL;
        const int t = isctx ? (d ? CTXL - 1 - step : step) : (d ? SEQ - 1 - (step - CTXL) : step - CTXL);
        const float r = nr, k = nk, v = nv, wd = nwd, ad = nad;
        if (step + 1 < NSTEP) { const int s2 = step + 1; const bool ic = s2 < CTXL; const int t2 = ic ? (d ? CTXL - 1 - s2 : s2) : (d ? SEQ - 1 - (s2 - CTXL) : s2 - CTXL);
            nr = mixed_val(F_ZA, ic, t2, c, mu_r); nk = mixed_val(F_ZA, ic, t2, 512 + c, mu_k); nv = mixed_val(F_ZA, ic, t2, 1024 + c, mu_v); nwd = mixed_val(F_ZA, ic, t2, col_w, mu_w); nad = mixed_val(F_ZA, ic, t2, col_a, mu_a); }
        const float twd = tanhf(wd);
        float wl = w0, al = a0;
#pragma unroll
        for (int rr = 0; rr < 64; ++rr) { const float tw = __builtin_bit_cast(float, __builtin_amdgcn_readlane(__builtin_bit_cast(int, twd), rr)); const float ta = __builtin_bit_cast(float, __builtin_amdgcn_readlane(__builtin_bit_cast(int, ad), rr));
            wl += tw * wup[rr]; al += ta * aup[rr]; }
        const float wv = -softplusf_(-wl) - 0.5f, dec = __expf(-__expf(wv)), a = sigmoidf_(al);
        float kk = k * kkc; const float n2 = wave_sum(kk * kk); kk = kk / fmaxf(sqrtf(n2), 1e-12f);
        const float kd = k * (1.0f + (a - 1.0f) * kac), kka = kk * a;
        float yv = 0.f;
#pragma unroll
        for (int i = 0; i < 8; ++i) {
            const float sa = wave_sum(S[i] * kk);
            const float vi = __builtin_bit_cast(float, __builtin_amdgcn_readlane(__builtin_bit_cast(int, v), 8 * w + i));
            S[i] = S[i] * dec - sa * kka + vi * kd;
            const float y = wave_sum(S[i] * r);
            yv = (j == i) ? y : yv;
        }
        if (!isctx && j < 8) Yd[(size_t)t * DR + h * 64 + 8 * w + j] = yv;
    }
}

constexpr int MB_LD = 136;
__device__ __forceinline__ void p3_mixer_b(Frame& F, const KArgs& A, int chunk) {
    LAS float* stats = (LAS float*)F.lds;
    LAS bf16* Wl = (LAS bf16*)(F.lds + 1024);
    LAS bf16* VT = (LAS bf16*)(F.lds + 1024 + 128 * MB_LD * 2);
    const int tok0 = chunk * 128, lane = F.lane, w = F.wave;
    for (int rr = 0; rr < 16; ++rr) {
        const int q = w * 16 + rr;
        const u32x4 raw = *(const u32x4*)(F_ZB + (size_t)(tok0 + q) * 1024 + 512 + 8 * lane);
        float g[8]; g[0] = gelu_tanh(bflo(raw.x)); g[1] = gelu_tanh(bfhi(raw.x)); g[2] = gelu_tanh(bflo(raw.y)); g[3] = gelu_tanh(bfhi(raw.y));
        g[4] = gelu_tanh(bflo(raw.z)); g[5] = gelu_tanh(bfhi(raw.z)); g[6] = gelu_tanh(bflo(raw.w)); g[7] = gelu_tanh(bfhi(raw.w));
        float s = 0.f;
#pragma unroll
        for (int i = 0; i < 8; ++i) s += g[i];
        const float mean = wave_sum(s) * (1.0f / 512.0f); float s2 = 0.f;
#pragma unroll
        for (int i = 0; i < 8; ++i) { const float dlt = g[i] - mean; s2 += dlt * dlt; }
        const float rstd = rsqrtf(wave_sum(s2) * (1.0f / 512.0f) + 1e-5f);
        if (lane == 0) { stats[q * 2] = mean; stats[q * 2 + 1] = rstd; }
    }
    __syncthreads();
    for (int g = 0; g < 4; ++g) {
        for (int i = F.tid; i < 128 * 32; i += 512) { const int p = i >> 5, q4 = (i & 31) * 4; const f32x4 wv = *(const f32x4*)(F_sg_w + (size_t)(g * 128 + p) * 128 + q4);
            u32x2 o; o.x = pk2(wv.x, wv.y); o.y = pk2(wv.z, wv.w); *(LAS u32x2*)(Wl + p * MB_LD + q4) = o; }
        for (int rr = 0; rr < 16; ++rr) {
            const int q = w * 16 + rr; const float mean = stats[q * 2], rstd = stats[q * 2 + 1];
            const unsigned raw = *(const unsigned*)(F_ZB + (size_t)(tok0 + q) * 1024 + 512 + g * 128 + 2 * lane);
            const int c0 = 2 * lane;
            const float v0 = (gelu_tanh(bflo(raw)) - mean) * rstd * F_sg_ln_w[g * 128 + c0] + F_sg_ln_b[g * 128 + c0];
            const float v1 = (gelu_tanh(bfhi(raw)) - mean) * rstd * F_sg_ln_w[g * 128 + c0 + 1] + F_sg_ln_b[g * 128 + c0 + 1];
            VT[c0 * MB_LD + q] = (bf16)f2bf(v0); VT[(c0 + 1) * MB_LD + q] = (bf16)f2bf(v1);
        }
        __syncthreads();
        const int fr = lane & 15, fq = lane >> 4;
        pg8::f32x4 acc[8];
#pragma unroll
        for (int ct = 0; ct < 8; ++ct) acc[ct] = (pg8::f32x4){0.f, 0.f, 0.f, 0.f};
#pragma unroll
        for (int ks = 0; ks < 4; ++ks) {
            const bf16x8 bfrag = *(const LAS bf16x8*)(Wl + (16 * w + fr) * MB_LD + 32 * ks + 8 * fq);
#pragma unroll
            for (int ct = 0; ct < 8; ++ct) { const bf16x8 afrag = *(const LAS bf16x8*)(VT + (16 * ct + fr) * MB_LD + 32 * ks + 8 * fq);
                acc[ct] = __builtin_amdgcn_mfma_f32_16x16x32_bf16(afrag, bfrag, acc[ct], 0, 0, 0); }
        }
        const int p = 16 * w + fr; const float sb = F_sg_b[g * 128 + p];
#pragma unroll
        for (int ct = 0; ct < 8; ++ct) {
            const int c0 = 16 * ct + 4 * fq;
            const u32x2 uraw = *(const u32x2*)(F_ZB + (size_t)(tok0 + p) * 1024 + g * 128 + c0);
            const float u0 = gelu_tanh(bflo(uraw.x)), u1 = gelu_tanh(bfhi(uraw.x)), u2 = gelu_tanh(bflo(uraw.y)), u3 = gelu_tanh(bfhi(uraw.y));
            u32x2 o; o.x = pk2(u0 * (acc[ct][0] + sb), u1 * (acc[ct][1] + sb)); o.y = pk2(u2 * (acc[ct][2] + sb), u3 * (acc[ct][3] + sb));
            *(u32x2*)(F_YB + (size_t)(tok0 + p) * DR + g * 128 + c0) = o;
        }
        __syncthreads();
    }
}

__device__ __forceinline__ void p4_rwkv_out(Frame& F, const KArgs& A) {
    const int gw = blockIdx.x * 8 + F.wave, NGW = F.G * 8, l = F.lane, h = l >> 3;
    for (int t = gw; t < SEQ; t += NGW) {
        float y[8];
        { const f32x4 a0 = *(const f32x4*)(F_Y + (size_t)t * DR + 8 * l), a1 = *(const f32x4*)(F_Y + (size_t)t * DR + 8 * l + 4);
          const f32x4 b0 = *(const f32x4*)(F_Y + (size_t)(SEQ + t) * DR + 8 * l), b1 = *(const f32x4*)(F_Y + (size_t)(SEQ + t) * DR + 8 * l + 4);
          y[0] = a0.x + b0.x; y[1] = a0.y + b0.y; y[2] = a0.z + b0.z; y[3] = a0.w + b0.w; y[4] = a1.x + b1.x; y[5] = a1.y + b1.y; y[6] = a1.z + b1.z; y[7] = a1.w + b1.w; }
        float s = 0.f;
#pragma unroll
        for (int i = 0; i < 8; ++i) s += y[i];
        s += __shfl_xor(s, 1); s += __shfl_xor(s, 2); s += __shfl_xor(s, 4);
        const float mean = s * (1.0f / 64.0f); float s2 = 0.f;
#pragma unroll
        for (int i = 0; i < 8; ++i) { const float dlt = y[i] - mean; s2 += dlt * dlt; }
        s2 += __shfl_xor(s2, 1); s2 += __shfl_xor(s2, 2); s2 += __shfl_xor(s2, 4);
        const float rstd = rsqrtf(s2 * (1.0f / 64.0f) + GN_EPS);
        float r[8], k[8], v[8];
        mixed8(F_ZA, t, 8 * l, F_mu, r); mixed8(F_ZA, t, 512 + 8 * l, F_mu, k); mixed8(F_ZA, t, 1024 + 8 * l, F_mu, v);
        float dp = 0.f;
#pragma unroll
        for (int i = 0; i < 8; ++i) dp += r[i] * k[i] * F_r_k[8 * l + i];
        dp += __shfl_xor(dp, 1); dp += __shfl_xor(dp, 2); dp += __shfl_xor(dp, 4);
        const float sg0 = sigmoidf_(mixed_val(F_ZA, false, t, 1792 + 2 * l, F_mu[1792 + 2 * l])), sg1 = sigmoidf_(mixed_val(F_ZA, false, t, 1793 + 2 * l, F_mu[1793 + 2 * l]));
        float g[8];
#pragma unroll
        for (int i = 0; i < 8; ++i) g[i] = 0.f;
        for (int rr = 0; rr < 64; ++rr) {
            const float s0 = __shfl(sg0, rr), s1 = __shfl(sg1, rr);
            const f32x4 u0 = *(const f32x4*)(F_g_up + (size_t)(2 * rr) * DR + 8 * l), u1 = *(const f32x4*)(F_g_up + (size_t)(2 * rr) * DR + 8 * l + 4);
            const f32x4 w0 = *(const f32x4*)(F_g_up + (size_t)(2 * rr + 1) * DR + 8 * l), w1 = *(const f32x4*)(F_g_up + (size_t)(2 * rr + 1) * DR + 8 * l + 4);
            g[0] += s0 * u0.x + s1 * w0.x; g[1] += s0 * u0.y + s1 * w0.y; g[2] += s0 * u0.z + s1 * w0.z; g[3] += s0 * u0.w + s1 * w0.w;
            g[4] += s0 * u1.x + s1 * w1.x; g[5] += s0 * u1.y + s1 * w1.y; g[6] += s0 * u1.z + s1 * w1.z; g[7] += s0 * u1.w + s1 * w1.w;
        }
        float o[8];
#pragma unroll
        for (int i = 0; i < 8; ++i) { const float yn = (y[i] - mean) * rstd * F_ln_w[8 * l + i] + F_ln_b[8 * l + i]; o[i] = (yn + dp * v[i]) * g[i]; }
        u32x4 pk; pk.x = pk2(o[0], o[1]); pk.y = pk2(o[2], o[3]); pk.z = pk2(o[4], o[5]); pk.w = pk2(o[6], o[7]);
        *(u32x4*)(F_YA + (size_t)t * DR + 8 * l) = pk;
        (void)h;
    }
}

struct SchedStd {
    int nM, nN, G, c;
    __device__ __forceinline__ bool next(int i, pg8::Unit& u) const { const long L = (long)i * G + c; if (L >= (long)nM * nN) return false; static_tile((int)L, nM, nN, u); return true; }
    __device__ __forceinline__ void a_ready(const pg8::Unit&) const {}
    __device__ __forceinline__ void done(const pg8::Unit&) const {}
};
__device__ __forceinline__ void sig8(const bf16* p, float (&o)[8]) {
    const u32x4 raw = *(const u32x4*)p;
    o[0] = sigmoidf_(bflo(raw.x)); o[1] = sigmoidf_(bfhi(raw.x)); o[2] = sigmoidf_(bflo(raw.y)); o[3] = sigmoidf_(bfhi(raw.y));
    o[4] = sigmoidf_(bflo(raw.z)); o[5] = sigmoidf_(bfhi(raw.z)); o[6] = sigmoidf_(bflo(raw.w)); o[7] = sigmoidf_(bfhi(raw.w));
}
struct EpiMergeA {
    static constexpr bool PERM = true, AFTER_DRAIN = false;
    float* T; const bf16* ZG;
    __device__ __forceinline__ void operator()(const pg8::f32x4 (&acc)[2][2][4][2], const pg8::Unit& u, int wr, int wc, int fr, int fq) const {
        const int row0 = u.pm * 256 + wr * 64 + fr, col0 = u.pn * 256 + wc * 32 + 8 * fq;
#pragma unroll
        for (int ai = 0; ai < 2; ++ai)
#pragma unroll
            for (int m = 0; m < 4; ++m) { const size_t row = (size_t)(row0 + ai * 128 + m * 16);
#pragma unroll
                for (int bj = 0; bj < 2; ++bj) { const int col = col0 + bj * 128; float gt[8]; sig8(ZG + row * 2048 + col, gt);
                    const pg8::f32x4 v0 = acc[ai][bj][m][0], v1 = acc[ai][bj][m][1];
                    *(f32x4*)(T + row * D + col) = (f32x4){gt[0] * v0[0], gt[1] * v0[1], gt[2] * v0[2], gt[3] * v0[3]};
                    *(f32x4*)(T + row * D + col + 4) = (f32x4){gt[4] * v1[0], gt[5] * v1[1], gt[6] * v1[2], gt[7] * v1[3]}; } }
    }
};
struct EpiMergeB {
    static constexpr bool PERM = true, AFTER_DRAIN = false;
    const float* T; const bf16* ZG; bf16* MG;
    __device__ __forceinline__ void operator()(const pg8::f32x4 (&acc)[2][2][4][2], const pg8::Unit& u, int wr, int wc, int fr, int fq) const {
        const int row0 = u.pm * 256 + wr * 64 + fr, col0 = u.pn * 256 + wc * 32 + 8 * fq;
#pragma unroll
        for (int ai = 0; ai < 2; ++ai)
#pragma unroll
            for (int m = 0; m < 4; ++m) { const size_t row = (size_t)(row0 + ai * 128 + m * 16);
#pragma unroll
                for (int bj = 0; bj < 2; ++bj) { const int col = col0 + bj * 128; float gt[8]; sig8(ZG + row * 2048 + 1024 + col, gt);
                    const pg8::f32x4 v0 = acc[ai][bj][m][0], v1 = acc[ai][bj][m][1];
                    const f32x4 t0 = *(const f32x4*)(T + row * D + col), t1 = *(const f32x4*)(T + row * D + col + 4);
                    u32x4 w; w.x = pk2(t0.x + gt[0] * v0[0], t0.y + gt[1] * v0[1]); w.y = pk2(t0.z + gt[2] * v0[2], t0.w + gt[3] * v0[3]);
                    w.z = pk2(t1.x + gt[4] * v1[0], t1.y + gt[5] * v1[1]); w.w = pk2(t1.z + gt[6] * v1[2], t1.w + gt[7] * v1[3]);
                    *(u32x4*)(MG + row * D + col) = w; } }
    }
};
struct EpiX1 {
    static constexpr bool PERM = false, AFTER_DRAIN = false;
    const float* x; const float* gt1; float* out;
    __device__ __forceinline__ void operator()(const pg8::f32x4 (&acc)[2][2][4][2], const pg8::Unit& u, int wr, int wc, int fr, int fq) const {
        const int row0 = u.pm * 256 + wr * 64 + fr, col0 = u.pn * 256 + wc * 32 + 4 * fq;
#pragma unroll
        for (int ai = 0; ai < 2; ++ai)
#pragma unroll
            for (int m = 0; m < 4; ++m) { const size_t row = (size_t)(row0 + ai * 128 + m * 16);
#pragma unroll
                for (int bj = 0; bj < 2; ++bj)
#pragma unroll
                    for (int n = 0; n < 2; ++n) { const int col = col0 + bj * 128 + n * 16;
                        const f32x4 xv = *(const f32x4*)(x + row * D + col), gv = *(const f32x4*)(gt1 + col); const pg8::f32x4 a = acc[ai][bj][m][n];
                        *(f32x4*)(out + row * D + col) = (f32x4){xv.x + gv.x * a[0], xv.y + gv.y * a[1], xv.z + gv.z * a[2], xv.w + gv.w * a[3]}; } }
    }
};

__device__ __forceinline__ void p7_router(Frame& F, const KArgs& A) {
    const int gw = blockIdx.x * 8 + F.wave, NGW = F.G * 8, lane = F.lane;
    const float* mod = F_MOD;
    for (int t = gw; t < SEQ; t += NGW) {
        const float* src = F_out + (size_t)t * D;
        float ss = 0.f;
#pragma unroll
        for (int j = 0; j < 4; ++j) { const f32x4 vv = ((const f32x4*)src)[lane + 64 * j]; ss += (vv.x * vv.x + vv.y * vv.y) + (vv.z * vv.z + vv.w * vv.w); }
        const float rinv = rsqrtf(wave_sum(ss) * (1.0f / D) + NORM_EPS);
        float lg[36];
#pragma unroll
        for (int e = 0; e < 36; ++e) lg[e] = 0.f;
#pragma unroll 1
        for (int j = 0; j < 4; ++j) {
            const f32x4 vv = ((const f32x4*)src)[lane + 64 * j];
            const f32x4 gg = ((const f32x4*)F_norm2_g)[lane + 64 * j], s1 = ((const f32x4*)(mod + 4096))[lane + 64 * j], s0 = ((const f32x4*)(mod + 3072))[lane + 64 * j];
            const f32x4 hv = (vv * rinv * gg) * (1.0f + s1) + s0;
            u32x2 o; o.x = pk2(hv.x, hv.y); o.y = pk2(hv.z, hv.w);
            ((u32x2*)(F_H + (size_t)t * D))[lane + 64 * j] = o;
            const int k0 = (lane + 64 * j) * 4;
#pragma unroll 1
            for (int i = 0; i < 4; ++i) {
                const float hh = (i == 0) ? hv.x : (i == 1) ? hv.y : (i == 2) ? hv.z : hv.w;
                const f32x4 gwv = *(const f32x4*)(F_grp_w + (size_t)(k0 + i) * 4);
                lg[0] += hh * gwv.x; lg[1] += hh * gwv.y; lg[2] += hh * gwv.z; lg[3] += hh * gwv.w;
#pragma unroll
                for (int q = 0; q < 8; ++q) { const f32x4 ew = *(const f32x4*)(F_exp_w + (size_t)(k0 + i) * 32 + 4 * q);
                    lg[4 + 4 * q] += hh * ew.x; lg[5 + 4 * q] += hh * ew.y; lg[6 + 4 * q] += hh * ew.z; lg[7 + 4 * q] += hh * ew.w; }
            }
        }
#pragma unroll
        for (int e = 0; e < 36; ++e) lg[e] = wave_sum(lg[e]);
        if (lane == 0) {
            float gl[4]; int grp = 0;
#pragma unroll
            for (int q = 0; q < 4; ++q) gl[q] = lg[q] + F_grp_b[q];
#pragma unroll
            for (int q = 1; q < 4; ++q) if (gl[q] > gl[grp]) grp = q;
            float den = 0.f;
#pragma unroll
            for (int q = 0; q < 4; ++q) den += __expf(gl[q] - gl[grp]);
            const float pg = 1.0f / den;
            float el[8];
#pragma unroll
            for (int q = 0; q < 8; ++q) { float val = 0.f;
#pragma unroll
                for (int gq = 0; gq < 4; ++gq) val = (grp == gq) ? lg[4 + gq * 8 + q] + F_exp_b[gq * 8 + q] : val;
                el[q] = val; }
            int i1 = 0;
#pragma unroll
            for (int q = 1; q < 8; ++q) if (el[q] > el[i1]) i1 = q;
            int i2 = (i1 == 0) ? 1 : 0;
#pragma unroll
            for (int q = 0; q < 8; ++q) if (q != i1 && el[q] > el[i2]) i2 = q;
            const float v1 = el[i1], v2 = el[i2];
            const float e2 = __expf(v2 - v1), w1 = pg / (1.0f + e2), w2 = pg * e2 / (1.0f + e2);
            const int e1x = grp * 8 + i1, e2x = grp * 8 + i2;
            const unsigned p1 = atomicAdd(F.ctl + CW_CNT + 64 * e1x, 1u), p2 = atomicAdd(F.ctl + CW_CNT + 64 * e2x, 1u);
            unsigned* rt = F_route + (size_t)t * 8;
            rt[0] = (unsigned)e1x; rt[1] = p1; rt[2] = __builtin_bit_cast(unsigned, w1); rt[3] = (unsigned)e2x; rt[4] = p2; rt[5] = __builtin_bit_cast(unsigned, w2);
        }
    }
    LAS float* scr = (LAS float*)(F.lds + F.wave * 16384);
    for (int it = gw; it < NEXP * 768; it += NGW) {
        const int e = it / 768; int r = it % 768;
        if (r < 512) { const bool up = r >= 256; r &= 255; const int kb = r / 16, nb = r % 16, n0 = 32 * nb;
            const float* W = (up ? F_wu : F_wg) + (size_t)e * D * DEXP;
            transpose_item(W, D, DEXP, 64 * kb, n0, F_WguT + (size_t)e * 1024 * D, 256 * (n0 >> 7) + (up ? 128 : 0) + (n0 & 127), scr, lane);
        } else { r -= 512; const int kb = r / 32, nb = r % 32;
            transpose_item(F_wd + (size_t)e * DEXP * D, DEXP, D, 64 * kb, 32 * nb, F_WdT + (size_t)e * 1024 * DEXP, 32 * nb, scr, lane); }
    }
}

__device__ __forceinline__ int moe_tables(Frame& F, const KArgs& A) {
    LAS int* tab = (LAS int*)(F.lds + TAB_OFF);
    __syncthreads();
    if (F.tid == 0) {
        int off = 0;
        for (int e = 0; e < NEXP; ++e) { const int cnt = (int)__hip_atomic_load(F.ctl + CW_CNT + 64 * e, __ATOMIC_RELAXED, __HIP_MEMORY_SCOPE_AGENT); const int nt = (cnt + 255) >> 8;
            tab[e] = off * 256; tab[64 + e] = cnt; for (int q = 0; q < nt && off + q < MAXTILES; ++q) tab[128 + off + q] = e; off += nt; }
        tab[32] = off < MAXTILES ? off : MAXTILES;
    }
    __syncthreads();
    return tab[32];
}

__device__ __forceinline__ void p8_gather(Frame& F, const KArgs& A) {
    const int ntiles = moe_tables(F, A);
    LAS int* tab = (LAS int*)(F.lds + TAB_OFF);
    const int gw = blockIdx.x * 8 + F.wave, NGW = F.G * 8, lane = F.lane;
    for (int t = gw; t < SEQ; t += NGW) {
        const unsigned* rt = F_route + (size_t)t * 8;
        const u32x4 h0 = ((const u32x4*)(F_H + (size_t)t * D))[lane], h1 = ((const u32x4*)(F_H + (size_t)t * D))[lane + 64];
#pragma unroll
        for (int s = 0; s < 2; ++s) {
            const int e = (int)rt[3 * s], pos = (int)rt[3 * s + 1]; const int row = tab[e] + pos;
            if (row < MAXTILES * 256) {
                ((u32x4*)(F_XG + (size_t)row * D))[lane] = h0; ((u32x4*)(F_XG + (size_t)row * D))[lane + 64] = h1;
                if (lane == 0) { F_rowinfo[row] = 2 * t + s; F_roww[row] = __builtin_bit_cast(float, rt[3 * s + 2]); }
            }
        }
    }
    for (int e = blockIdx.x; e < NEXP; e += F.G) {
        const int cnt = tab[64 + e], r0 = tab[e] + cnt, r1 = tab[e] + (((cnt + 255) >> 8) << 8);
        for (int row = r0 + F.wave; row < r1 && row < MAXTILES * 256; row += 8) {
            ((u32x4*)(F_XG + (size_t)row * D))[lane] = (u32x4){0u, 0u, 0u, 0u}; ((u32x4*)(F_XG + (size_t)row * D))[lane + 64] = (u32x4){0u, 0u, 0u, 0u};
            if (lane == 0) { F_rowinfo[row] = -1; F_roww[row] = 0.f; }
        }
    }
    (void)ntiles;
}

struct MoeOrder {
    const LAS int* tile_e; int T4, G, c;
    __device__ __forceinline__ bool next(int i, pg8::Unit& u) const { const long L = (long)i * G + c; if (L >= T4) return false; const int rt = (int)(L >> 2), j = (int)(L & 3); u.pm = rt; u.pn = tile_e[rt] * 4 + j; return true; }
    __device__ __forceinline__ void a_ready(const pg8::Unit&) const {}
    __device__ __forceinline__ void done(const pg8::Unit&) const {}
};
struct EpiSwiGLU {
    static constexpr bool PERM = true, AFTER_DRAIN = false;
    bf16* HM;
    __device__ __forceinline__ void operator()(const pg8::f32x4 (&acc)[2][2][4][2], const pg8::Unit& u, int wr, int wc, int fr, int fq) const {
        const int row0 = u.pm * 256 + wr * 64 + fr, col0 = (u.pn & 3) * 128 + wc * 32 + 8 * fq;
#pragma unroll
        for (int ai = 0; ai < 2; ++ai)
#pragma unroll
            for (int m = 0; m < 4; ++m) { const size_t row = (size_t)(row0 + ai * 128 + m * 16);
                const pg8::f32x4 g0 = acc[ai][0][m][0], g1 = acc[ai][0][m][1], u0 = acc[ai][1][m][0], u1 = acc[ai][1][m][1];
                u32x4 w; w.x = pk2(siluf_(g0[0]) * u0[0], siluf_(g0[1]) * u0[1]); w.y = pk2(siluf_(g0[2]) * u0[2], siluf_(g0[3]) * u0[3]);
                w.z = pk2(siluf_(g1[0]) * u1[0], siluf_(g1[1]) * u1[1]); w.w = pk2(siluf_(g1[2]) * u1[2], siluf_(g1[3]) * u1[3]);
                *(u32x4*)(HM + row * DEXP + col0) = w; }
    }
};
struct EpiScatter {
    static constexpr bool PERM = true, AFTER_DRAIN = false;
    bf16* YBUF; const int* rowinfo; const float* roww;
    __device__ __forceinline__ void operator()(const pg8::f32x4 (&acc)[2][2][4][2], const pg8::Unit& u, int wr, int wc, int fr, int fq) const {
        const int row0 = u.pm * 256 + wr * 64 + fr, col0 = (u.pn & 3) * 256 + wc * 32 + 8 * fq;
#pragma unroll
        for (int ai = 0; ai < 2; ++ai)
#pragma unroll
            for (int m = 0; m < 4; ++m) { const int row = row0 + ai * 128 + m * 16; const int info = rowinfo[row]; const float wt = roww[row];
                if (info >= 0) {
#pragma unroll
                    for (int bj = 0; bj < 2; ++bj) { const pg8::f32x4 v0 = acc[ai][bj][m][0], v1 = acc[ai][bj][m][1];
                        u32x4 w; w.x = pk2(wt * v0[0], wt * v0[1]); w.y = pk2(wt * v0[2], wt * v0[3]); w.z = pk2(wt * v1[0], wt * v1[1]); w.w = pk2(wt * v1[2], wt * v1[3]);
                        *(u32x4*)(YBUF + (size_t)info * D + col0 + bj * 128) = w; } } }
    }
};

__device__ __forceinline__ void p11_final(Frame& F, const KArgs& A) {
    const int gw = blockIdx.x * 8 + F.wave, NGW = F.G * 8, lane = F.lane;
    const float* gt2 = F_MOD + 5120;
    for (int t = gw; t < SEQ; t += NGW) {
        float* row = F_out + (size_t)t * D;
        f32x4 v[4]; float ss = 0.f;
#pragma unroll
        for (int j = 0; j < 4; ++j) {
            const f32x4 x1 = ((const f32x4*)row)[lane + 64 * j], g2 = ((const f32x4*)gt2)[lane + 64 * j];
            const u32x2 y0 = ((const u32x2*)(F_YBUF + (size_t)(2 * t) * D))[lane + 64 * j], y1 = ((const u32x2*)(F_YBUF + (size_t)(2 * t + 1) * D))[lane + 64 * j];
            f32x4 ys; ys.x = bflo(y0.x) + bflo(y1.x); ys.y = bfhi(y0.x) + bfhi(y1.x); ys.z = bflo(y0.y) + bflo(y1.y); ys.w = bfhi(y0.y) + bfhi(y1.y);
            v[j] = x1 + g2 * ys;
            ss += (v[j].x * v[j].x + v[j].y * v[j].y) + (v[j].z * v[j].z + v[j].w * v[j].w);
        }
        const float rinv = rsqrtf(wave_sum(ss) * (1.0f / D) + NORM_EPS);
#pragma unroll
        for (int j = 0; j < 4; ++j) { const f32x4 fg = ((const f32x4*)F_fin_g)[lane + 64 * j]; ((f32x4*)row)[lane + 64 * j] = v[j] * rinv * fg; }
    }
}

__global__ void __launch_bounds__(512, 2) fwd(Args AA) {
    extern __shared__ __attribute__((aligned(16))) unsigned char lds_raw[];
    Frame F;
    F.lds = (LAS unsigned char*)lds_raw;
    F.tid = threadIdx.x; F.lane = F.tid & 63; F.wave = __builtin_amdgcn_readfirstlane(F.tid >> 6); F.G = gridDim.x;
    F.ws = AA.ws; F.in = nullptr; F.ctl = (unsigned*)(AA.ws + WS_CTL);

    for (int u = F.tid; u < (LDS_BYTES - MISC_OFF) / 4; u += 512) ((LAS unsigned*)(F.lds + MISC_OFF))[u] = 0u;
    __syncthreads();
    XcdBarrier bar; bar.bar = F.ctl + CW_BAR; bar.x = 0; bar.st = nullptr;
    if (!MK_LAUNCH_PER_PHASE) bar = xcd_barrier_post(F.ctl + CW_BAR, (volatile LAS unsigned*)(F.lds + MISC_OFF));
    const int lo = AA.ph_lo, hi = AA.ph_hi;
#ifndef ONLY_PHASE
#define ONLY_PHASE -1
#endif
#define IN(k) ((ONLY_PHASE < 0 || ONLY_PHASE == (k)) && lo <= (k) && (k) < hi)
#define FRESH() do { int t_ = threadIdx.x; asm volatile("" : "+v"(t_)); F.tid = t_; F.lane = t_ & 63; } while (0)
#define SEAM(k) do { if (!MK_LAUNCH_PER_PHASE && IN(k) && IN((k) + 1)) xcd_barrier(bar); } while (0)

    if (IN(0)) { FRESH(); FRESH_KA(A); p0_prologue(F, A); } SEAM(0);
    if (IN(1)) { FRESH(); FRESH_KA(A); p1_norm1(F, A); } SEAM(1);
    if (IN(2)) { FRESH(); FRESH_KA(A);
        pg8::Gemm g{F_H, F_WinT, MTOT, NPAD, D}; Sched1 S{F.G, (int)blockIdx.x}; EpiZ E{F_ZA, F_ZB, F_ZG};
        pg8::gemm_phase<EpiZ, Sched1, true, true>(F.lds, g, S, E);
    } SEAM(2);
    if (IN(3)) { FRESH(); FRESH_KA(A);
        if (blockIdx.x < 16) p3_scan_naive(F, A, (int)blockIdx.x);
        else for (int ch = (int)blockIdx.x - 16; ch < SEQ / 128; ch += F.G - 16) p3_mixer_b(F, A, ch);
    } SEAM(3);
    if (IN(4)) { FRESH(); FRESH_KA(A); p4_rwkv_out(F, A); } SEAM(4);
    if (IN(5)) { FRESH(); FRESH_KA(A);
        SchedStd S{64, 4, F.G, (int)blockIdx.x};
        { pg8::Gemm g{F_YA, F_WaT, SEQ, D, DR}; EpiMergeA E{F_Y, F_ZG}; pg8::gemm_phase<EpiMergeA, SchedStd, true, true>(F.lds, g, S, E); }
        __syncthreads();
        { pg8::Gemm g{F_YB, F_WbT, SEQ, D, DR}; EpiMergeB E{F_Y, F_ZG, F_MG}; pg8::gemm_phase<EpiMergeB, SchedStd, true, true>(F.lds, g, S, E); }
    } SEAM(5);
    if (IN(6)) { FRESH(); FRESH_KA(A);
        SchedStd S{64, 4, F.G, (int)blockIdx.x};
        pg8::Gemm g{F_MG, F_WoutT, SEQ, D, D}; EpiX1 E{F_x, F_MOD + 2048, F_out}; pg8::gemm_phase<EpiX1, SchedStd, true, true>(F.lds, g, S, E);
    } SEAM(6);
    if (IN(7)) { FRESH(); FRESH_KA(A); p7_router(F, A); } SEAM(7);
    if (IN(8)) { FRESH(); FRESH_KA(A); p8_gather(F, A); } SEAM(8);
    if (IN(9)) { FRESH(); FRESH_KA(A);
        const int ntiles = moe_tables(F, A);
        MoeOrder S{(const LAS int*)(F.lds + TAB_OFF) + 128, ntiles * 4, F.G, (int)blockIdx.x};
        pg8::Gemm g{F_XG, F_WguT, MAXTILES * 256, NEXP * 1024, D}; EpiSwiGLU E{F_HMID};
        pg8::gemm_phase<EpiSwiGLU, MoeOrder, true, true>(F.lds, g, S, E);
    } SEAM(9);
    if (IN(10)) { FRESH(); FRESH_KA(A);
        const int ntiles = moe_tables(F, A);
        MoeOrder S{(const LAS int*)(F.lds + TAB_OFF) + 128, ntiles * 4, F.G, (int)blockIdx.x};
        pg8::Gemm g{F_HMID, F_WdT, MAXTILES * 256, NEXP * 1024, DEXP}; EpiScatter E{F_YBUF, F_rowinfo, F_roww};
        pg8::gemm_phase<EpiScatter, MoeOrder, true, true>(F.lds, g, S, E);
    } SEAM(10);
    if (IN(11)) { FRESH(); FRESH_KA(A); p11_final(F, A); }
#undef IN
#undef SEAM
}

extern "C" void kernel_launch(void* const* d_in, const int* in_sizes, int n_in, void* d_out, int out_size, void* d_ws, size_t ws_size, hipStream_t stream) {
    static int grid = 0;
    if (grid == 0) {
        if (n_in != 35 || in_sizes[0] != SEQ * D || out_size != SEQ * D || ws_size < WS_END) {
            fprintf(stderr, "kernel_launch: unexpected shapes: n_in %d in0 %d out %d ws %zu (need %zu); nothing launched\n", n_in, n_in > 0 ? in_sizes[0] : -1, out_size, ws_size, (size_t)WS_END); grid = -1; return; }
        int dev = 0, cus = 0, per_cu = 0;
        if (hipGetDevice(&dev) != hipSuccess || hipDeviceGetAttribute(&cus, hipDeviceAttributeMultiprocessorCount, dev) != hipSuccess) { grid = -1; return; }
        if (hipFuncSetAttribute((const void*)fwd, hipFuncAttributeMaxDynamicSharedMemorySize, LDS_BYTES) != hipSuccess) { fprintf(stderr, "kernel_launch: hipFuncSetAttribute failed\n"); grid = -1; return; }
        if (hipOccupancyMaxActiveBlocksPerMultiprocessor(&per_cu, (const void*)fwd, 512, LDS_BYTES) != hipSuccess || per_cu < 1) fprintf(stderr, "kernel_launch: occupancy query says %d\n", per_cu);
        (void)hipGetLastError();
        grid = cus;
    }
    if (grid < 0) return;
    if (hipMemsetAsync((char*)d_ws + WS_CTL, 0, CTL_ZERO_BYTES, stream) != hipSuccess) return;
    Args a{};
    for (int i = 0; i < 35; ++i) a.in[i] = (const float*)d_in[i];
    a.out = (float*)d_out; a.ws = (unsigned char*)d_ws;
#if MK_LAUNCH_PER_PHASE
    for (int p = 0; p < NPHASE; ++p) { a.ph_lo = p; a.ph_hi = p + 1; hipLaunchKernelGGL(fwd, dim3(grid), dim3(512), LDS_BYTES, stream, a); }
#else
#ifndef MK_PH_HI
#define MK_PH_HI NPHASE
#endif
    a.ph_lo = 0; a.ph_hi = MK_PH_HI;
    hipLaunchKernelGGL(fwd, dim3(grid), dim3(512), LDS_BYTES, stream, a);
#endif
}
```

```cpp
#include <hip/hip_runtime.h>
#include <cstdio>
#include <cstdint>
namespace pg8 {
#define PG8_LAS __attribute__((address_space(3)))
typedef unsigned short bf16_t;
typedef short bf16x8 __attribute__((ext_vector_type(8)));
typedef float f32x4 __attribute__((ext_vector_type(4)));
typedef unsigned u32x4 __attribute__((ext_vector_type(4)));
constexpr int BM = 256, BK = 64, HALF = 128, HTB = HALF * BK * 2  , STAGE_BYTES = 8 * HTB, NXCD = 8, WGM = 8;

__host__ __device__ __forceinline__ int lds_byte(int r, int c) { const int st = (r >> 4) * 2 + (c >> 5), rr = r & 15, cc = c & 31, ob = rr * 64 + cc * 2; return st * 1024 + (ob ^ (((ob >> 9) & 1) << 5)); }
__host__ __device__ __forceinline__ void stage_rc(int b, int& R, int& C) { const int st = b / 1024, sb = b % 1024, swz = sb ^ (((sb >> 9) & 1) << 5); R = (st >> 1) * 16 + swz / 64; C = (st & 1) * 32 + (swz % 64) / 2; }
__host__ __device__ __forceinline__ int perm32(int rho) { const int n = rho >> 4, i = rho & 15; return 8 * (i >> 2) + 4 * n + (i & 3); }

struct Unit { int pm, pn; };
struct Gemm { const bf16_t* A; const bf16_t* Bt; int M, N, K; };

struct StaticOrder {
    int nM, nN, nwg, G, c;
    __host__ __device__ void init(int M, int N, int G_, int c_) { nM = M / BM; nN = N / BM; nwg = nM * nN; G = G_; c = c_; }
    __host__ __device__ bool next(int i, Unit& u) const {
        const long L = (long)i * G + c; if (L >= nwg) return false;
        int wgid = (int)L; { const int q = nwg / NXCD, r = nwg % NXCD, xcd = wgid % NXCD, off = wgid / NXCD; wgid = (xcd < r ? xcd * (q + 1) : r * (q + 1) + (xcd - r) * q) + off; }
        const int nig = WGM * nN, gid = wgid / nig, fm = gid * WGM, gsz = (nM - fm) < WGM ? (nM - fm) : WGM;
        u.pm = fm + ((wgid % nig) % gsz); u.pn = (wgid % nig) / gsz; return true;
    }
    __device__ __forceinline__ void a_ready(const Unit&) const {}
    __device__ __forceinline__ void done(const Unit&) const {}
};

__device__ __forceinline__ unsigned cvt_pk_bf16(float lo, float hi) { unsigned r; asm volatile("v_cvt_pk_bf16_f32 %0, %1, %2" : "=v"(r) : "v"(lo), "v"(hi)); return r; }
template <class Epi, class Sched, bool ALIGN_EPI = false, bool SP2 = false>
__device__ __forceinline__ void gemm_phase(PG8_LAS unsigned char* lds, const Gemm g, const Sched& S, const Epi& E) {
    int tid_ = threadIdx.x; asm volatile("" : "+v"(tid_));
    const int tid = tid_, wid = __builtin_amdgcn_readfirstlane(tid >> 6), lane = tid & 63, wr = wid >> 2, wc = wid & 3, fr = lane & 15, fq = lane >> 4;
    const int K = g.K, nt = K / BK;
    unsigned voffA[2], voffB[2];
#pragma unroll
    for (int i = 0; i < 2; ++i) { int R, C; stage_rc(tid * 16 + i * 8192, R, C); const int Rb = Epi::PERM ? ((R & ~31) + perm32(R & 31)) : R;
        voffA[i] = (unsigned)(R * K + C) * 2u; voffB[i] = (unsigned)(Rb * K + C) * 2u; }
    const size_t kstep = (size_t)(BK * 2);
    const size_t hstep = (size_t)HALF * K * 2;
    const size_t tstep = 2 * hstep;
    const unsigned ldsw = (unsigned)wid * 1024u;
    const int aoff = lds_byte(wr * 64 + fr, fq * 8), boff = lds_byte(wc * 32 + fr, fq * 8);
#define PG8_SA(b, h) (((b) * 2 + (h)) * HTB)
#define PG8_SB(b, h) ((4 + (b) * 2 + (h)) * HTB)
#define PG8_STAGE(bufoff, gbase, voff) do { _Pragma("unroll") for (int _i = 0; _i < 2; ++_i) \
        __builtin_amdgcn_global_load_lds((const unsigned*)((const char*)(gbase) + (voff)[_i]), (PG8_LAS unsigned*)(lds + (bufoff) + ldsw + _i * 8192), 16, 0, 0); } while (0)
#define PG8_LDA(dst, b, h) do { _Pragma("unroll") for (int m = 0; m < 4; ++m) _Pragma("unroll") for (int k = 0; k < 2; ++k) dst[m][k] = *(const PG8_LAS bf16x8*)(lds + PG8_SA(b, h) + aoff + m * 2048 + k * 1024); } while (0)
#define PG8_LDB(dst, b, h) do { _Pragma("unroll") for (int n = 0; n < 2; ++n) _Pragma("unroll") for (int k = 0; k < 2; ++k) dst[n][k] = *(const PG8_LAS bf16x8*)(lds + PG8_SB(b, h) + boff + n * 2048 + k * 1024); } while (0)
#define PG8_MMA(ai, bj, At, Bt) do { __builtin_amdgcn_s_setprio(1); _Pragma("unroll") for (int m = 0; m < 4; ++m) _Pragma("unroll") for (int n = 0; n < 2; ++n) _Pragma("unroll") for (int k = 0; k < 2; ++k) \
        acc[ai][bj][m][n] = __builtin_amdgcn_mfma_f32_16x16x32_bf16(Bt[n][k], At[m][k], acc[ai][bj][m][n], 0, 0, 0); __builtin_amdgcn_s_setprio(0); } while (0)
#define PG8_WAIT_V(n) asm volatile("s_waitcnt vmcnt(" #n ")" ::: "memory")
#define PG8_WAIT_L(n) asm volatile("s_waitcnt lgkmcnt(" #n ")" ::: "memory")
#define PG8_BAR __builtin_amdgcn_s_barrier()
#define PG8_SCHED __builtin_amdgcn_sched_barrier(0)
    Unit cur, nxt; int ui = 0;
    if (!S.next(0, cur)) return;
    f32x4 acc[2][2][4][2];
#pragma unroll
    for (int a = 0; a < 2; ++a)
#pragma unroll
        for (int b = 0; b < 2; ++b)
#pragma unroll
            for (int m = 0; m < 4; ++m)
#pragma unroll
                for (int n = 0; n < 2; ++n) acc[a][b][m][n] = (f32x4){0.f, 0.f, 0.f, 0.f};
    bf16x8 At[4][2], B0[2][2], B1[2][2];
    const char* cA = (const char*)g.A + (size_t)cur.pm * tstep; const char* cB = (const char*)g.Bt + (size_t)cur.pn * tstep;
    S.a_ready(cur);
    if constexpr (SP2) {
        PG8_STAGE(PG8_SB(0, 0), cB, voffB); PG8_STAGE(PG8_SB(0, 1), cB + hstep, voffB); PG8_STAGE(PG8_SA(0, 0), cA, voffA); PG8_STAGE(PG8_SA(0, 1), cA + hstep, voffA);
        if (wr == 1) PG8_BAR;
        PG8_WAIT_V(2); PG8_BAR;
        PG8_STAGE(PG8_SB(1, 0), cB + kstep, voffB); PG8_STAGE(PG8_SA(1, 0), cA + kstep, voffA); PG8_STAGE(PG8_SB(1, 1), cB + hstep + kstep, voffB);
        PG8_WAIT_V(6); PG8_BAR;
    } else {
        PG8_STAGE(PG8_SB(0, 0), cB, voffB); PG8_STAGE(PG8_SA(0, 0), cA, voffA); PG8_STAGE(PG8_SB(0, 1), cB + hstep, voffB); PG8_STAGE(PG8_SA(0, 1), cA + hstep, voffA);
        if (wr == 1) PG8_BAR;
        PG8_WAIT_V(4); PG8_BAR;
        PG8_STAGE(PG8_SB(1, 0), cB + kstep, voffB); PG8_STAGE(PG8_SA(1, 0), cA + kstep, voffA); PG8_STAGE(PG8_SB(1, 1), cB + hstep + kstep, voffB);
        PG8_WAIT_V(6); PG8_BAR;
    }
    for (;;) {
        const bool has_next = S.next(ui + 1, nxt);
        const char* nA = has_next ? (const char*)g.A + (size_t)nxt.pm * tstep : cA; const char* nB = has_next ? (const char*)g.Bt + (size_t)nxt.pn * tstep : cB;
        for (int t = 0; t < nt; t += 2) {
            const bool last = (t == nt - 2);
            const char* a1 = cA + (size_t)(t + 1) * kstep;
            const char* a2 = last ? nA : cA + (size_t)(t + 2) * kstep; const char* b2 = last ? nB : cB + (size_t)(t + 2) * kstep;
            const char* a3 = a2 + kstep; const char* b3 = b2 + kstep;
            if (last && has_next) S.a_ready(nxt);
            if constexpr (SP2) {
            PG8_LDB(B0, 0, 0); PG8_LDB(B1, 0, 1); PG8_SCHED; PG8_LDA(At, 0, 0); PG8_STAGE(PG8_SA(1, 1), a1 + hstep, voffA);
            PG8_WAIT_V(8); PG8_WAIT_L(0); PG8_BAR; PG8_MMA(0, 0, At, B0); PG8_MMA(0, 1, At, B1); PG8_BAR; PG8_SCHED;
            PG8_LDA(At, 0, 1); PG8_STAGE(PG8_SB(0, 0), b2, voffB); PG8_STAGE(PG8_SB(0, 1), b2 + hstep, voffB); PG8_STAGE(PG8_SA(0, 0), a2, voffA);
            PG8_WAIT_V(8); PG8_WAIT_L(0); PG8_BAR; PG8_MMA(1, 0, At, B0); PG8_MMA(1, 1, At, B1); PG8_BAR; PG8_SCHED;
            PG8_LDB(B0, 1, 0); PG8_LDB(B1, 1, 1); PG8_SCHED; PG8_LDA(At, 1, 0); PG8_STAGE(PG8_SA(0, 1), a2 + hstep, voffA);
            PG8_WAIT_V(8); PG8_WAIT_L(0); PG8_BAR; PG8_MMA(0, 0, At, B0); PG8_MMA(0, 1, At, B1); PG8_BAR; PG8_SCHED;
            PG8_LDA(At, 1, 1); PG8_STAGE(PG8_SB(1, 0), b3, voffB); PG8_STAGE(PG8_SB(1, 1), b3 + hstep, voffB); PG8_STAGE(PG8_SA(1, 0), a3, voffA);
            PG8_WAIT_V(8); PG8_WAIT_L(0); PG8_BAR; PG8_MMA(1, 0, At, B0); PG8_MMA(1, 1, At, B1); PG8_BAR; PG8_SCHED;
            } else {
            PG8_LDB(B0, 0, 0); PG8_SCHED; PG8_LDA(At, 0, 0); PG8_STAGE(PG8_SA(1, 1), a1 + hstep, voffA);
            PG8_WAIT_L(8); PG8_BAR; PG8_WAIT_L(0); PG8_MMA(0, 0, At, B0); PG8_BAR; PG8_SCHED;
            PG8_LDB(B1, 0, 1); PG8_STAGE(PG8_SB(0, 0), b2, voffB);
            PG8_BAR; PG8_WAIT_L(0); PG8_MMA(0, 1, At, B1); PG8_BAR;
            PG8_LDA(At, 0, 1); PG8_STAGE(PG8_SA(0, 0), a2, voffA);
            PG8_BAR; PG8_WAIT_L(0); PG8_MMA(1, 0, At, B0); PG8_BAR; PG8_SCHED;
            PG8_STAGE(PG8_SB(0, 1), b2 + hstep, voffB);
            PG8_WAIT_V(6); PG8_BAR; PG8_MMA(1, 1, At, B1); PG8_BAR;
            PG8_LDB(B0, 1, 0); PG8_SCHED; PG8_LDA(At, 1, 0); PG8_STAGE(PG8_SA(0, 1), a2 + hstep, voffA);
            PG8_WAIT_L(8); PG8_BAR; PG8_WAIT_L(0); PG8_MMA(0, 0, At, B0); PG8_BAR; PG8_SCHED;
            PG8_LDB(B1, 1, 1); PG8_STAGE(PG8_SB(1, 0), b3, voffB);
            PG8_BAR; PG8_WAIT_L(0); PG8_MMA(0, 1, At, B1); PG8_BAR;
            PG8_LDA(At, 1, 1); PG8_STAGE(PG8_SA(1, 0), a3, voffA);
            PG8_BAR; PG8_WAIT_L(0); PG8_MMA(1, 0, At, B0); PG8_BAR; PG8_SCHED;
            PG8_STAGE(PG8_SB(1, 1), b3 + hstep, voffB);
            PG8_WAIT_V(6); PG8_BAR; PG8_MMA(1, 1, At, B1); PG8_BAR;
            }
        }
        if constexpr (ALIGN_EPI) { if (wr == 0) PG8_BAR; }
        if constexpr (!Epi::AFTER_DRAIN) { E(acc, cur, wr, wc, fr, fq); S.done(cur); }
        if (!has_next) break;
#pragma unroll
        for (int a = 0; a < 2; ++a)
#pragma unroll
            for (int b = 0; b < 2; ++b)
#pragma unroll
                for (int m = 0; m < 4; ++m)
#pragma unroll
                    for (int n = 0; n < 2; ++n) acc[a][b][m][n] = (f32x4){0.f, 0.f, 0.f, 0.f};
        cur = nxt; cA = nA; cB = nB; ++ui;
        if constexpr (ALIGN_EPI) { if (wr == 1) PG8_BAR; }
    }
    PG8_WAIT_V(0);
    if constexpr (!ALIGN_EPI) { if (wr == 0) PG8_BAR; }
    PG8_BAR;
    if constexpr (Epi::AFTER_DRAIN) { E.fused(acc, cur, wr, wc, fr, fq, lds, wid, lane); S.done(cur); }
#undef PG8_SA
#undef PG8_SB
#undef PG8_STAGE
#undef PG8_LDA
#undef PG8_LDB
#undef PG8_MMA
#undef PG8_WAIT_V
#undef PG8_WAIT_L
#undef PG8_BAR
#undef PG8_SCHED
}
}

#ifndef MK_LAUNCH_PER_PHASE
#define MK_LAUNCH_PER_PHASE 0
#endif
constexpr int D = 1024, SEQ = 16384, CTXL = 256, MTOT = SEQ + CTXL, GW = 64, GROWS = SEQ / GW;
constexpr int DR = 512, NH = 8, HD = 64, PA = 1920, WINC = 4992, NPAD = 5120;
constexpr int NEXP = 32, DEXP = 512;
constexpr float NORM_EPS = 1e-6f, GN_EPS = 64e-5f;
constexpr int NPHASE = 13;

constexpr size_t MiB = 1u << 20;
constexpr size_t WS_CTL = 0, CTL_ZERO_BYTES = 64 * 1024;
constexpr size_t WS_MOD = 1 * MiB;
constexpr size_t WS_ROWINFO = WS_MOD + 64 * 1024;
constexpr size_t WS_ROWW = WS_MOD + 256 * 1024;
constexpr size_t WS_ROUTE = WS_MOD + 512 * 1024;
constexpr size_t WS_WIN = 2 * MiB;
constexpr size_t WS_WA = 12 * MiB, WS_WB = 13 * MiB, WS_WOUT = 14 * MiB;
constexpr size_t WS_H = 16 * MiB;
constexpr size_t WS_ZA = 49 * MiB;
constexpr size_t WS_ZB = 114 * MiB;
constexpr size_t WS_ZG = 146 * MiB;
constexpr size_t WS_YB = 210 * MiB;
constexpr size_t WS_YA = 226 * MiB;
constexpr size_t WS_Y = 242 * MiB;
constexpr size_t WS_END = 306 * MiB;
constexpr size_t WS_WGU = 49 * MiB;
constexpr size_t WS_WD = 113 * MiB;
constexpr size_t WS_XG = 145 * MiB;
constexpr size_t WS_HMID = 225 * MiB;
constexpr size_t WS_WUPT = 512 * 1024, WS_AUPT = 640 * 1024, WS_GUPT = 768 * 1024;
constexpr size_t WS_PQ = 16 * MiB;
constexpr size_t WS_S0 = 33 * MiB;
constexpr size_t WS_GY = 242 * MiB;
constexpr int MAXTILES = 160;
constexpr int CW_TMO = 0, CW_BAR = 4096, CW_CNT = 8192;

constexpr int RING_BYTES = 131072, MISC_OFF = 159744, TAB_OFF = MISC_OFF + 256, LDS_BYTES = 163840;

#define GAS __attribute__((address_space(1)))
#define LAS __attribute__((address_space(3)))
typedef unsigned short bf16;
typedef float f32x4 __attribute__((ext_vector_type(4)));
typedef unsigned u32x4 __attribute__((ext_vector_type(4)));
typedef unsigned u32x2 __attribute__((ext_vector_type(2)));
typedef short bf16x8 __attribute__((ext_vector_type(8)));
#define LDS_WAIT() asm volatile("s_waitcnt lgkmcnt(0)" ::: "memory")
#define VM_WAIT() asm volatile("s_waitcnt vmcnt(0)" ::: "memory")

__device__ __forceinline__ unsigned f2bf(float f) { unsigned u = __builtin_bit_cast(unsigned, f); return (u + 0x7fffu + ((u >> 16) & 1u)) >> 16; }
__device__ __forceinline__ unsigned pk2(float lo, float hi) { return f2bf(lo) | (f2bf(hi) << 16); }
__device__ __forceinline__ float bf2f(unsigned b) { return __builtin_bit_cast(float, b << 16); }
__device__ __forceinline__ float bflo(unsigned w) { return __builtin_bit_cast(float, w << 16); }
__device__ __forceinline__ float bfhi(unsigned w) { return __builtin_bit_cast(float, w & 0xffff0000u); }
__device__ __forceinline__ float sigmoidf_(float x) { return 1.0f / (1.0f + __expf(-x)); }
__device__ __forceinline__ float siluf_(float x) { return x / (1.0f + __expf(-x)); }
__device__ __forceinline__ float softplusf_(float x) { return fmaxf(x, 0.f) + log1pf(__expf(-fabsf(x))); }
__device__ __forceinline__ float gelu_tanh(float x) { const float u = 0.7978845608028654f * (x + 0.044715f * x * x * x); return 0.5f * x * (1.0f + tanhf(u)); }
__device__ __forceinline__ float wave_sum(float v) {
#pragma unroll
    for (int o = 1; o < 64; o <<= 1) v += __shfl_xor(v, o);
    return v;
}

#define XB_TMO      128
#define XB_XCNT(j)  (256  + 64 * (j))
#define XB_XSUB(j)  (1280 + 64 * (j))
#define XB_XGEN(j)  (2304 + 64 * (j))
#define XB_TOP      3328
#define XB_TOPGEN   3392
#define XCD_BAR_WORDS 3456
#define XB_SPIN_CAP (1u << 26)
#define LAS __attribute__((address_space(3)))

__device__ __forceinline__ unsigned xb_ld(unsigned* p)              { return __hip_atomic_load(p, __ATOMIC_RELAXED, __HIP_MEMORY_SCOPE_AGENT); }
__device__ __forceinline__ unsigned xb_add(unsigned* p, unsigned v) { return __hip_atomic_fetch_add(p, v, __ATOMIC_RELAXED, __HIP_MEMORY_SCOPE_AGENT); }
__device__ __forceinline__ unsigned xb_xcc_id() { return (unsigned)__builtin_amdgcn_s_getreg((3 << 11) | 20) & 0xFu; }
#define XB_SPIN(cond, bar) do { unsigned _sp = 0; while (cond) { __builtin_amdgcn_s_sleep(1); \
    if ((++_sp & 255u) == 0u) { if (xb_ld(&(bar)[XB_TMO])) break; if (_sp > XB_SPIN_CAP) { atomicAdd(&(bar)[XB_TMO], 1u); break; } } } } while (0)

struct XcdBarrier {
    unsigned* bar; unsigned x;
    volatile LAS unsigned* st;
};

__device__ __forceinline__ XcdBarrier xcd_barrier_post(unsigned* bar, volatile LAS unsigned* st) {
    XcdBarrier b; b.bar = bar; b.x = xb_xcc_id(); b.st = st;
    if (threadIdx.x == 0) (void)xb_add(&bar[XB_XCNT(b.x)], 1u);
    return b;
}
__device__ __forceinline__ void xcd_barrier_complete(unsigned* bar, unsigned x, unsigned& nloc, unsigned& nx) {
    const unsigned G = gridDim.x * gridDim.y * gridDim.z;
    unsigned sum, cnt, mine, sp = 0u;
    for (;;) {
        sum = 0u; cnt = 0u; mine = 0u;
#pragma unroll
        for (unsigned j = 0; j < 16; ++j) { const unsigned c = xb_ld(&bar[XB_XCNT(j)]); sum += c; cnt += (c > 0u) ? 1u : 0u; mine = (j == x) ? c : mine; }
        if (sum == G) break;
        __builtin_amdgcn_s_sleep(1);
        if ((++sp & 255u) == 0u) { if (xb_ld(&bar[XB_TMO])) break; if (sp > XB_SPIN_CAP) { atomicAdd(&bar[XB_TMO], 1u); break; } }
    }
    nloc = mine > 0u ? mine : 1u; nx = cnt > 0u ? cnt : 1u;
}

__device__ __forceinline__ void xcd_barrier(const XcdBarrier& b) {
    asm volatile("s_waitcnt vmcnt(0)" ::: "memory");
    __syncthreads();
    if (threadIdx.x == 0) {
        unsigned* bar = b.bar;
        __builtin_amdgcn_s_waitcnt(0);
        unsigned nloc = b.st[0], nx = b.st[1];
        if (nloc == 0u) { xcd_barrier_complete(bar, b.x, nloc, nx); b.st[0] = nloc; b.st[1] = nx; }
        const unsigned old = xb_add(&bar[XB_XSUB(b.x)], 1u);
        const unsigned gen = old / nloc;
        if (old + 1u == (gen + 1u) * nloc) {
            __builtin_amdgcn_fence(__ATOMIC_RELEASE, "agent");
            asm volatile("s_waitcnt vmcnt(0)" ::: "memory");
            const unsigned og = xb_add(&bar[XB_TOP], 1u);
            const unsigned tg = og / nx;
            if (og + 1u == (tg + 1u) * nx) xb_add(&bar[XB_TOPGEN], 1u);
            else XB_SPIN(xb_ld(&bar[XB_TOPGEN]) == tg, bar);
            __builtin_amdgcn_fence(__ATOMIC_ACQUIRE, "agent");
            xb_add(&bar[XB_XGEN(b.x)], 1u);
            asm volatile("s_waitcnt vmcnt(0)" ::: "memory");
        } else {
            XB_SPIN(xb_ld(&bar[XB_XGEN(b.x)]) == gen, bar);
            __builtin_amdgcn_fence(__ATOMIC_ACQUIRE, "agent");
            asm volatile("s_waitcnt vmcnt(0)" ::: "memory");
        }
    }
    __syncthreads();
}

struct Args { const float* in[35]; float* out; unsigned char* ws; int ph_lo, ph_hi; };

typedef const __attribute__((address_space(4))) unsigned char* kptr_t;
struct KArgs {
    kptr_t p;
    __device__ __forceinline__ const float* in(int i) const { return *(const float* const __attribute__((address_space(4)))*)(p + 8 * i); }
    __device__ __forceinline__ float* out() const { return *(float* const __attribute__((address_space(4)))*)(p + 280); }
    __device__ __forceinline__ unsigned char* ws() const { return *(unsigned char* const __attribute__((address_space(4)))*)(p + 288); }
};
#define FRESH_KA(name) KArgs name; { kptr_t q_ = (kptr_t)__builtin_amdgcn_kernarg_segment_ptr(); asm volatile("" : "+s"(q_)); name.p = q_; }
#define F_x (A.in(0))
#define F_c (A.in(1))
#define F_ctx (A.in(2))
#define F_cctx (A.in(3))
#define F_ada_w (A.in(4))
#define F_ada_b (A.in(5))
#define F_norm1_g (A.in(6))
#define F_norm2_g (A.in(7))
#define F_w_in (A.in(8))
#define F_mu (A.in(9))
#define F_w0 (A.in(10))
#define F_w_up (A.in(11))
#define F_a0 (A.in(12))
#define F_a_up (A.in(13))
#define F_g_up (A.in(14))
#define F_k_k (A.in(15))
#define F_k_a (A.in(16))
#define F_r_k (A.in(17))
#define F_ln_w (A.in(18))
#define F_ln_b (A.in(19))
#define F_w_ba (A.in(20))
#define F_sg_ln_w (A.in(21))
#define F_sg_ln_b (A.in(22))
#define F_sg_w (A.in(23))
#define F_sg_b (A.in(24))
#define F_w_bb (A.in(25))
#define F_w_out (A.in(26))
#define F_grp_w (A.in(27))
#define F_grp_b (A.in(28))
#define F_exp_w (A.in(29))
#define F_exp_b (A.in(30))
#define F_wg (A.in(31))
#define F_wu (A.in(32))
#define F_wd (A.in(33))
#define F_fin_g (A.in(34))
#define F_MOD ((float*)(A.ws() + WS_MOD))
#define F_rowinfo ((int*)(A.ws() + WS_ROWINFO))
#define F_roww ((float*)(A.ws() + WS_ROWW))
#define F_route ((unsigned*)(A.ws() + WS_ROUTE))
#define F_WinT ((bf16*)(A.ws() + WS_WIN))
#define F_WaT ((bf16*)(A.ws() + WS_WA))
#define F_WbT ((bf16*)(A.ws() + WS_WB))
#define F_WoutT ((bf16*)(A.ws() + WS_WOUT))
#define F_H ((bf16*)(A.ws() + WS_H))
#define F_ZA ((bf16*)(A.ws() + WS_ZA))
#define F_ZB ((bf16*)(A.ws() + WS_ZB))
#define F_ZG ((bf16*)(A.ws() + WS_ZG))
#define F_YB ((bf16*)(A.ws() + WS_YB))
#define F_YA ((bf16*)(A.ws() + WS_YA))
#define F_WguT ((bf16*)(A.ws() + WS_WGU))
#define F_WdT ((bf16*)(A.ws() + WS_WD))
#define F_XG ((bf16*)(A.ws() + WS_XG))
#define F_HMID ((bf16*)(A.ws() + WS_HMID))
#define F_YBUF ((bf16*)(A.ws() + WS_XG))
#define F_MG ((bf16*)(A.ws() + WS_ZB))
#define F_Y ((float*)(A.ws() + WS_Y))
#define F_out (A.out())
struct Frame {
    LAS unsigned char* lds;
    unsigned* ctl;
    unsigned char* ws;
    const float* const* in;
    int tid, lane, wave, G;
};


__device__ __forceinline__ void static_tile(int wgid, int nM, int nN, pg8::Unit& u) {
    const int nwg = nM * nN;
    { const int q = nwg / 8, r = nwg % 8, xcd = wgid % 8, off = wgid / 8; wgid = (xcd < r ? xcd * (q + 1) : r * (q + 1) + (xcd - r) * q) + off; }
    const int nig = 8 * nN, gid = wgid / nig, fm = gid * 8, gsz = (nM - fm) < 8 ? (nM - fm) : 8;
    u.pm = fm + ((wgid % nig) % gsz); u.pn = (wgid % nig) / gsz;
}

__device__ __forceinline__ void transpose_item(const float* W, int K, int N, int k0, int n0, bf16* WT, int dst_row0, LAS float* scr, int lane) {
#pragma unroll 8
    for (int i = 0; i < 32; ++i) { const int kk = 2 * i + (lane >> 5); scr[kk * 33 + (lane & 31)] = W[(size_t)(k0 + kk) * N + n0 + (lane & 31)]; }
    LDS_WAIT(); asm volatile("" ::: "memory");
    const int c = lane & 7;
#pragma unroll
    for (int j = 0; j < 4; ++j) { const int n = (lane >> 3) + 8 * j; const LAS float* s = scr + (8 * c) * 33 + n;
        u32x4 o; o.x = pk2(s[0 * 33], s[1 * 33]); o.y = pk2(s[2 * 33], s[3 * 33]); o.z = pk2(s[4 * 33], s[5 * 33]); o.w = pk2(s[6 * 33], s[7 * 33]);
        *(u32x4*)(WT + (size_t)(dst_row0 + n) * K + k0 + 8 * c) = o; }
    LDS_WAIT(); asm volatile("" ::: "memory");
}

__device__ __forceinline__ void p0_prologue(Frame& F, const KArgs& A) {
    {
        LAS float* red = (LAS float*)F.lds;
        const int cl = F.tid & 31, kg = F.tid >> 5;
        for (int cb = blockIdx.x; cb < 256; cb += F.G) {
            const int col = cb * 24 + cl; float a0 = 0.f, a1 = 0.f;
            if (cl < 24) for (int k = kg; k < D; k += 16) { const float w = F_ada_w[(size_t)k * 6144 + col]; a0 += siluf_(F_c[k]) * w; a1 += siluf_(F_cctx[k]) * w; }
            red[(kg * 32 + cl) * 2] = a0; red[(kg * 32 + cl) * 2 + 1] = a1;
            __syncthreads();
            if (F.tid < 48) { const int cc = F.tid % 24, i = F.tid / 24; float s = 0.f; for (int g = 0; g < 16; ++g) s += red[(g * 32 + cc) * 2 + i]; F_MOD[i * 6144 + cb * 24 + cc] = s + F_ada_b[cb * 24 + cc]; }
            __syncthreads();
        }
    }
    LAS float* scr = (LAS float*)(F.lds + F.wave * 16384);
    const int gw = blockIdx.x * 8 + F.wave, NGW = F.G * 8;
    constexpr int I_IN = 16 * 156, I_A = 8 * 32, I_B = 8 * 32, I_O = 16 * 32, NIT = I_IN + I_A + I_B + I_O;
    for (int it = gw; it < NIT; it += NGW) {
        int r = it;
        if (r < I_IN) { const int kb = r / 156, nb = r % 156, n0 = 32 * nb; transpose_item(F_w_in, D, WINC, 64 * kb, n0, F_WinT, n0 + (n0 >= PA ? 128 : 0), scr, F.lane); continue; } r -= I_IN;
        if (r < I_A) { const int kb = r / 32, nb = r % 32; transpose_item(F_w_ba, DR, D, 64 * kb, 32 * nb, F_WaT, 32 * nb, scr, F.lane); continue; } r -= I_A;
        if (r < I_B) { const int kb = r / 32, nb = r % 32; transpose_item(F_w_bb, DR, D, 64 * kb, 32 * nb, F_WbT, 32 * nb, scr, F.lane); continue; } r -= I_B;
        { const int kb = r / 32, nb = r % 32; transpose_item(F_w_out, D, D, 64 * kb, 32 * nb, F_WoutT, 32 * nb, scr, F.lane); }
    }
    for (int i = blockIdx.x * 512 + F.tid; i < 65536; i += F.G * 512) {
        const int ch = i >> 12, c = (i >> 6) & 63, r = i & 63, dd = ch >> 3, hh = ch & 7;
        ((bf16*)(A.ws() + WS_WUPT))[i] = (bf16)f2bf(F_w_up[(size_t)(dd * 64 + r) * DR + hh * 64 + c]);
        ((bf16*)(A.ws() + WS_AUPT))[i] = (bf16)f2bf(F_a_up[(size_t)(dd * 64 + r) * DR + hh * 64 + c]);
        const int hg = i >> 13, cg = (i >> 7) & 63, rg = i & 127;
        ((bf16*)(A.ws() + WS_GUPT))[i] = (bf16)f2bf(F_g_up[(size_t)rg * DR + hg * 64 + cg]);
    }
    for (int i = blockIdx.x * 512 + F.tid; i < 16384; i += F.G * 512) ((u32x4*)(F_WinT + (size_t)PA * D))[i] = (u32x4){0u, 0u, 0u, 0u};
}

__device__ __forceinline__ void norm_row_bf16(const float* src, const float* g, const float* sh, const float* sc, bf16* dst, int lane) {
    f32x4 v[4]; float ss = 0.f;
#pragma unroll
    for (int j = 0; j < 4; ++j) { v[j] = ((const f32x4*)src)[lane + 64 * j]; ss += (v[j].x * v[j].x + v[j].y * v[j].y) + (v[j].z * v[j].z + v[j].w * v[j].w); }
    const float rinv = rsqrtf(wave_sum(ss) * (1.0f / D) + NORM_EPS);
#pragma unroll
    for (int j = 0; j < 4; ++j) {
        const f32x4 gg = ((const f32x4*)g)[lane + 64 * j], s1 = ((const f32x4*)sc)[lane + 64 * j], s0 = ((const f32x4*)sh)[lane + 64 * j];
        const f32x4 hv = (v[j] * rinv * gg) * (1.0f + s1) + s0;
        u32x2 o; o.x = pk2(hv.x, hv.y); o.y = pk2(hv.z, hv.w);
        ((u32x2*)dst)[lane + 64 * j] = o;
    }
}
__device__ __forceinline__ void p1_norm1(Frame& F, const KArgs& A) {
    const int gw = blockIdx.x * 8 + F.wave, NGW = F.G * 8;
    for (int row = gw; row < MTOT; row += NGW) {
        const bool isctx = row >= SEQ;
        const float* src = isctx ? F_ctx + (size_t)(row - SEQ) * D : F_x + (size_t)row * D;
        const float* mod = F_MOD + (isctx ? 6144 : 0);
        norm_row_bf16(src, F_norm1_g, mod, mod + 1024, F_H + (size_t)row * D, F.lane);
    }
}

struct Sched1 {
    int G, c;
    __device__ __forceinline__ bool next(int i, pg8::Unit& u) const {
        long L = (long)i * G + c; if (L < 8) { u.pm = 64; u.pn = (int)L; return true; }
        L -= 8; if (L >= 1280) return false; static_tile((int)L, 64, 20, u); return true;
    }
    __device__ __forceinline__ void a_ready(const pg8::Unit&) const {}
    __device__ __forceinline__ void done(const pg8::Unit&) const {}
};
struct EpiZ {
    static constexpr bool PERM = true, AFTER_DRAIN = false;
    bf16 *ZA, *ZB, *ZG;
    __device__ __forceinline__ void operator()(const pg8::f32x4 (&acc)[2][2][4][2], const pg8::Unit& u, int wr, int wc, int fr, int fq) const {
        const int row0 = u.pm * 256 + wr * 64 + fr;
        bf16* base; int ld, colt;
        if (u.pn < 8) { base = ZA; ld = 2048; colt = u.pn * 256; } else if (u.pn < 12) { base = ZB; ld = 1024; colt = (u.pn - 8) * 256; } else { base = ZG; ld = 2048; colt = (u.pn - 12) * 256; }
        const int col0 = colt + wc * 32 + 8 * fq;
#pragma unroll
        for (int ai = 0; ai < 2; ++ai)
#pragma unroll
            for (int m = 0; m < 4; ++m) { bf16* rowp = base + (size_t)(row0 + ai * 128 + m * 16) * ld + col0;
#pragma unroll
                for (int bj = 0; bj < 2; ++bj) { const pg8::f32x4 v0 = acc[ai][bj][m][0], v1 = acc[ai][bj][m][1];
                    u32x4 w; w.x = pg8::cvt_pk_bf16(v0[0], v0[1]); w.y = pg8::cvt_pk_bf16(v0[2], v0[3]); w.z = pg8::cvt_pk_bf16(v1[0], v1[1]); w.w = pg8::cvt_pk_bf16(v1[2], v1[3]);
                    *(u32x4*)(rowp + bj * 128) = w; } }
    }
};

__device__ __forceinline__ float mixed_val(const bf16* ZA, bool isctx, int t, int col, float mu) {
    const int row = isctx ? SEQ + t : t;
    const bf16* Z = ZA + (size_t)row * 2048;
    int dr; bool ok;
    if (isctx) { const bool ev = (col & 1) == 0; dr = ev ? -1 : 1; ok = ev ? (t > 0) : (t < CTXL - 1); }
    else { const int s = col & 3, gx = t & 63, gy = t >> 6;
        dr = (s == 0) ? -1 : (s == 1) ? 1 : (s == 2) ? -64 : 64;
        ok = (s == 0) ? (gx > 0) : (s == 1) ? (gx < 63) : (s == 2) ? (gy > 0) : (gy < GROWS - 1); }
    const int dsafe = ok ? dr : 0;
    const float z = bf2f(Z[col]);
    const float nbv = bf2f(Z[col + dsafe * 2048]);
    const float nb = ok ? nbv : 0.f;
    return z + mu * (nb - z);
}
__device__ __forceinline__ void mixed8(const bf16* ZA, int t, int col0, const float* mu, float (&o)[8]) {
    const bf16* Z = ZA + (size_t)t * 2048 + col0;
    const int gx = t & 63, gy = t >> 6;
    const u32x4 z = *(const u32x4*)Z;
    const u32x4 zero = (u32x4){0u, 0u, 0u, 0u};
    const u32x4 l = gx > 0 ? *(const u32x4*)(Z - 2048) : zero, r = gx < 63 ? *(const u32x4*)(Z + 2048) : zero;
    const u32x4 up = gy > 0 ? *(const u32x4*)(Z - 64 * 2048) : zero, dn = gy < GROWS - 1 ? *(const u32x4*)(Z + 64 * 2048) : zero;
    const f32x4 m0 = *(const f32x4*)(mu + col0), m1 = *(const f32x4*)(mu + col0 + 4);
    float zz[8], nn[8];
    zz[0] = bflo(z.x); zz[1] = bfhi(z.x); zz[2] = bflo(z.y); zz[3] = bfhi(z.y); zz[4] = bflo(z.z); zz[5] = bfhi(z.z); zz[6] = bflo(z.w); zz[7] = bfhi(z.w);
    nn[0] = bflo(l.x); nn[1] = bfhi(r.x); nn[2] = bflo(up.y); nn[3] = bfhi(dn.y); nn[4] = bflo(l.z); nn[5] = bfhi(r.z); nn[6] = bflo(up.w); nn[7] = bfhi(dn.w);
    const float mm[8] = {m0.x, m0.y, m0.z, m0.w, m1.x, m1.y, m1.z, m1.w};
#pragma unroll
    for (int i = 0; i < 8; ++i) o[i] = zz[i] + mm[i] * (nn[i] - zz[i]);
}

__device__ __forceinline__ void p3_scan_naive(Frame& F, const KArgs& A, int chain) {
    const int d = chain >> 3, h = chain & 7, j = F.lane, c = h * 64 + j, w = F.wave;
    float wup[64], aup[64];
#pragma unroll
    for (int r = 0; r < 64; ++r) { wup[r] = F_w_up[(size_t)(d * 64 + r) * DR + c]; aup[r] = F_a_up[(size_t)(d * 64 + r) * DR + c]; }
    const float w0 = F_w0[d * DR + c], a0 = F_a0[d * DR + c], kkc = F_k_k[c], kac = F_k_a[c];
    const int col_w = 1536 + d * 64 + j, col_a = 1664 + d * 64 + j;
    const float mu_r = F_mu[c], mu_k = F_mu[512 + c], mu_v = F_mu[1024 + c], mu_w = F_mu[col_w], mu_a = F_mu[col_a];
    float S[8];
#pragma unroll
    for (int i = 0; i < 8; ++i) S[i] = 0.f;
    float* Yd = F_Y + (size_t)d * SEQ * DR;
    const int NSTEP = CTXL + SEQ;
    float nr, nk, nv, nwd, nad;
    { const bool ic = true; const int t = d ? CTXL - 1 : 0;
      nr = mixed_val(F_ZA, ic, t, c, mu_r); nk = mixed_val(F_ZA, ic, t, 512 + c, mu_k); nv = mixed_val(F_ZA, ic, t, 1024 + c, mu_v); nwd = mixed_val(F_ZA, ic, t, col_w, mu_w); nad = mixed_val(F_ZA, ic, t, col_a, mu_a); }
    for (int step = 0; step < NSTEP; ++step) {
        const bool isctx = step < CTXL;
        const int t = isctx ? (d ? CTXL - 1 - step : step) : (d ? SEQ - 1 - (step - CTXL) : step - CTXL);
        const float r = nr, k = nk, v = nv, wd = nwd, ad = nad;
        if (step + 1 < NSTEP) { const int s2 = step + 1; const bool ic = s2 < CTXL; const int t2 = ic ? (d ? CTXL - 1 - s2 : s2) : (d ? SEQ - 1 - (s2 - CTXL) : s2 - CTXL);
            nr = mixed_val(F_ZA, ic, t2, c, mu_r); nk = mixed_val(F_ZA, ic, t2, 512 + c, mu_k); nv = mixed_val(F_ZA, ic, t2, 1024 + c, mu_v); nwd = mixed_val(F_ZA, ic, t2, col_w, mu_w); nad = mixed_val(F_ZA, ic, t2, col_a, mu_a); }
        const float twd = tanhf(wd);
        float wl = w0, al = a0;
#pragma unroll
        for (int rr = 0; rr < 64; ++rr) { const float tw = __builtin_bit_cast(float, __builtin_amdgcn_readlane(__builtin_bit_cast(int, twd), rr)); const float ta = __builtin_bit_cast(float, __builtin_amdgcn_readlane(__builtin_bit_cast(int, ad), rr));
            wl += tw * wup[rr]; al += ta * aup[rr]; }
        const float wv = -softplusf_(-wl) - 0.5f, dec = __expf(-__expf(wv)), a = sigmoidf_(al);
        float kk = k * kkc; const float n2 = wave_sum(kk * kk); kk = kk / fmaxf(sqrtf(n2), 1e-12f);
        const float kd = k * (1.0f + (a - 1.0f) * kac), kka = kk * a;
        float yv = 0.f;
#pragma unroll
        for (int i = 0; i < 8; ++i) {
            const float sa = wave_sum(S[i] * kk);
            const float vi = __builtin_bit_cast(float, __builtin_amdgcn_readlane(__builtin_bit_cast(int, v), 8 * w + i));
            S[i] = S[i] * dec - sa * kka + vi * kd;
            const float y = wave_sum(S[i] * r);
            yv = (j == i) ? y : yv;
        }
        if (!isctx && j < 8) Yd[(size_t)t * DR + h * 64 + 8 * w + j] = yv;
    }
}

constexpr int MB_LD = 136;
__device__ __forceinline__ void p3_mixer_b(Frame& F, const KArgs& A, int chunk) {
    LAS float* stats = (LAS float*)F.lds;
    LAS bf16* Wl = (LAS bf16*)(F.lds + 1024);
    LAS bf16* VT = (LAS bf16*)(F.lds + 1024 + 128 * MB_LD * 2);
    const int tok0 = chunk * 128, lane = F.lane, w = F.wave;
    for (int rr = 0; rr < 16; ++rr) {
        const int q = w * 16 + rr;
        const u32x4 raw = *(const u32x4*)(F_ZB + (size_t)(tok0 + q) * 1024 + 512 + 8 * lane);
        float g[8]; g[0] = gelu_tanh(bflo(raw.x)); g[1] = gelu_tanh(bfhi(raw.x)); g[2] = gelu_tanh(bflo(raw.y)); g[3] = gelu_tanh(bfhi(raw.y));
        g[4] = gelu_tanh(bflo(raw.z)); g[5] = gelu_tanh(bfhi(raw.z)); g[6] = gelu_tanh(bflo(raw.w)); g[7] = gelu_tanh(bfhi(raw.w));
        float s = 0.f;
#pragma unroll
        for (int i = 0; i < 8; ++i) s += g[i];
        const float mean = wave_sum(s) * (1.0f / 512.0f); float s2 = 0.f;
#pragma unroll
        for (int i = 0; i < 8; ++i) { const float dlt = g[i] - mean; s2 += dlt * dlt; }
        const float rstd = rsqrtf(wave_sum(s2) * (1.0f / 512.0f) + 1e-5f);
        if (lane == 0) { stats[q * 2] = mean; stats[q * 2 + 1] = rstd; }
    }
    __syncthreads();
    for (int g = 0; g < 4; ++g) {
        for (int i = F.tid; i < 128 * 32; i += 512) { const int p = i >> 5, q4 = (i & 31) * 4; const f32x4 wv = *(const f32x4*)(F_sg_w + (size_t)(g * 128 + p) * 128 + q4);
            u32x2 o; o.x = pk2(wv.x, wv.y); o.y = pk2(wv.z, wv.w); *(LAS u32x2*)(Wl + p * MB_LD + q4) = o; }
        for (int rr = 0; rr < 16; ++rr) {
            const int q = w * 16 + rr; const float mean = stats[q * 2], rstd = stats[q * 2 + 1];
            const unsigned raw = *(const unsigned*)(F_ZB + (size_t)(tok0 + q) * 1024 + 512 + g * 128 + 2 * lane);
            const int c0 = 2 * lane;
            const float v0 = (gelu_tanh(bflo(raw)) - mean) * rstd * F_sg_ln_w[g * 128 + c0] + F_sg_ln_b[g * 128 + c0];
            const float v1 = (gelu_tanh(bfhi(raw)) - mean) * rstd * F_sg_ln_w[g * 128 + c0 + 1] + F_sg_ln_b[g * 128 + c0 + 1];
            VT[c0 * MB_LD + q] = (bf16)f2bf(v0); VT[(c0 + 1) * MB_LD + q] = (bf16)f2bf(v1);
        }
        __syncthreads();
        const int fr = lane & 15, fq = lane >> 4;
        pg8::f32x4 acc[8];
#pragma unroll
        for (int ct = 0; ct < 8; ++ct) acc[ct] = (pg8::f32x4){0.f, 0.f, 0.f, 0.f};
#pragma unroll
        for (int ks = 0; ks < 4; ++ks) {
            const bf16x8 bfrag = *(const LAS bf16x8*)(Wl + (16 * w + fr) * MB_LD + 32 * ks + 8 * fq);
#pragma unroll
            for (int ct = 0; ct < 8; ++ct) { const bf16x8 afrag = *(const LAS bf16x8*)(VT + (16 * ct + fr) * MB_LD + 32 * ks + 8 * fq);
                acc[ct] = __builtin_amdgcn_mfma_f32_16x16x32_bf16(afrag, bfrag, acc[ct], 0, 0, 0); }
        }
        const int p = 16 * w + fr; const float sb = F_sg_b[g * 128 + p];
#pragma unroll
        for (int ct = 0; ct < 8; ++ct) {
            const int c0 = 16 * ct + 4 * fq;
            const u32x2 uraw = *(const u32x2*)(F_ZB + (size_t)(tok0 + p) * 1024 + g * 128 + c0);
            const float u0 = gelu_tanh(bflo(uraw.x)), u1 = gelu_tanh(bfhi(uraw.x)), u2 = gelu_tanh(bflo(uraw.y)), u3 = gelu_tanh(bfhi(uraw.y));
            u32x2 o; o.x = pk2(u0 * (acc[ct][0] + sb), u1 * (acc[ct][1] + sb)); o.y = pk2(u2 * (acc[ct][2] + sb), u3 * (acc[ct][3] + sb));
            *(u32x2*)(F_YB + (size_t)(tok0 + p) * DR + g * 128 + c0) = o;
        }
        __syncthreads();
    }
}

__device__ __forceinline__ void p4_rwkv_out(Frame& F, const KArgs& A) {
    const int gw = blockIdx.x * 8 + F.wave, NGW = F.G * 8, l = F.lane, h = l >> 3;
    for (int t = gw; t < SEQ; t += NGW) {
        float y[8];
        { const f32x4 a0 = *(const f32x4*)(F_Y + (size_t)t * DR + 8 * l), a1 = *(const f32x4*)(F_Y + (size_t)t * DR + 8 * l + 4);
          const f32x4 b0 = *(const f32x4*)(F_Y + (size_t)(SEQ + t) * DR + 8 * l), b1 = *(const f32x4*)(F_Y + (size_t)(SEQ + t) * DR + 8 * l + 4);
          y[0] = a0.x + b0.x; y[1] = a0.y + b0.y; y[2] = a0.z + b0.z; y[3] = a0.w + b0.w; y[4] = a1.x + b1.x; y[5] = a1.y + b1.y; y[6] = a1.z + b1.z; y[7] = a1.w + b1.w; }
        float s = 0.f;
#pragma unroll
        for (int i = 0; i < 8; ++i) s += y[i];
        s += __shfl_xor(s, 1); s += __shfl_xor(s, 2); s += __shfl_xor(s, 4);
        const float mean = s * (1.0f / 64.0f); float s2 = 0.f;
#pragma unroll
        for (int i = 0; i < 8; ++i) { const float dlt = y[i] - mean; s2 += dlt * dlt; }
        s2 += __shfl_xor(s2, 1); s2 += __shfl_xor(s2, 2); s2 += __shfl_xor(s2, 4);
        const float rstd = rsqrtf(s2 * (1.0f / 64.0f) + GN_EPS);
        float r[8], k[8], v[8];
        mixed8(F_ZA, t, 8 * l, F_mu, r); mixed8(F_ZA, t, 512 + 8 * l, F_mu, k); mixed8(F_ZA, t, 1024 + 8 * l, F_mu, v);
        float dp = 0.f;
#pragma unroll
        for (int i = 0; i < 8; ++i) dp += r[i] * k[i] * F_r_k[8 * l + i];
        dp += __shfl_xor(dp, 1); dp += __shfl_xor(dp, 2); dp += __shfl_xor(dp, 4);
        const float sg0 = sigmoidf_(mixed_val(F_ZA, false, t, 1792 + 2 * l, F_mu[1792 + 2 * l])), sg1 = sigmoidf_(mixed_val(F_ZA, false, t, 1793 + 2 * l, F_mu[1793 + 2 * l]));
        float g[8];
#pragma unroll
        for (int i = 0; i < 8; ++i) g[i] = 0.f;
        for (int rr = 0; rr < 64; ++rr) {
            const float s0 = __shfl(sg0, rr), s1 = __shfl(sg1, rr);
            const f32x4 u0 = *(const f32x4*)(F_g_up + (size_t)(2 * rr) * DR + 8 * l), u1 = *(const f32x4*)(F_g_up + (size_t)(2 * rr) * DR + 8 * l + 4);
            const f32x4 w0 = *(const f32x4*)(F_g_up + (size_t)(2 * rr + 1) * DR + 8 * l), w1 = *(const f32x4*)(F_g_up + (size_t)(2 * rr + 1) * DR + 8 * l + 4);
            g[0] += s0 * u0.x + s1 * w0.x; g[1] += s0 * u0.y + s1 * w0.y; g[2] += s0 * u0.z + s1 * w0.z; g[3] += s0 * u0.w + s1 * w0.w;
            g[4] += s0 * u1.x + s1 * w1.x; g[5] += s0 * u1.y + s1 * w1.y; g[6] += s0 * u1.z + s1 * w1.z; g[7] += s0 * u1.w + s1 * w1.w;
        }
        float o[8];
#pragma unroll
        for (int i = 0; i < 8; ++i) { const float yn = (y[i] - mean) * rstd * F_ln_w[8 * l + i] + F_ln_b[8 * l + i]; o[i] = (yn + dp * v[i]) * g[i]; }
        u32x4 pk; pk.x = pk2(o[0], o[1]); pk.y = pk2(o[2], o[3]); pk.z = pk2(o[4], o[5]); pk.w = pk2(o[6], o[7]);
        *(u32x4*)(F_YA + (size_t)t * DR + 8 * l) = pk;
        (void)h;
    }
}

struct SchedStd {
    int nM, nN, G, c;
    __device__ __forceinline__ bool next(int i, pg8::Unit& u) const { const long L = (long)i * G + c; if (L >= (long)nM * nN) return false; static_tile((int)L, nM, nN, u); return true; }
    __device__ __forceinline__ void a_ready(const pg8::Unit&) const {}
    __device__ __forceinline__ void done(const pg8::Unit&) const {}
};
__device__ __forceinline__ void sig8(const bf16* p, float (&o)[8]) {
    const u32x4 raw = *(const u32x4*)p;
    o[0] = sigmoidf_(bflo(raw.x)); o[1] = sigmoidf_(bfhi(raw.x)); o[2] = sigmoidf_(bflo(raw.y)); o[3] = sigmoidf_(bfhi(raw.y));
    o[4] = sigmoidf_(bflo(raw.z)); o[5] = sigmoidf_(bfhi(raw.z)); o[6] = sigmoidf_(bflo(raw.w)); o[7] = sigmoidf_(bfhi(raw.w));
}
struct EpiMergeA {
    static constexpr bool PERM = true, AFTER_DRAIN = false;
    float* T; const bf16* ZG;
    __device__ __forceinline__ void operator()(const pg8::f32x4 (&acc)[2][2][4][2], const pg8::Unit& u, int wr, int wc, int fr, int fq) const {
        const int row0 = u.pm * 256 + wr * 64 + fr, col0 = u.pn * 256 + wc * 32 + 8 * fq;
#pragma unroll
        for (int ai = 0; ai < 2; ++ai)
#pragma unroll
            for (int m = 0; m < 4; ++m) { const size_t row = (size_t)(row0 + ai * 128 + m * 16);
#pragma unroll
                for (int bj = 0; bj < 2; ++bj) { const int col = col0 + bj * 128; float gt[8]; sig8(ZG + row * 2048 + col, gt);
                    const pg8::f32x4 v0 = acc[ai][bj][m][0], v1 = acc[ai][bj][m][1];
                    *(f32x4*)(T + row * D + col) = (f32x4){gt[0] * v0[0], gt[1] * v0[1], gt[2] * v0[2], gt[3] * v0[3]};
                    *(f32x4*)(T + row * D + col + 4) = (f32x4){gt[4] * v1[0], gt[5] * v1[1], gt[6] * v1[2], gt[7] * v1[3]}; } }
    }
};
struct EpiMergeB {
    static constexpr bool PERM = true, AFTER_DRAIN = false;
    const float* T; const bf16* ZG; bf16* MG;
    __device__ __forceinline__ void operator()(const pg8::f32x4 (&acc)[2][2][4][2], const pg8::Unit& u, int wr, int wc, int fr, int fq) const {
        const int row0 = u.pm * 256 + wr * 64 + fr, col0 = u.pn * 256 + wc * 32 + 8 * fq;
#pragma unroll
        for (int ai = 0; ai < 2; ++ai)
#pragma unroll
            for (int m = 0; m < 4; ++m) { const size_t row = (size_t)(row0 + ai * 128 + m * 16);
#pragma unroll
                for (int bj = 0; bj < 2; ++bj) { const int col = col0 + bj * 128; float gt[8]; sig8(ZG + row * 2048 + 1024 + col, gt);
                    const pg8::f32x4 v0 = acc[ai][bj][m][0], v1 = acc[ai][bj][m][1];
                    const f32x4 t0 = *(const f32x4*)(T + row * D + col), t1 = *(const f32x4*)(T + row * D + col + 4);
                    u32x4 w; w.x = pk2(t0.x + gt[0] * v0[0], t0.y + gt[1] * v0[1]); w.y = pk2(t0.z + gt[2] * v0[2], t0.w + gt[3] * v0[3]);
                    w.z = pk2(t1.x + gt[4] * v1[0], t1.y + gt[5] * v1[1]); w.w = pk2(t1.z + gt[6] * v1[2], t1.w + gt[7] * v1[3]);
                    *(u32x4*)(MG + row * D + col) = w; } }
    }
};
struct EpiX1 {
    static constexpr bool PERM = false, AFTER_DRAIN = false;
    const float* x; const float* gt1; float* out;
    __device__ __forceinline__ void operator()(const pg8::f32x4 (&acc)[2][2][4][2], const pg8::Unit& u, int wr, int wc, int fr, int fq) const {
        const int row0 = u.pm * 256 + wr * 64 + fr, col0 = u.pn * 256 + wc * 32 + 4 * fq;
#pragma unroll
        for (int ai = 0; ai < 2; ++ai)
#pragma unroll
            for (int m = 0; m < 4; ++m) { const size_t row = (size_t)(row0 + ai * 128 + m * 16);
#pragma unroll
                for (int bj = 0; bj < 2; ++bj)
#pragma unroll
                    for (int n = 0; n < 2; ++n) { const int col = col0 + bj * 128 + n * 16;
                        const f32x4 xv = *(const f32x4*)(x + row * D + col), gv = *(const f32x4*)(gt1 + col); const pg8::f32x4 a = acc[ai][bj][m][n];
                        *(f32x4*)(out + row * D + col) = (f32x4){xv.x + gv.x * a[0], xv.y + gv.y * a[1], xv.z + gv.z * a[2], xv.w + gv.w * a[3]}; } }
    }
};

__device__ __forceinline__ void p7_router(Frame& F, const KArgs& A) {
    const int gw = blockIdx.x * 8 + F.wave, NGW = F.G * 8, lane = F.lane;
    const float* mod = F_MOD;
    for (int t = gw; t < SEQ; t += NGW) {
        const float* src = F_out + (size_t)t * D;
        float ss = 0.f;
#pragma unroll
        for (int j = 0; j < 4; ++j) { const f32x4 vv = ((const f32x4*)src)[lane + 64 * j]; ss += (vv.x * vv.x + vv.y * vv.y) + (vv.z * vv.z + vv.w * vv.w); }
        const float rinv = rsqrtf(wave_sum(ss) * (1.0f / D) + NORM_EPS);
        float lg[36];
#pragma unroll
        for (int e = 0; e < 36; ++e) lg[e] = 0.f;
#pragma unroll 1
        for (int j = 0; j < 4; ++j) {
            const f32x4 vv = ((const f32x4*)src)[lane + 64 * j];
            const f32x4 gg = ((const f32x4*)F_norm2_g)[lane + 64 * j], s1 = ((const f32x4*)(mod + 4096))[lane + 64 * j], s0 = ((const f32x4*)(mod + 3072))[lane + 64 * j];
            const f32x4 hv = (vv * rinv * gg) * (1.0f + s1) + s0;
            u32x2 o; o.x = pk2(hv.x, hv.y); o.y = pk2(hv.z, hv.w);
            ((u32x2*)(F_H + (size_t)t * D))[lane + 64 * j] = o;
            const int k0 = (lane + 64 * j) * 4;
#pragma unroll 1
            for (int i = 0; i < 4; ++i) {
                const float hh = (i == 0) ? hv.x : (i == 1) ? hv.y : (i == 2) ? hv.z : hv.w;
                const f32x4 gwv = *(const f32x4*)(F_grp_w + (size_t)(k0 + i) * 4);
                lg[0] += hh * gwv.x; lg[1] += hh * gwv.y; lg[2] += hh * gwv.z; lg[3] += hh * gwv.w;
#pragma unroll
                for (int q = 0; q < 8; ++q) { const f32x4 ew = *(const f32x4*)(F_exp_w + (size_t)(k0 + i) * 32 + 4 * q);
                    lg[4 + 4 * q] += hh * ew.x; lg[5 + 4 * q] += hh * ew.y; lg[6 + 4 * q] += hh * ew.z; lg[7 + 4 * q] += hh * ew.w; }
            }
        }
#pragma unroll
        for (int e = 0; e < 36; ++e) lg[e] = wave_sum(lg[e]);
        if (lane == 0) {
            float gl[4]; int grp = 0;
#pragma unroll
            for (int q = 0; q < 4; ++q) gl[q] = lg[q] + F_grp_b[q];
#pragma unroll
            for (int q = 1; q < 4; ++q) if (gl[q] > gl[grp]) grp = q;
            float den = 0.f;
#pragma unroll
            for (int q = 0; q < 4; ++q) den += __expf(gl[q] - gl[grp]);
            const float pg = 1.0f / den;
            float el[8];
#pragma unroll
            for (int q = 0; q < 8; ++q) { float val = 0.f;
#pragma unroll
                for (int gq = 0; gq < 4; ++gq) val = (grp == gq) ? lg[4 + gq * 8 + q] + F_exp_b[gq * 8 + q] : val;
                el[q] = val; }
            int i1 = 0;
#pragma unroll
            for (int q = 1; q < 8; ++q) if (el[q] > el[i1]) i1 = q;
            int i2 = (i1 == 0) ? 1 : 0;
#pragma unroll
            for (int q = 0; q < 8; ++q) if (q != i1 && el[q] > el[i2]) i2 = q;
            const float v1 = el[i1], v2 = el[i2];
            const float e2 = __expf(v2 - v1), w1 = pg / (1.0f + e2), w2 = pg * e2 / (1.0f + e2);
            const int e1x = grp * 8 + i1, e2x = grp * 8 + i2;
            const unsigned p1 = atomicAdd(F.ctl + CW_CNT + 64 * e1x, 1u), p2 = atomicAdd(F.ctl + CW_CNT + 64 * e2x, 1u);
            unsigned* rt = F_route + (size_t)t * 8;
            rt[0] = (unsigned)e1x; rt[1] = p1; rt[2] = __builtin_bit_cast(unsigned, w1); rt[3] = (unsigned)e2x; rt[4] = p2; rt[5] = __builtin_bit_cast(unsigned, w2);
        }
    }
    LAS float* scr = (LAS float*)(F.lds + F.wave * 16384);
    for (int it = gw; it < NEXP * 768; it += NGW) {
        const int e = it / 768; int r = it % 768;
        if (r < 512) { const bool up = r >= 256; r &= 255; const int kb = r / 16, nb = r % 16, n0 = 32 * nb;
            const float* W = (up ? F_wu : F_wg) + (size_t)e * D * DEXP;
            transpose_item(W, D, DEXP, 64 * kb, n0, F_WguT + (size_t)e * 1024 * D, 256 * (n0 >> 7) + (up ? 128 : 0) + (n0 & 127), scr, lane);
        } else { r -= 512; const int kb = r / 32, nb = r % 32;
            transpose_item(F_wd + (size_t)e * DEXP * D, DEXP, D, 64 * kb, 32 * nb, F_WdT + (size_t)e * 1024 * DEXP, 32 * nb, scr, lane); }
    }
}

__device__ __forceinline__ int moe_tables(Frame& F, const KArgs& A) {
    LAS int* tab = (LAS int*)(F.lds + TAB_OFF);
    __syncthreads();
    if (F.tid == 0) {
        int off = 0;
        for (int e = 0; e < NEXP; ++e) { const int cnt = (int)__hip_atomic_load(F.ctl + CW_CNT + 64 * e, __ATOMIC_RELAXED, __HIP_MEMORY_SCOPE_AGENT); const int nt = (cnt + 255) >> 8;
            tab[e] = off * 256; tab[64 + e] = cnt; for (int q = 0; q < nt && off + q < MAXTILES; ++q) tab[128 + off + q] = e; off += nt; }
        tab[32] = off < MAXTILES ? off : MAXTILES;
    }
    __syncthreads();
    return tab[32];
}

__device__ __forceinline__ void p8_gather(Frame& F, const KArgs& A) {
    const int ntiles = moe_tables(F, A);
    LAS int* tab = (LAS int*)(F.lds + TAB_OFF);
    const int gw = blockIdx.x * 8 + F.wave, NGW = F.G * 8, lane = F.lane;
    for (int t = gw; t < SEQ; t += NGW) {
        const unsigned* rt = F_route + (size_t)t * 8;
        const u32x4 h0 = ((const u32x4*)(F_H + (size_t)t * D))[lane], h1 = ((const u32x4*)(F_H + (size_t)t * D))[lane + 64];
#pragma unroll
        for (int s = 0; s < 2; ++s) {
            const int e = (int)rt[3 * s], pos = (int)rt[3 * s + 1]; const int row = tab[e] + pos;
            if (row < MAXTILES * 256) {
                ((u32x4*)(F_XG + (size_t)row * D))[lane] = h0; ((u32x4*)(F_XG + (size_t)row * D))[lane + 64] = h1;
                if (lane == 0) { F_rowinfo[row] = 2 * t + s; F_roww[row] = __builtin_bit_cast(float, rt[3 * s + 2]); }
            }
        }
    }
    for (int e = blockIdx.x; e < NEXP; e += F.G) {
        const int cnt = tab[64 + e], r0 = tab[e] + cnt, r1 = tab[e] + (((cnt + 255) >> 8) << 8);
        for (int row = r0 + F.wave; row < r1 && row < MAXTILES * 256; row += 8) {
            ((u32x4*)(F_XG + (size_t)row * D))[lane] = (u32x4){0u, 0u, 0u, 0u}; ((u32x4*)(F_XG + (size_t)row * D))[lane + 64] = (u32x4){0u, 0u, 0u, 0u};
            if (lane == 0) { F_rowinfo[row] = -1; F_roww[row] = 0.f; }
        }
    }
    (void)ntiles;
}

struct MoeOrder {
    const LAS int* tile_e; int T4, G, c;
    __device__ __forceinline__ bool next(int i, pg8::Unit& u) const { const long L = (long)i * G + c; if (L >= T4) return false; const int rt = (int)(L >> 2), j = (int)(L & 3); u.pm = rt; u.pn = tile_e[rt] * 4 + j; return true; }
    __device__ __forceinline__ void a_ready(const pg8::Unit&) const {}
    __device__ __forceinline__ void done(const pg8::Unit&) const {}
};
struct EpiSwiGLU {
    static constexpr bool PERM = true, AFTER_DRAIN = false;
    bf16* HM;
    __device__ __forceinline__ void operator()(const pg8::f32x4 (&acc)[2][2][4][2], const pg8::Unit& u, int wr, int wc, int fr, int fq) const {
        const int row0 = u.pm * 256 + wr * 64 + fr, col0 = (u.pn & 3) * 128 + wc * 32 + 8 * fq;
#pragma unroll
        for (int ai = 0; ai < 2; ++ai)
#pragma unroll
            for (int m = 0; m < 4; ++m) { const size_t row = (size_t)(row0 + ai * 128 + m * 16);
                const pg8::f32x4 g0 = acc[ai][0][m][0], g1 = acc[ai][0][m][1], u0 = acc[ai][1][m][0], u1 = acc[ai][1][m][1];
                u32x4 w; w.x = pk2(siluf_(g0[0]) * u0[0], siluf_(g0[1]) * u0[1]); w.y = pk2(siluf_(g0[2]) * u0[2], siluf_(g0[3]) * u0[3]);
                w.z = pk2(siluf_(g1[0]) * u1[0], siluf_(g1[1]) * u1[1]); w.w = pk2(siluf_(g1[2]) * u1[2], siluf_(g1[3]) * u1[3]);
                *(u32x4*)(HM + row * DEXP + col0) = w; }
    }
};
struct EpiScatter {
    static constexpr bool PERM = true, AFTER_DRAIN = false;
    bf16* YBUF; const int* rowinfo; const float* roww;
    __device__ __forceinline__ void operator()(const pg8::f32x4 (&acc)[2][2][4][2], const pg8::Unit& u, int wr, int wc, int fr, int fq) const {
        const int row0 = u.pm * 256 + wr * 64 + fr, col0 = (u.pn & 3) * 256 + wc * 32 + 8 * fq;
#pragma unroll
        for (int ai = 0; ai < 2; ++ai)
#pragma unroll
            for (int m = 0; m < 4; ++m) { const int row = row0 + ai * 128 + m * 16; const int info = rowinfo[row]; const float wt = roww[row];
                if (info >= 0) {
#pragma unroll
                    for (int bj = 0; bj < 2; ++bj) { const pg8::f32x4 v0 = acc[ai][bj][m][0], v1 = acc[ai][bj][m][1];
                        u32x4 w; w.x = pk2(wt * v0[0], wt * v0[1]); w.y = pk2(wt * v0[2], wt * v0[3]); w.z = pk2(wt * v1[0], wt * v1[1]); w.w = pk2(wt * v1[2], wt * v1[3]);
                        *(u32x4*)(YBUF + (size_t)info * D + col0 + bj * 128) = w; } } }
    }
};

__device__ __forceinline__ void p11_final(Frame& F, const KArgs& A) {
    const int gw = blockIdx.x * 8 + F.wave, NGW = F.G * 8, lane = F.lane;
    const float* gt2 = F_MOD + 5120;
    for (int t = gw; t < SEQ; t += NGW) {
        float* row = F_out + (size_t)t * D;
        f32x4 v[4]; float ss = 0.f;
#pragma unroll
        for (int j = 0; j < 4; ++j) {
            const f32x4 x1 = ((const f32x4*)row)[lane + 64 * j], g2 = ((const f32x4*)gt2)[lane + 64 * j];
            const u32x2 y0 = ((const u32x2*)(F_YBUF + (size_t)(2 * t) * D))[lane + 64 * j], y1 = ((const u32x2*)(F_YBUF + (size_t)(2 * t + 1) * D))[lane + 64 * j];
            f32x4 ys; ys.x = bflo(y0.x) + bflo(y1.x); ys.y = bfhi(y0.x) + bfhi(y1.x); ys.z = bflo(y0.y) + bflo(y1.y); ys.w = bfhi(y0.y) + bfhi(y1.y);
            v[j] = x1 + g2 * ys;
            ss += (v[j].x * v[j].x + v[j].y * v[j].y) + (v[j].z * v[j].z + v[j].w * v[j].w);
        }
        const float rinv = rsqrtf(wave_sum(ss) * (1.0f / D) + NORM_EPS);
#pragma unroll
        for (int j = 0; j < 4; ++j) { const f32x4 fg = ((const f32x4*)F_fin_g)[lane + 64 * j]; ((f32x4*)row)[lane + 64 * j] = v[j] * rinv * fg; }
    }
}


constexpr int SL = 8192;
constexpr int SC_LBUF = 12 * SL;
constexpr int SC_MISC = 19 * SL;

__device__ __forceinline__ int m_off(int r, int c) { return r * 128 + ((((c >> 3) ^ r) & 7) << 4) + ((c & 7) << 1); }
__device__ __forceinline__ int frag_off(int r, int chunk) { return r * 128 + (((chunk ^ r) & 7) << 4); }
__device__ __forceinline__ float tanh_fast(float x) { const float e = __expf(2.0f * x); return 1.0f - 2.0f / (e + 1.0f); }

template <bool SWAP> __device__ __forceinline__ void mm_tiles(const LAS unsigned char* X, const LAS unsigned char* Y, int mt, int nt0, int fr, int fq, pg8::f32x4 (&acc)[2]) {
#pragma unroll
    for (int ks = 0; ks < 2; ++ks) {
        const bf16x8 xf = *(const LAS bf16x8*)(X + frag_off(16 * mt + fr, 4 * ks + fq));
#pragma unroll
        for (int n = 0; n < 2; ++n) {
            const bf16x8 yf = *(const LAS bf16x8*)(Y + frag_off(16 * (nt0 + n) + fr, 4 * ks + fq));
            acc[n] = SWAP ? __builtin_amdgcn_mfma_f32_16x16x32_bf16(yf, xf, acc[n], 0, 0, 0) : __builtin_amdgcn_mfma_f32_16x16x32_bf16(xf, yf, acc[n], 0, 0, 0);
        }
    }
}
__device__ __forceinline__ void st4(LAS unsigned char* slot, int r, int c, float a, float b, float cc, float d) { u32x2 o; o.x = pk2(a, b); o.y = pk2(cc, d); *(LAS u32x2*)(slot + m_off(r, c)) = o; }
__device__ __forceinline__ pg8::f32x4 ld4(const LAS unsigned char* slot, int r, int c) { const u32x2 w = *(const LAS u32x2*)(slot + m_off(r, c)); return (pg8::f32x4){bflo(w.x), bfhi(w.x), bflo(w.y), bfhi(w.y)}; }
__device__ __forceinline__ int opq(int x) { asm volatile("" : "+v"(x)); return x; }
#define ZERO2(a) do { a[0] = (pg8::f32x4){0.f, 0.f, 0.f, 0.f}; a[1] = (pg8::f32x4){0.f, 0.f, 0.f, 0.f}; } while (0)

__device__ __forceinline__ void mix8(const bf16* Z, int col0, const float* mu, int dl, int dr, int du, int dd, bool okl, bool okr, bool oku, bool okd, float (&o)[8]) {
    const u32x4 z = *(const u32x4*)(Z + col0);
    const u32x4 l = *(const u32x4*)(Z + col0 + dl * 2048), r = *(const u32x4*)(Z + col0 + dr * 2048), up = *(const u32x4*)(Z + col0 + du * 2048), dn = *(const u32x4*)(Z + col0 + dd * 2048);
    const f32x4 m0 = *(const f32x4*)(mu + col0), m1 = *(const f32x4*)(mu + col0 + 4);
    float zz[8], nn[8];
    zz[0] = bflo(z.x); zz[1] = bfhi(z.x); zz[2] = bflo(z.y); zz[3] = bfhi(z.y); zz[4] = bflo(z.z); zz[5] = bfhi(z.z); zz[6] = bflo(z.w); zz[7] = bfhi(z.w);
    nn[0] = okl ? bflo(l.x) : 0.f; nn[1] = okr ? bfhi(r.x) : 0.f; nn[2] = oku ? bflo(up.y) : 0.f; nn[3] = okd ? bfhi(dn.y) : 0.f;
    nn[4] = okl ? bflo(l.z) : 0.f; nn[5] = okr ? bfhi(r.z) : 0.f; nn[6] = oku ? bflo(up.w) : 0.f; nn[7] = okd ? bfhi(dn.w) : 0.f;
    const float mm[8] = {m0.x, m0.y, m0.z, m0.w, m1.x, m1.y, m1.z, m1.w};
#pragma unroll
    for (int i = 0; i < 8; ++i) o[i] = zz[i] + mm[i] * (nn[i] - zz[i]);
}
__device__ __forceinline__ void mix4(const bf16* Z, int col0, const float* mu, int dl, int dr, int du, int dd, bool okl, bool okr, bool oku, bool okd, float (&o)[4]) {
    const u32x2 z = *(const u32x2*)(Z + col0);
    const u32x2 l = *(const u32x2*)(Z + col0 + dl * 2048), r = *(const u32x2*)(Z + col0 + dr * 2048), up = *(const u32x2*)(Z + col0 + du * 2048), dn = *(const u32x2*)(Z + col0 + dd * 2048);
    const f32x4 m0 = *(const f32x4*)(mu + col0);
    const float zz[4] = {bflo(z.x), bfhi(z.x), bflo(z.y), bfhi(z.y)};
    const float nn[4] = {okl ? bflo(l.x) : 0.f, okr ? bfhi(r.x) : 0.f, oku ? bflo(up.y) : 0.f, okd ? bfhi(dn.y) : 0.f};
    const float mm[4] = {m0.x, m0.y, m0.z, m0.w};
#pragma unroll
    for (int i = 0; i < 4; ++i) o[i] = zz[i] + mm[i] * (nn[i] - zz[i]);
}

__device__ __forceinline__ void scan_pass1_unit(Frame& F, const KArgs& A, int chain, int scidx) {
    const int d = chain >> 3, h = chain & 7, tid = F.tid, lane = F.lane, w = F.wave, fr = lane & 15, fq = lane >> 4, mt = w >> 1, nt0 = 2 * (w & 1);
    LAS unsigned char* const L = F.lds;
#define S_(i) (L + opq((i) * SL))
    const bool isctx = (scidx == 0); const int sc = scidx - 1;
    const bf16* ZA = F_ZA; const float* mu = F_mu;
    { const int r = tid >> 3, ch = tid & 7; u32x4 idv = (u32x4){0u, 0u, 0u, 0u};
      if ((r >> 3) == ch) { const unsigned one = 0x3f80u; const int e = r & 7; if (e == 0) idv.x = one; else if (e == 1) idv.x = one << 16; else if (e == 2) idv.y = one; else if (e == 3) idv.y = one << 16; else if (e == 4) idv.z = one; else if (e == 5) idv.z = one << 16; else if (e == 6) idv.w = one; else idv.w = one << 16; }
      *(LAS u32x4*)(S_(14) + frag_off(r, ch)) = idv; *(LAS u32x4*)(S_(16) + frag_off(r, ch)) = (u32x4){0u, 0u, 0u, 0u}; }
    int ppc = 14, qpc = 16;
    for (int j = 0; j < 4; ++j) {
        const int ppn = ppc ^ 1, qpn = qpc ^ 1;
        const int t = tid >> 3, cg = tid & 7, x = d ? 63 - t : t;
        int tokchunk; const bf16* Z; int dl, dr, du, dd; bool okl, okr, oku, okd;
        if (isctx) { tokchunk = d ? 3 - j : j; const int tc = tokchunk * 64 + x; Z = ZA + (size_t)(SEQ + tc) * 2048; okl = tc > 0; okr = tc < CTXL - 1; oku = okl; okd = okr; dl = okl ? -1 : 0; dr = okr ? 1 : 0; du = dl; dd = dr; }
        else { tokchunk = d ? 255 - (4 * sc + j) : 4 * sc + j; const int tok = tokchunk * 64 + x; Z = ZA + (size_t)tok * 2048; okl = x > 0; okr = x < 63; oku = tokchunk > 0; okd = tokchunk < GROWS - 1; dl = okl ? -1 : 0; dr = okr ? 1 : 0; du = oku ? -64 : 0; dd = okd ? 64 : 0; }
        float rv[8], kv[8];
        {
            float vv[8], wdv[8], adv[8];
            mix8(Z, h * 64 + 8 * cg, mu, dl, dr, du, dd, okl, okr, oku, okd, rv);
            mix8(Z, 512 + h * 64 + 8 * cg, mu, dl, dr, du, dd, okl, okr, oku, okd, kv);
            mix8(Z, 1024 + h * 64 + 8 * cg, mu, dl, dr, du, dd, okl, okr, oku, okd, vv);
            mix8(Z, 1536 + d * 64 + 8 * cg, mu, dl, dr, du, dd, okl, okr, oku, okd, wdv);
            mix8(Z, 1664 + d * 64 + 8 * cg, mu, dl, dr, du, dd, okl, okr, oku, okd, adv);
#pragma unroll
            for (int i = 0; i < 8; ++i) *(LAS bf16*)(S_(7) + m_off(8 * cg + i, t)) = (bf16)f2bf(vv[i]);
            u32x4 o; o.x = pk2(tanh_fast(wdv[0]), tanh_fast(wdv[1])); o.y = pk2(tanh_fast(wdv[2]), tanh_fast(wdv[3])); o.z = pk2(tanh_fast(wdv[4]), tanh_fast(wdv[5])); o.w = pk2(tanh_fast(wdv[6]), tanh_fast(wdv[7]));
            *(LAS u32x4*)(S_(8) + frag_off(t, cg)) = o;
            o.x = pk2(adv[0], adv[1]); o.y = pk2(adv[2], adv[3]); o.z = pk2(adv[4], adv[5]); o.w = pk2(adv[6], adv[7]);
            *(LAS u32x4*)(S_(9) + frag_off(t, cg)) = o;
            const bf16* wt = (const bf16*)(A.ws() + WS_WUPT) + (size_t)chain * 4096, *at = (const bf16*)(A.ws() + WS_AUPT) + (size_t)chain * 4096;
            *(LAS u32x4*)(S_(10) + frag_off(t, cg)) = *(const u32x4*)(wt + t * 64 + 8 * cg);
            *(LAS u32x4*)(S_(11) + frag_off(t, cg)) = *(const u32x4*)(at + t * 64 + 8 * cg);
        }
        __syncthreads();
        {
            pg8::f32x4 acw[2], aca[2]; ZERO2(acw); ZERO2(aca);
            mm_tiles<true>(S_(8), S_(10), mt, nt0, fr, fq, acw);
            mm_tiles<true>(S_(9), S_(11), mt, nt0, fr, fq, aca);
            const int row = 16 * mt + fr;
#pragma unroll
            for (int n = 0; n < 2; ++n) { const int c0 = 16 * (nt0 + n) + 4 * fq;
                const f32x4 w0v = *(const f32x4*)(F_w0 + d * DR + h * 64 + c0), a0v = *(const f32x4*)(F_a0 + d * DR + h * 64 + c0);
                f32x4 ld; float aa[4];
#pragma unroll
                for (int i = 0; i < 4; ++i) { const float xw = acw[n][i] + w0v[i]; const float wv = -softplusf_(-xw) - 0.5f; ld[i] = -__expf(wv); aa[i] = sigmoidf_(aca[n][i] + a0v[i]); }
                *(LAS f32x4*)(L + opq(SC_LBUF) + (row * 64 + c0) * 4) = ld;
                st4(S_(18), row, c0, aa[0], aa[1], aa[2], aa[3]); }
        }
        __syncthreads();
        {
            const int c = tid & 63, seg = tid >> 6; LAS float* lb = (LAS float*)(L + opq(SC_LBUF)); LAS float* segtot = (LAS float*)(L + opq(SC_MISC));
            float run = 0.f, loc[8];
#pragma unroll
            for (int i = 0; i < 8; ++i) { run += lb[(8 * seg + i) * 64 + c]; loc[i] = run; }
            segtot[seg * 64 + c] = run;
            __syncthreads();
            float off = 0.f;
#pragma unroll
            for (int s = 0; s < 8; ++s) off += (s < seg) ? segtot[s * 64 + c] : 0.f;
#pragma unroll
            for (int i = 0; i < 8; ++i) lb[(8 * seg + i) * 64 + c] = loc[i] + off;
        }
        __syncthreads();
        {
            const LAS float* lb = (const LAS float*)(L + opq(SC_LBUF));
            float Lt[8], Lp[8], LC[8], av[8];
            { const f32x4 a0 = *(const LAS f32x4*)(lb + t * 64 + 8 * cg), a1 = *(const LAS f32x4*)(lb + t * 64 + 8 * cg + 4);
              const int tp = t > 0 ? t - 1 : 0; const f32x4 b0 = *(const LAS f32x4*)(lb + tp * 64 + 8 * cg), b1 = *(const LAS f32x4*)(lb + tp * 64 + 8 * cg + 4);
              const f32x4 c0 = *(const LAS f32x4*)(lb + 63 * 64 + 8 * cg), c1 = *(const LAS f32x4*)(lb + 63 * 64 + 8 * cg + 4);
#pragma unroll
              for (int i = 0; i < 4; ++i) { Lt[i] = a0[i]; Lt[4 + i] = a1[i]; Lp[i] = t > 0 ? b0[i] : 0.f; Lp[4 + i] = t > 0 ? b1[i] : 0.f; LC[i] = c0[i]; LC[4 + i] = c1[i]; }
              const u32x4 aw = *(const LAS u32x4*)(S_(18) + frag_off(t, cg));
              av[0] = bflo(aw.x); av[1] = bfhi(aw.x); av[2] = bflo(aw.y); av[3] = bfhi(aw.y); av[4] = bflo(aw.z); av[5] = bfhi(aw.z); av[6] = bflo(aw.w); av[7] = bfhi(aw.w); }
            const int cb = h * 64 + 8 * cg;
            const f32x4 kk0 = *(const f32x4*)(F_k_k + cb), kk1 = *(const f32x4*)(F_k_k + cb + 4), ka0 = *(const f32x4*)(F_k_a + cb), ka1 = *(const f32x4*)(F_k_a + cb + 4);
            const float kkc[8] = {kk0.x, kk0.y, kk0.z, kk0.w, kk1.x, kk1.y, kk1.z, kk1.w}, kac[8] = {ka0.x, ka0.y, ka0.z, ka0.w, ka1.x, ka1.y, ka1.z, ka1.w};
            float kkv[8], n2 = 0.f;
#pragma unroll
            for (int i = 0; i < 8; ++i) { kkv[i] = kv[i] * kkc[i]; n2 += kkv[i] * kkv[i]; }
            n2 += __shfl_xor(n2, 1); n2 += __shfl_xor(n2, 2); n2 += __shfl_xor(n2, 4);
            const float inv = 1.0f / fmaxf(sqrtf(n2), 1e-12f);
            float kb[8], rb[8], ah[8], kh[8], ahc[8], khc[8];
#pragma unroll
            for (int i = 0; i < 8; ++i) { const float kk = kkv[i] * inv, al = kk * av[i], kt = kv[i] * (1.0f + (av[i] - 1.0f) * kac[i]);
                const float ep = __expf(Lp[i]), et = __expf(Lt[i]), en = __expf(-Lt[i]), ec = __expf(LC[i] - Lt[i]);
                kb[i] = kk * ep; rb[i] = rv[i] * et; ah[i] = al * en; kh[i] = kt * en; ahc[i] = al * ec; khc[i] = kt * ec; }
            u32x4 o;
            o.x = pk2(kb[0], kb[1]); o.y = pk2(kb[2], kb[3]); o.z = pk2(kb[4], kb[5]); o.w = pk2(kb[6], kb[7]); *(LAS u32x4*)(S_(0) + frag_off(t, cg)) = o;
            o.x = pk2(rb[0], rb[1]); o.y = pk2(rb[2], rb[3]); o.z = pk2(rb[4], rb[5]); o.w = pk2(rb[6], rb[7]); *(LAS u32x4*)(S_(1) + frag_off(t, cg)) = o;
            o.x = pk2(ah[0], ah[1]); o.y = pk2(ah[2], ah[3]); o.z = pk2(ah[4], ah[5]); o.w = pk2(ah[6], ah[7]); *(LAS u32x4*)(S_(2) + frag_off(t, cg)) = o;
            o.x = pk2(kh[0], kh[1]); o.y = pk2(kh[2], kh[3]); o.z = pk2(kh[4], kh[5]); o.w = pk2(kh[6], kh[7]); *(LAS u32x4*)(S_(3) + frag_off(t, cg)) = o;
#pragma unroll
            for (int i = 0; i < 8; ++i) { *(LAS bf16*)(S_(4) + m_off(8 * cg + i, t)) = (bf16)f2bf(kb[i]); *(LAS bf16*)(S_(5) + m_off(8 * cg + i, t)) = (bf16)f2bf(ahc[i]); *(LAS bf16*)(S_(6) + m_off(8 * cg + i, t)) = (bf16)f2bf(khc[i]); }
            if (t == 0) { LAS float* gam = (LAS float*)(L + opq(SC_MISC) + 2048);
#pragma unroll
                for (int i = 0; i < 8; ++i) gam[8 * cg + i] = __expf(LC[i]); }
        }
        __syncthreads();
        {
            pg8::f32x4 a1[2], a2[2]; ZERO2(a1); ZERO2(a2);
            mm_tiles<true>(S_(0), S_(2), mt, nt0, fr, fq, a1);
            mm_tiles<false>(S_(0), S_(2), mt, nt0, fr, fq, a2);
#pragma unroll
            for (int n = 0; n < 2; ++n) {
                { const int tt = 16 * mt + fr, s0 = 16 * (nt0 + n) + 4 * fq; float m[4], t0[4];
#pragma unroll
                  for (int i = 0; i < 4; ++i) { m[i] = (s0 + i < tt) ? -a1[n][i] : 0.f; t0[i] = m[i] + ((s0 + i == tt) ? 1.0f : 0.f); }
                  st4(S_(8), tt, s0, m[0], m[1], m[2], m[3]); st4(S_(18), tt, s0, t0[0], t0[1], t0[2], t0[3]); }
                { const int t0r = 16 * mt + 4 * fq, ss = 16 * (nt0 + n) + fr; float m[4];
#pragma unroll
                  for (int i = 0; i < 4; ++i) m[i] = (ss < t0r + i) ? -a2[n][i] : 0.f;
                  st4(S_(9), ss, t0r, m[0], m[1], m[2], m[3]); }
            }
            ZERO2(a1); ZERO2(a2);
            mm_tiles<true>(S_(0), S_(3), mt, nt0, fr, fq, a1);
            mm_tiles<true>(S_(1), S_(2), mt, nt0, fr, fq, a2);
            pg8::f32x4 a3[2]; ZERO2(a3);
            mm_tiles<true>(S_(1), S_(3), mt, nt0, fr, fq, a3);
#pragma unroll
            for (int n = 0; n < 2; ++n) { const int tt = 16 * mt + fr, s0 = 16 * (nt0 + n) + 4 * fq; float u[4], v2[4], v3[4];
#pragma unroll
                for (int i = 0; i < 4; ++i) { u[i] = (s0 + i < tt) ? a1[n][i] : 0.f; v2[i] = (s0 + i <= tt) ? a2[n][i] : 0.f; v3[i] = (s0 + i <= tt) ? a3[n][i] : 0.f; }
                st4(S_(10), tt, s0, u[0], u[1], u[2], u[3]); st4(S_(11), tt, s0, v2[0], v2[1], v2[2], v2[3]); st4(S_(12), tt, s0, v3[0], v3[1], v3[2], v3[3]); }
        }
        __syncthreads();
        {
            pg8::f32x4 a1[2], a2[2], a3[2]; ZERO2(a1); ZERO2(a2); ZERO2(a3);
            mm_tiles<false>(S_(10), S_(7), mt, nt0, fr, fq, a1);
            mm_tiles<true>(S_(8), S_(9), mt, nt0, fr, fq, a2);
            mm_tiles<false>(S_(8), S_(9), mt, nt0, fr, fq, a3);
#pragma unroll
            for (int n = 0; n < 2; ++n) {
                st4(S_(13), 16 * (nt0 + n) + fr, 16 * mt + 4 * fq, a1[n][0], a1[n][1], a1[n][2], a1[n][3]);
                st4(S_(0), 16 * mt + fr, 16 * (nt0 + n) + 4 * fq, a2[n][0], a2[n][1], a2[n][2], a2[n][3]);
                st4(S_(2), 16 * (nt0 + n) + fr, 16 * mt + 4 * fq, a3[n][0], a3[n][1], a3[n][2], a3[n][3]); }
        }
        __syncthreads();
#pragma unroll
        for (int k = 1; k <= 5; ++k) {
            const int pc = (k & 1) ? 0 : 8, pct = (k & 1) ? 2 : 9, pn = (k & 1) ? 8 : 0, pnt = (k & 1) ? 9 : 2, tc = (k & 1) ? 18 : 10, tn = (k & 1) ? 10 : 18;
            pg8::f32x4 a1[2], a2[2], a3[2];
#pragma unroll
            for (int n = 0; n < 2; ++n) a1[n] = ld4(S_(tc), 16 * mt + fr, 16 * (nt0 + n) + 4 * fq);
            mm_tiles<true>(S_(tc), S_(pct), mt, nt0, fr, fq, a1);
            if (k < 5) { ZERO2(a2); ZERO2(a3); mm_tiles<true>(S_(pc), S_(pct), mt, nt0, fr, fq, a2); mm_tiles<false>(S_(pc), S_(pct), mt, nt0, fr, fq, a3); }
#pragma unroll
            for (int n = 0; n < 2; ++n) {
                st4(S_(tn), 16 * mt + fr, 16 * (nt0 + n) + 4 * fq, a1[n][0], a1[n][1], a1[n][2], a1[n][3]);
                if (k < 5) { st4(S_(pn), 16 * mt + fr, 16 * (nt0 + n) + 4 * fq, a2[n][0], a2[n][1], a2[n][2], a2[n][3]);
                             st4(S_(pnt), 16 * (nt0 + n) + fr, 16 * mt + 4 * fq, a3[n][0], a3[n][1], a3[n][2], a3[n][3]); } }
            __syncthreads();
        }
        {
            pg8::f32x4 a1[2], a2[2]; ZERO2(a1); ZERO2(a2);
            mm_tiles<false>(S_(10), S_(4), mt, nt0, fr, fq, a1);
            mm_tiles<false>(S_(10), S_(13), mt, nt0, fr, fq, a2);
#pragma unroll
            for (int n = 0; n < 2; ++n) {
                st4(S_(8), 16 * (nt0 + n) + fr, 16 * mt + 4 * fq, -a1[n][0], -a1[n][1], -a1[n][2], -a1[n][3]);
                st4(S_(9), 16 * (nt0 + n) + fr, 16 * mt + 4 * fq, -a2[n][0], -a2[n][1], -a2[n][2], -a2[n][3]); }
        }
        __syncthreads();
        pg8::f32x4 accY[2];
        {
            pg8::f32x4 a1[2], a2[2], a3[2];
#pragma unroll
            for (int n = 0; n < 2; ++n) a1[n] = ld4(S_(1), 16 * mt + fr, 16 * (nt0 + n) + 4 * fq);
            mm_tiles<true>(S_(11), S_(8), mt, nt0, fr, fq, a1);
            ZERO2(accY); mm_tiles<true>(S_(12), S_(7), mt, nt0, fr, fq, accY); mm_tiles<true>(S_(11), S_(9), mt, nt0, fr, fq, accY);
            ZERO2(a2); mm_tiles<true>(S_(5), S_(8), mt, nt0, fr, fq, a2);
            ZERO2(a3); mm_tiles<true>(S_(7), S_(6), mt, nt0, fr, fq, a3); mm_tiles<true>(S_(9), S_(5), mt, nt0, fr, fq, a3);
            const LAS float* gam = (const LAS float*)(L + opq(SC_MISC) + 2048);
#pragma unroll
            for (int n = 0; n < 2; ++n) { const int rr = 16 * mt + fr, c0 = 16 * (nt0 + n) + 4 * fq;
                st4(S_(0), rr, c0, a1[n][0], a1[n][1], a1[n][2], a1[n][3]);
                const float gj = gam[rr];
                st4(S_(2), rr, c0, a2[n][0] + (c0 + 0 == rr ? gj : 0.f), a2[n][1] + (c0 + 1 == rr ? gj : 0.f), a2[n][2] + (c0 + 2 == rr ? gj : 0.f), a2[n][3] + (c0 + 3 == rr ? gj : 0.f));
                st4(S_(3), rr, c0, a3[n][0], a3[n][1], a3[n][2], a3[n][3]); }
        }
        __syncthreads();
        {
            pg8::f32x4 a1[2], a2[2], a3[2]; ZERO2(a1);
            mm_tiles<true>(S_(0), S_(ppc), mt, nt0, fr, fq, a1);
            mm_tiles<true>(S_(0), S_(qpc), mt, nt0, fr, fq, accY);
            ZERO2(a2); mm_tiles<true>(S_(ppc), S_(2), mt, nt0, fr, fq, a2);
#pragma unroll
            for (int n = 0; n < 2; ++n) a3[n] = ld4(S_(3), 16 * mt + fr, 16 * (nt0 + n) + 4 * fq);
            mm_tiles<true>(S_(qpc), S_(2), mt, nt0, fr, fq, a3);
            if (!isctx) {
                const int tt = 16 * mt + fr, xr = d ? 63 - tt : tt;
                bf16* gy = (bf16*)(A.ws() + WS_GY) + ((size_t)chain * 256 + tokchunk) * 8192;
#pragma unroll
                for (int n = 0; n < 2; ++n) { const int c0 = 16 * (nt0 + n) + 4 * fq; u32x2 o;
                    o.x = pk2(a1[n][0], a1[n][1]); o.y = pk2(a1[n][2], a1[n][3]); *(u32x2*)(gy + xr * 64 + c0) = o;
                    o.x = pk2(accY[n][0], accY[n][1]); o.y = pk2(accY[n][2], accY[n][3]); *(u32x2*)(gy + 4096 + xr * 64 + c0) = o; }
            }
            if (j < 3) {
#pragma unroll
                for (int n = 0; n < 2; ++n) { const int rr = 16 * mt + fr, c0 = 16 * (nt0 + n) + 4 * fq;
                    st4(S_(ppn), rr, c0, a2[n][0], a2[n][1], a2[n][2], a2[n][3]); st4(S_(qpn), rr, c0, a3[n][0], a3[n][1], a3[n][2], a3[n][3]); }
            } else {
                pg8::f32x4 a4[2]; ZERO2(a4); mm_tiles<false>(S_(ppc), S_(2), mt, nt0, fr, fq, a4);
                bf16* pq = (bf16*)(A.ws() + WS_PQ) + ((size_t)chain * 65 + scidx) * 8192;
#pragma unroll
                for (int n = 0; n < 2; ++n) { u32x2 o;
                    o.x = pk2(a4[n][0], a4[n][1]); o.y = pk2(a4[n][2], a4[n][3]); *(u32x2*)(pq + (16 * (nt0 + n) + fr) * 64 + 16 * mt + 4 * fq) = o;
                    o.x = pk2(a3[n][0], a3[n][1]); o.y = pk2(a3[n][2], a3[n][3]); *(u32x2*)(pq + 4096 + (16 * mt + fr) * 64 + 16 * (nt0 + n) + 4 * fq) = o; }
            }
        }
        __syncthreads();
        ppc = ppn; qpc = qpn;
    }
#undef S_
}

__device__ __forceinline__ void scan_chain(Frame& F, const KArgs& A, int chain) {
    if (F.wave >= 4) return;
    const int vb = F.wave, lane = F.lane, fr = lane & 15, fq = lane >> 4, v = 16 * vb + fr;
    const bf16* pq = (const bf16*)(A.ws() + WS_PQ) + (size_t)chain * 65 * 8192;
    bf16* s0 = (bf16*)(A.ws() + WS_S0) + (size_t)chain * 64 * 4096;
    pg8::f32x4 st[4];
#pragma unroll
    for (int it = 0; it < 4; ++it) { const u32x2 q = *(const u32x2*)(pq + 4096 + v * 64 + 16 * it + 4 * fq); st[it] = (pg8::f32x4){bflo(q.x), bfhi(q.x), bflo(q.y), bfhi(q.y)}; }
    u32x2 pa[4][2][2], qn[4];
    { const bf16* p = pq + 8192;
#pragma unroll
      for (int jt = 0; jt < 4; ++jt) { qn[jt] = *(const u32x2*)(p + 4096 + v * 64 + 16 * jt + 4 * fq);
#pragma unroll
          for (int ks = 0; ks < 2; ++ks) { pa[jt][ks][0] = *(const u32x2*)(p + (16 * jt + fr) * 64 + 32 * ks + 4 * fq); pa[jt][ks][1] = *(const u32x2*)(p + (16 * jt + fr) * 64 + 32 * ks + 16 + 4 * fq); } } }
    for (int sc = 0; sc < 64; ++sc) {
#pragma unroll
        for (int it = 0; it < 4; ++it) { u32x2 o; o.x = pk2(st[it][0], st[it][1]); o.y = pk2(st[it][2], st[it][3]); *(u32x2*)(s0 + (size_t)sc * 4096 + v * 64 + 16 * it + 4 * fq) = o; }
        if (sc == 63) break;
        u32x2 ca[4][2][2], cq[4];
#pragma unroll
        for (int jt = 0; jt < 4; ++jt) { cq[jt] = qn[jt];
#pragma unroll
            for (int ks = 0; ks < 2; ++ks) { ca[jt][ks][0] = pa[jt][ks][0]; ca[jt][ks][1] = pa[jt][ks][1]; } }
        if (sc + 1 < 63) { const bf16* p = pq + (size_t)(sc + 2) * 8192;
#pragma unroll
            for (int jt = 0; jt < 4; ++jt) { qn[jt] = *(const u32x2*)(p + 4096 + v * 64 + 16 * jt + 4 * fq);
#pragma unroll
                for (int ks = 0; ks < 2; ++ks) { pa[jt][ks][0] = *(const u32x2*)(p + (16 * jt + fr) * 64 + 32 * ks + 4 * fq); pa[jt][ks][1] = *(const u32x2*)(p + (16 * jt + fr) * 64 + 32 * ks + 16 + 4 * fq); } } }
        bf16x8 bfrag[2];
#pragma unroll
        for (int ks = 0; ks < 2; ++ks) { u32x4 b; b.x = pk2(st[2 * ks][0], st[2 * ks][1]); b.y = pk2(st[2 * ks][2], st[2 * ks][3]); b.z = pk2(st[2 * ks + 1][0], st[2 * ks + 1][1]); b.w = pk2(st[2 * ks + 1][2], st[2 * ks + 1][3]); bfrag[ks] = __builtin_bit_cast(bf16x8, b); }
        pg8::f32x4 nw[4];
#pragma unroll
        for (int jt = 0; jt < 4; ++jt) { nw[jt] = (pg8::f32x4){bflo(cq[jt].x), bfhi(cq[jt].x), bflo(cq[jt].y), bfhi(cq[jt].y)};
#pragma unroll
            for (int ks = 0; ks < 2; ++ks) { u32x4 a; a.x = ca[jt][ks][0].x; a.y = ca[jt][ks][0].y; a.z = ca[jt][ks][1].x; a.w = ca[jt][ks][1].y;
                nw[jt] = __builtin_amdgcn_mfma_f32_16x16x32_bf16(__builtin_bit_cast(bf16x8, a), bfrag[ks], nw[jt], 0, 0, 0); } }
#pragma unroll
        for (int jt = 0; jt < 4; ++jt) st[jt] = nw[jt];
    }
}

__device__ __forceinline__ void scan_pass2_unit(Frame& F, const KArgs& A, int h, int c) {
    const int tid = F.tid, lane = F.lane, w = F.wave, fr = lane & 15, fq = lane >> 4;
    LAS unsigned char* const L = F.lds;
#define S_(i) (L + opq((i) * SL))
    const bf16* gyf = (const bf16*)(A.ws() + WS_GY) + ((size_t)(0 * 8 + h) * 256 + c) * 8192;
    const bf16* gyb = (const bf16*)(A.ws() + WS_GY) + ((size_t)(1 * 8 + h) * 256 + c) * 8192;
    const bf16* s0f = (const bf16*)(A.ws() + WS_S0) + ((size_t)(0 * 8 + h) * 64 + (c >> 2)) * 4096;
    const bf16* s0b = (const bf16*)(A.ws() + WS_S0) + ((size_t)(1 * 8 + h) * 64 + ((255 - c) >> 2)) * 4096;
    const bf16* gut = (const bf16*)(A.ws() + WS_GUPT) + (size_t)h * 8192;
    const bf16* ZA = F_ZA; const float* mu = F_mu;
    {
        const int r = tid >> 3, ch = tid & 7;
        *(LAS u32x4*)(S_(0) + frag_off(r, ch)) = *(const u32x4*)(gyf + r * 64 + 8 * ch);
        *(LAS u32x4*)(S_(1) + frag_off(r, ch)) = *(const u32x4*)(gyb + r * 64 + 8 * ch);
        *(LAS u32x4*)(S_(2) + frag_off(r, ch)) = *(const u32x4*)(s0f + r * 64 + 8 * ch);
        *(LAS u32x4*)(S_(3) + frag_off(r, ch)) = *(const u32x4*)(s0b + r * 64 + 8 * ch);
        *(LAS u32x4*)(S_(4) + frag_off(r, ch)) = *(const u32x4*)(gut + r * 128 + 8 * ch);
        *(LAS u32x4*)(S_(5) + frag_off(r, ch)) = *(const u32x4*)(gut + r * 128 + 64 + 8 * ch);
        const int tok = c * 64 + r; const bf16* Z = ZA + (size_t)tok * 2048;
        const bool okl = r > 0, okr = r < 63, oku = c > 0, okd = c < GROWS - 1; const int dl = okl ? -1 : 0, dr = okr ? 1 : 0, du = oku ? -64 : 0, dd = okd ? 64 : 0;
#pragma unroll
        for (int half = 0; half < 2; ++half) { float g8[8]; const int col = 16 * ch + 8 * half; mix8(Z, 1792 + col, mu, dl, dr, du, dd, okl, okr, oku, okd, g8);
            u32x4 o; o.x = pk2(sigmoidf_(g8[0]), sigmoidf_(g8[1])); o.y = pk2(sigmoidf_(g8[2]), sigmoidf_(g8[3])); o.z = pk2(sigmoidf_(g8[4]), sigmoidf_(g8[5])); o.w = pk2(sigmoidf_(g8[6]), sigmoidf_(g8[7]));
            *(LAS u32x4*)(S_(6 + (col >> 6)) + frag_off(r, (col & 63) >> 3)) = o; }
    }
    __syncthreads();
    if (w >= 4) {
        const int mt = w - 4;
#pragma unroll
        for (int np = 0; np < 2; ++np) { pg8::f32x4 g[2]; ZERO2(g);
            mm_tiles<true>(S_(6), S_(4), mt, 2 * np, fr, fq, g); mm_tiles<true>(S_(7), S_(5), mt, 2 * np, fr, fq, g);
#pragma unroll
            for (int n = 0; n < 2; ++n) *(LAS f32x4*)(L + opq(8 * SL) + ((16 * mt + fr) * 64 + 16 * (2 * np + n) + 4 * fq) * 4) = (f32x4){g[n][0], g[n][1], g[n][2], g[n][3]}; }
    }
    pg8::f32x4 y[4];
    const int mt2 = w & 3, tt = 16 * mt2 + fr, tok = c * 64 + tt;
    if (w < 4) {
#pragma unroll
        for (int np = 0; np < 2; ++np) { pg8::f32x4 a[2];
#pragma unroll
            for (int n = 0; n < 2; ++n) { const int c0 = 16 * (2 * np + n) + 4 * fq; const u32x2 yf = *(const u32x2*)(gyf + 4096 + tt * 64 + c0), yb = *(const u32x2*)(gyb + 4096 + tt * 64 + c0);
                a[n] = (pg8::f32x4){bflo(yf.x) + bflo(yb.x), bfhi(yf.x) + bfhi(yb.x), bflo(yf.y) + bflo(yb.y), bfhi(yf.y) + bfhi(yb.y)}; }
            mm_tiles<true>(S_(0), S_(2), mt2, 2 * np, fr, fq, a); mm_tiles<true>(S_(1), S_(3), mt2, 2 * np, fr, fq, a);
            y[2 * np] = a[0]; y[2 * np + 1] = a[1]; }
    }
    __syncthreads();
    if (w < 4) {
        float s = 0.f;
#pragma unroll
        for (int n = 0; n < 4; ++n) s += (y[n][0] + y[n][1]) + (y[n][2] + y[n][3]);
        s += __shfl_xor(s, 16); s += __shfl_xor(s, 32);
        const float mean = s * (1.0f / 64.0f); float s2 = 0.f;
#pragma unroll
        for (int n = 0; n < 4; ++n)
#pragma unroll
            for (int i = 0; i < 4; ++i) { const float dlt = y[n][i] - mean; s2 += dlt * dlt; }
        s2 += __shfl_xor(s2, 16); s2 += __shfl_xor(s2, 32);
        const float rstd = rsqrtf(s2 * (1.0f / 64.0f) + GN_EPS);
        const bf16* Z = ZA + (size_t)tok * 2048;
        const bool okl = tt > 0, okr = tt < 63, oku = c > 0, okd = c < GROWS - 1; const int dl = okl ? -1 : 0, dr = okr ? 1 : 0, du = oku ? -64 : 0, dd = okd ? 64 : 0;
        float rr[4][4], kk[4][4], vv[4][4]; float dp = 0.f;
#pragma unroll
        for (int n = 0; n < 4; ++n) { const int cc = h * 64 + 16 * n + 4 * fq;
            mix4(Z, cc, mu, dl, dr, du, dd, okl, okr, oku, okd, rr[n]); mix4(Z, 512 + cc, mu, dl, dr, du, dd, okl, okr, oku, okd, kk[n]); mix4(Z, 1024 + cc, mu, dl, dr, du, dd, okl, okr, oku, okd, vv[n]);
            const f32x4 rk = *(const f32x4*)(F_r_k + cc);
            dp += rr[n][0] * kk[n][0] * rk.x + rr[n][1] * kk[n][1] * rk.y + rr[n][2] * kk[n][2] * rk.z + rr[n][3] * kk[n][3] * rk.w; }
        dp += __shfl_xor(dp, 16); dp += __shfl_xor(dp, 32);
#pragma unroll
        for (int n = 0; n < 4; ++n) { const int cl = 16 * n + 4 * fq, cc = h * 64 + cl;
            const f32x4 lw = *(const f32x4*)(F_ln_w + cc), lb = *(const f32x4*)(F_ln_b + cc);
            const f32x4 g = *(const LAS f32x4*)(L + opq(8 * SL) + (tt * 64 + cl) * 4);
            float o[4];
#pragma unroll
            for (int i = 0; i < 4; ++i) { const float yn = (y[n][i] - mean) * rstd * lw[i] + lb[i]; o[i] = (yn + dp * vv[n][i]) * g[i]; }
            u32x2 pk; pk.x = pk2(o[0], o[1]); pk.y = pk2(o[2], o[3]);
            *(u32x2*)(F_YA + (size_t)tok * DR + cc) = pk; }
    }
    __syncthreads();
#undef S_
}

__global__ void __launch_bounds__(512, 2) fwd(Args AA) {
    extern __shared__ __attribute__((aligned(16))) unsigned char lds_raw[];
    Frame F;
    F.lds = (LAS unsigned char*)lds_raw;
    F.tid = threadIdx.x; F.lane = F.tid & 63; F.wave = __builtin_amdgcn_readfirstlane(F.tid >> 6); F.G = gridDim.x;
    F.ws = AA.ws; F.in = nullptr; F.ctl = (unsigned*)(AA.ws + WS_CTL);

    for (int u = F.tid; u < (LDS_BYTES - MISC_OFF) / 4; u += 512) ((LAS unsigned*)(F.lds + MISC_OFF))[u] = 0u;
    __syncthreads();
    XcdBarrier bar; bar.bar = F.ctl + CW_BAR; bar.x = 0; bar.st = nullptr;
    if (!MK_LAUNCH_PER_PHASE) bar = xcd_barrier_post(F.ctl + CW_BAR, (volatile LAS unsigned*)(F.lds + MISC_OFF));
    const int lo = AA.ph_lo, hi = AA.ph_hi;
#ifndef ONLY_PHASE
#define ONLY_PHASE -1
#endif
#define IN(k) ((ONLY_PHASE < 0 || ONLY_PHASE == (k)) && lo <= (k) && (k) < hi)
#define FRESH() do { int t_ = threadIdx.x; asm volatile("" : "+v"(t_)); F.tid = t_; F.lane = t_ & 63; } while (0)
#define SEAM(k) do { if (!MK_LAUNCH_PER_PHASE && IN(k) && IN((k) + 1)) xcd_barrier(bar); } while (0)

    if (IN(0)) { FRESH(); FRESH_KA(A); p0_prologue(F, A); } SEAM(0);
    if (IN(1)) { FRESH(); FRESH_KA(A); p1_norm1(F, A); } SEAM(1);
    if (IN(2)) { FRESH(); FRESH_KA(A);
        pg8::Gemm g{F_H, F_WinT, MTOT, NPAD, D}; Sched1 S{F.G, (int)blockIdx.x}; EpiZ E{F_ZA, F_ZB, F_ZG};
        pg8::gemm_phase<EpiZ, Sched1, true, true>(F.lds, g, S, E);
    } SEAM(2);
#ifndef SCAN_NAIVE
#define SCAN_NAIVE 0
#endif
    if (IN(3)) { FRESH(); FRESH_KA(A);
#if SCAN_NAIVE
        if (blockIdx.x < 16) p3_scan_naive(F, A, (int)blockIdx.x);
        else for (int ch = (int)blockIdx.x - 16; ch < SEQ / 128; ch += F.G - 16) p3_mixer_b(F, A, ch);
#else
        for (int u = (int)blockIdx.x; u < 16 * 65; u += F.G) scan_pass1_unit(F, A, u & 15, u >> 4);
#endif
    } SEAM(3);
    if (IN(4)) { FRESH(); FRESH_KA(A);
#if !SCAN_NAIVE
        if (blockIdx.x < 16) scan_chain(F, A, (int)blockIdx.x);
        else for (int ch = (int)blockIdx.x - 16; ch < SEQ / 128; ch += F.G - 16) p3_mixer_b(F, A, ch);
#endif
    } SEAM(4);
    if (IN(5)) { FRESH(); FRESH_KA(A);
#if SCAN_NAIVE
        p4_rwkv_out(F, A);
#else
        for (int u = (int)blockIdx.x; u < 8 * 256; u += F.G) scan_pass2_unit(F, A, u & 7, u >> 3);
#endif
    } SEAM(5);
    if (IN(6)) { FRESH(); FRESH_KA(A);
        SchedStd S{64, 4, F.G, (int)blockIdx.x};
        { pg8::Gemm g{F_YA, F_WaT, SEQ, D, DR}; EpiMergeA E{F_Y, F_ZG}; pg8::gemm_phase<EpiMergeA, SchedStd, true, true>(F.lds, g, S, E); }
        __syncthreads();
        { pg8::Gemm g{F_YB, F_WbT, SEQ, D, DR}; EpiMergeB E{F_Y, F_ZG, F_MG}; pg8::gemm_phase<EpiMergeB, SchedStd, true, true>(F.lds, g, S, E); }
    } SEAM(6);
    if (IN(7)) { FRESH(); FRESH_KA(A);
        SchedStd S{64, 4, F.G, (int)blockIdx.x};
        pg8::Gemm g{F_MG, F_WoutT, SEQ, D, D}; EpiX1 E{F_x, F_MOD + 2048, F_out}; pg8::gemm_phase<EpiX1, SchedStd, true, true>(F.lds, g, S, E);
    } SEAM(7);
    if (IN(8)) { FRESH(); FRESH_KA(A); p7_router(F, A); } SEAM(8);
    if (IN(9)) { FRESH(); FRESH_KA(A); p8_gather(F, A); } SEAM(9);
    if (IN(10)) { FRESH(); FRESH_KA(A);
        const int ntiles = moe_tables(F, A);
        MoeOrder S{(const LAS int*)(F.lds + TAB_OFF) + 128, ntiles * 4, F.G, (int)blockIdx.x};
        pg8::Gemm g{F_XG, F_WguT, MAXTILES * 256, NEXP * 1024, D}; EpiSwiGLU E{F_HMID};
        pg8::gemm_phase<EpiSwiGLU, MoeOrder, true, true>(F.lds, g, S, E);
    } SEAM(10);
    if (IN(11)) { FRESH(); FRESH_KA(A);
        const int ntiles = moe_tables(F, A);
        MoeOrder S{(const LAS int*)(F.lds + TAB_OFF) + 128, ntiles * 4, F.G, (int)blockIdx.x};
        pg8::Gemm g{F_HMID, F_WdT, MAXTILES * 256, NEXP * 1024, DEXP}; EpiScatter E{F_YBUF, F_rowinfo, F_roww};
        pg8::gemm_phase<EpiScatter, MoeOrder, true, true>(F.lds, g, S, E);
    } SEAM(11);
    if (IN(12)) { FRESH(); FRESH_KA(A); p11_final(F, A); }
#undef IN
#undef SEAM
}

extern "C" void kernel_launch(void* const* d_in, const int* in_sizes, int n_in, void* d_out, int out_size, void* d_ws, size_t ws_size, hipStream_t stream) {
    static int grid = 0;
    if (grid == 0) {
        if (n_in != 35 || in_sizes[0] != SEQ * D || out_size != SEQ * D || ws_size < WS_END) {
            fprintf(stderr, "kernel_launch: unexpected shapes: n_in %d in0 %d out %d ws %zu (need %zu); nothing launched\n", n_in, n_in > 0 ? in_sizes[0] : -1, out_size, ws_size, (size_t)WS_END); grid = -1; return; }
        int dev = 0, cus = 0, per_cu = 0;
        if (hipGetDevice(&dev) != hipSuccess || hipDeviceGetAttribute(&cus, hipDeviceAttributeMultiprocessorCount, dev) != hipSuccess) { grid = -1; return; }
        if (hipFuncSetAttribute((const void*)fwd, hipFuncAttributeMaxDynamicSharedMemorySize, LDS_BYTES) != hipSuccess) { fprintf(stderr, "kernel_launch: hipFuncSetAttribute failed\n"); grid = -1; return; }
        if (hipOccupancyMaxActiveBlocksPerMultiprocessor(&per_cu, (const void*)fwd, 512, LDS_BYTES) != hipSuccess || per_cu < 1) fprintf(stderr, "kernel_launch: occupancy query says %d\n", per_cu);
        (void)hipGetLastError();
        grid = cus;
    }
    if (grid < 0) return;
    if (hipMemsetAsync((char*)d_ws + WS_CTL, 0, CTL_ZERO_BYTES, stream) != hipSuccess) return;
    Args a{};
    for (int i = 0; i < 35; ++i) a.in[i] = (const float*)d_in[i];
    a.out = (float*)d_out; a.ws = (unsigned char*)d_ws;
#if MK_LAUNCH_PER_PHASE
    for (int p = 0; p < NPHASE; ++p) { a.ph_lo = p; a.ph_hi = p + 1; hipLaunchKernelGGL(fwd, dim3(grid), dim3(512), LDS_BYTES, stream, a); }
#else
#ifndef MK_PH_HI
#define MK_PH_HI NPHASE
#endif
    a.ph_lo = 0; a.ph_hi = MK_PH_HI;
    hipLaunchKernelGGL(fwd, dim3(grid), dim3(512), LDS_BYTES, stream, a);
#endif
}
```

```cpp
#include <hip/hip_runtime.h>
#include <cstdio>
#include <cstdint>
namespace pg8 {
#define PG8_LAS __attribute__((address_space(3)))
typedef unsigned short bf16_t;
typedef short bf16x8 __attribute__((ext_vector_type(8)));
typedef float f32x4 __attribute__((ext_vector_type(4)));
typedef unsigned u32x4 __attribute__((ext_vector_type(4)));
constexpr int BM = 256, BK = 64, HALF = 128, HTB = HALF * BK * 2  , STAGE_BYTES = 8 * HTB, NXCD = 8, WGM = 8;

__host__ __device__ __forceinline__ int lds_byte(int r, int c) { const int st = (r >> 4) * 2 + (c >> 5), rr = r & 15, cc = c & 31, ob = rr * 64 + cc * 2; return st * 1024 + (ob ^ (((ob >> 9) & 1) << 5)); }
__host__ __device__ __forceinline__ void stage_rc(int b, int& R, int& C) { const int st = b / 1024, sb = b % 1024, swz = sb ^ (((sb >> 9) & 1) << 5); R = (st >> 1) * 16 + swz / 64; C = (st & 1) * 32 + (swz % 64) / 2; }
__host__ __device__ __forceinline__ int perm32(int rho) { const int n = rho >> 4, i = rho & 15; return 8 * (i >> 2) + 4 * n + (i & 3); }

struct Unit { int pm, pn; };
struct Gemm { const bf16_t* A; const bf16_t* Bt; int M, N, K; };

struct StaticOrder {
    int nM, nN, nwg, G, c;
    __host__ __device__ void init(int M, int N, int G_, int c_) { nM = M / BM; nN = N / BM; nwg = nM * nN; G = G_; c = c_; }
    __host__ __device__ bool next(int i, Unit& u) const {
        const long L = (long)i * G + c; if (L >= nwg) return false;
        int wgid = (int)L; { const int q = nwg / NXCD, r = nwg % NXCD, xcd = wgid % NXCD, off = wgid / NXCD; wgid = (xcd < r ? xcd * (q + 1) : r * (q + 1) + (xcd - r) * q) + off; }
        const int nig = WGM * nN, gid = wgid / nig, fm = gid * WGM, gsz = (nM - fm) < WGM ? (nM - fm) : WGM;
        u.pm = fm + ((wgid % nig) % gsz); u.pn = (wgid % nig) / gsz; return true;
    }
    __device__ __forceinline__ void a_ready(const Unit&) const {}
    __device__ __forceinline__ void done(const Unit&) const {}
};

__device__ __forceinline__ unsigned cvt_pk_bf16(float lo, float hi) { unsigned r; asm volatile("v_cvt_pk_bf16_f32 %0, %1, %2" : "=v"(r) : "v"(lo), "v"(hi)); return r; }
template <class Epi, class Sched, bool ALIGN_EPI = false, bool SP2 = false>
__device__ __forceinline__ void gemm_phase(PG8_LAS unsigned char* lds, const Gemm g, const Sched& S, const Epi& E) {
    int tid_ = threadIdx.x; asm volatile("" : "+v"(tid_));
    const int tid = tid_, wid = __builtin_amdgcn_readfirstlane(tid >> 6), lane = tid & 63, wr = wid >> 2, wc = wid & 3, fr = lane & 15, fq = lane >> 4;
    const int K = g.K, nt = K / BK;
    unsigned voffA[2], voffB[2];
#pragma unroll
    for (int i = 0; i < 2; ++i) { int R, C; stage_rc(tid * 16 + i * 8192, R, C); const int Rb = Epi::PERM ? ((R & ~31) + perm32(R & 31)) : R;
        voffA[i] = (unsigned)(R * K + C) * 2u; voffB[i] = (unsigned)(Rb * K + C) * 2u; }
    const size_t kstep = (size_t)(BK * 2);
    const size_t hstep = (size_t)HALF * K * 2;
    const size_t tstep = 2 * hstep;
    const unsigned ldsw = (unsigned)wid * 1024u;
    const int aoff = lds_byte(wr * 64 + fr, fq * 8), boff = lds_byte(wc * 32 + fr, fq * 8);
#define PG8_SA(b, h) (((b) * 2 + (h)) * HTB)
#define PG8_SB(b, h) ((4 + (b) * 2 + (h)) * HTB)
#define PG8_STAGE(bufoff, gbase, voff) do { _Pragma("unroll") for (int _i = 0; _i < 2; ++_i) \
        __builtin_amdgcn_global_load_lds((const unsigned*)((const char*)(gbase) + (voff)[_i]), (PG8_LAS unsigned*)(lds + (bufoff) + ldsw + _i * 8192), 16, 0, 0); } while (0)
#define PG8_LDA(dst, b, h) do { _Pragma("unroll") for (int m = 0; m < 4; ++m) _Pragma("unroll") for (int k = 0; k < 2; ++k) dst[m][k] = *(const PG8_LAS bf16x8*)(lds + PG8_SA(b, h) + aoff + m * 2048 + k * 1024); } while (0)
#define PG8_LDB(dst, b, h) do { _Pragma("unroll") for (int n = 0; n < 2; ++n) _Pragma("unroll") for (int k = 0; k < 2; ++k) dst[n][k] = *(const PG8_LAS bf16x8*)(lds + PG8_SB(b, h) + boff + n * 2048 + k * 1024); } while (0)
#define PG8_MMA(ai, bj, At, Bt) do { __builtin_amdgcn_s_setprio(1); _Pragma("unroll") for (int m = 0; m < 4; ++m) _Pragma("unroll") for (int n = 0; n < 2; ++n) _Pragma("unroll") for (int k = 0; k < 2; ++k) \
        acc[ai][bj][m][n] = __builtin_amdgcn_mfma_f32_16x16x32_bf16(Bt[n][k], At[m][k], acc[ai][bj][m][n], 0, 0, 0); __builtin_amdgcn_s_setprio(0); } while (0)
#define PG8_WAIT_V(n) asm volatile("s_waitcnt vmcnt(" #n ")" ::: "memory")
#define PG8_WAIT_L(n) asm volatile("s_waitcnt lgkmcnt(" #n ")" ::: "memory")
#define PG8_BAR __builtin_amdgcn_s_barrier()
#define PG8_SCHED __builtin_amdgcn_sched_barrier(0)
    Unit cur, nxt; int ui = 0;
    if (!S.next(0, cur)) return;
    f32x4 acc[2][2][4][2];
#pragma unroll
    for (int a = 0; a < 2; ++a)
#pragma unroll
        for (int b = 0; b < 2; ++b)
#pragma unroll
            for (int m = 0; m < 4; ++m)
#pragma unroll
                for (int n = 0; n < 2; ++n) acc[a][b][m][n] = (f32x4){0.f, 0.f, 0.f, 0.f};
    bf16x8 At[4][2], B0[2][2], B1[2][2];
    const char* cA = (const char*)g.A + (size_t)cur.pm * tstep; const char* cB = (const char*)g.Bt + (size_t)cur.pn * tstep;
    S.a_ready(cur);
    if constexpr (SP2) {
        PG8_STAGE(PG8_SB(0, 0), cB, voffB); PG8_STAGE(PG8_SB(0, 1), cB + hstep, voffB); PG8_STAGE(PG8_SA(0, 0), cA, voffA); PG8_STAGE(PG8_SA(0, 1), cA + hstep, voffA);
        if (wr == 1) PG8_BAR;
        PG8_WAIT_V(2); PG8_BAR;
        PG8_STAGE(PG8_SB(1, 0), cB + kstep, voffB); PG8_STAGE(PG8_SA(1, 0), cA + kstep, voffA); PG8_STAGE(PG8_SB(1, 1), cB + hstep + kstep, voffB);
        PG8_WAIT_V(6); PG8_BAR;
    } else {
        PG8_STAGE(PG8_SB(0, 0), cB, voffB); PG8_STAGE(PG8_SA(0, 0), cA, voffA); PG8_STAGE(PG8_SB(0, 1), cB + hstep, voffB); PG8_STAGE(PG8_SA(0, 1), cA + hstep, voffA);
        if (wr == 1) PG8_BAR;
        PG8_WAIT_V(4); PG8_BAR;
        PG8_STAGE(PG8_SB(1, 0), cB + kstep, voffB); PG8_STAGE(PG8_SA(1, 0), cA + kstep, voffA); PG8_STAGE(PG8_SB(1, 1), cB + hstep + kstep, voffB);
        PG8_WAIT_V(6); PG8_BAR;
    }
    for (;;) {
        const bool has_next = S.next(ui + 1, nxt);
        const char* nA = has_next ? (const char*)g.A + (size_t)nxt.pm * tstep : cA; const char* nB = has_next ? (const char*)g.Bt + (size_t)nxt.pn * tstep : cB;
        for (int t = 0; t < nt; t += 2) {
            const bool last = (t == nt - 2);
            const char* a1 = cA + (size_t)(t + 1) * kstep;
            const char* a2 = last ? nA : cA + (size_t)(t + 2) * kstep; const char* b2 = last ? nB : cB + (size_t)(t + 2) * kstep;
            const char* a3 = a2 + kstep; const char* b3 = b2 + kstep;
            if (last && has_next) S.a_ready(nxt);
            if constexpr (SP2) {
            PG8_LDB(B0, 0, 0); PG8_LDB(B1, 0, 1); PG8_SCHED; PG8_LDA(At, 0, 0); PG8_STAGE(PG8_SA(1, 1), a1 + hstep, voffA);
            PG8_WAIT_V(8); PG8_WAIT_L(0); PG8_BAR; PG8_MMA(0, 0, At, B0); PG8_MMA(0, 1, At, B1); PG8_BAR; PG8_SCHED;
            PG8_LDA(At, 0, 1); PG8_STAGE(PG8_SB(0, 0), b2, voffB); PG8_STAGE(PG8_SB(0, 1), b2 + hstep, voffB); PG8_STAGE(PG8_SA(0, 0), a2, voffA);
            PG8_WAIT_V(8); PG8_WAIT_L(0); PG8_BAR; PG8_MMA(1, 0, At, B0); PG8_MMA(1, 1, At, B1); PG8_BAR; PG8_SCHED;
            PG8_LDB(B0, 1, 0); PG8_LDB(B1, 1, 1); PG8_SCHED; PG8_LDA(At, 1, 0); PG8_STAGE(PG8_SA(0, 1), a2 + hstep, voffA);
            PG8_WAIT_V(8); PG8_WAIT_L(0); PG8_BAR; PG8_MMA(0, 0, At, B0); PG8_MMA(0, 1, At, B1); PG8_BAR; PG8_SCHED;
            PG8_LDA(At, 1, 1); PG8_STAGE(PG8_SB(1, 0), b3, voffB); PG8_STAGE(PG8_SB(1, 1), b3 + hstep, voffB); PG8_STAGE(PG8_SA(1, 0), a3, voffA);
            PG8_WAIT_V(8); PG8_WAIT_L(0); PG8_BAR; PG8_MMA(1, 0, At, B0); PG8_MMA(1, 1, At, B1); PG8_BAR; PG8_SCHED;
            } else {
            PG8_LDB(B0, 0, 0); PG8_SCHED; PG8_LDA(At, 0, 0); PG8_STAGE(PG8_SA(1, 1), a1 + hstep, voffA);
            PG8_WAIT_L(8); PG8_BAR; PG8_WAIT_L(0); PG8_MMA(0, 0, At, B0); PG8_BAR; PG8_SCHED;
            PG8_LDB(B1, 0, 1); PG8_STAGE(PG8_SB(0, 0), b2, voffB);
            PG8_BAR; PG8_WAIT_L(0); PG8_MMA(0, 1, At, B1); PG8_BAR;
            PG8_LDA(At, 0, 1); PG8_STAGE(PG8_SA(0, 0), a2, voffA);
            PG8_BAR; PG8_WAIT_L(0); PG8_MMA(1, 0, At, B0); PG8_BAR; PG8_SCHED;
            PG8_STAGE(PG8_SB(0, 1), b2 + hstep, voffB);
            PG8_WAIT_V(6); PG8_BAR; PG8_MMA(1, 1, At, B1); PG8_BAR;
            PG8_LDB(B0, 1, 0); PG8_SCHED; PG8_LDA(At, 1, 0); PG8_STAGE(PG8_SA(0, 1), a2 + hstep, voffA);
            PG8_WAIT_L(8); PG8_BAR; PG8_WAIT_L(0); PG8_MMA(0, 0, At, B0); PG8_BAR; PG8_SCHED;
            PG8_LDB(B1, 1, 1); PG8_STAGE(PG8_SB(1, 0), b3, voffB);
            PG8_BAR; PG8_WAIT_L(0); PG8_MMA(0, 1, At, B1); PG8_BAR;
            PG8_LDA(At, 1, 1); PG8_STAGE(PG8_SA(1, 0), a3, voffA);
            PG8_BAR; PG8_WAIT_L(0); PG8_MMA(1, 0, At, B0); PG8_BAR; PG8_SCHED;
            PG8_STAGE(PG8_SB(1, 1), b3 + hstep, voffB);
            PG8_WAIT_V(6); PG8_BAR; PG8_MMA(1, 1, At, B1); PG8_BAR;
            }
        }
        if constexpr (ALIGN_EPI) { if (wr == 0) PG8_BAR; }
        if constexpr (!Epi::AFTER_DRAIN) { E(acc, cur, wr, wc, fr, fq); S.done(cur); }
        if (!has_next) break;
#pragma unroll
        for (int a = 0; a < 2; ++a)
#pragma unroll
            for (int b = 0; b < 2; ++b)
#pragma unroll
                for (int m = 0; m < 4; ++m)
#pragma unroll
                    for (int n = 0; n < 2; ++n) acc[a][b][m][n] = (f32x4){0.f, 0.f, 0.f, 0.f};
        cur = nxt; cA = nA; cB = nB; ++ui;
        if constexpr (ALIGN_EPI) { if (wr == 1) PG8_BAR; }
    }
    PG8_WAIT_V(0);
    if constexpr (!ALIGN_EPI) { if (wr == 0) PG8_BAR; }
    PG8_BAR;
    if constexpr (Epi::AFTER_DRAIN) { E.fused(acc, cur, wr, wc, fr, fq, lds, wid, lane); S.done(cur); }
#undef PG8_SA
#undef PG8_SB
#undef PG8_STAGE
#undef PG8_LDA
#undef PG8_LDB
#undef PG8_MMA
#undef PG8_WAIT_V
#undef PG8_WAIT_L
#undef PG8_BAR
#undef PG8_SCHED
}
}

#ifndef MK_LAUNCH_PER_PHASE
#define MK_LAUNCH_PER_PHASE 0
#endif
constexpr int D = 1024, SEQ = 16384, CTXL = 256, MTOT = SEQ + CTXL, GW = 64, GROWS = SEQ / GW;
constexpr int DR = 512, NH = 8, HD = 64, PA = 1920, WINC = 4992, NPAD = 5120;
constexpr int NEXP = 32, DEXP = 512;
constexpr float NORM_EPS = 1e-6f, GN_EPS = 64e-5f;
constexpr int NPHASE = 13;

constexpr size_t MiB = 1u << 20;
constexpr size_t WS_CTL = 0, CTL_ZERO_BYTES = 64 * 1024;
constexpr size_t WS_MOD = 1 * MiB;
constexpr size_t WS_ROWINFO = WS_MOD + 64 * 1024;
constexpr size_t WS_ROWW = WS_MOD + 256 * 1024;
constexpr size_t WS_ROUTE = WS_MOD + 512 * 1024;
constexpr size_t WS_WIN = 2 * MiB;
constexpr size_t WS_WA = 12 * MiB, WS_WB = 13 * MiB, WS_WOUT = 14 * MiB;
constexpr size_t WS_H = 16 * MiB;
constexpr size_t WS_ZA = 49 * MiB;
constexpr size_t WS_ZB = 114 * MiB;
constexpr size_t WS_ZG = 146 * MiB;
constexpr size_t WS_YB = 210 * MiB;
constexpr size_t WS_YA = 226 * MiB;
constexpr size_t WS_Y = 242 * MiB;
constexpr size_t WS_END = 306 * MiB;
constexpr size_t WS_WGU = 49 * MiB;
constexpr size_t WS_WD = 113 * MiB;
constexpr size_t WS_XG = 145 * MiB;
constexpr size_t WS_HMID = 225 * MiB;
constexpr size_t WS_WUPT = 512 * 1024, WS_AUPT = 640 * 1024, WS_GUPT = 768 * 1024;
constexpr size_t WS_PQ = 16 * MiB;
constexpr size_t WS_S0 = 33 * MiB;
constexpr size_t WS_GY = 242 * MiB;
constexpr size_t WS_WRT = 48 * MiB + 512 * 1024;
constexpr int MAXTILES = 160;
constexpr int CW_TMO = 0, CW_BAR = 4096, CW_CNT = 8192;

constexpr int RING_BYTES = 131072, MISC_OFF = 159744, TAB_OFF = MISC_OFF + 256, LDS_BYTES = 163840;

#define GAS __attribute__((address_space(1)))
#define LAS __attribute__((address_space(3)))
typedef unsigned short bf16;
typedef float f32x4 __attribute__((ext_vector_type(4)));
typedef unsigned u32x4 __attribute__((ext_vector_type(4)));
typedef unsigned u32x2 __attribute__((ext_vector_type(2)));
typedef short bf16x8 __attribute__((ext_vector_type(8)));
#define LDS_WAIT() asm volatile("s_waitcnt lgkmcnt(0)" ::: "memory")
#define VM_WAIT() asm volatile("s_waitcnt vmcnt(0)" ::: "memory")

typedef __bf16 bf2_t __attribute__((ext_vector_type(2)));
__device__ __forceinline__ unsigned f2bf(float f) { return (unsigned)__builtin_bit_cast(unsigned short, (__bf16)f); }
__device__ __forceinline__ unsigned pk2(float lo, float hi) { bf2_t v; v.x = (__bf16)lo; v.y = (__bf16)hi; return __builtin_bit_cast(unsigned, v); }
__device__ __forceinline__ float bf2f(unsigned b) { return __builtin_bit_cast(float, b << 16); }
__device__ __forceinline__ float bflo(unsigned w) { return __builtin_bit_cast(float, w << 16); }
__device__ __forceinline__ float bfhi(unsigned w) { return __builtin_bit_cast(float, w & 0xffff0000u); }
__device__ __forceinline__ float sigmoidf_(float x) { return 1.0f / (1.0f + __expf(-x)); }
__device__ __forceinline__ float siluf_(float x) { return x / (1.0f + __expf(-x)); }
__device__ __forceinline__ float softplusf_(float x) { return fmaxf(x, 0.f) + log1pf(__expf(-fabsf(x))); }
__device__ __forceinline__ float gelu_tanh(float x) { const float u = 0.7978845608028654f * (x + 0.044715f * x * x * x); return 0.5f * x * (1.0f + tanhf(u)); }
__device__ __forceinline__ float wave_sum(float v) {
#pragma unroll
    for (int o = 1; o < 64; o <<= 1) v += __shfl_xor(v, o);
    return v;
}

#define XB_TMO      128
#define XB_XCNT(j)  (256  + 64 * (j))
#define XB_XSUB(j)  (1280 + 64 * (j))
#define XB_XGEN(j)  (2304 + 64 * (j))
#define XB_TOP      3328
#define XB_TOPGEN   3392
#define XCD_BAR_WORDS 3456
#define XB_SPIN_CAP (1u << 26)
#define LAS __attribute__((address_space(3)))

__device__ __forceinline__ unsigned xb_ld(unsigned* p)              { return __hip_atomic_load(p, __ATOMIC_RELAXED, __HIP_MEMORY_SCOPE_AGENT); }
__device__ __forceinline__ unsigned xb_add(unsigned* p, unsigned v) { return __hip_atomic_fetch_add(p, v, __ATOMIC_RELAXED, __HIP_MEMORY_SCOPE_AGENT); }
__device__ __forceinline__ unsigned xb_xcc_id() { return (unsigned)__builtin_amdgcn_s_getreg((3 << 11) | 20) & 0xFu; }
#define XB_SPIN(cond, bar) do { unsigned _sp = 0; while (cond) { __builtin_amdgcn_s_sleep(1); \
    if ((++_sp & 255u) == 0u) { if (xb_ld(&(bar)[XB_TMO])) break; if (_sp > XB_SPIN_CAP) { atomicAdd(&(bar)[XB_TMO], 1u); break; } } } } while (0)

struct XcdBarrier {
    unsigned* bar; unsigned x;
    volatile LAS unsigned* st;
};

__device__ __forceinline__ XcdBarrier xcd_barrier_post(unsigned* bar, volatile LAS unsigned* st) {
    XcdBarrier b; b.bar = bar; b.x = xb_xcc_id(); b.st = st;
    if (threadIdx.x == 0) (void)xb_add(&bar[XB_XCNT(b.x)], 1u);
    return b;
}
__device__ __forceinline__ void xcd_barrier_complete(unsigned* bar, unsigned x, unsigned& nloc, unsigned& nx) {
    const unsigned G = gridDim.x * gridDim.y * gridDim.z;
    unsigned sum, cnt, mine, sp = 0u;
    for (;;) {
        sum = 0u; cnt = 0u; mine = 0u;
#pragma unroll
        for (unsigned j = 0; j < 16; ++j) { const unsigned c = xb_ld(&bar[XB_XCNT(j)]); sum += c; cnt += (c > 0u) ? 1u : 0u; mine = (j == x) ? c : mine; }
        if (sum == G) break;
        __builtin_amdgcn_s_sleep(1);
        if ((++sp & 255u) == 0u) { if (xb_ld(&bar[XB_TMO])) break; if (sp > XB_SPIN_CAP) { atomicAdd(&bar[XB_TMO], 1u); break; } }
    }
    nloc = mine > 0u ? mine : 1u; nx = cnt > 0u ? cnt : 1u;
}

__device__ __forceinline__ void xcd_barrier(const XcdBarrier& b) {
    asm volatile("s_waitcnt vmcnt(0)" ::: "memory");
    __syncthreads();
    if (threadIdx.x == 0) {
        unsigned* bar = b.bar;
        __builtin_amdgcn_s_waitcnt(0);
        unsigned nloc = b.st[0], nx = b.st[1];
        if (nloc == 0u) { xcd_barrier_complete(bar, b.x, nloc, nx); b.st[0] = nloc; b.st[1] = nx; }
        const unsigned old = xb_add(&bar[XB_XSUB(b.x)], 1u);
        const unsigned gen = old / nloc;
        if (old + 1u == (gen + 1u) * nloc) {
            __builtin_amdgcn_fence(__ATOMIC_RELEASE, "agent");
            asm volatile("s_waitcnt vmcnt(0)" ::: "memory");
            const unsigned og = xb_add(&bar[XB_TOP], 1u);
            const unsigned tg = og / nx;
            if (og + 1u == (tg + 1u) * nx) xb_add(&bar[XB_TOPGEN], 1u);
            else XB_SPIN(xb_ld(&bar[XB_TOPGEN]) == tg, bar);
            __builtin_amdgcn_fence(__ATOMIC_ACQUIRE, "agent");
            xb_add(&bar[XB_XGEN(b.x)], 1u);
            asm volatile("s_waitcnt vmcnt(0)" ::: "memory");
        } else {
            XB_SPIN(xb_ld(&bar[XB_XGEN(b.x)]) == gen, bar);
            __builtin_amdgcn_fence(__ATOMIC_ACQUIRE, "agent");
            asm volatile("s_waitcnt vmcnt(0)" ::: "memory");
        }
    }
    __syncthreads();
}

struct Args { const float* in[35]; float* out; unsigned char* ws; int ph_lo, ph_hi; };

typedef const __attribute__((address_space(4))) unsigned char* kptr_t;
struct KArgs {
    kptr_t p;
    __device__ __forceinline__ const float* in(int i) const { return *(const float* const __attribute__((address_space(4)))*)(p + 8 * i); }
    __device__ __forceinline__ float* out() const { return *(float* const __attribute__((address_space(4)))*)(p + 280); }
    __device__ __forceinline__ unsigned char* ws() const { return *(unsigned char* const __attribute__((address_space(4)))*)(p + 288); }
};
#define FRESH_KA(name) KArgs name; { kptr_t q_ = (kptr_t)__builtin_amdgcn_kernarg_segment_ptr(); asm volatile("" : "+s"(q_)); name.p = q_; }
#define F_x (A.in(0))
#define F_c (A.in(1))
#define F_ctx (A.in(2))
#define F_cctx (A.in(3))
#define F_ada_w (A.in(4))
#define F_ada_b (A.in(5))
#define F_norm1_g (A.in(6))
#define F_norm2_g (A.in(7))
#define F_w_in (A.in(8))
#define F_mu (A.in(9))
#define F_w0 (A.in(10))
#define F_w_up (A.in(11))
#define F_a0 (A.in(12))
#define F_a_up (A.in(13))
#define F_g_up (A.in(14))
#define F_k_k (A.in(15))
#define F_k_a (A.in(16))
#define F_r_k (A.in(17))
#define F_ln_w (A.in(18))
#define F_ln_b (A.in(19))
#define F_w_ba (A.in(20))
#define F_sg_ln_w (A.in(21))
#define F_sg_ln_b (A.in(22))
#define F_sg_w (A.in(23))
#define F_sg_b (A.in(24))
#define F_w_bb (A.in(25))
#define F_w_out (A.in(26))
#define F_grp_w (A.in(27))
#define F_grp_b (A.in(28))
#define F_exp_w (A.in(29))
#define F_exp_b (A.in(30))
#define F_wg (A.in(31))
#define F_wu (A.in(32))
#define F_wd (A.in(33))
#define F_fin_g (A.in(34))
#define F_MOD ((float*)(A.ws() + WS_MOD))
#define F_rowinfo ((int*)(A.ws() + WS_ROWINFO))
#define F_roww ((float*)(A.ws() + WS_ROWW))
#define F_route ((unsigned*)(A.ws() + WS_ROUTE))
#define F_WinT ((bf16*)(A.ws() + WS_WIN))
#define F_WaT ((bf16*)(A.ws() + WS_WA))
#define F_WbT ((bf16*)(A.ws() + WS_WB))
#define F_WoutT ((bf16*)(A.ws() + WS_WOUT))
#define F_H ((bf16*)(A.ws() + WS_H))
#define F_ZA ((bf16*)(A.ws() + WS_ZA))
#define F_ZB ((bf16*)(A.ws() + WS_ZB))
#define F_ZG ((bf16*)(A.ws() + WS_ZG))
#define F_YB ((bf16*)(A.ws() + WS_YB))
#define F_YA ((bf16*)(A.ws() + WS_YA))
#define F_WguT ((bf16*)(A.ws() + WS_WGU))
#define F_WdT ((bf16*)(A.ws() + WS_WD))
#define F_XG ((bf16*)(A.ws() + WS_XG))
#define F_HMID ((bf16*)(A.ws() + WS_HMID))
#define F_YBUF ((bf16*)(A.ws() + WS_XG))
#define F_MG ((bf16*)(A.ws() + WS_ZB))
#define F_Y ((float*)(A.ws() + WS_Y))
#define F_out (A.out())
struct Frame {
    LAS unsigned char* lds;
    unsigned* ctl;
    unsigned char* ws;
    const float* const* in;
    int tid, lane, wave, G;
};


__device__ __forceinline__ void static_tile(int wgid, int nM, int nN, pg8::Unit& u) {
    const int nwg = nM * nN;
    { const int q = nwg / 8, r = nwg % 8, xcd = wgid % 8, off = wgid / 8; wgid = (xcd < r ? xcd * (q + 1) : r * (q + 1) + (xcd - r) * q) + off; }
    const int nig = 8 * nN, gid = wgid / nig, fm = gid * 8, gsz = (nM - fm) < 8 ? (nM - fm) : 8;
    u.pm = fm + ((wgid % nig) % gsz); u.pn = (wgid % nig) / gsz;
}

__device__ __forceinline__ void transpose_item(const float* W, int K, int N, int k0, int n0, bf16* WT, int dst_row0, LAS float* scr, int lane) {
#pragma unroll 8
    for (int i = 0; i < 32; ++i) { const int kk = 2 * i + (lane >> 5); scr[kk * 33 + (lane & 31)] = W[(size_t)(k0 + kk) * N + n0 + (lane & 31)]; }
    LDS_WAIT(); asm volatile("" ::: "memory");
    const int c = lane & 7;
#pragma unroll
    for (int j = 0; j < 4; ++j) { const int n = (lane >> 3) + 8 * j; const LAS float* s = scr + (8 * c) * 33 + n;
        u32x4 o; o.x = pk2(s[0 * 33], s[1 * 33]); o.y = pk2(s[2 * 33], s[3 * 33]); o.z = pk2(s[4 * 33], s[5 * 33]); o.w = pk2(s[6 * 33], s[7 * 33]);
        *(u32x4*)(WT + (size_t)(dst_row0 + n) * K + k0 + 8 * c) = o; }
    LDS_WAIT(); asm volatile("" ::: "memory");
}

__device__ __forceinline__ void p0_prologue(Frame& F, const KArgs& A) {
    {
        LAS float* red = (LAS float*)F.lds;
        const int cl = F.tid & 31, kg = F.tid >> 5;
        for (int cb = blockIdx.x; cb < 256; cb += F.G) {
            const int col = cb * 24 + cl; float a0 = 0.f, a1 = 0.f;
            if (cl < 24) for (int k = kg; k < D; k += 16) { const float w = F_ada_w[(size_t)k * 6144 + col]; a0 += siluf_(F_c[k]) * w; a1 += siluf_(F_cctx[k]) * w; }
            red[(kg * 32 + cl) * 2] = a0; red[(kg * 32 + cl) * 2 + 1] = a1;
            __syncthreads();
            if (F.tid < 48) { const int cc = F.tid % 24, i = F.tid / 24; float s = 0.f; for (int g = 0; g < 16; ++g) s += red[(g * 32 + cc) * 2 + i]; F_MOD[i * 6144 + cb * 24 + cc] = s + F_ada_b[cb * 24 + cc]; }
            __syncthreads();
        }
    }
    LAS float* scr = (LAS float*)(F.lds + F.wave * 16384);
    const int gw = blockIdx.x * 8 + F.wave, NGW = F.G * 8;
    constexpr int I_IN = 16 * 156, I_A = 8 * 32, I_B = 8 * 32, I_O = 16 * 32, NIT = I_IN + I_A + I_B + I_O;
    for (int it = gw; it < NIT; it += NGW) {
        int r = it;
        if (r < I_IN) { const int kb = r / 156, nb = r % 156, n0 = 32 * nb; transpose_item(F_w_in, D, WINC, 64 * kb, n0, F_WinT, n0 + (n0 >= PA ? 128 : 0), scr, F.lane); continue; } r -= I_IN;
        if (r < I_A) { const int kb = r / 32, nb = r % 32; transpose_item(F_w_ba, DR, D, 64 * kb, 32 * nb, F_WaT, 32 * nb, scr, F.lane); continue; } r -= I_A;
        if (r < I_B) { const int kb = r / 32, nb = r % 32; transpose_item(F_w_bb, DR, D, 64 * kb, 32 * nb, F_WbT, 32 * nb, scr, F.lane); continue; } r -= I_B;
        { const int kb = r / 32, nb = r % 32; transpose_item(F_w_out, D, D, 64 * kb, 32 * nb, F_WoutT, 32 * nb, scr, F.lane); }
    }
    for (int i = blockIdx.x * 512 + F.tid; i < 65536; i += F.G * 512) {
        const int ch = i >> 12, c = (i >> 6) & 63, r = i & 63, dd = ch >> 3, hh = ch & 7;
        ((bf16*)(A.ws() + WS_WUPT))[i] = (bf16)f2bf(F_w_up[(size_t)(dd * 64 + r) * DR + hh * 64 + c]);
        ((bf16*)(A.ws() + WS_AUPT))[i] = (bf16)f2bf(F_a_up[(size_t)(dd * 64 + r) * DR + hh * 64 + c]);
        const int hg = i >> 13, cg = (i >> 7) & 63, rg = i & 127;
        ((bf16*)(A.ws() + WS_GUPT))[i] = (bf16)f2bf(F_g_up[(size_t)rg * DR + hg * 64 + cg]);
    }
    for (int i = blockIdx.x * 512 + F.tid; i < 36 * D; i += F.G * 512) { const int ee = i >> 10, k = i & 1023;
        ((float*)(A.ws() + WS_WRT))[i] = ee < 4 ? F_grp_w[k * 4 + ee] : F_exp_w[k * 32 + ee - 4]; }
    for (int i = blockIdx.x * 512 + F.tid; i < 16384; i += F.G * 512) ((u32x4*)(F_WinT + (size_t)PA * D))[i] = (u32x4){0u, 0u, 0u, 0u};
}

__device__ __forceinline__ void norm_row_bf16(const float* src, const float* g, const float* sh, const float* sc, bf16* dst, int lane) {
    f32x4 v[4]; float ss = 0.f;
#pragma unroll
    for (int j = 0; j < 4; ++j) { v[j] = ((const f32x4*)src)[lane + 64 * j]; ss += (v[j].x * v[j].x + v[j].y * v[j].y) + (v[j].z * v[j].z + v[j].w * v[j].w); }
    const float rinv = rsqrtf(wave_sum(ss) * (1.0f / D) + NORM_EPS);
#pragma unroll
    for (int j = 0; j < 4; ++j) {
        const f32x4 gg = ((const f32x4*)g)[lane + 64 * j], s1 = ((const f32x4*)sc)[lane + 64 * j], s0 = ((const f32x4*)sh)[lane + 64 * j];
        const f32x4 hv = (v[j] * rinv * gg) * (1.0f + s1) + s0;
        u32x2 o; o.x = pk2(hv.x, hv.y); o.y = pk2(hv.z, hv.w);
        ((u32x2*)dst)[lane + 64 * j] = o;
    }
}
__device__ __forceinline__ void p1_norm1(Frame& F, const KArgs& A) {
    const int gw = blockIdx.x * 8 + F.wave, NGW = F.G * 8;
    for (int row = gw; row < MTOT; row += NGW) {
        const bool isctx = row >= SEQ;
        const float* src = isctx ? F_ctx + (size_t)(row - SEQ) * D : F_x + (size_t)row * D;
        const float* mod = F_MOD + (isctx ? 6144 : 0);
        norm_row_bf16(src, F_norm1_g, mod, mod + 1024, F_H + (size_t)row * D, F.lane);
    }
}

struct Sched1 {
    int G, c;
    __device__ __forceinline__ bool next(int i, pg8::Unit& u) const {
        long L = (long)i * G + c; if (L < 8) { u.pm = 64; u.pn = (int)L; return true; }
        L -= 8; if (L >= 1280) return false; static_tile((int)L, 64, 20, u); return true;
    }
    __device__ __forceinline__ void a_ready(const pg8::Unit&) const {}
    __device__ __forceinline__ void done(const pg8::Unit&) const {}
};
struct EpiZ {
    static constexpr bool PERM = true, AFTER_DRAIN = false;
    bf16 *ZA, *ZB, *ZG;
    __device__ __forceinline__ void operator()(const pg8::f32x4 (&acc)[2][2][4][2], const pg8::Unit& u, int wr, int wc, int fr, int fq) const {
        const int row0 = u.pm * 256 + wr * 64 + fr;
        bf16* base; int ld, colt;
        if (u.pn < 8) { base = ZA; ld = 2048; colt = u.pn * 256; } else if (u.pn < 12) { base = ZB; ld = 1024; colt = (u.pn - 8) * 256; } else { base = ZG; ld = 2048; colt = (u.pn - 12) * 256; }
        const int col0 = colt + wc * 32 + 8 * fq;
#pragma unroll
        for (int ai = 0; ai < 2; ++ai)
#pragma unroll
            for (int m = 0; m < 4; ++m) { bf16* rowp = base + (size_t)(row0 + ai * 128 + m * 16) * ld + col0;
#pragma unroll
                for (int bj = 0; bj < 2; ++bj) { const pg8::f32x4 v0 = acc[ai][bj][m][0], v1 = acc[ai][bj][m][1];
                    u32x4 w; w.x = pg8::cvt_pk_bf16(v0[0], v0[1]); w.y = pg8::cvt_pk_bf16(v0[2], v0[3]); w.z = pg8::cvt_pk_bf16(v1[0], v1[1]); w.w = pg8::cvt_pk_bf16(v1[2], v1[3]);
                    *(u32x4*)(rowp + bj * 128) = w; } }
    }
};

__device__ __forceinline__ float mixed_val(const bf16* ZA, bool isctx, int t, int col, float mu) {
    const int row = isctx ? SEQ + t : t;
    const bf16* Z = ZA + (size_t)row * 2048;
    int dr; bool ok;
    if (isctx) { const bool ev = (col & 1) == 0; dr = ev ? -1 : 1; ok = ev ? (t > 0) : (t < CTXL - 1); }
    else { const int s = col & 3, gx = t & 63, gy = t >> 6;
        dr = (s == 0) ? -1 : (s == 1) ? 1 : (s == 2) ? -64 : 64;
        ok = (s == 0) ? (gx > 0) : (s == 1) ? (gx < 63) : (s == 2) ? (gy > 0) : (gy < GROWS - 1); }
    const int dsafe = ok ? dr : 0;
    const float z = bf2f(Z[col]);
    const float nbv = bf2f(Z[col + dsafe * 2048]);
    const float nb = ok ? nbv : 0.f;
    return z + mu * (nb - z);
}
__device__ __forceinline__ void mixed8(const bf16* ZA, int t, int col0, const float* mu, float (&o)[8]) {
    const bf16* Z = ZA + (size_t)t * 2048 + col0;
    const int gx = t & 63, gy = t >> 6;
    const u32x4 z = *(const u32x4*)Z;
    const u32x4 zero = (u32x4){0u, 0u, 0u, 0u};
    const u32x4 l = gx > 0 ? *(const u32x4*)(Z - 2048) : zero, r = gx < 63 ? *(const u32x4*)(Z + 2048) : zero;
    const u32x4 up = gy > 0 ? *(const u32x4*)(Z - 64 * 2048) : zero, dn = gy < GROWS - 1 ? *(const u32x4*)(Z + 64 * 2048) : zero;
    const f32x4 m0 = *(const f32x4*)(mu + col0), m1 = *(const f32x4*)(mu + col0 + 4);
    float zz[8], nn[8];
    zz[0] = bflo(z.x); zz[1] = bfhi(z.x); zz[2] = bflo(z.y); zz[3] = bfhi(z.y); zz[4] = bflo(z.z); zz[5] = bfhi(z.z); zz[6] = bflo(z.w); zz[7] = bfhi(z.w);
    nn[0] = bflo(l.x); nn[1] = bfhi(r.x); nn[2] = bflo(up.y); nn[3] = bfhi(dn.y); nn[4] = bflo(l.z); nn[5] = bfhi(r.z); nn[6] = bflo(up.w); nn[7] = bfhi(dn.w);
    const float mm[8] = {m0.x, m0.y, m0.z, m0.w, m1.x, m1.y, m1.z, m1.w};
#pragma unroll
    for (int i = 0; i < 8; ++i) o[i] = zz[i] + mm[i] * (nn[i] - zz[i]);
}

__device__ __forceinline__ void p3_scan_naive(Frame& F, const KArgs& A, int chain) {
    const int d = chain >> 3, h = chain & 7, j = F.lane, c = h * 64 + j, w = F.wave;
    float wup[64], aup[64];
#pragma unroll
    for (int r = 0; r < 64; ++r) { wup[r] = F_w_up[(size_t)(d * 64 + r) * DR + c]; aup[r] = F_a_up[(size_t)(d * 64 + r) * DR + c]; }
    const float w0 = F_w0[d * DR + c], a0 = F_a0[d * DR + c], kkc = F_k_k[c], kac = F_k_a[c];
    const int col_w = 1536 + d * 64 + j, col_a = 1664 + d * 64 + j;
    const float mu_r = F_mu[c], mu_k = F_mu[512 + c], mu_v = F_mu[1024 + c], mu_w = F_mu[col_w], mu_a = F_mu[col_a];
    float S[8];
#pragma unroll
    for (int i = 0; i < 8; ++i) S[i] = 0.f;
    float* Yd = F_Y + (size_t)d * SEQ * DR;
    const int NSTEP = CTXL + SEQ;
    float nr, nk, nv, nwd, nad;
    { const bool ic = true; const int t = d ? CTXL - 1 : 0;
      nr = mixed_val(F_ZA, ic, t, c, mu_r); nk = mixed_val(F_ZA, ic, t, 512 + c, mu_k); nv = mixed_val(F_ZA, ic, t, 1024 + c, mu_v); nwd = mixed_val(F_ZA, ic, t, col_w, mu_w); nad = mixed_val(F_ZA, ic, t, col_a, mu_a); }
    for (int step = 0; step < NSTEP; ++step) {
        const bool isctx = step < CTXL;
        const int t = isctx ? (d ? CTXL - 1 - step : step) : (d ? SEQ - 1 - (step - CTXL) : step - CTXL);
        const float r = nr, k = nk, v = nv, wd = nwd, ad = nad;
        if (step + 1 < NSTEP) { const int s2 = step + 1; const bool ic = s2 < CTXL; const int t2 = ic ? (d ? CTXL - 1 - s2 : s2) : (d ? SEQ - 1 - (s2 - CTXL) : s2 - CTXL);
            nr = mixed_val(F_ZA, ic, t2, c, mu_r); nk = mixed_val(F_ZA, ic, t2, 512 + c, mu_k); nv = mixed_val(F_ZA, ic, t2, 1024 + c, mu_v); nwd = mixed_val(F_ZA, ic, t2, col_w, mu_w); nad = mixed_val(F_ZA, ic, t2, col_a, mu_a); }
        const float twd = tanhf(wd);
        float wl = w0, al = a0;
#pragma unroll
        for (int rr = 0; rr < 64; ++rr) { const float tw = __builtin_bit_cast(float, __builtin_amdgcn_readlane(__builtin_bit_cast(int, twd), rr)); const float ta = __builtin_bit_cast(float, __builtin_amdgcn_readlane(__builtin_bit_cast(int, ad), rr));
            wl += tw * wup[rr]; al += ta * aup[rr]; }
        const float wv = -softplusf_(-wl) - 0.5f, dec = __expf(-__expf(wv)), a = sigmoidf_(al);
        float kk = k * kkc; const float n2 = wave_sum(kk * kk); kk = kk / fmaxf(sqrtf(n2), 1e-12f);
        const float kd = k * (1.0f + (a - 1.0f) * kac), kka = kk * a;
        float yv = 0.f;
#pragma unroll
        for (int i = 0; i < 8; ++i) {
            const float sa = wave_sum(S[i] * kk);
            const float vi = __builtin_bit_cast(float, __builtin_amdgcn_readlane(__builtin_bit_cast(int, v), 8 * w + i));
            S[i] = S[i] * dec - sa * kka + vi * kd;
            const float y = wave_sum(S[i] * r);
            yv = (j == i) ? y : yv;
        }
        if (!isctx && j < 8) Yd[(size_t)t * DR + h * 64 + 8 * w + j] = yv;
    }
}

constexpr int MB_LD = 136;
__device__ __forceinline__ void p3_mixer_b(Frame& F, const KArgs& A, int chunk) {
    LAS float* stats = (LAS float*)F.lds;
    LAS bf16* Wl = (LAS bf16*)(F.lds + 1024);
    LAS bf16* VT = (LAS bf16*)(F.lds + 1024 + 128 * MB_LD * 2);
    const int tok0 = chunk * 128, lane = F.lane, w = F.wave;
    for (int rr = 0; rr < 16; ++rr) {
        const int q = w * 16 + rr;
        const u32x4 raw = *(const u32x4*)(F_ZB + (size_t)(tok0 + q) * 1024 + 512 + 8 * lane);
        float g[8]; g[0] = gelu_tanh(bflo(raw.x)); g[1] = gelu_tanh(bfhi(raw.x)); g[2] = gelu_tanh(bflo(raw.y)); g[3] = gelu_tanh(bfhi(raw.y));
        g[4] = gelu_tanh(bflo(raw.z)); g[5] = gelu_tanh(bfhi(raw.z)); g[6] = gelu_tanh(bflo(raw.w)); g[7] = gelu_tanh(bfhi(raw.w));
        float s = 0.f;
#pragma unroll
        for (int i = 0; i < 8; ++i) s += g[i];
        const float mean = wave_sum(s) * (1.0f / 512.0f); float s2 = 0.f;
#pragma unroll
        for (int i = 0; i < 8; ++i) { const float dlt = g[i] - mean; s2 += dlt * dlt; }
        const float rstd = rsqrtf(wave_sum(s2) * (1.0f / 512.0f) + 1e-5f);
        if (lane == 0) { stats[q * 2] = mean; stats[q * 2 + 1] = rstd; }
    }
    __syncthreads();
    for (int g = 0; g < 4; ++g) {
        for (int i = F.tid; i < 128 * 32; i += 512) { const int p = i >> 5, q4 = (i & 31) * 4; const f32x4 wv = *(const f32x4*)(F_sg_w + (size_t)(g * 128 + p) * 128 + q4);
            u32x2 o; o.x = pk2(wv.x, wv.y); o.y = pk2(wv.z, wv.w); *(LAS u32x2*)(Wl + p * MB_LD + q4) = o; }
        for (int rr = 0; rr < 16; ++rr) {
            const int q = w * 16 + rr; const float mean = stats[q * 2], rstd = stats[q * 2 + 1];
            const unsigned raw = *(const unsigned*)(F_ZB + (size_t)(tok0 + q) * 1024 + 512 + g * 128 + 2 * lane);
            const int c0 = 2 * lane;
            const float v0 = (gelu_tanh(bflo(raw)) - mean) * rstd * F_sg_ln_w[g * 128 + c0] + F_sg_ln_b[g * 128 + c0];
            const float v1 = (gelu_tanh(bfhi(raw)) - mean) * rstd * F_sg_ln_w[g * 128 + c0 + 1] + F_sg_ln_b[g * 128 + c0 + 1];
            VT[c0 * MB_LD + q] = (bf16)f2bf(v0); VT[(c0 + 1) * MB_LD + q] = (bf16)f2bf(v1);
        }
        __syncthreads();
        const int fr = lane & 15, fq = lane >> 4;
        pg8::f32x4 acc[8];
#pragma unroll
        for (int ct = 0; ct < 8; ++ct) acc[ct] = (pg8::f32x4){0.f, 0.f, 0.f, 0.f};
#pragma unroll
        for (int ks = 0; ks < 4; ++ks) {
            const bf16x8 bfrag = *(const LAS bf16x8*)(Wl + (16 * w + fr) * MB_LD + 32 * ks + 8 * fq);
#pragma unroll
            for (int ct = 0; ct < 8; ++ct) { const bf16x8 afrag = *(const LAS bf16x8*)(VT + (16 * ct + fr) * MB_LD + 32 * ks + 8 * fq);
                acc[ct] = __builtin_amdgcn_mfma_f32_16x16x32_bf16(afrag, bfrag, acc[ct], 0, 0, 0); }
        }
        const int p = 16 * w + fr; const float sb = F_sg_b[g * 128 + p];
#pragma unroll
        for (int ct = 0; ct < 8; ++ct) {
            const int c0 = 16 * ct + 4 * fq;
            const u32x2 uraw = *(const u32x2*)(F_ZB + (size_t)(tok0 + p) * 1024 + g * 128 + c0);
            const float u0 = gelu_tanh(bflo(uraw.x)), u1 = gelu_tanh(bfhi(uraw.x)), u2 = gelu_tanh(bflo(uraw.y)), u3 = gelu_tanh(bfhi(uraw.y));
            u32x2 o; o.x = pk2(u0 * (acc[ct][0] + sb), u1 * (acc[ct][1] + sb)); o.y = pk2(u2 * (acc[ct][2] + sb), u3 * (acc[ct][3] + sb));
            *(u32x2*)(F_YB + (size_t)(tok0 + p) * DR + g * 128 + c0) = o;
        }
        __syncthreads();
    }
}

__device__ __forceinline__ void p4_rwkv_out(Frame& F, const KArgs& A) {
    const int gw = blockIdx.x * 8 + F.wave, NGW = F.G * 8, l = F.lane, h = l >> 3;
    for (int t = gw; t < SEQ; t += NGW) {
        float y[8];
        { const f32x4 a0 = *(const f32x4*)(F_Y + (size_t)t * DR + 8 * l), a1 = *(const f32x4*)(F_Y + (size_t)t * DR + 8 * l + 4);
          const f32x4 b0 = *(const f32x4*)(F_Y + (size_t)(SEQ + t) * DR + 8 * l), b1 = *(const f32x4*)(F_Y + (size_t)(SEQ + t) * DR + 8 * l + 4);
          y[0] = a0.x + b0.x; y[1] = a0.y + b0.y; y[2] = a0.z + b0.z; y[3] = a0.w + b0.w; y[4] = a1.x + b1.x; y[5] = a1.y + b1.y; y[6] = a1.z + b1.z; y[7] = a1.w + b1.w; }
        float s = 0.f;
#pragma unroll
        for (int i = 0; i < 8; ++i) s += y[i];
        s += __shfl_xor(s, 1); s += __shfl_xor(s, 2); s += __shfl_xor(s, 4);
        const float mean = s * (1.0f / 64.0f); float s2 = 0.f;
#pragma unroll
        for (int i = 0; i < 8; ++i) { const float dlt = y[i] - mean; s2 += dlt * dlt; }
        s2 += __shfl_xor(s2, 1); s2 += __shfl_xor(s2, 2); s2 += __shfl_xor(s2, 4);
        const float rstd = rsqrtf(s2 * (1.0f / 64.0f) + GN_EPS);
        float r[8], k[8], v[8];
        mixed8(F_ZA, t, 8 * l, F_mu, r); mixed8(F_ZA, t, 512 + 8 * l, F_mu, k); mixed8(F_ZA, t, 1024 + 8 * l, F_mu, v);
        float dp = 0.f;
#pragma unroll
        for (int i = 0; i < 8; ++i) dp += r[i] * k[i] * F_r_k[8 * l + i];
        dp += __shfl_xor(dp, 1); dp += __shfl_xor(dp, 2); dp += __shfl_xor(dp, 4);
        const float sg0 = sigmoidf_(mixed_val(F_ZA, false, t, 1792 + 2 * l, F_mu[1792 + 2 * l])), sg1 = sigmoidf_(mixed_val(F_ZA, false, t, 1793 + 2 * l, F_mu[1793 + 2 * l]));
        float g[8];
#pragma unroll
        for (int i = 0; i < 8; ++i) g[i] = 0.f;
        for (int rr = 0; rr < 64; ++rr) {
            const float s0 = __shfl(sg0, rr), s1 = __shfl(sg1, rr);
            const f32x4 u0 = *(const f32x4*)(F_g_up + (size_t)(2 * rr) * DR + 8 * l), u1 = *(const f32x4*)(F_g_up + (size_t)(2 * rr) * DR + 8 * l + 4);
            const f32x4 w0 = *(const f32x4*)(F_g_up + (size_t)(2 * rr + 1) * DR + 8 * l), w1 = *(const f32x4*)(F_g_up + (size_t)(2 * rr + 1) * DR + 8 * l + 4);
            g[0] += s0 * u0.x + s1 * w0.x; g[1] += s0 * u0.y + s1 * w0.y; g[2] += s0 * u0.z + s1 * w0.z; g[3] += s0 * u0.w + s1 * w0.w;
            g[4] += s0 * u1.x + s1 * w1.x; g[5] += s0 * u1.y + s1 * w1.y; g[6] += s0 * u1.z + s1 * w1.z; g[7] += s0 * u1.w + s1 * w1.w;
        }
        float o[8];
#pragma unroll
        for (int i = 0; i < 8; ++i) { const float yn = (y[i] - mean) * rstd * F_ln_w[8 * l + i] + F_ln_b[8 * l + i]; o[i] = (yn + dp * v[i]) * g[i]; }
        u32x4 pk; pk.x = pk2(o[0], o[1]); pk.y = pk2(o[2], o[3]); pk.z = pk2(o[4], o[5]); pk.w = pk2(o[6], o[7]);
        *(u32x4*)(F_YA + (size_t)t * DR + 8 * l) = pk;
        (void)h;
    }
}

struct SchedStd {
    int nM, nN, G, c;
    __device__ __forceinline__ bool next(int i, pg8::Unit& u) const { const long L = (long)i * G + c; if (L >= (long)nM * nN) return false; static_tile((int)L, nM, nN, u); return true; }
    __device__ __forceinline__ void a_ready(const pg8::Unit&) const {}
    __device__ __forceinline__ void done(const pg8::Unit&) const {}
};
__device__ __forceinline__ void sig8(const bf16* p, float (&o)[8]) {
    const u32x4 raw = *(const u32x4*)p;
    o[0] = sigmoidf_(bflo(raw.x)); o[1] = sigmoidf_(bfhi(raw.x)); o[2] = sigmoidf_(bflo(raw.y)); o[3] = sigmoidf_(bfhi(raw.y));
    o[4] = sigmoidf_(bflo(raw.z)); o[5] = sigmoidf_(bfhi(raw.z)); o[6] = sigmoidf_(bflo(raw.w)); o[7] = sigmoidf_(bfhi(raw.w));
}
struct EpiMergeA {
    static constexpr bool PERM = true, AFTER_DRAIN = false;
    float* T; const bf16* ZG;
    __device__ __forceinline__ void operator()(const pg8::f32x4 (&acc)[2][2][4][2], const pg8::Unit& u, int wr, int wc, int fr, int fq) const {
        const int row0 = u.pm * 256 + wr * 64 + fr, col0 = u.pn * 256 + wc * 32 + 8 * fq;
#pragma unroll
        for (int ai = 0; ai < 2; ++ai)
#pragma unroll
            for (int m = 0; m < 4; ++m) { const size_t row = (size_t)(row0 + ai * 128 + m * 16);
#pragma unroll
                for (int bj = 0; bj < 2; ++bj) { const int col = col0 + bj * 128; float gt[8]; sig8(ZG + row * 2048 + col, gt);
                    const pg8::f32x4 v0 = acc[ai][bj][m][0], v1 = acc[ai][bj][m][1];
                    *(f32x4*)(T + row * D + col) = (f32x4){gt[0] * v0[0], gt[1] * v0[1], gt[2] * v0[2], gt[3] * v0[3]};
                    *(f32x4*)(T + row * D + col + 4) = (f32x4){gt[4] * v1[0], gt[5] * v1[1], gt[6] * v1[2], gt[7] * v1[3]}; } }
    }
};
struct EpiMergeB {
    static constexpr bool PERM = true, AFTER_DRAIN = false;
    const float* T; const bf16* ZG; bf16* MG;
    __device__ __forceinline__ void operator()(const pg8::f32x4 (&acc)[2][2][4][2], const pg8::Unit& u, int wr, int wc, int fr, int fq) const {
        const int row0 = u.pm * 256 + wr * 64 + fr, col0 = u.pn * 256 + wc * 32 + 8 * fq;
#pragma unroll
        for (int ai = 0; ai < 2; ++ai)
#pragma unroll
            for (int m = 0; m < 4; ++m) { const size_t row = (size_t)(row0 + ai * 128 + m * 16);
#pragma unroll
                for (int bj = 0; bj < 2; ++bj) { const int col = col0 + bj * 128; float gt[8]; sig8(ZG + row * 2048 + 1024 + col, gt);
                    const pg8::f32x4 v0 = acc[ai][bj][m][0], v1 = acc[ai][bj][m][1];
                    const f32x4 t0 = *(const f32x4*)(T + row * D + col), t1 = *(const f32x4*)(T + row * D + col + 4);
                    u32x4 w; w.x = pk2(t0.x + gt[0] * v0[0], t0.y + gt[1] * v0[1]); w.y = pk2(t0.z + gt[2] * v0[2], t0.w + gt[3] * v0[3]);
                    w.z = pk2(t1.x + gt[4] * v1[0], t1.y + gt[5] * v1[1]); w.w = pk2(t1.z + gt[6] * v1[2], t1.w + gt[7] * v1[3]);
                    *(u32x4*)(MG + row * D + col) = w; } }
    }
};
struct EpiX1 {
    static constexpr bool PERM = false, AFTER_DRAIN = false;
    const float* x; const float* gt1; float* out;
    __device__ __forceinline__ void operator()(const pg8::f32x4 (&acc)[2][2][4][2], const pg8::Unit& u, int wr, int wc, int fr, int fq) const {
        const int row0 = u.pm * 256 + wr * 64 + fr, col0 = u.pn * 256 + wc * 32 + 4 * fq;
#pragma unroll
        for (int ai = 0; ai < 2; ++ai)
#pragma unroll
            for (int m = 0; m < 4; ++m) { const size_t row = (size_t)(row0 + ai * 128 + m * 16);
#pragma unroll
                for (int bj = 0; bj < 2; ++bj)
#pragma unroll
                    for (int n = 0; n < 2; ++n) { const int col = col0 + bj * 128 + n * 16;
                        const f32x4 xv = *(const f32x4*)(x + row * D + col), gv = *(const f32x4*)(gt1 + col); const pg8::f32x4 a = acc[ai][bj][m][n];
                        *(f32x4*)(out + row * D + col) = (f32x4){xv.x + gv.x * a[0], xv.y + gv.y * a[1], xv.z + gv.z * a[2], xv.w + gv.w * a[3]}; } }
    }
};

__device__ __forceinline__ void route_decide(const float (&lg)[36], const float* grp_b, const float* exp_b, unsigned* ctl, unsigned* rt) {
    float gl[4]; int grp = 0;
#pragma unroll
    for (int q = 0; q < 4; ++q) gl[q] = lg[q] + grp_b[q];
#pragma unroll
    for (int q = 1; q < 4; ++q) if (gl[q] > gl[grp]) grp = q;
    float den = 0.f;
#pragma unroll
    for (int q = 0; q < 4; ++q) den += __expf(gl[q] - gl[grp]);
    const float pg = 1.0f / den;
    float el[8];
#pragma unroll
    for (int q = 0; q < 8; ++q) { float val = 0.f;
#pragma unroll
        for (int gq = 0; gq < 4; ++gq) val = (grp == gq) ? lg[4 + gq * 8 + q] + exp_b[gq * 8 + q] : val;
        el[q] = val; }
    int i1 = 0;
#pragma unroll
    for (int q = 1; q < 8; ++q) if (el[q] > el[i1]) i1 = q;
    int i2 = (i1 == 0) ? 1 : 0;
#pragma unroll
    for (int q = 0; q < 8; ++q) if (q != i1 && el[q] > el[i2]) i2 = q;
    const float v1 = el[i1], v2 = el[i2];
    const float e2 = __expf(v2 - v1), w1 = pg / (1.0f + e2), w2 = pg * e2 / (1.0f + e2);
    const int e1x = grp * 8 + i1, e2x = grp * 8 + i2;
    const unsigned p1 = atomicAdd(ctl + CW_CNT + 64 * e1x, 1u), p2 = atomicAdd(ctl + CW_CNT + 64 * e2x, 1u);
    rt[0] = (unsigned)e1x; rt[1] = p1; rt[2] = __builtin_bit_cast(unsigned, w1); rt[3] = (unsigned)e2x; rt[4] = p2; rt[5] = __builtin_bit_cast(unsigned, w2);
}
__device__ __forceinline__ void p7_router(Frame& F, const KArgs& A) {
    const int gw = blockIdx.x * 8 + F.wave, NGW = F.G * 8, lane = F.lane;
    const float* mod = F_MOD;
    { const f32x4* src = (const f32x4*)(A.ws() + WS_WRT); LAS f32x4* dst = (LAS f32x4*)F.lds;
      for (int i = F.tid; i < 36 * D / 4; i += 512) dst[i] = src[i]; }
    __syncthreads();
    const LAS f32x4* wl = (const LAS f32x4*)F.lds;
    for (int tp = gw; tp < SEQ / 2; tp += NGW) {
        const int t0 = 2 * tp;
        const float* src0 = F_out + (size_t)t0 * D; const float* src1 = src0 + D;
        f32x4 h0[4], h1[4]; float ss0 = 0.f, ss1 = 0.f;
#pragma unroll
        for (int j = 0; j < 4; ++j) { h0[j] = ((const f32x4*)src0)[lane + 64 * j]; h1[j] = ((const f32x4*)src1)[lane + 64 * j];
            ss0 += (h0[j].x * h0[j].x + h0[j].y * h0[j].y) + (h0[j].z * h0[j].z + h0[j].w * h0[j].w); ss1 += (h1[j].x * h1[j].x + h1[j].y * h1[j].y) + (h1[j].z * h1[j].z + h1[j].w * h1[j].w); }
        const float r0 = rsqrtf(wave_sum(ss0) * (1.0f / D) + NORM_EPS), r1 = rsqrtf(wave_sum(ss1) * (1.0f / D) + NORM_EPS);
#pragma unroll
        for (int j = 0; j < 4; ++j) {
            const f32x4 gg = ((const f32x4*)F_norm2_g)[lane + 64 * j], s1 = ((const f32x4*)(mod + 4096))[lane + 64 * j], s0 = ((const f32x4*)(mod + 3072))[lane + 64 * j];
            const f32x4 gs = gg * (1.0f + s1);
            h0[j] = (h0[j] * r0) * gs + s0; h1[j] = (h1[j] * r1) * gs + s0;
            u32x2 o; o.x = pk2(h0[j].x, h0[j].y); o.y = pk2(h0[j].z, h0[j].w); ((u32x2*)(F_H + (size_t)t0 * D))[lane + 64 * j] = o;
            o.x = pk2(h1[j].x, h1[j].y); o.y = pk2(h1[j].z, h1[j].w); ((u32x2*)(F_H + (size_t)(t0 + 1) * D))[lane + 64 * j] = o;
        }
        LAS float* lgs = (LAS float*)(F.lds + 147456 + F.wave * 512);
#pragma unroll 2
        for (int e = 0; e < 36; ++e) {
            float a0 = 0.f, a1 = 0.f;
#pragma unroll
            for (int j = 0; j < 4; ++j) { const f32x4 wv = wl[e * 256 + lane + 64 * j];
                a0 += (h0[j].x * wv.x + h0[j].y * wv.y) + (h0[j].z * wv.z + h0[j].w * wv.w); a1 += (h1[j].x * wv.x + h1[j].y * wv.y) + (h1[j].z * wv.z + h1[j].w * wv.w); }
            const bool lo = lane < 32; float xk = lo ? a0 : a1; const float yk = lo ? a1 : a0;
            xk += __shfl_xor(yk, 32);
            xk += __shfl_xor(xk, 16); xk += __shfl_xor(xk, 8); xk += __shfl_xor(xk, 4); xk += __shfl_xor(xk, 2); xk += __shfl_xor(xk, 1);
            if ((lane & 31) == 0) lgs[(lane >> 5) * 36 + e] = xk;
        }
        LDS_WAIT();
        float lg[36];
        if ((lane & 31) == 0) {
#pragma unroll
            for (int q = 0; q < 9; ++q) { const f32x4 v4 = *(const LAS f32x4*)(lgs + (lane >> 5) * 36 + 4 * q); lg[4 * q] = v4.x; lg[4 * q + 1] = v4.y; lg[4 * q + 2] = v4.z; lg[4 * q + 3] = v4.w; }
        }
        if ((lane & 31) == 0) route_decide(lg, F_grp_b, F_exp_b, F.ctl, F_route + (size_t)(t0 + (lane >> 5)) * 8);
    }
    __syncthreads();
    {
    LAS float* scr = (LAS float*)(F.lds + F.wave * 16384);
    for (int it = gw; it < NEXP * 768; it += NGW) {
        const int e = it / 768; int r = it % 768;
        if (r < 512) { const bool up = r >= 256; r &= 255; const int kb = r / 16, nb = r % 16, n0 = 32 * nb;
            const float* W = (up ? F_wu : F_wg) + (size_t)e * D * DEXP;
            transpose_item(W, D, DEXP, 64 * kb, n0, F_WguT + (size_t)e * 1024 * D, 256 * (n0 >> 7) + (up ? 128 : 0) + (n0 & 127), scr, lane);
        } else { r -= 512; const int kb = r / 32, nb = r % 32;
            transpose_item(F_wd + (size_t)e * DEXP * D, DEXP, D, 64 * kb, 32 * nb, F_WdT + (size_t)e * 1024 * DEXP, 32 * nb, scr, lane); }
    }
    }
}

__device__ __forceinline__ int moe_tables(Frame& F, const KArgs& A) {
    LAS int* tab = (LAS int*)(F.lds + TAB_OFF);
    __syncthreads();
    if (F.tid == 0) {
        int off = 0;
        for (int e = 0; e < NEXP; ++e) { const int cnt = (int)__hip_atomic_load(F.ctl + CW_CNT + 64 * e, __ATOMIC_RELAXED, __HIP_MEMORY_SCOPE_AGENT); const int nt = (cnt + 255) >> 8;
            tab[e] = off * 256; tab[64 + e] = cnt; for (int q = 0; q < nt && off + q < MAXTILES; ++q) tab[128 + off + q] = e; off += nt; }
        tab[32] = off < MAXTILES ? off : MAXTILES;
    }
    __syncthreads();
    return tab[32];
}

__device__ __forceinline__ void p8_gather(Frame& F, const KArgs& A) {
    const int ntiles = moe_tables(F, A);
    LAS int* tab = (LAS int*)(F.lds + TAB_OFF);
    const int gw = blockIdx.x * 8 + F.wave, NGW = F.G * 8, lane = F.lane;
    for (int t = gw; t < SEQ; t += NGW) {
        const unsigned* rt = F_route + (size_t)t * 8;
        const u32x4 h0 = ((const u32x4*)(F_H + (size_t)t * D))[lane], h1 = ((const u32x4*)(F_H + (size_t)t * D))[lane + 64];
#pragma unroll
        for (int s = 0; s < 2; ++s) {
            const int e = (int)rt[3 * s], pos = (int)rt[3 * s + 1]; const int row = tab[e] + pos;
            if (row < MAXTILES * 256) {
                ((u32x4*)(F_XG + (size_t)row * D))[lane] = h0; ((u32x4*)(F_XG + (size_t)row * D))[lane + 64] = h1;
                if (lane == 0) { F_rowinfo[row] = 2 * t + s; F_roww[row] = __builtin_bit_cast(float, rt[3 * s + 2]); }
            }
        }
    }
    for (int e = blockIdx.x; e < NEXP; e += F.G) {
        const int cnt = tab[64 + e], r0 = tab[e] + cnt, r1 = tab[e] + (((cnt + 255) >> 8) << 8);
        for (int row = r0 + F.wave; row < r1 && row < MAXTILES * 256; row += 8) {
            ((u32x4*)(F_XG + (size_t)row * D))[lane] = (u32x4){0u, 0u, 0u, 0u}; ((u32x4*)(F_XG + (size_t)row * D))[lane + 64] = (u32x4){0u, 0u, 0u, 0u};
            if (lane == 0) { F_rowinfo[row] = -1; F_roww[row] = 0.f; }
        }
    }
    (void)ntiles;
}

struct MoeOrder {
    const LAS int* tile_e; int T4, G, c;
    __device__ __forceinline__ bool next(int i, pg8::Unit& u) const { const long L = (long)i * G + c; if (L >= T4) return false; const int rt = (int)(L >> 2), j = (int)(L & 3); u.pm = rt; u.pn = tile_e[rt] * 4 + j; return true; }
    __device__ __forceinline__ void a_ready(const pg8::Unit&) const {}
    __device__ __forceinline__ void done(const pg8::Unit&) const {}
};
struct EpiSwiGLU {
    static constexpr bool PERM = true, AFTER_DRAIN = false;
    bf16* HM;
    __device__ __forceinline__ void operator()(const pg8::f32x4 (&acc)[2][2][4][2], const pg8::Unit& u, int wr, int wc, int fr, int fq) const {
        const int row0 = u.pm * 256 + wr * 64 + fr, col0 = (u.pn & 3) * 128 + wc * 32 + 8 * fq;
#pragma unroll
        for (int ai = 0; ai < 2; ++ai)
#pragma unroll
            for (int m = 0; m < 4; ++m) { const size_t row = (size_t)(row0 + ai * 128 + m * 16);
                const pg8::f32x4 g0 = acc[ai][0][m][0], g1 = acc[ai][0][m][1], u0 = acc[ai][1][m][0], u1 = acc[ai][1][m][1];
                u32x4 w; w.x = pk2(siluf_(g0[0]) * u0[0], siluf_(g0[1]) * u0[1]); w.y = pk2(siluf_(g0[2]) * u0[2], siluf_(g0[3]) * u0[3]);
                w.z = pk2(siluf_(g1[0]) * u1[0], siluf_(g1[1]) * u1[1]); w.w = pk2(siluf_(g1[2]) * u1[2], siluf_(g1[3]) * u1[3]);
                *(u32x4*)(HM + row * DEXP + col0) = w; }
    }
};
struct EpiScatter {
    static constexpr bool PERM = true, AFTER_DRAIN = false;
    bf16* YBUF; const int* rowinfo; const float* roww;
    __device__ __forceinline__ void operator()(const pg8::f32x4 (&acc)[2][2][4][2], const pg8::Unit& u, int wr, int wc, int fr, int fq) const {
        const int row0 = u.pm * 256 + wr * 64 + fr, col0 = (u.pn & 3) * 256 + wc * 32 + 8 * fq;
#pragma unroll
        for (int ai = 0; ai < 2; ++ai)
#pragma unroll
            for (int m = 0; m < 4; ++m) { const int row = row0 + ai * 128 + m * 16; const int info = rowinfo[row]; const float wt = roww[row];
                if (info >= 0) {
#pragma unroll
                    for (int bj = 0; bj < 2; ++bj) { const pg8::f32x4 v0 = acc[ai][bj][m][0], v1 = acc[ai][bj][m][1];
                        u32x4 w; w.x = pk2(wt * v0[0], wt * v0[1]); w.y = pk2(wt * v0[2], wt * v0[3]); w.z = pk2(wt * v1[0], wt * v1[1]); w.w = pk2(wt * v1[2], wt * v1[3]);
                        *(u32x4*)(YBUF + (size_t)info * D + col0 + bj * 128) = w; } } }
    }
};

__device__ __forceinline__ void p11_final(Frame& F, const KArgs& A) {
    const int gw = blockIdx.x * 8 + F.wave, NGW = F.G * 8, lane = F.lane;
    const float* gt2 = F_MOD + 5120;
    for (int t = gw; t < SEQ; t += NGW) {
        float* row = F_out + (size_t)t * D;
        f32x4 v[4]; float ss = 0.f;
#pragma unroll
        for (int j = 0; j < 4; ++j) {
            const f32x4 x1 = ((const f32x4*)row)[lane + 64 * j], g2 = ((const f32x4*)gt2)[lane + 64 * j];
            const u32x2 y0 = ((const u32x2*)(F_YBUF + (size_t)(2 * t) * D))[lane + 64 * j], y1 = ((const u32x2*)(F_YBUF + (size_t)(2 * t + 1) * D))[lane + 64 * j];
            f32x4 ys; ys.x = bflo(y0.x) + bflo(y1.x); ys.y = bfhi(y0.x) + bfhi(y1.x); ys.z = bflo(y0.y) + bflo(y1.y); ys.w = bfhi(y0.y) + bfhi(y1.y);
            v[j] = x1 + g2 * ys;
            ss += (v[j].x * v[j].x + v[j].y * v[j].y) + (v[j].z * v[j].z + v[j].w * v[j].w);
        }
        const float rinv = rsqrtf(wave_sum(ss) * (1.0f / D) + NORM_EPS);
#pragma unroll
        for (int j = 0; j < 4; ++j) { const f32x4 fg = ((const f32x4*)F_fin_g)[lane + 64 * j]; ((f32x4*)row)[lane + 64 * j] = v[j] * rinv * fg; }
    }
}


constexpr int SL = 8192;
constexpr int SC_LBUF = 12 * SL;
constexpr int SC_MISC = 19 * SL;

__device__ __forceinline__ int m_off(int r, int c) { return r * 128 + ((((c >> 3) ^ r) & 7) << 4) + ((c & 7) << 1); }
__device__ __forceinline__ int frag_off(int r, int chunk) { return r * 128 + (((chunk ^ r) & 7) << 4); }
__device__ __forceinline__ float tanh_fast(float x) { const float e = __expf(2.0f * x); return 1.0f - 2.0f / (e + 1.0f); }

template <bool SWAP> __device__ __forceinline__ void mm_tiles(const LAS unsigned char* X, const LAS unsigned char* Y, int mt, int nt0, int fr, int fq, pg8::f32x4 (&acc)[2]) {
#pragma unroll
    for (int ks = 0; ks < 2; ++ks) {
        const bf16x8 xf = *(const LAS bf16x8*)(X + frag_off(16 * mt + fr, 4 * ks + fq));
#pragma unroll
        for (int n = 0; n < 2; ++n) {
            const bf16x8 yf = *(const LAS bf16x8*)(Y + frag_off(16 * (nt0 + n) + fr, 4 * ks + fq));
            acc[n] = SWAP ? __builtin_amdgcn_mfma_f32_16x16x32_bf16(yf, xf, acc[n], 0, 0, 0) : __builtin_amdgcn_mfma_f32_16x16x32_bf16(xf, yf, acc[n], 0, 0, 0);
        }
    }
}
__device__ __forceinline__ void st4(LAS unsigned char* slot, int r, int c, float a, float b, float cc, float d) { u32x2 o; o.x = pk2(a, b); o.y = pk2(cc, d); *(LAS u32x2*)(slot + m_off(r, c)) = o; }
__device__ __forceinline__ pg8::f32x4 ld4(const LAS unsigned char* slot, int r, int c) { const u32x2 w = *(const LAS u32x2*)(slot + m_off(r, c)); return (pg8::f32x4){bflo(w.x), bfhi(w.x), bflo(w.y), bfhi(w.y)}; }
__device__ __forceinline__ int opq(int x) { asm volatile("" : "+v"(x)); return x; }
#define ZERO2(a) do { a[0] = (pg8::f32x4){0.f, 0.f, 0.f, 0.f}; a[1] = (pg8::f32x4){0.f, 0.f, 0.f, 0.f}; } while (0)

__device__ __forceinline__ void mix8(const bf16* Z, int col0, const float* mu, int dl, int dr, int du, int dd, bool okl, bool okr, bool oku, bool okd, float (&o)[8]) {
    const u32x4 z = *(const u32x4*)(Z + col0);
    const u32x4 l = *(const u32x4*)(Z + col0 + dl * 2048), r = *(const u32x4*)(Z + col0 + dr * 2048), up = *(const u32x4*)(Z + col0 + du * 2048), dn = *(const u32x4*)(Z + col0 + dd * 2048);
    const f32x4 m0 = *(const f32x4*)(mu + col0), m1 = *(const f32x4*)(mu + col0 + 4);
    float zz[8], nn[8];
    zz[0] = bflo(z.x); zz[1] = bfhi(z.x); zz[2] = bflo(z.y); zz[3] = bfhi(z.y); zz[4] = bflo(z.z); zz[5] = bfhi(z.z); zz[6] = bflo(z.w); zz[7] = bfhi(z.w);
    nn[0] = okl ? bflo(l.x) : 0.f; nn[1] = okr ? bfhi(r.x) : 0.f; nn[2] = oku ? bflo(up.y) : 0.f; nn[3] = okd ? bfhi(dn.y) : 0.f;
    nn[4] = okl ? bflo(l.z) : 0.f; nn[5] = okr ? bfhi(r.z) : 0.f; nn[6] = oku ? bflo(up.w) : 0.f; nn[7] = okd ? bfhi(dn.w) : 0.f;
    const float mm[8] = {m0.x, m0.y, m0.z, m0.w, m1.x, m1.y, m1.z, m1.w};
#pragma unroll
    for (int i = 0; i < 8; ++i) o[i] = zz[i] + mm[i] * (nn[i] - zz[i]);
}
__device__ __forceinline__ void mix4(const bf16* Z, int col0, const float* mu, int dl, int dr, int du, int dd, bool okl, bool okr, bool oku, bool okd, float (&o)[4]) {
    const u32x2 z = *(const u32x2*)(Z + col0);
    const u32x2 l = *(const u32x2*)(Z + col0 + dl * 2048), r = *(const u32x2*)(Z + col0 + dr * 2048), up = *(const u32x2*)(Z + col0 + du * 2048), dn = *(const u32x2*)(Z + col0 + dd * 2048);
    const f32x4 m0 = *(const f32x4*)(mu + col0);
    const float zz[4] = {bflo(z.x), bfhi(z.x), bflo(z.y), bfhi(z.y)};
    const float nn[4] = {okl ? bflo(l.x) : 0.f, okr ? bfhi(r.x) : 0.f, oku ? bflo(up.y) : 0.f, okd ? bfhi(dn.y) : 0.f};
    const float mm[4] = {m0.x, m0.y, m0.z, m0.w};
#pragma unroll
    for (int i = 0; i < 4; ++i) o[i] = zz[i] + mm[i] * (nn[i] - zz[i]);
}

__device__ __forceinline__ void scan_pass1_unit(Frame& F, const KArgs& A, int chain, int scidx) {
    const int d = chain >> 3, h = chain & 7, tid = F.tid, lane = F.lane, w = F.wave, fr = lane & 15, fq = lane >> 4, mt = w >> 1, nt0 = 2 * (w & 1);
    LAS unsigned char* const L = F.lds;
#define S_(i) (L + opq((i) * SL))
    const bool isctx = (scidx == 0); const int sc = scidx - 1;
    const bf16* ZA = F_ZA; const float* mu = F_mu;
    { const int r = tid >> 3, ch = tid & 7; u32x4 idv = (u32x4){0u, 0u, 0u, 0u};
      if ((r >> 3) == ch) { const unsigned one = 0x3f80u; const int e = r & 7; if (e == 0) idv.x = one; else if (e == 1) idv.x = one << 16; else if (e == 2) idv.y = one; else if (e == 3) idv.y = one << 16; else if (e == 4) idv.z = one; else if (e == 5) idv.z = one << 16; else if (e == 6) idv.w = one; else idv.w = one << 16; }
      *(LAS u32x4*)(S_(14) + frag_off(r, ch)) = idv; *(LAS u32x4*)(S_(16) + frag_off(r, ch)) = (u32x4){0u, 0u, 0u, 0u}; }
    int ppc = 14, qpc = 16;
    for (int j = 0; j < 4; ++j) {
        const int ppn = ppc ^ 1, qpn = qpc ^ 1;
        const int t = tid >> 3, cg = tid & 7, x = d ? 63 - t : t;
        int tokchunk; const bf16* Z; int dl, dr, du, dd; bool okl, okr, oku, okd;
        if (isctx) { tokchunk = d ? 3 - j : j; const int tc = tokchunk * 64 + x; Z = ZA + (size_t)(SEQ + tc) * 2048; okl = tc > 0; okr = tc < CTXL - 1; oku = okl; okd = okr; dl = okl ? -1 : 0; dr = okr ? 1 : 0; du = dl; dd = dr; }
        else { tokchunk = d ? 255 - (4 * sc + j) : 4 * sc + j; const int tok = tokchunk * 64 + x; Z = ZA + (size_t)tok * 2048; okl = x > 0; okr = x < 63; oku = tokchunk > 0; okd = tokchunk < GROWS - 1; dl = okl ? -1 : 0; dr = okr ? 1 : 0; du = oku ? -64 : 0; dd = okd ? 64 : 0; }
        float rv[8], kv[8];
        {
            float vv[8], wdv[8], adv[8];
            mix8(Z, h * 64 + 8 * cg, mu, dl, dr, du, dd, okl, okr, oku, okd, rv);
            mix8(Z, 512 + h * 64 + 8 * cg, mu, dl, dr, du, dd, okl, okr, oku, okd, kv);
            mix8(Z, 1024 + h * 64 + 8 * cg, mu, dl, dr, du, dd, okl, okr, oku, okd, vv);
            mix8(Z, 1536 + d * 64 + 8 * cg, mu, dl, dr, du, dd, okl, okr, oku, okd, wdv);
            mix8(Z, 1664 + d * 64 + 8 * cg, mu, dl, dr, du, dd, okl, okr, oku, okd, adv);
#pragma unroll
            for (int i = 0; i < 8; ++i) *(LAS bf16*)(S_(7) + m_off(8 * cg + i, t)) = (bf16)f2bf(vv[i]);
            u32x4 o; o.x = pk2(tanh_fast(wdv[0]), tanh_fast(wdv[1])); o.y = pk2(tanh_fast(wdv[2]), tanh_fast(wdv[3])); o.z = pk2(tanh_fast(wdv[4]), tanh_fast(wdv[5])); o.w = pk2(tanh_fast(wdv[6]), tanh_fast(wdv[7]));
            *(LAS u32x4*)(S_(8) + frag_off(t, cg)) = o;
            o.x = pk2(adv[0], adv[1]); o.y = pk2(adv[2], adv[3]); o.z = pk2(adv[4], adv[5]); o.w = pk2(adv[6], adv[7]);
            *(LAS u32x4*)(S_(9) + frag_off(t, cg)) = o;
            const bf16* wt = (const bf16*)(A.ws() + WS_WUPT) + (size_t)chain * 4096, *at = (const bf16*)(A.ws() + WS_AUPT) + (size_t)chain * 4096;
            *(LAS u32x4*)(S_(10) + frag_off(t, cg)) = *(const u32x4*)(wt + t * 64 + 8 * cg);
            *(LAS u32x4*)(S_(11) + frag_off(t, cg)) = *(const u32x4*)(at + t * 64 + 8 * cg);
        }
        __syncthreads();
        {
            pg8::f32x4 acw[2], aca[2]; ZERO2(acw); ZERO2(aca);
            mm_tiles<true>(S_(8), S_(10), mt, nt0, fr, fq, acw);
            mm_tiles<true>(S_(9), S_(11), mt, nt0, fr, fq, aca);
            const int row = 16 * mt + fr;
#pragma unroll
            for (int n = 0; n < 2; ++n) { const int c0 = 16 * (nt0 + n) + 4 * fq;
                const f32x4 w0v = *(const f32x4*)(F_w0 + d * DR + h * 64 + c0), a0v = *(const f32x4*)(F_a0 + d * DR + h * 64 + c0);
                f32x4 ld; float aa[4];
#pragma unroll
                for (int i = 0; i < 4; ++i) { const float xw = acw[n][i] + w0v[i]; const float wv = -softplusf_(-xw) - 0.5f; ld[i] = -__expf(wv); aa[i] = sigmoidf_(aca[n][i] + a0v[i]); }
                *(LAS f32x4*)(L + opq(SC_LBUF) + (row * 64 + c0) * 4) = ld;
                st4(S_(18), row, c0, aa[0], aa[1], aa[2], aa[3]); }
        }
        __syncthreads();
        {
            const int c = tid & 63, seg = tid >> 6; LAS float* lb = (LAS float*)(L + opq(SC_LBUF)); LAS float* segtot = (LAS float*)(L + opq(SC_MISC));
            float run = 0.f, loc[8];
#pragma unroll
            for (int i = 0; i < 8; ++i) { run += lb[(8 * seg + i) * 64 + c]; loc[i] = run; }
            segtot[seg * 64 + c] = run;
            __syncthreads();
            float off = 0.f;
#pragma unroll
            for (int s = 0; s < 8; ++s) off += (s < seg) ? segtot[s * 64 + c] : 0.f;
#pragma unroll
            for (int i = 0; i < 8; ++i) lb[(8 * seg + i) * 64 + c] = loc[i] + off;
        }
        __syncthreads();
        {
            const LAS float* lb = (const LAS float*)(L + opq(SC_LBUF));
            float Lt[8], Lp[8], LC[8], av[8];
            { const f32x4 a0 = *(const LAS f32x4*)(lb + t * 64 + 8 * cg), a1 = *(const LAS f32x4*)(lb + t * 64 + 8 * cg + 4);
              const int tp = t > 0 ? t - 1 : 0; const f32x4 b0 = *(const LAS f32x4*)(lb + tp * 64 + 8 * cg), b1 = *(const LAS f32x4*)(lb + tp * 64 + 8 * cg + 4);
              const f32x4 c0 = *(const LAS f32x4*)(lb + 63 * 64 + 8 * cg), c1 = *(const LAS f32x4*)(lb + 63 * 64 + 8 * cg + 4);
#pragma unroll
              for (int i = 0; i < 4; ++i) { Lt[i] = a0[i]; Lt[4 + i] = a1[i]; Lp[i] = t > 0 ? b0[i] : 0.f; Lp[4 + i] = t > 0 ? b1[i] : 0.f; LC[i] = c0[i]; LC[4 + i] = c1[i]; }
              const u32x4 aw = *(const LAS u32x4*)(S_(18) + frag_off(t, cg));
              av[0] = bflo(aw.x); av[1] = bfhi(aw.x); av[2] = bflo(aw.y); av[3] = bfhi(aw.y); av[4] = bflo(aw.z); av[5] = bfhi(aw.z); av[6] = bflo(aw.w); av[7] = bfhi(aw.w); }
            const int cb = h * 64 + 8 * cg;
            const f32x4 kk0 = *(const f32x4*)(F_k_k + cb), kk1 = *(const f32x4*)(F_k_k + cb + 4), ka0 = *(const f32x4*)(F_k_a + cb), ka1 = *(const f32x4*)(F_k_a + cb + 4);
            const float kkc[8] = {kk0.x, kk0.y, kk0.z, kk0.w, kk1.x, kk1.y, kk1.z, kk1.w}, kac[8] = {ka0.x, ka0.y, ka0.z, ka0.w, ka1.x, ka1.y, ka1.z, ka1.w};
            float kkv[8], n2 = 0.f;
#pragma unroll
            for (int i = 0; i < 8; ++i) { kkv[i] = kv[i] * kkc[i]; n2 += kkv[i] * kkv[i]; }
            n2 += __shfl_xor(n2, 1); n2 += __shfl_xor(n2, 2); n2 += __shfl_xor(n2, 4);
            const float inv = 1.0f / fmaxf(sqrtf(n2), 1e-12f);
            float kb[8], rb[8], ah[8], kh[8], ahc[8], khc[8];
#pragma unroll
            for (int i = 0; i < 8; ++i) { const float kk = kkv[i] * inv, al = kk * av[i], kt = kv[i] * (1.0f + (av[i] - 1.0f) * kac[i]);
                const float ep = __expf(Lp[i]), et = __expf(Lt[i]), en = __expf(-Lt[i]), ec = __expf(LC[i] - Lt[i]);
                kb[i] = kk * ep; rb[i] = rv[i] * et; ah[i] = al * en; kh[i] = kt * en; ahc[i] = al * ec; khc[i] = kt * ec; }
            u32x4 o;
            o.x = pk2(kb[0], kb[1]); o.y = pk2(kb[2], kb[3]); o.z = pk2(kb[4], kb[5]); o.w = pk2(kb[6], kb[7]); *(LAS u32x4*)(S_(0) + frag_off(t, cg)) = o;
            o.x = pk2(rb[0], rb[1]); o.y = pk2(rb[2], rb[3]); o.z = pk2(rb[4], rb[5]); o.w = pk2(rb[6], rb[7]); *(LAS u32x4*)(S_(1) + frag_off(t, cg)) = o;
            o.x = pk2(ah[0], ah[1]); o.y = pk2(ah[2], ah[3]); o.z = pk2(ah[4], ah[5]); o.w = pk2(ah[6], ah[7]); *(LAS u32x4*)(S_(2) + frag_off(t, cg)) = o;
            o.x = pk2(kh[0], kh[1]); o.y = pk2(kh[2], kh[3]); o.z = pk2(kh[4], kh[5]); o.w = pk2(kh[6], kh[7]); *(LAS u32x4*)(S_(3) + frag_off(t, cg)) = o;
#pragma unroll
            for (int i = 0; i < 8; ++i) { *(LAS bf16*)(S_(4) + m_off(8 * cg + i, t)) = (bf16)f2bf(kb[i]); *(LAS bf16*)(S_(5) + m_off(8 * cg + i, t)) = (bf16)f2bf(ahc[i]); *(LAS bf16*)(S_(6) + m_off(8 * cg + i, t)) = (bf16)f2bf(khc[i]); }
            if (t == 0) { LAS float* gam = (LAS float*)(L + opq(SC_MISC) + 2048);
#pragma unroll
                for (int i = 0; i < 8; ++i) gam[8 * cg + i] = __expf(LC[i]); }
        }
        __syncthreads();
        {
            pg8::f32x4 a1[2], a2[2]; ZERO2(a1); ZERO2(a2);
            mm_tiles<true>(S_(0), S_(2), mt, nt0, fr, fq, a1);
            mm_tiles<false>(S_(0), S_(2), mt, nt0, fr, fq, a2);
#pragma unroll
            for (int n = 0; n < 2; ++n) {
                { const int tt = 16 * mt + fr, s0 = 16 * (nt0 + n) + 4 * fq; float m[4], t0[4];
#pragma unroll
                  for (int i = 0; i < 4; ++i) { m[i] = (s0 + i < tt) ? -a1[n][i] : 0.f; t0[i] = m[i] + ((s0 + i == tt) ? 1.0f : 0.f); }
                  st4(S_(8), tt, s0, m[0], m[1], m[2], m[3]); st4(S_(18), tt, s0, t0[0], t0[1], t0[2], t0[3]); }
                { const int t0r = 16 * mt + 4 * fq, ss = 16 * (nt0 + n) + fr; float m[4];
#pragma unroll
                  for (int i = 0; i < 4; ++i) m[i] = (ss < t0r + i) ? -a2[n][i] : 0.f;
                  st4(S_(9), ss, t0r, m[0], m[1], m[2], m[3]); }
            }
            ZERO2(a1); ZERO2(a2);
            mm_tiles<true>(S_(0), S_(3), mt, nt0, fr, fq, a1);
            mm_tiles<true>(S_(1), S_(2), mt, nt0, fr, fq, a2);
            pg8::f32x4 a3[2]; ZERO2(a3);
            mm_tiles<true>(S_(1), S_(3), mt, nt0, fr, fq, a3);
#pragma unroll
            for (int n = 0; n < 2; ++n) { const int tt = 16 * mt + fr, s0 = 16 * (nt0 + n) + 4 * fq; float u[4], v2[4], v3[4];
#pragma unroll
                for (int i = 0; i < 4; ++i) { u[i] = (s0 + i < tt) ? a1[n][i] : 0.f; v2[i] = (s0 + i <= tt) ? a2[n][i] : 0.f; v3[i] = (s0 + i <= tt) ? a3[n][i] : 0.f; }
                st4(S_(10), tt, s0, u[0], u[1], u[2], u[3]); st4(S_(11), tt, s0, v2[0], v2[1], v2[2], v2[3]); st4(S_(12), tt, s0, v3[0], v3[1], v3[2], v3[3]); }
        }
        __syncthreads();
        {
            pg8::f32x4 a1[2], a2[2], a3[2]; ZERO2(a1); ZERO2(a2); ZERO2(a3);
            mm_tiles<false>(S_(10), S_(7), mt, nt0, fr, fq, a1);
            mm_tiles<true>(S_(8), S_(9), mt, nt0, fr, fq, a2);
            mm_tiles<false>(S_(8), S_(9), mt, nt0, fr, fq, a3);
#pragma unroll
            for (int n = 0; n < 2; ++n) {
                st4(S_(13), 16 * (nt0 + n) + fr, 16 * mt + 4 * fq, a1[n][0], a1[n][1], a1[n][2], a1[n][3]);
                st4(S_(0), 16 * mt + fr, 16 * (nt0 + n) + 4 * fq, a2[n][0], a2[n][1], a2[n][2], a2[n][3]);
                st4(S_(2), 16 * (nt0 + n) + fr, 16 * mt + 4 * fq, a3[n][0], a3[n][1], a3[n][2], a3[n][3]); }
        }
        __syncthreads();
#pragma unroll
        for (int k = 1; k <= 5; ++k) {
            const int pc = (k & 1) ? 0 : 8, pct = (k & 1) ? 2 : 9, pn = (k & 1) ? 8 : 0, pnt = (k & 1) ? 9 : 2, tc = (k & 1) ? 18 : 10, tn = (k & 1) ? 10 : 18;
            pg8::f32x4 a1[2], a2[2], a3[2];
#pragma unroll
            for (int n = 0; n < 2; ++n) a1[n] = ld4(S_(tc), 16 * mt + fr, 16 * (nt0 + n) + 4 * fq);
            mm_tiles<true>(S_(tc), S_(pct), mt, nt0, fr, fq, a1);
            if (k < 5) { ZERO2(a2); ZERO2(a3); mm_tiles<true>(S_(pc), S_(pct), mt, nt0, fr, fq, a2); mm_tiles<false>(S_(pc), S_(pct), mt, nt0, fr, fq, a3); }
#pragma unroll
            for (int n = 0; n < 2; ++n) {
                st4(S_(tn), 16 * mt + fr, 16 * (nt0 + n) + 4 * fq, a1[n][0], a1[n][1], a1[n][2], a1[n][3]);
                if (k < 5) { st4(S_(pn), 16 * mt + fr, 16 * (nt0 + n) + 4 * fq, a2[n][0], a2[n][1], a2[n][2], a2[n][3]);
                             st4(S_(pnt), 16 * (nt0 + n) + fr, 16 * mt + 4 * fq, a3[n][0], a3[n][1], a3[n][2], a3[n][3]); } }
            __syncthreads();
        }
        {
            pg8::f32x4 a1[2], a2[2]; ZERO2(a1); ZERO2(a2);
            mm_tiles<false>(S_(10), S_(4), mt, nt0, fr, fq, a1);
            mm_tiles<false>(S_(10), S_(13), mt, nt0, fr, fq, a2);
#pragma unroll
            for (int n = 0; n < 2; ++n) {
                st4(S_(8), 16 * (nt0 + n) + fr, 16 * mt + 4 * fq, -a1[n][0], -a1[n][1], -a1[n][2], -a1[n][3]);
                st4(S_(9), 16 * (nt0 + n) + fr, 16 * mt + 4 * fq, -a2[n][0], -a2[n][1], -a2[n][2], -a2[n][3]); }
        }
        __syncthreads();
        pg8::f32x4 accY[2];
        {
            pg8::f32x4 a1[2], a2[2], a3[2];
#pragma unroll
            for (int n = 0; n < 2; ++n) a1[n] = ld4(S_(1), 16 * mt + fr, 16 * (nt0 + n) + 4 * fq);
            mm_tiles<true>(S_(11), S_(8), mt, nt0, fr, fq, a1);
            ZERO2(accY); mm_tiles<true>(S_(12), S_(7), mt, nt0, fr, fq, accY); mm_tiles<true>(S_(11), S_(9), mt, nt0, fr, fq, accY);
            ZERO2(a2); mm_tiles<true>(S_(5), S_(8), mt, nt0, fr, fq, a2);
            ZERO2(a3); mm_tiles<true>(S_(7), S_(6), mt, nt0, fr, fq, a3); mm_tiles<true>(S_(9), S_(5), mt, nt0, fr, fq, a3);
            const LAS float* gam = (const LAS float*)(L + opq(SC_MISC) + 2048);
#pragma unroll
            for (int n = 0; n < 2; ++n) { const int rr = 16 * mt + fr, c0 = 16 * (nt0 + n) + 4 * fq;
                st4(S_(0), rr, c0, a1[n][0], a1[n][1], a1[n][2], a1[n][3]);
                const float gj = gam[rr];
                st4(S_(2), rr, c0, a2[n][0] + (c0 + 0 == rr ? gj : 0.f), a2[n][1] + (c0 + 1 == rr ? gj : 0.f), a2[n][2] + (c0 + 2 == rr ? gj : 0.f), a2[n][3] + (c0 + 3 == rr ? gj : 0.f));
                st4(S_(3), rr, c0, a3[n][0], a3[n][1], a3[n][2], a3[n][3]); }
        }
        __syncthreads();
        {
            pg8::f32x4 a1[2], a2[2], a3[2]; ZERO2(a1);
            mm_tiles<true>(S_(0), S_(ppc), mt, nt0, fr, fq, a1);
            mm_tiles<true>(S_(0), S_(qpc), mt, nt0, fr, fq, accY);
            ZERO2(a2); mm_tiles<true>(S_(ppc), S_(2), mt, nt0, fr, fq, a2);
#pragma unroll
            for (int n = 0; n < 2; ++n) a3[n] = ld4(S_(3), 16 * mt + fr, 16 * (nt0 + n) + 4 * fq);
            mm_tiles<true>(S_(qpc), S_(2), mt, nt0, fr, fq, a3);
            if (!isctx) {
                const int tt = 16 * mt + fr, xr = d ? 63 - tt : tt;
                bf16* gy = (bf16*)(A.ws() + WS_GY) + ((size_t)chain * 256 + tokchunk) * 8192;
#pragma unroll
                for (int n = 0; n < 2; ++n) { const int c0 = 16 * (nt0 + n) + 4 * fq; u32x2 o;
                    o.x = pk2(a1[n][0], a1[n][1]); o.y = pk2(a1[n][2], a1[n][3]); *(u32x2*)(gy + xr * 64 + c0) = o;
                    o.x = pk2(accY[n][0], accY[n][1]); o.y = pk2(accY[n][2], accY[n][3]); *(u32x2*)(gy + 4096 + xr * 64 + c0) = o; }
            }
            if (j < 3) {
#pragma unroll
                for (int n = 0; n < 2; ++n) { const int rr = 16 * mt + fr, c0 = 16 * (nt0 + n) + 4 * fq;
                    st4(S_(ppn), rr, c0, a2[n][0], a2[n][1], a2[n][2], a2[n][3]); st4(S_(qpn), rr, c0, a3[n][0], a3[n][1], a3[n][2], a3[n][3]); }
            } else {
                pg8::f32x4 a4[2]; ZERO2(a4); mm_tiles<false>(S_(ppc), S_(2), mt, nt0, fr, fq, a4);
                bf16* pq = (bf16*)(A.ws() + WS_PQ) + ((size_t)chain * 65 + scidx) * 8192;
#pragma unroll
                for (int n = 0; n < 2; ++n) { u32x2 o;
                    o.x = pk2(a4[n][0], a4[n][1]); o.y = pk2(a4[n][2], a4[n][3]); *(u32x2*)(pq + (16 * (nt0 + n) + fr) * 64 + 16 * mt + 4 * fq) = o;
                    o.x = pk2(a3[n][0], a3[n][1]); o.y = pk2(a3[n][2], a3[n][3]); *(u32x2*)(pq + 4096 + (16 * mt + fr) * 64 + 16 * (nt0 + n) + 4 * fq) = o; }
            }
        }
        __syncthreads();
        ppc = ppn; qpc = qpn;
    }
#undef S_
}

__device__ __forceinline__ void scan_chain(Frame& F, const KArgs& A, int chain) {
    if (F.wave >= 4) return;
    const int vb = F.wave, lane = F.lane, fr = lane & 15, fq = lane >> 4, v = 16 * vb + fr;
    const bf16* pq = (const bf16*)(A.ws() + WS_PQ) + (size_t)chain * 65 * 8192;
    bf16* s0 = (bf16*)(A.ws() + WS_S0) + (size_t)chain * 64 * 4096;
    pg8::f32x4 st[4];
#pragma unroll
    for (int it = 0; it < 4; ++it) { const u32x2 q = *(const u32x2*)(pq + 4096 + v * 64 + 16 * it + 4 * fq); st[it] = (pg8::f32x4){bflo(q.x), bfhi(q.x), bflo(q.y), bfhi(q.y)}; }
    u32x2 pa[4][2][2], qn[4];
    { const bf16* p = pq + 8192;
#pragma unroll
      for (int jt = 0; jt < 4; ++jt) { qn[jt] = *(const u32x2*)(p + 4096 + v * 64 + 16 * jt + 4 * fq);
#pragma unroll
          for (int ks = 0; ks < 2; ++ks) { pa[jt][ks][0] = *(const u32x2*)(p + (16 * jt + fr) * 64 + 32 * ks + 4 * fq); pa[jt][ks][1] = *(const u32x2*)(p + (16 * jt + fr) * 64 + 32 * ks + 16 + 4 * fq); } } }
    for (int sc = 0; sc < 64; ++sc) {
#pragma unroll
        for (int it = 0; it < 4; ++it) { u32x2 o; o.x = pk2(st[it][0], st[it][1]); o.y = pk2(st[it][2], st[it][3]); *(u32x2*)(s0 + (size_t)sc * 4096 + v * 64 + 16 * it + 4 * fq) = o; }
        if (sc == 63) break;
        u32x2 ca[4][2][2], cq[4];
#pragma unroll
        for (int jt = 0; jt < 4; ++jt) { cq[jt] = qn[jt];
#pragma unroll
            for (int ks = 0; ks < 2; ++ks) { ca[jt][ks][0] = pa[jt][ks][0]; ca[jt][ks][1] = pa[jt][ks][1]; } }
        if (sc + 1 < 63) { const bf16* p = pq + (size_t)(sc + 2) * 8192;
#pragma unroll
            for (int jt = 0; jt < 4; ++jt) { qn[jt] = *(const u32x2*)(p + 4096 + v * 64 + 16 * jt + 4 * fq);
#pragma unroll
                for (int ks = 0; ks < 2; ++ks) { pa[jt][ks][0] = *(const u32x2*)(p + (16 * jt + fr) * 64 + 32 * ks + 4 * fq); pa[jt][ks][1] = *(const u32x2*)(p + (16 * jt + fr) * 64 + 32 * ks + 16 + 4 * fq); } } }
        bf16x8 bfrag[2];
#pragma unroll
        for (int ks = 0; ks < 2; ++ks) { u32x4 b; b.x = pk2(st[2 * ks][0], st[2 * ks][1]); b.y = pk2(st[2 * ks][2], st[2 * ks][3]); b.z = pk2(st[2 * ks + 1][0], st[2 * ks + 1][1]); b.w = pk2(st[2 * ks + 1][2], st[2 * ks + 1][3]); bfrag[ks] = __builtin_bit_cast(bf16x8, b); }
        pg8::f32x4 nw[4];
#pragma unroll
        for (int jt = 0; jt < 4; ++jt) { nw[jt] = (pg8::f32x4){bflo(cq[jt].x), bfhi(cq[jt].x), bflo(cq[jt].y), bfhi(cq[jt].y)};
#pragma unroll
            for (int ks = 0; ks < 2; ++ks) { u32x4 a; a.x = ca[jt][ks][0].x; a.y = ca[jt][ks][0].y; a.z = ca[jt][ks][1].x; a.w = ca[jt][ks][1].y;
                nw[jt] = __builtin_amdgcn_mfma_f32_16x16x32_bf16(__builtin_bit_cast(bf16x8, a), bfrag[ks], nw[jt], 0, 0, 0); } }
#pragma unroll
        for (int jt = 0; jt < 4; ++jt) st[jt] = nw[jt];
    }
}

__device__ __forceinline__ void scan_pass2_unit(Frame& F, const KArgs& A, int h, int c) {
    const int tid = F.tid, lane = F.lane, w = F.wave, fr = lane & 15, fq = lane >> 4;
    LAS unsigned char* const L = F.lds;
#define S_(i) (L + opq((i) * SL))
    const bf16* gyf = (const bf16*)(A.ws() + WS_GY) + ((size_t)(0 * 8 + h) * 256 + c) * 8192;
    const bf16* gyb = (const bf16*)(A.ws() + WS_GY) + ((size_t)(1 * 8 + h) * 256 + c) * 8192;
    const bf16* s0f = (const bf16*)(A.ws() + WS_S0) + ((size_t)(0 * 8 + h) * 64 + (c >> 2)) * 4096;
    const bf16* s0b = (const bf16*)(A.ws() + WS_S0) + ((size_t)(1 * 8 + h) * 64 + ((255 - c) >> 2)) * 4096;
    const bf16* gut = (const bf16*)(A.ws() + WS_GUPT) + (size_t)h * 8192;
    const bf16* ZA = F_ZA; const float* mu = F_mu;
    {
        const int r = tid >> 3, ch = tid & 7;
        *(LAS u32x4*)(S_(0) + frag_off(r, ch)) = *(const u32x4*)(gyf + r * 64 + 8 * ch);
        *(LAS u32x4*)(S_(1) + frag_off(r, ch)) = *(const u32x4*)(gyb + r * 64 + 8 * ch);
        *(LAS u32x4*)(S_(2) + frag_off(r, ch)) = *(const u32x4*)(s0f + r * 64 + 8 * ch);
        *(LAS u32x4*)(S_(3) + frag_off(r, ch)) = *(const u32x4*)(s0b + r * 64 + 8 * ch);
        *(LAS u32x4*)(S_(4) + frag_off(r, ch)) = *(const u32x4*)(gut + r * 128 + 8 * ch);
        *(LAS u32x4*)(S_(5) + frag_off(r, ch)) = *(const u32x4*)(gut + r * 128 + 64 + 8 * ch);
        const int tok = c * 64 + r; const bf16* Z = ZA + (size_t)tok * 2048;
        const bool okl = r > 0, okr = r < 63, oku = c > 0, okd = c < GROWS - 1; const int dl = okl ? -1 : 0, dr = okr ? 1 : 0, du = oku ? -64 : 0, dd = okd ? 64 : 0;
#pragma unroll
        for (int half = 0; half < 2; ++half) { float g8[8]; const int col = 16 * ch + 8 * half; mix8(Z, 1792 + col, mu, dl, dr, du, dd, okl, okr, oku, okd, g8);
            u32x4 o; o.x = pk2(sigmoidf_(g8[0]), sigmoidf_(g8[1])); o.y = pk2(sigmoidf_(g8[2]), sigmoidf_(g8[3])); o.z = pk2(sigmoidf_(g8[4]), sigmoidf_(g8[5])); o.w = pk2(sigmoidf_(g8[6]), sigmoidf_(g8[7]));
            *(LAS u32x4*)(S_(6 + (col >> 6)) + frag_off(r, (col & 63) >> 3)) = o; }
    }
    __syncthreads();
    if (w >= 4) {
        const int mt = w - 4;
#pragma unroll
        for (int np = 0; np < 2; ++np) { pg8::f32x4 g[2]; ZERO2(g);
            mm_tiles<true>(S_(6), S_(4), mt, 2 * np, fr, fq, g); mm_tiles<true>(S_(7), S_(5), mt, 2 * np, fr, fq, g);
#pragma unroll
            for (int n = 0; n < 2; ++n) *(LAS f32x4*)(L + opq(8 * SL) + ((16 * mt + fr) * 64 + 16 * (2 * np + n) + 4 * fq) * 4) = (f32x4){g[n][0], g[n][1], g[n][2], g[n][3]}; }
    }
    pg8::f32x4 y[4];
    const int mt2 = w & 3, tt = 16 * mt2 + fr, tok = c * 64 + tt;
    if (w < 4) {
#pragma unroll
        for (int np = 0; np < 2; ++np) { pg8::f32x4 a[2];
#pragma unroll
            for (int n = 0; n < 2; ++n) { const int c0 = 16 * (2 * np + n) + 4 * fq; const u32x2 yf = *(const u32x2*)(gyf + 4096 + tt * 64 + c0), yb = *(const u32x2*)(gyb + 4096 + tt * 64 + c0);
                a[n] = (pg8::f32x4){bflo(yf.x) + bflo(yb.x), bfhi(yf.x) + bfhi(yb.x), bflo(yf.y) + bflo(yb.y), bfhi(yf.y) + bfhi(yb.y)}; }
            mm_tiles<true>(S_(0), S_(2), mt2, 2 * np, fr, fq, a); mm_tiles<true>(S_(1), S_(3), mt2, 2 * np, fr, fq, a);
            y[2 * np] = a[0]; y[2 * np + 1] = a[1]; }
    }
    __syncthreads();
    if (w < 4) {
        float s = 0.f;
#pragma unroll
        for (int n = 0; n < 4; ++n) s += (y[n][0] + y[n][1]) + (y[n][2] + y[n][3]);
        s += __shfl_xor(s, 16); s += __shfl_xor(s, 32);
        const float mean = s * (1.0f / 64.0f); float s2 = 0.f;
#pragma unroll
        for (int n = 0; n < 4; ++n)
#pragma unroll
            for (int i = 0; i < 4; ++i) { const float dlt = y[n][i] - mean; s2 += dlt * dlt; }
        s2 += __shfl_xor(s2, 16); s2 += __shfl_xor(s2, 32);
        const float rstd = rsqrtf(s2 * (1.0f / 64.0f) + GN_EPS);
        const bf16* Z = ZA + (size_t)tok * 2048;
        const bool okl = tt > 0, okr = tt < 63, oku = c > 0, okd = c < GROWS - 1; const int dl = okl ? -1 : 0, dr = okr ? 1 : 0, du = oku ? -64 : 0, dd = okd ? 64 : 0;
        float rr[4][4], kk[4][4], vv[4][4]; float dp = 0.f;
#pragma unroll
        for (int n = 0; n < 4; ++n) { const int cc = h * 64 + 16 * n + 4 * fq;
            mix4(Z, cc, mu, dl, dr, du, dd, okl, okr, oku, okd, rr[n]); mix4(Z, 512 + cc, mu, dl, dr, du, dd, okl, okr, oku, okd, kk[n]); mix4(Z, 1024 + cc, mu, dl, dr, du, dd, okl, okr, oku, okd, vv[n]);
            const f32x4 rk = *(const f32x4*)(F_r_k + cc);
            dp += rr[n][0] * kk[n][0] * rk.x + rr[n][1] * kk[n][1] * rk.y + rr[n][2] * kk[n][2] * rk.z + rr[n][3] * kk[n][3] * rk.w; }
        dp += __shfl_xor(dp, 16); dp += __shfl_xor(dp, 32);
#pragma unroll
        for (int n = 0; n < 4; ++n) { const int cl = 16 * n + 4 * fq, cc = h * 64 + cl;
            const f32x4 lw = *(const f32x4*)(F_ln_w + cc), lb = *(const f32x4*)(F_ln_b + cc);
            const f32x4 g = *(const LAS f32x4*)(L + opq(8 * SL) + (tt * 64 + cl) * 4);
            float o[4];
#pragma unroll
            for (int i = 0; i < 4; ++i) { const float yn = (y[n][i] - mean) * rstd * lw[i] + lb[i]; o[i] = (yn + dp * vv[n][i]) * g[i]; }
            u32x2 pk; pk.x = pk2(o[0], o[1]); pk.y = pk2(o[2], o[3]);
            *(u32x2*)(F_YA + (size_t)tok * DR + cc) = pk; }
    }
    __syncthreads();
#undef S_
}

__global__ void __launch_bounds__(512, 2) fwd(Args AA) {
    extern __shared__ __attribute__((aligned(16))) unsigned char lds_raw[];
    Frame F;
    F.lds = (LAS unsigned char*)lds_raw;
    F.tid = threadIdx.x; F.lane = F.tid & 63; F.wave = __builtin_amdgcn_readfirstlane(F.tid >> 6); F.G = gridDim.x;
    F.ws = AA.ws; F.in = nullptr; F.ctl = (unsigned*)(AA.ws + WS_CTL);

    for (int u = F.tid; u < (LDS_BYTES - MISC_OFF) / 4; u += 512) ((LAS unsigned*)(F.lds + MISC_OFF))[u] = 0u;
    __syncthreads();
    XcdBarrier bar; bar.bar = F.ctl + CW_BAR; bar.x = 0; bar.st = nullptr;
    if (!MK_LAUNCH_PER_PHASE) bar = xcd_barrier_post(F.ctl + CW_BAR, (volatile LAS unsigned*)(F.lds + MISC_OFF));
    const int lo = AA.ph_lo, hi = AA.ph_hi;
#ifndef ONLY_PHASE
#define ONLY_PHASE -1
#endif
#define IN(k) ((ONLY_PHASE < 0 || ONLY_PHASE == (k)) && lo <= (k) && (k) < hi)
#define FRESH() do { int t_ = threadIdx.x; asm volatile("" : "+v"(t_)); F.tid = t_; F.lane = t_ & 63; } while (0)
#ifndef REP_MASK
#define REP_MASK 0
#endif
#define REPS(k) (((REP_MASK >> (k)) & 1) ? 2 : 1)
#define SEAM(k) do { if (!MK_LAUNCH_PER_PHASE && IN(k) && IN((k) + 1)) xcd_barrier(bar); } while (0)

    if (IN(0)) for (int rep_ = 0; rep_ < REPS(0); ++rep_) { FRESH(); FRESH_KA(A); p0_prologue(F, A); } SEAM(0);
    if (IN(1)) for (int rep_ = 0; rep_ < REPS(1); ++rep_) { FRESH(); FRESH_KA(A); p1_norm1(F, A); } SEAM(1);
    if (IN(2)) for (int rep_ = 0; rep_ < REPS(2); ++rep_) { FRESH(); FRESH_KA(A);
        pg8::Gemm g{F_H, F_WinT, MTOT, NPAD, D}; Sched1 S{F.G, (int)blockIdx.x}; EpiZ E{F_ZA, F_ZB, F_ZG};
        pg8::gemm_phase<EpiZ, Sched1, true, true>(F.lds, g, S, E);
    } SEAM(2);
#ifndef SCAN_NAIVE
#define SCAN_NAIVE 0
#endif
    if (IN(3)) for (int rep_ = 0; rep_ < REPS(3); ++rep_) { FRESH(); FRESH_KA(A);
#if SCAN_NAIVE
        if (blockIdx.x < 16) p3_scan_naive(F, A, (int)blockIdx.x);
        else for (int ch = (int)blockIdx.x - 16; ch < SEQ / 128; ch += F.G - 16) p3_mixer_b(F, A, ch);
#else
        for (int u = (int)blockIdx.x; u < 16 * 65; u += F.G) scan_pass1_unit(F, A, u & 15, u >> 4);
#endif
    } SEAM(3);
    if (IN(4)) for (int rep_ = 0; rep_ < REPS(4); ++rep_) { FRESH(); FRESH_KA(A);
#if !SCAN_NAIVE
        if (blockIdx.x < 16) scan_chain(F, A, (int)blockIdx.x);
        else for (int ch = (int)blockIdx.x - 16; ch < SEQ / 128; ch += F.G - 16) p3_mixer_b(F, A, ch);
#endif
    } SEAM(4);
    if (IN(5)) for (int rep_ = 0; rep_ < REPS(5); ++rep_) { FRESH(); FRESH_KA(A);
#if SCAN_NAIVE
        p4_rwkv_out(F, A);
#else
        for (int u = (int)blockIdx.x; u < 8 * 256; u += F.G) scan_pass2_unit(F, A, u & 7, u >> 3);
#endif
    } SEAM(5);
    if (IN(6)) for (int rep_ = 0; rep_ < REPS(6); ++rep_) { FRESH(); FRESH_KA(A);
        SchedStd S{64, 4, F.G, (int)blockIdx.x};
        { pg8::Gemm g{F_YA, F_WaT, SEQ, D, DR}; EpiMergeA E{F_Y, F_ZG}; pg8::gemm_phase<EpiMergeA, SchedStd, true, true>(F.lds, g, S, E); }
        __syncthreads();
        { pg8::Gemm g{F_YB, F_WbT, SEQ, D, DR}; EpiMergeB E{F_Y, F_ZG, F_MG}; pg8::gemm_phase<EpiMergeB, SchedStd, true, true>(F.lds, g, S, E); }
    } SEAM(6);
    if (IN(7)) for (int rep_ = 0; rep_ < REPS(7); ++rep_) { FRESH(); FRESH_KA(A);
        SchedStd S{64, 4, F.G, (int)blockIdx.x};
        pg8::Gemm g{F_MG, F_WoutT, SEQ, D, D}; EpiX1 E{F_x, F_MOD + 2048, F_out}; pg8::gemm_phase<EpiX1, SchedStd, true, true>(F.lds, g, S, E);
    } SEAM(7);
    if (IN(8)) for (int rep_ = 0; rep_ < REPS(8); ++rep_) { FRESH(); FRESH_KA(A); p7_router(F, A); } SEAM(8);
    if (IN(9)) for (int rep_ = 0; rep_ < REPS(9); ++rep_) { FRESH(); FRESH_KA(A); p8_gather(F, A); } SEAM(9);
    if (IN(10)) for (int rep_ = 0; rep_ < REPS(10); ++rep_) { FRESH(); FRESH_KA(A);
        const int ntiles = moe_tables(F, A);
        MoeOrder S{(const LAS int*)(F.lds + TAB_OFF) + 128, ntiles * 4, F.G, (int)blockIdx.x};
        pg8::Gemm g{F_XG, F_WguT, MAXTILES * 256, NEXP * 1024, D}; EpiSwiGLU E{F_HMID};
        pg8::gemm_phase<EpiSwiGLU, MoeOrder, true, true>(F.lds, g, S, E);
    } SEAM(10);
    if (IN(11)) for (int rep_ = 0; rep_ < REPS(11); ++rep_) { FRESH(); FRESH_KA(A);
        const int ntiles = moe_tables(F, A);
        MoeOrder S{(const LAS int*)(F.lds + TAB_OFF) + 128, ntiles * 4, F.G, (int)blockIdx.x};
        pg8::Gemm g{F_HMID, F_WdT, MAXTILES * 256, NEXP * 1024, DEXP}; EpiScatter E{F_YBUF, F_rowinfo, F_roww};
        pg8::gemm_phase<EpiScatter, MoeOrder, true, true>(F.lds, g, S, E);
    } SEAM(11);
    if (IN(12)) for (int rep_ = 0; rep_ < REPS(12); ++rep_) { FRESH(); FRESH_KA(A); p11_final(F, A); }
#undef IN
#undef SEAM
}

extern "C" void kernel_launch(void* const* d_in, const int* in_sizes, int n_in, void* d_out, int out_size, void* d_ws, size_t ws_size, hipStream_t stream) {
    static int grid = 0;
    if (grid == 0) {
        if (n_in != 35 || in_sizes[0] != SEQ * D || out_size != SEQ * D || ws_size < WS_END) {
            fprintf(stderr, "kernel_launch: unexpected shapes: n_in %d in0 %d out %d ws %zu (need %zu); nothing launched\n", n_in, n_in > 0 ? in_sizes[0] : -1, out_size, ws_size, (size_t)WS_END); grid = -1; return; }
        int dev = 0, cus = 0, per_cu = 0;
        if (hipGetDevice(&dev) != hipSuccess || hipDeviceGetAttribute(&cus, hipDeviceAttributeMultiprocessorCount, dev) != hipSuccess) { grid = -1; return; }
        if (hipFuncSetAttribute((const void*)fwd, hipFuncAttributeMaxDynamicSharedMemorySize, LDS_BYTES) != hipSuccess) { fprintf(stderr, "kernel_launch: hipFuncSetAttribute failed\n"); grid = -1; return; }
        if (hipOccupancyMaxActiveBlocksPerMultiprocessor(&per_cu, (const void*)fwd, 512, LDS_BYTES) != hipSuccess || per_cu < 1) fprintf(stderr, "kernel_launch: occupancy query says %d\n", per_cu);
        (void)hipGetLastError();
        grid = cus;
    }
    if (grid < 0) return;
    if (hipMemsetAsync((char*)d_ws + WS_CTL, 0, CTL_ZERO_BYTES, stream) != hipSuccess) return;
    Args a{};
    for (int i = 0; i < 35; ++i) a.in[i] = (const float*)d_in[i];
    a.out = (float*)d_out; a.ws = (unsigned char*)d_ws;
#if MK_LAUNCH_PER_PHASE
    for (int p = 0; p < NPHASE; ++p) { a.ph_lo = p; a.ph_hi = p + 1; hipLaunchKernelGGL(fwd, dim3(grid), dim3(512), LDS_BYTES, stream, a); }
#else
#ifndef MK_PH_HI
#define MK_PH_HI NPHASE
#endif
    a.ph_lo = 0; a.ph_hi = MK_PH_HI;
    hipLaunchKernelGGL(fwd, dim3(grid), dim3(512), LDS_BYTES, stream, a);
#endif
}
```

```cpp
#include <hip/hip_runtime.h>
#include <cstdio>
#include <cstdint>
namespace pg8 {
#define PG8_LAS __attribute__((address_space(3)))
typedef unsigned short bf16_t;
typedef short bf16x8 __attribute__((ext_vector_type(8)));
typedef float f32x4 __attribute__((ext_vector_type(4)));
typedef unsigned u32x4 __attribute__((ext_vector_type(4)));
constexpr int BM = 256, BK = 64, HALF = 128, HTB = HALF * BK * 2  , STAGE_BYTES = 8 * HTB, NXCD = 8, WGM = 8;

__host__ __device__ __forceinline__ int lds_byte(int r, int c) { const int st = (r >> 4) * 2 + (c >> 5), rr = r & 15, cc = c & 31, ob = rr * 64 + cc * 2; return st * 1024 + (ob ^ (((ob >> 9) & 1) << 5)); }
__host__ __device__ __forceinline__ void stage_rc(int b, int& R, int& C) { const int st = b / 1024, sb = b % 1024, swz = sb ^ (((sb >> 9) & 1) << 5); R = (st >> 1) * 16 + swz / 64; C = (st & 1) * 32 + (swz % 64) / 2; }
__host__ __device__ __forceinline__ int perm32(int rho) { const int n = rho >> 4, i = rho & 15; return 8 * (i >> 2) + 4 * n + (i & 3); }

struct Unit { int pm, pn; };
struct Gemm { const bf16_t* A; const bf16_t* Bt; int M, N, K; };

struct StaticOrder {
    int nM, nN, nwg, G, c;
    __host__ __device__ void init(int M, int N, int G_, int c_) { nM = M / BM; nN = N / BM; nwg = nM * nN; G = G_; c = c_; }
    __host__ __device__ bool next(int i, Unit& u) const {
        const long L = (long)i * G + c; if (L >= nwg) return false;
        int wgid = (int)L; { const int q = nwg / NXCD, r = nwg % NXCD, xcd = wgid % NXCD, off = wgid / NXCD; wgid = (xcd < r ? xcd * (q + 1) : r * (q + 1) + (xcd - r) * q) + off; }
        const int nig = WGM * nN, gid = wgid / nig, fm = gid * WGM, gsz = (nM - fm) < WGM ? (nM - fm) : WGM;
        u.pm = fm + ((wgid % nig) % gsz); u.pn = (wgid % nig) / gsz; return true;
    }
    __device__ __forceinline__ void a_ready(const Unit&) const {}
    __device__ __forceinline__ void done(const Unit&) const {}
};

__device__ __forceinline__ unsigned cvt_pk_bf16(float lo, float hi) { unsigned r; asm volatile("v_cvt_pk_bf16_f32 %0, %1, %2" : "=v"(r) : "v"(lo), "v"(hi)); return r; }
template <class Epi, class Sched, bool ALIGN_EPI = false, bool SP2 = false>
__device__ __forceinline__ void gemm_phase(PG8_LAS unsigned char* lds, const Gemm g, const Sched& S, const Epi& E) {
    int tid_ = threadIdx.x; asm volatile("" : "+v"(tid_));
    const int tid = tid_, wid = __builtin_amdgcn_readfirstlane(tid >> 6), lane = tid & 63, wr = wid >> 2, wc = wid & 3, fr = lane & 15, fq = lane >> 4;
    const int K = g.K, nt = K / BK;
    unsigned voffA[2], voffB[2];
#pragma unroll
    for (int i = 0; i < 2; ++i) { int R, C; stage_rc(tid * 16 + i * 8192, R, C); const int Rb = Epi::PERM ? ((R & ~31) + perm32(R & 31)) : R;
        voffA[i] = (unsigned)(R * K + C) * 2u; voffB[i] = (unsigned)(Rb * K + C) * 2u; }
    const size_t kstep = (size_t)(BK * 2);
    const size_t hstep = (size_t)HALF * K * 2;
    const size_t tstep = 2 * hstep;
    const unsigned ldsw = (unsigned)wid * 1024u;
    const int aoff = lds_byte(wr * 64 + fr, fq * 8), boff = lds_byte(wc * 32 + fr, fq * 8);
#define PG8_SA(b, h) (((b) * 2 + (h)) * HTB)
#define PG8_SB(b, h) ((4 + (b) * 2 + (h)) * HTB)
#define PG8_STAGE(bufoff, gbase, voff) do { _Pragma("unroll") for (int _i = 0; _i < 2; ++_i) \
        __builtin_amdgcn_global_load_lds((const unsigned*)((const char*)(gbase) + (voff)[_i]), (PG8_LAS unsigned*)(lds + (bufoff) + ldsw + _i * 8192), 16, 0, 0); } while (0)
#define PG8_LDA(dst, b, h) do { _Pragma("unroll") for (int m = 0; m < 4; ++m) _Pragma("unroll") for (int k = 0; k < 2; ++k) dst[m][k] = *(const PG8_LAS bf16x8*)(lds + PG8_SA(b, h) + aoff + m * 2048 + k * 1024); } while (0)
#define PG8_LDB(dst, b, h) do { _Pragma("unroll") for (int n = 0; n < 2; ++n) _Pragma("unroll") for (int k = 0; k < 2; ++k) dst[n][k] = *(const PG8_LAS bf16x8*)(lds + PG8_SB(b, h) + boff + n * 2048 + k * 1024); } while (0)
#define PG8_MMA(ai, bj, At, Bt) do { __builtin_amdgcn_s_setprio(1); _Pragma("unroll") for (int m = 0; m < 4; ++m) _Pragma("unroll") for (int n = 0; n < 2; ++n) _Pragma("unroll") for (int k = 0; k < 2; ++k) \
        acc[ai][bj][m][n] = __builtin_amdgcn_mfma_f32_16x16x32_bf16(Bt[n][k], At[m][k], acc[ai][bj][m][n], 0, 0, 0); __builtin_amdgcn_s_setprio(0); } while (0)
#define PG8_WAIT_V(n) asm volatile("s_waitcnt vmcnt(" #n ")" ::: "memory")
#define PG8_WAIT_L(n) asm volatile("s_waitcnt lgkmcnt(" #n ")" ::: "memory")
#define PG8_BAR __builtin_amdgcn_s_barrier()
#define PG8_SCHED __builtin_amdgcn_sched_barrier(0)
    Unit cur, nxt; int ui = 0;
    if (!S.next(0, cur)) return;
    f32x4 acc[2][2][4][2];
#pragma unroll
    for (int a = 0; a < 2; ++a)
#pragma unroll
        for (int b = 0; b < 2; ++b)
#pragma unroll
            for (int m = 0; m < 4; ++m)
#pragma unroll
                for (int n = 0; n < 2; ++n) acc[a][b][m][n] = (f32x4){0.f, 0.f, 0.f, 0.f};
    bf16x8 At[4][2], B0[2][2], B1[2][2];
    const char* cA = (const char*)g.A + (size_t)cur.pm * tstep; const char* cB = (const char*)g.Bt + (size_t)cur.pn * tstep;
    S.a_ready(cur);
    if constexpr (SP2) {
        PG8_STAGE(PG8_SB(0, 0), cB, voffB); PG8_STAGE(PG8_SB(0, 1), cB + hstep, voffB); PG8_STAGE(PG8_SA(0, 0), cA, voffA); PG8_STAGE(PG8_SA(0, 1), cA + hstep, voffA);
        if (wr == 1) PG8_BAR;
        PG8_WAIT_V(2); PG8_BAR;
        PG8_STAGE(PG8_SB(1, 0), cB + kstep, voffB); PG8_STAGE(PG8_SA(1, 0), cA + kstep, voffA); PG8_STAGE(PG8_SB(1, 1), cB + hstep + kstep, voffB);
        PG8_WAIT_V(6); PG8_BAR;
    } else {
        PG8_STAGE(PG8_SB(0, 0), cB, voffB); PG8_STAGE(PG8_SA(0, 0), cA, voffA); PG8_STAGE(PG8_SB(0, 1), cB + hstep, voffB); PG8_STAGE(PG8_SA(0, 1), cA + hstep, voffA);
        if (wr == 1) PG8_BAR;
        PG8_WAIT_V(4); PG8_BAR;
        PG8_STAGE(PG8_SB(1, 0), cB + kstep, voffB); PG8_STAGE(PG8_SA(1, 0), cA + kstep, voffA); PG8_STAGE(PG8_SB(1, 1), cB + hstep + kstep, voffB);
        PG8_WAIT_V(6); PG8_BAR;
    }
    for (;;) {
        const bool has_next = S.next(ui + 1, nxt);
        const char* nA = has_next ? (const char*)g.A + (size_t)nxt.pm * tstep : cA; const char* nB = has_next ? (const char*)g.Bt + (size_t)nxt.pn * tstep : cB;
        for (int t = 0; t < nt; t += 2) {
            const bool last = (t == nt - 2);
            const char* a1 = cA + (size_t)(t + 1) * kstep;
            const char* a2 = last ? nA : cA + (size_t)(t + 2) * kstep; const char* b2 = last ? nB : cB + (size_t)(t + 2) * kstep;
            const char* a3 = a2 + kstep; const char* b3 = b2 + kstep;
            if (last && has_next) S.a_ready(nxt);
            if constexpr (SP2) {
            PG8_LDB(B0, 0, 0); PG8_LDB(B1, 0, 1); PG8_SCHED; PG8_LDA(At, 0, 0); PG8_STAGE(PG8_SA(1, 1), a1 + hstep, voffA);
            PG8_WAIT_V(8); PG8_WAIT_L(0); PG8_BAR; PG8_MMA(0, 0, At, B0); PG8_MMA(0, 1, At, B1); PG8_BAR; PG8_SCHED;
            PG8_LDA(At, 0, 1); PG8_STAGE(PG8_SB(0, 0), b2, voffB); PG8_STAGE(PG8_SB(0, 1), b2 + hstep, voffB); PG8_STAGE(PG8_SA(0, 0), a2, voffA);
            PG8_WAIT_V(8); PG8_WAIT_L(0); PG8_BAR; PG8_MMA(1, 0, At, B0); PG8_MMA(1, 1, At, B1); PG8_BAR; PG8_SCHED;
            PG8_LDB(B0, 1, 0); PG8_LDB(B1, 1, 1); PG8_SCHED; PG8_LDA(At, 1, 0); PG8_STAGE(PG8_SA(0, 1), a2 + hstep, voffA);
            PG8_WAIT_V(8); PG8_WAIT_L(0); PG8_BAR; PG8_MMA(0, 0, At, B0); PG8_MMA(0, 1, At, B1); PG8_BAR; PG8_SCHED;
            PG8_LDA(At, 1, 1); PG8_STAGE(PG8_SB(1, 0), b3, voffB); PG8_STAGE(PG8_SB(1, 1), b3 + hstep, voffB); PG8_STAGE(PG8_SA(1, 0), a3, voffA);
            PG8_WAIT_V(8); PG8_WAIT_L(0); PG8_BAR; PG8_MMA(1, 0, At, B0); PG8_MMA(1, 1, At, B1); PG8_BAR; PG8_SCHED;
            } else {
            PG8_LDB(B0, 0, 0); PG8_SCHED; PG8_LDA(At, 0, 0); PG8_STAGE(PG8_SA(1, 1), a1 + hstep, voffA);
            PG8_WAIT_L(8); PG8_BAR; PG8_WAIT_L(0); PG8_MMA(0, 0, At, B0); PG8_BAR; PG8_SCHED;
            PG8_LDB(B1, 0, 1); PG8_STAGE(PG8_SB(0, 0), b2, voffB);
            PG8_BAR; PG8_WAIT_L(0); PG8_MMA(0, 1, At, B1); PG8_BAR;
            PG8_LDA(At, 0, 1); PG8_STAGE(PG8_SA(0, 0), a2, voffA);
            PG8_BAR; PG8_WAIT_L(0); PG8_MMA(1, 0, At, B0); PG8_BAR; PG8_SCHED;
            PG8_STAGE(PG8_SB(0, 1), b2 + hstep, voffB);
            PG8_WAIT_V(6); PG8_BAR; PG8_MMA(1, 1, At, B1); PG8_BAR;
            PG8_LDB(B0, 1, 0); PG8_SCHED; PG8_LDA(At, 1, 0); PG8_STAGE(PG8_SA(0, 1), a2 + hstep, voffA);
            PG8_WAIT_L(8); PG8_BAR; PG8_WAIT_L(0); PG8_MMA(0, 0, At, B0); PG8_BAR; PG8_SCHED;
            PG8_LDB(B1, 1, 1); PG8_STAGE(PG8_SB(1, 0), b3, voffB);
            PG8_BAR; PG8_WAIT_L(0); PG8_MMA(0, 1, At, B1); PG8_BAR;
            PG8_LDA(At, 1, 1); PG8_STAGE(PG8_SA(1, 0), a3, voffA);
            PG8_BAR; PG8_WAIT_L(0); PG8_MMA(1, 0, At, B0); PG8_BAR; PG8_SCHED;
            PG8_STAGE(PG8_SB(1, 1), b3 + hstep, voffB);
            PG8_WAIT_V(6); PG8_BAR; PG8_MMA(1, 1, At, B1); PG8_BAR;
            }
        }
        if constexpr (ALIGN_EPI) { if (wr == 0) PG8_BAR; }
        if constexpr (!Epi::AFTER_DRAIN) { E(acc, cur, wr, wc, fr, fq); S.done(cur); }
        if (!has_next) break;
#pragma unroll
        for (int a = 0; a < 2; ++a)
#pragma unroll
            for (int b = 0; b < 2; ++b)
#pragma unroll
                for (int m = 0; m < 4; ++m)
#pragma unroll
                    for (int n = 0; n < 2; ++n) acc[a][b][m][n] = (f32x4){0.f, 0.f, 0.f, 0.f};
        cur = nxt; cA = nA; cB = nB; ++ui;
        if constexpr (ALIGN_EPI) { if (wr == 1) PG8_BAR; }
    }
    PG8_WAIT_V(0);
    if constexpr (!ALIGN_EPI) { if (wr == 0) PG8_BAR; }
    PG8_BAR;
    if constexpr (Epi::AFTER_DRAIN) { E.fused(acc, cur, wr, wc, fr, fq, lds, wid, lane); S.done(cur); }
#undef PG8_SA
#undef PG8_SB
#undef PG8_STAGE
#undef PG8_LDA
#undef PG8_LDB
#undef PG8_MMA
#undef PG8_WAIT_V
#undef PG8_WAIT_L
#undef PG8_BAR
#undef PG8_SCHED
}
}

#ifndef MK_LAUNCH_PER_PHASE
#define MK_LAUNCH_PER_PHASE 0
#endif
constexpr int D = 1024, SEQ = 16384, CTXL = 256, MTOT = SEQ + CTXL, GW = 64, GROWS = SEQ / GW;
constexpr int DR = 512, NH = 8, HD = 64, PA = 1920, WINC = 4992, NPAD = 5120;
constexpr int NEXP = 32, DEXP = 512;
constexpr float NORM_EPS = 1e-6f, GN_EPS = 64e-5f;
constexpr int NPHASE = 13;

constexpr size_t MiB = 1u << 20;
constexpr size_t WS_CTL = 0, CTL_ZERO_BYTES = 64 * 1024;
constexpr size_t WS_MOD = 1 * MiB;
constexpr size_t WS_ROWINFO = WS_MOD + 64 * 1024;
constexpr size_t WS_ROWW = WS_MOD + 256 * 1024;
constexpr size_t WS_ROUTE = WS_MOD + 512 * 1024;
constexpr size_t WS_WIN = 2 * MiB;
constexpr size_t WS_WA = 12 * MiB, WS_WB = 13 * MiB, WS_WOUT = 14 * MiB;
constexpr size_t WS_H = 16 * MiB;
constexpr size_t WS_ZA = 49 * MiB;
constexpr size_t WS_ZB = 114 * MiB;
constexpr size_t WS_ZG = 146 * MiB;
constexpr size_t WS_YB = 210 * MiB;
constexpr size_t WS_YA = 226 * MiB;
constexpr size_t WS_Y = 242 * MiB;
constexpr size_t WS_END = 306 * MiB;
constexpr size_t WS_WGU = 49 * MiB;
constexpr size_t WS_WD = 113 * MiB;
constexpr size_t WS_XG = 145 * MiB;
constexpr size_t WS_HMID = 225 * MiB;
constexpr size_t WS_WUPT = 512 * 1024, WS_AUPT = 640 * 1024, WS_GUPT = 768 * 1024;
constexpr size_t WS_PQ = 16 * MiB;
constexpr size_t WS_S0 = 33 * MiB;
constexpr size_t WS_GY = 242 * MiB;
constexpr size_t WS_WRT = 48 * MiB + 512 * 1024;
constexpr int MAXTILES = 160;
constexpr int CW_TMO = 0, CW_BAR = 4096, CW_CNT = 8192;

constexpr int RING_BYTES = 131072, MISC_OFF = 159744, TAB_OFF = MISC_OFF + 256, LDS_BYTES = 163840;

#define GAS __attribute__((address_space(1)))
#define LAS __attribute__((address_space(3)))
typedef unsigned short bf16;
typedef float f32x4 __attribute__((ext_vector_type(4)));
typedef unsigned u32x4 __attribute__((ext_vector_type(4)));
typedef unsigned u32x2 __attribute__((ext_vector_type(2)));
typedef short bf16x8 __attribute__((ext_vector_type(8)));
#define LDS_WAIT() asm volatile("s_waitcnt lgkmcnt(0)" ::: "memory")
#define VM_WAIT() asm volatile("s_waitcnt vmcnt(0)" ::: "memory")

typedef __bf16 bf2_t __attribute__((ext_vector_type(2)));
__device__ __forceinline__ unsigned f2bf(float f) { return (unsigned)__builtin_bit_cast(unsigned short, (__bf16)f); }
__device__ __forceinline__ unsigned pk2(float lo, float hi) { bf2_t v; v.x = (__bf16)lo; v.y = (__bf16)hi; return __builtin_bit_cast(unsigned, v); }
__device__ __forceinline__ float bf2f(unsigned b) { return __builtin_bit_cast(float, b << 16); }
__device__ __forceinline__ float bflo(unsigned w) { return __builtin_bit_cast(float, w << 16); }
__device__ __forceinline__ float bfhi(unsigned w) { return __builtin_bit_cast(float, w & 0xffff0000u); }
__device__ __forceinline__ float sigmoidf_(float x) { return 1.0f / (1.0f + __expf(-x)); }
__device__ __forceinline__ float siluf_(float x) { return x / (1.0f + __expf(-x)); }
__device__ __forceinline__ float softplusf_(float x) { return fmaxf(x, 0.f) + log1pf(__expf(-fabsf(x))); }
__device__ __forceinline__ float gelu_tanh(float x) { const float u = 0.7978845608028654f * (x + 0.044715f * x * x * x); return 0.5f * x * (1.0f + tanhf(u)); }
__device__ __forceinline__ float wave_sum(float v) {
#pragma unroll
    for (int o = 1; o < 64; o <<= 1) v += __shfl_xor(v, o);
    return v;
}

#define XB_TMO      128
#define XB_XCNT(j)  (256  + 64 * (j))
#define XB_XSUB(j)  (1280 + 64 * (j))
#define XB_XGEN(j)  (2304 + 64 * (j))
#define XB_TOP      3328
#define XB_TOPGEN   3392
#define XCD_BAR_WORDS 3456
#define XB_SPIN_CAP (1u << 26)
#define LAS __attribute__((address_space(3)))

__device__ __forceinline__ unsigned xb_ld(unsigned* p)              { return __hip_atomic_load(p, __ATOMIC_RELAXED, __HIP_MEMORY_SCOPE_AGENT); }
__device__ __forceinline__ unsigned xb_add(unsigned* p, unsigned v) { return __hip_atomic_fetch_add(p, v, __ATOMIC_RELAXED, __HIP_MEMORY_SCOPE_AGENT); }
__device__ __forceinline__ unsigned xb_xcc_id() { return (unsigned)__builtin_amdgcn_s_getreg((3 << 11) | 20) & 0xFu; }
#define XB_SPIN(cond, bar) do { unsigned _sp = 0; while (cond) { __builtin_amdgcn_s_sleep(1); \
    if ((++_sp & 255u) == 0u) { if (xb_ld(&(bar)[XB_TMO])) break; if (_sp > XB_SPIN_CAP) { atomicAdd(&(bar)[XB_TMO], 1u); break; } } } } while (0)

struct XcdBarrier {
    unsigned* bar; unsigned x;
    volatile LAS unsigned* st;
};

__device__ __forceinline__ XcdBarrier xcd_barrier_post(unsigned* bar, volatile LAS unsigned* st) {
    XcdBarrier b; b.bar = bar; b.x = xb_xcc_id(); b.st = st;
    if (threadIdx.x == 0) (void)xb_add(&bar[XB_XCNT(b.x)], 1u);
    return b;
}
__device__ __forceinline__ void xcd_barrier_complete(unsigned* bar, unsigned x, unsigned& nloc, unsigned& nx) {
    const unsigned G = gridDim.x * gridDim.y * gridDim.z;
    unsigned sum, cnt, mine, sp = 0u;
    for (;;) {
        sum = 0u; cnt = 0u; mine = 0u;
#pragma unroll
        for (unsigned j = 0; j < 16; ++j) { const unsigned c = xb_ld(&bar[XB_XCNT(j)]); sum += c; cnt += (c > 0u) ? 1u : 0u; mine = (j == x) ? c : mine; }
        if (sum == G) break;
        __builtin_amdgcn_s_sleep(1);
        if ((++sp & 255u) == 0u) { if (xb_ld(&bar[XB_TMO])) break; if (sp > XB_SPIN_CAP) { atomicAdd(&bar[XB_TMO], 1u); break; } }
    }
    nloc = mine > 0u ? mine : 1u; nx = cnt > 0u ? cnt : 1u;
}

__device__ __forceinline__ void xcd_barrier(const XcdBarrier& b) {
    asm volatile("s_waitcnt vmcnt(0)" ::: "memory");
    __syncthreads();
    if (threadIdx.x == 0) {
        unsigned* bar = b.bar;
        __builtin_amdgcn_s_waitcnt(0);
        unsigned nloc = b.st[0], nx = b.st[1];
        if (nloc == 0u) { xcd_barrier_complete(bar, b.x, nloc, nx); b.st[0] = nloc; b.st[1] = nx; }
        const unsigned old = xb_add(&bar[XB_XSUB(b.x)], 1u);
        const unsigned gen = old / nloc;
        if (old + 1u == (gen + 1u) * nloc) {
            __builtin_amdgcn_fence(__ATOMIC_RELEASE, "agent");
            asm volatile("s_waitcnt vmcnt(0)" ::: "memory");
            const unsigned og = xb_add(&bar[XB_TOP], 1u);
            const unsigned tg = og / nx;
            if (og + 1u == (tg + 1u) * nx) xb_add(&bar[XB_TOPGEN], 1u);
            else XB_SPIN(xb_ld(&bar[XB_TOPGEN]) == tg, bar);
            __builtin_amdgcn_fence(__ATOMIC_ACQUIRE, "agent");
            xb_add(&bar[XB_XGEN(b.x)], 1u);
            asm volatile("s_waitcnt vmcnt(0)" ::: "memory");
        } else {
            XB_SPIN(xb_ld(&bar[XB_XGEN(b.x)]) == gen, bar);
            __builtin_amdgcn_fence(__ATOMIC_ACQUIRE, "agent");
            asm volatile("s_waitcnt vmcnt(0)" ::: "memory");
        }
    }
    __syncthreads();
}

struct Args { const float* in[35]; float* out; unsigned char* ws; int ph_lo, ph_hi; };

typedef const __attribute__((address_space(4))) unsigned char* kptr_t;
struct KArgs {
    kptr_t p;
    __device__ __forceinline__ const float* in(int i) const { return *(const float* const __attribute__((address_space(4)))*)(p + 8 * i); }
    __device__ __forceinline__ float* out() const { return *(float* const __attribute__((address_space(4)))*)(p + 280); }
    __device__ __forceinline__ unsigned char* ws() const { return *(unsigned char* const __attribute__((address_space(4)))*)(p + 288); }
};
#define FRESH_KA(name) KArgs name; { kptr_t q_ = (kptr_t)__builtin_amdgcn_kernarg_segment_ptr(); asm volatile("" : "+s"(q_)); name.p = q_; }
#define F_x (A.in(0))
#define F_c (A.in(1))
#define F_ctx (A.in(2))
#define F_cctx (A.in(3))
#define F_ada_w (A.in(4))
#define F_ada_b (A.in(5))
#define F_norm1_g (A.in(6))
#define F_norm2_g (A.in(7))
#define F_w_in (A.in(8))
#define F_mu (A.in(9))
#define F_w0 (A.in(10))
#define F_w_up (A.in(11))
#define F_a0 (A.in(12))
#define F_a_up (A.in(13))
#define F_g_up (A.in(14))
#define F_k_k (A.in(15))
#define F_k_a (A.in(16))
#define F_r_k (A.in(17))
#define F_ln_w (A.in(18))
#define F_ln_b (A.in(19))
#define F_w_ba (A.in(20))
#define F_sg_ln_w (A.in(21))
#define F_sg_ln_b (A.in(22))
#define F_sg_w (A.in(23))
#define F_sg_b (A.in(24))
#define F_w_bb (A.in(25))
#define F_w_out (A.in(26))
#define F_grp_w (A.in(27))
#define F_grp_b (A.in(28))
#define F_exp_w (A.in(29))
#define F_exp_b (A.in(30))
#define F_wg (A.in(31))
#define F_wu (A.in(32))
#define F_wd (A.in(33))
#define F_fin_g (A.in(34))
#define F_MOD ((float*)(A.ws() + WS_MOD))
#define F_rowinfo ((int*)(A.ws() + WS_ROWINFO))
#define F_roww ((float*)(A.ws() + WS_ROWW))
#define F_route ((unsigned*)(A.ws() + WS_ROUTE))
#define F_WinT ((bf16*)(A.ws() + WS_WIN))
#define F_WaT ((bf16*)(A.ws() + WS_WA))
#define F_WbT ((bf16*)(A.ws() + WS_WB))
#define F_WoutT ((bf16*)(A.ws() + WS_WOUT))
#define F_H ((bf16*)(A.ws() + WS_H))
#define F_ZA ((bf16*)(A.ws() + WS_ZA))
#define F_ZB ((bf16*)(A.ws() + WS_ZB))
#define F_ZG ((bf16*)(A.ws() + WS_ZG))
#define F_YB ((bf16*)(A.ws() + WS_YB))
#define F_YA ((bf16*)(A.ws() + WS_YA))
#define F_WguT ((bf16*)(A.ws() + WS_WGU))
#define F_WdT ((bf16*)(A.ws() + WS_WD))
#define F_XG ((bf16*)(A.ws() + WS_XG))
#define F_HMID ((bf16*)(A.ws() + WS_HMID))
#define F_YBUF ((bf16*)(A.ws() + WS_XG))
#define F_MG ((bf16*)(A.ws() + WS_ZB))
#define F_Y ((float*)(A.ws() + WS_Y))
#define F_out (A.out())
struct Frame {
    LAS unsigned char* lds;
    unsigned* ctl;
    unsigned char* ws;
    const float* const* in;
    int tid, lane, wave, G;
};


__device__ __forceinline__ void static_tile(int wgid, int nM, int nN, pg8::Unit& u) {
    const int nwg = nM * nN;
    { const int q = nwg / 8, r = nwg % 8, xcd = wgid % 8, off = wgid / 8; wgid = (xcd < r ? xcd * (q + 1) : r * (q + 1) + (xcd - r) * q) + off; }
    const int nig = 8 * nN, gid = wgid / nig, fm = gid * 8, gsz = (nM - fm) < 8 ? (nM - fm) : 8;
    u.pm = fm + ((wgid % nig) % gsz); u.pn = (wgid % nig) / gsz;
}

__device__ __forceinline__ void transpose_item(const float* W, int K, int N, int k0, int n0, bf16* WT, int dst_row0, LAS float* scr, int lane) {
#pragma unroll 8
    for (int i = 0; i < 32; ++i) { const int kk = 2 * i + (lane >> 5); scr[kk * 33 + (lane & 31)] = W[(size_t)(k0 + kk) * N + n0 + (lane & 31)]; }
    LDS_WAIT(); asm volatile("" ::: "memory");
    const int c = lane & 7;
#pragma unroll
    for (int j = 0; j < 4; ++j) { const int n = (lane >> 3) + 8 * j; const LAS float* s = scr + (8 * c) * 33 + n;
        u32x4 o; o.x = pk2(s[0 * 33], s[1 * 33]); o.y = pk2(s[2 * 33], s[3 * 33]); o.z = pk2(s[4 * 33], s[5 * 33]); o.w = pk2(s[6 * 33], s[7 * 33]);
        *(u32x4*)(WT + (size_t)(dst_row0 + n) * K + k0 + 8 * c) = o; }
    LDS_WAIT(); asm volatile("" ::: "memory");
}

__device__ __forceinline__ void transpose_item64(const float* W, int K, int N, int k0, int n0, bf16* WT, int dst_row0, LAS float* scr, int lane) {
    const int c16 = lane & 15, r4 = lane >> 4;
    f32x4 v[16];
#pragma unroll
    for (int i = 0; i < 16; ++i) v[i] = *(const f32x4*)(W + (size_t)(k0 + 4 * i + r4) * N + n0 + 4 * c16);
#pragma unroll
    for (int i = 0; i < 16; ++i) { LAS float* p = scr + (4 * c16) * 65 + 4 * i + r4; p[0] = v[i].x; p[65] = v[i].y; p[130] = v[i].z; p[195] = v[i].w; }
    LDS_WAIT(); asm volatile("" ::: "memory");
    const int c = lane & 7;
#pragma unroll
    for (int j = 0; j < 8; ++j) { const int n = (lane >> 3) + 8 * j; const LAS float* s = scr + n * 65 + 8 * c;
        u32x4 o; o.x = pk2(s[0], s[1]); o.y = pk2(s[2], s[3]); o.z = pk2(s[4], s[5]); o.w = pk2(s[6], s[7]);
        *(u32x4*)(WT + (size_t)(dst_row0 + n) * K + k0 + 8 * c) = o; }
    LDS_WAIT(); asm volatile("" ::: "memory");
}

__device__ __forceinline__ void p0_prologue(Frame& F, const KArgs& A) {
    {
        LAS float* red = (LAS float*)F.lds;
        const int cl = F.tid & 31, kg = F.tid >> 5;
        for (int cb = blockIdx.x; cb < 256; cb += F.G) {
            const int col = cb * 24 + cl; float a0 = 0.f, a1 = 0.f;
            if (cl < 24) for (int k = kg; k < D; k += 16) { const float w = F_ada_w[(size_t)k * 6144 + col]; a0 += siluf_(F_c[k]) * w; a1 += siluf_(F_cctx[k]) * w; }
            red[(kg * 32 + cl) * 2] = a0; red[(kg * 32 + cl) * 2 + 1] = a1;
            __syncthreads();
            if (F.tid < 48) { const int cc = F.tid % 24, i = F.tid / 24; float s = 0.f; for (int g = 0; g < 16; ++g) s += red[(g * 32 + cc) * 2 + i]; F_MOD[i * 6144 + cb * 24 + cc] = s + F_ada_b[cb * 24 + cc]; }
            __syncthreads();
        }
    }
    LAS float* scr = (LAS float*)(F.lds + F.wave * 16640);
    const int gw = blockIdx.x * 8 + F.wave, NGW = F.G * 8;
    constexpr int I_IN = 16 * 78, I_A = 8 * 16, I_B = 8 * 16, I_O = 16 * 16, NIT = I_IN + I_A + I_B + I_O;
    for (int it = gw; it < NIT; it += NGW) {
        int r = it;
        if (r < I_IN) { const int kb = r / 78, nb = r % 78, n0 = 64 * nb; transpose_item64(F_w_in, D, WINC, 64 * kb, n0, F_WinT, n0 + (n0 >= PA ? 128 : 0), scr, F.lane); continue; } r -= I_IN;
        if (r < I_A) { const int kb = r / 16, nb = r % 16; transpose_item64(F_w_ba, DR, D, 64 * kb, 64 * nb, F_WaT, 64 * nb, scr, F.lane); continue; } r -= I_A;
        if (r < I_B) { const int kb = r / 16, nb = r % 16; transpose_item64(F_w_bb, DR, D, 64 * kb, 64 * nb, F_WbT, 64 * nb, scr, F.lane); continue; } r -= I_B;
        { const int kb = r / 16, nb = r % 16; transpose_item64(F_w_out, D, D, 64 * kb, 64 * nb, F_WoutT, 64 * nb, scr, F.lane); }
    }
    for (int i = blockIdx.x * 512 + F.tid; i < 65536; i += F.G * 512) {
        const int ch = i >> 12, c = (i >> 6) & 63, r = i & 63, dd = ch >> 3, hh = ch & 7;
        ((bf16*)(A.ws() + WS_WUPT))[i] = (bf16)f2bf(F_w_up[(size_t)(dd * 64 + r) * DR + hh * 64 + c]);
        ((bf16*)(A.ws() + WS_AUPT))[i] = (bf16)f2bf(F_a_up[(size_t)(dd * 64 + r) * DR + hh * 64 + c]);
        const int hg = i >> 13, cg = (i >> 7) & 63, rg = i & 127;
        ((bf16*)(A.ws() + WS_GUPT))[i] = (bf16)f2bf(F_g_up[(size_t)rg * DR + hg * 64 + cg]);
    }
    for (int i = blockIdx.x * 512 + F.tid; i < 36 * D; i += F.G * 512) { const int ee = i >> 10, k = i & 1023;
        ((float*)(A.ws() + WS_WRT))[i] = ee < 4 ? F_grp_w[k * 4 + ee] : F_exp_w[k * 32 + ee - 4]; }
    for (int i = blockIdx.x * 512 + F.tid; i < 16384; i += F.G * 512) ((u32x4*)(F_WinT + (size_t)PA * D))[i] = (u32x4){0u, 0u, 0u, 0u};
}

__device__ __forceinline__ void norm_row_bf16(const float* src, const float* g, const float* sh, const float* sc, bf16* dst, int lane) {
    f32x4 v[4]; float ss = 0.f;
#pragma unroll
    for (int j = 0; j < 4; ++j) { v[j] = ((const f32x4*)src)[lane + 64 * j]; ss += (v[j].x * v[j].x + v[j].y * v[j].y) + (v[j].z * v[j].z + v[j].w * v[j].w); }
    const float rinv = rsqrtf(wave_sum(ss) * (1.0f / D) + NORM_EPS);
#pragma unroll
    for (int j = 0; j < 4; ++j) {
        const f32x4 gg = ((const f32x4*)g)[lane + 64 * j], s1 = ((const f32x4*)sc)[lane + 64 * j], s0 = ((const f32x4*)sh)[lane + 64 * j];
        const f32x4 hv = (v[j] * rinv * gg) * (1.0f + s1) + s0;
        u32x2 o; o.x = pk2(hv.x, hv.y); o.y = pk2(hv.z, hv.w);
        ((u32x2*)dst)[lane + 64 * j] = o;
    }
}
__device__ __forceinline__ void p1_norm1(Frame& F, const KArgs& A) {
    const int gw = blockIdx.x * 8 + F.wave, NGW = F.G * 8;
    for (int row = gw; row < MTOT; row += NGW) {
        const bool isctx = row >= SEQ;
        const float* src = isctx ? F_ctx + (size_t)(row - SEQ) * D : F_x + (size_t)row * D;
        const float* mod = F_MOD + (isctx ? 6144 : 0);
        norm_row_bf16(src, F_norm1_g, mod, mod + 1024, F_H + (size_t)row * D, F.lane);
    }
}

struct Sched1 {
    int G, c;
    __device__ __forceinline__ bool next(int i, pg8::Unit& u) const {
        long L = (long)i * G + c; if (L < 8) { u.pm = 64; u.pn = (int)L; return true; }
        L -= 8; if (L >= 1280) return false; static_tile((int)L, 64, 20, u); return true;
    }
    __device__ __forceinline__ void a_ready(const pg8::Unit&) const {}
    __device__ __forceinline__ void done(const pg8::Unit&) const {}
};
struct EpiZ {
    static constexpr bool PERM = true, AFTER_DRAIN = false;
    bf16 *ZA, *ZB, *ZG;
    __device__ __forceinline__ void operator()(const pg8::f32x4 (&acc)[2][2][4][2], const pg8::Unit& u, int wr, int wc, int fr, int fq) const {
        const int row0 = u.pm * 256 + wr * 64 + fr;
        bf16* base; int ld, colt;
        if (u.pn < 8) { base = ZA; ld = 2048; colt = u.pn * 256; } else if (u.pn < 12) { base = ZB; ld = 1024; colt = (u.pn - 8) * 256; } else { base = ZG; ld = 2048; colt = (u.pn - 12) * 256; }
        const int col0 = colt + wc * 32 + 8 * fq;
#pragma unroll
        for (int ai = 0; ai < 2; ++ai)
#pragma unroll
            for (int m = 0; m < 4; ++m) { bf16* rowp = base + (size_t)(row0 + ai * 128 + m * 16) * ld + col0;
#pragma unroll
                for (int bj = 0; bj < 2; ++bj) { const pg8::f32x4 v0 = acc[ai][bj][m][0], v1 = acc[ai][bj][m][1];
                    u32x4 w; w.x = pg8::cvt_pk_bf16(v0[0], v0[1]); w.y = pg8::cvt_pk_bf16(v0[2], v0[3]); w.z = pg8::cvt_pk_bf16(v1[0], v1[1]); w.w = pg8::cvt_pk_bf16(v1[2], v1[3]);
                    *(u32x4*)(rowp + bj * 128) = w; } }
    }
};

__device__ __forceinline__ float mixed_val(const bf16* ZA, bool isctx, int t, int col, float mu) {
    const int row = isctx ? SEQ + t : t;
    const bf16* Z = ZA + (size_t)row * 2048;
    int dr; bool ok;
    if (isctx) { const bool ev = (col & 1) == 0; dr = ev ? -1 : 1; ok = ev ? (t > 0) : (t < CTXL - 1); }
    else { const int s = col & 3, gx = t & 63, gy = t >> 6;
        dr = (s == 0) ? -1 : (s == 1) ? 1 : (s == 2) ? -64 : 64;
        ok = (s == 0) ? (gx > 0) : (s == 1) ? (gx < 63) : (s == 2) ? (gy > 0) : (gy < GROWS - 1); }
    const int dsafe = ok ? dr : 0;
    const float z = bf2f(Z[col]);
    const float nbv = bf2f(Z[col + dsafe * 2048]);
    const float nb = ok ? nbv : 0.f;
    return z + mu * (nb - z);
}
__device__ __forceinline__ void mixed8(const bf16* ZA, int t, int col0, const float* mu, float (&o)[8]) {
    const bf16* Z = ZA + (size_t)t * 2048 + col0;
    const int gx = t & 63, gy = t >> 6;
    const u32x4 z = *(const u32x4*)Z;
    const u32x4 zero = (u32x4){0u, 0u, 0u, 0u};
    const u32x4 l = gx > 0 ? *(const u32x4*)(Z - 2048) : zero, r = gx < 63 ? *(const u32x4*)(Z + 2048) : zero;
    const u32x4 up = gy > 0 ? *(const u32x4*)(Z - 64 * 2048) : zero, dn = gy < GROWS - 1 ? *(const u32x4*)(Z + 64 * 2048) : zero;
    const f32x4 m0 = *(const f32x4*)(mu + col0), m1 = *(const f32x4*)(mu + col0 + 4);
    float zz[8], nn[8];
    zz[0] = bflo(z.x); zz[1] = bfhi(z.x); zz[2] = bflo(z.y); zz[3] = bfhi(z.y); zz[4] = bflo(z.z); zz[5] = bfhi(z.z); zz[6] = bflo(z.w); zz[7] = bfhi(z.w);
    nn[0] = bflo(l.x); nn[1] = bfhi(r.x); nn[2] = bflo(up.y); nn[3] = bfhi(dn.y); nn[4] = bflo(l.z); nn[5] = bfhi(r.z); nn[6] = bflo(up.w); nn[7] = bfhi(dn.w);
    const float mm[8] = {m0.x, m0.y, m0.z, m0.w, m1.x, m1.y, m1.z, m1.w};
#pragma unroll
    for (int i = 0; i < 8; ++i) o[i] = zz[i] + mm[i] * (nn[i] - zz[i]);
}

__device__ __forceinline__ void p3_scan_naive(Frame& F, const KArgs& A, int chain) {
    const int d = chain >> 3, h = chain & 7, j = F.lane, c = h * 64 + j, w = F.wave;
    float wup[64], aup[64];
#pragma unroll
    for (int r = 0; r < 64; ++r) { wup[r] = F_w_up[(size_t)(d * 64 + r) * DR + c]; aup[r] = F_a_up[(size_t)(d * 64 + r) * DR + c]; }
    const float w0 = F_w0[d * DR + c], a0 = F_a0[d * DR + c], kkc = F_k_k[c], kac = F_k_a[c];
    const int col_w = 1536 + d * 64 + j, col_a = 1664 + d * 64 + j;
    const float mu_r = F_mu[c], mu_k = F_mu[512 + c], mu_v = F_mu[1024 + c], mu_w = F_mu[col_w], mu_a = F_mu[col_a];
    float S[8];
#pragma unroll
    for (int i = 0; i < 8; ++i) S[i] = 0.f;
    float* Yd = F_Y + (size_t)d * SEQ * DR;
    const int NSTEP = CTXL + SEQ;
    float nr, nk, nv, nwd, nad;
    { const bool ic = true; const int t = d ? CTXL - 1 : 0;
      nr = mixed_val(F_ZA, ic, t, c, mu_r); nk = mixed_val(F_ZA, ic, t, 512 + c, mu_k); nv = mixed_val(F_ZA, ic, t, 1024 + c, mu_v); nwd = mixed_val(F_ZA, ic, t, col_w, mu_w); nad = mixed_val(F_ZA, ic, t, col_a, mu_a); }
    for (int step = 0; step < NSTEP; ++step) {
        const bool isctx = step < CTXL;
        const int t = isctx ? (d ? CTXL - 1 - step : step) : (d ? SEQ - 1 - (step - CTXL) : step - CTXL);
        const float r = nr, k = nk, v = nv, wd = nwd, ad = nad;
        if (step + 1 < NSTEP) { const int s2 = step + 1; const bool ic = s2 < CTXL; const int t2 = ic ? (d ? CTXL - 1 - s2 : s2) : (d ? SEQ - 1 - (s2 - CTXL) : s2 - CTXL);
            nr = mixed_val(F_ZA, ic, t2, c, mu_r); nk = mixed_val(F_ZA, ic, t2, 512 + c, mu_k); nv = mixed_val(F_ZA, ic, t2, 1024 + c, mu_v); nwd = mixed_val(F_ZA, ic, t2, col_w, mu_w); nad = mixed_val(F_ZA, ic, t2, col_a, mu_a); }
        const float twd = tanhf(wd);
        float wl = w0, al = a0;
#pragma unroll
        for (int rr = 0; rr < 64; ++rr) { const float tw = __builtin_bit_cast(float, __builtin_amdgcn_readlane(__builtin_bit_cast(int, twd), rr)); const float ta = __builtin_bit_cast(float, __builtin_amdgcn_readlane(__builtin_bit_cast(int, ad), rr));
            wl += tw * wup[rr]; al += ta * aup[rr]; }
        const float wv = -softplusf_(-wl) - 0.5f, dec = __expf(-__expf(wv)), a = sigmoidf_(al);
        float kk = k * kkc; const float n2 = wave_sum(kk * kk); kk = kk / fmaxf(sqrtf(n2), 1e-12f);
        const float kd = k * (1.0f + (a - 1.0f) * kac), kka = kk * a;
        float yv = 0.f;
#pragma unroll
        for (int i = 0; i < 8; ++i) {
            const float sa = wave_sum(S[i] * kk);
            const float vi = __builtin_bit_cast(float, __builtin_amdgcn_readlane(__builtin_bit_cast(int, v), 8 * w + i));
            S[i] = S[i] * dec - sa * kka + vi * kd;
            const float y = wave_sum(S[i] * r);
            yv = (j == i) ? y : yv;
        }
        if (!isctx && j < 8) Yd[(size_t)t * DR + h * 64 + 8 * w + j] = yv;
    }
}

constexpr int MB_LD = 136;
__device__ __forceinline__ void p3_mixer_b(Frame& F, const KArgs& A, int chunk) {
    LAS float* stats = (LAS float*)F.lds;
    LAS bf16* Wl = (LAS bf16*)(F.lds + 1024);
    LAS bf16* VT = (LAS bf16*)(F.lds + 1024 + 128 * MB_LD * 2);
    const int tok0 = chunk * 128, lane = F.lane, w = F.wave;
    for (int rr = 0; rr < 16; ++rr) {
        const int q = w * 16 + rr;
        const u32x4 raw = *(const u32x4*)(F_ZB + (size_t)(tok0 + q) * 1024 + 512 + 8 * lane);
        float g[8]; g[0] = gelu_tanh(bflo(raw.x)); g[1] = gelu_tanh(bfhi(raw.x)); g[2] = gelu_tanh(bflo(raw.y)); g[3] = gelu_tanh(bfhi(raw.y));
        g[4] = gelu_tanh(bflo(raw.z)); g[5] = gelu_tanh(bfhi(raw.z)); g[6] = gelu_tanh(bflo(raw.w)); g[7] = gelu_tanh(bfhi(raw.w));
        float s = 0.f;
#pragma unroll
        for (int i = 0; i < 8; ++i) s += g[i];
        const float mean = wave_sum(s) * (1.0f / 512.0f); float s2 = 0.f;
#pragma unroll
        for (int i = 0; i < 8; ++i) { const float dlt = g[i] - mean; s2 += dlt * dlt; }
        const float rstd = rsqrtf(wave_sum(s2) * (1.0f / 512.0f) + 1e-5f);
        if (lane == 0) { stats[q * 2] = mean; stats[q * 2 + 1] = rstd; }
    }
    __syncthreads();
    for (int g = 0; g < 4; ++g) {
        for (int i = F.tid; i < 128 * 32; i += 512) { const int p = i >> 5, q4 = (i & 31) * 4; const f32x4 wv = *(const f32x4*)(F_sg_w + (size_t)(g * 128 + p) * 128 + q4);
            u32x2 o; o.x = pk2(wv.x, wv.y); o.y = pk2(wv.z, wv.w); *(LAS u32x2*)(Wl + p * MB_LD + q4) = o; }
        for (int rr = 0; rr < 16; ++rr) {
            const int q = w * 16 + rr; const float mean = stats[q * 2], rstd = stats[q * 2 + 1];
            const unsigned raw = *(const unsigned*)(F_ZB + (size_t)(tok0 + q) * 1024 + 512 + g * 128 + 2 * lane);
            const int c0 = 2 * lane;
            const float v0 = (gelu_tanh(bflo(raw)) - mean) * rstd * F_sg_ln_w[g * 128 + c0] + F_sg_ln_b[g * 128 + c0];
            const float v1 = (gelu_tanh(bfhi(raw)) - mean) * rstd * F_sg_ln_w[g * 128 + c0 + 1] + F_sg_ln_b[g * 128 + c0 + 1];
            VT[c0 * MB_LD + q] = (bf16)f2bf(v0); VT[(c0 + 1) * MB_LD + q] = (bf16)f2bf(v1);
        }
        __syncthreads();
        const int fr = lane & 15, fq = lane >> 4;
        pg8::f32x4 acc[8];
#pragma unroll
        for (int ct = 0; ct < 8; ++ct) acc[ct] = (pg8::f32x4){0.f, 0.f, 0.f, 0.f};
#pragma unroll
        for (int ks = 0; ks < 4; ++ks) {
            const bf16x8 bfrag = *(const LAS bf16x8*)(Wl + (16 * w + fr) * MB_LD + 32 * ks + 8 * fq);
#pragma unroll
            for (int ct = 0; ct < 8; ++ct) { const bf16x8 afrag = *(const LAS bf16x8*)(VT + (16 * ct + fr) * MB_LD + 32 * ks + 8 * fq);
                acc[ct] = __builtin_amdgcn_mfma_f32_16x16x32_bf16(afrag, bfrag, acc[ct], 0, 0, 0); }
        }
        const int p = 16 * w + fr; const float sb = F_sg_b[g * 128 + p];
#pragma unroll
        for (int ct = 0; ct < 8; ++ct) {
            const int c0 = 16 * ct + 4 * fq;
            const u32x2 uraw = *(const u32x2*)(F_ZB + (size_t)(tok0 + p) * 1024 + g * 128 + c0);
            const float u0 = gelu_tanh(bflo(uraw.x)), u1 = gelu_tanh(bfhi(uraw.x)), u2 = gelu_tanh(bflo(uraw.y)), u3 = gelu_tanh(bfhi(uraw.y));
            u32x2 o; o.x = pk2(u0 * (acc[ct][0] + sb), u1 * (acc[ct][1] + sb)); o.y = pk2(u2 * (acc[ct][2] + sb), u3 * (acc[ct][3] + sb));
            *(u32x2*)(F_YB + (size_t)(tok0 + p) * DR + g * 128 + c0) = o;
        }
        __syncthreads();
    }
}

__device__ __forceinline__ void p4_rwkv_out(Frame& F, const KArgs& A) {
    const int gw = blockIdx.x * 8 + F.wave, NGW = F.G * 8, l = F.lane, h = l >> 3;
    for (int t = gw; t < SEQ; t += NGW) {
        float y[8];
        { const f32x4 a0 = *(const f32x4*)(F_Y + (size_t)t * DR + 8 * l), a1 = *(const f32x4*)(F_Y + (size_t)t * DR + 8 * l + 4);
          const f32x4 b0 = *(const f32x4*)(F_Y + (size_t)(SEQ + t) * DR + 8 * l), b1 = *(const f32x4*)(F_Y + (size_t)(SEQ + t) * DR + 8 * l + 4);
          y[0] = a0.x + b0.x; y[1] = a0.y + b0.y; y[2] = a0.z + b0.z; y[3] = a0.w + b0.w; y[4] = a1.x + b1.x; y[5] = a1.y + b1.y; y[6] = a1.z + b1.z; y[7] = a1.w + b1.w; }
        float s = 0.f;
#pragma unroll
        for (int i = 0; i < 8; ++i) s += y[i];
        s += __shfl_xor(s, 1); s += __shfl_xor(s, 2); s += __shfl_xor(s, 4);
        const float mean = s * (1.0f / 64.0f); float s2 = 0.f;
#pragma unroll
        for (int i = 0; i < 8; ++i) { const float dlt = y[i] - mean; s2 += dlt * dlt; }
        s2 += __shfl_xor(s2, 1); s2 += __shfl_xor(s2, 2); s2 += __shfl_xor(s2, 4);
        const float rstd = rsqrtf(s2 * (1.0f / 64.0f) + GN_EPS);
        float r[8], k[8], v[8];
        mixed8(F_ZA, t, 8 * l, F_mu, r); mixed8(F_ZA, t, 512 + 8 * l, F_mu, k); mixed8(F_ZA, t, 1024 + 8 * l, F_mu, v);
        float dp = 0.f;
#pragma unroll
        for (int i = 0; i < 8; ++i) dp += r[i] * k[i] * F_r_k[8 * l + i];
        dp += __shfl_xor(dp, 1); dp += __shfl_xor(dp, 2); dp += __shfl_xor(dp, 4);
        const float sg0 = sigmoidf_(mixed_val(F_ZA, false, t, 1792 + 2 * l, F_mu[1792 + 2 * l])), sg1 = sigmoidf_(mixed_val(F_ZA, false, t, 1793 + 2 * l, F_mu[1793 + 2 * l]));
        float g[8];
#pragma unroll
        for (int i = 0; i < 8; ++i) g[i] = 0.f;
        for (int rr = 0; rr < 64; ++rr) {
            const float s0 = __shfl(sg0, rr), s1 = __shfl(sg1, rr);
            const f32x4 u0 = *(const f32x4*)(F_g_up + (size_t)(2 * rr) * DR + 8 * l), u1 = *(const f32x4*)(F_g_up + (size_t)(2 * rr) * DR + 8 * l + 4);
            const f32x4 w0 = *(const f32x4*)(F_g_up + (size_t)(2 * rr + 1) * DR + 8 * l), w1 = *(const f32x4*)(F_g_up + (size_t)(2 * rr + 1) * DR + 8 * l + 4);
            g[0] += s0 * u0.x + s1 * w0.x; g[1] += s0 * u0.y + s1 * w0.y; g[2] += s0 * u0.z + s1 * w0.z; g[3] += s0 * u0.w + s1 * w0.w;
            g[4] += s0 * u1.x + s1 * w1.x; g[5] += s0 * u1.y + s1 * w1.y; g[6] += s0 * u1.z + s1 * w1.z; g[7] += s0 * u1.w + s1 * w1.w;
        }
        float o[8];
#pragma unroll
        for (int i = 0; i < 8; ++i) { const float yn = (y[i] - mean) * rstd * F_ln_w[8 * l + i] + F_ln_b[8 * l + i]; o[i] = (yn + dp * v[i]) * g[i]; }
        u32x4 pk; pk.x = pk2(o[0], o[1]); pk.y = pk2(o[2], o[3]); pk.z = pk2(o[4], o[5]); pk.w = pk2(o[6], o[7]);
        *(u32x4*)(F_YA + (size_t)t * DR + 8 * l) = pk;
        (void)h;
    }
}

struct SchedStd {
    int nM, nN, G, c;
    __device__ __forceinline__ bool next(int i, pg8::Unit& u) const { const long L = (long)i * G + c; if (L >= (long)nM * nN) return false; static_tile((int)L, nM, nN, u); return true; }
    __device__ __forceinline__ void a_ready(const pg8::Unit&) const {}
    __device__ __forceinline__ void done(const pg8::Unit&) const {}
};
__device__ __forceinline__ void sig8(const bf16* p, float (&o)[8]) {
    const u32x4 raw = *(const u32x4*)p;
    o[0] = sigmoidf_(bflo(raw.x)); o[1] = sigmoidf_(bfhi(raw.x)); o[2] = sigmoidf_(bflo(raw.y)); o[3] = sigmoidf_(bfhi(raw.y));
    o[4] = sigmoidf_(bflo(raw.z)); o[5] = sigmoidf_(bfhi(raw.z)); o[6] = sigmoidf_(bflo(raw.w)); o[7] = sigmoidf_(bfhi(raw.w));
}
struct EpiMergeA {
    static constexpr bool PERM = true, AFTER_DRAIN = false;
    float* T; const bf16* ZG;
    __device__ __forceinline__ void operator()(const pg8::f32x4 (&acc)[2][2][4][2], const pg8::Unit& u, int wr, int wc, int fr, int fq) const {
        const int row0 = u.pm * 256 + wr * 64 + fr, col0 = u.pn * 256 + wc * 32 + 8 * fq;
#pragma unroll
        for (int ai = 0; ai < 2; ++ai)
#pragma unroll
            for (int m = 0; m < 4; ++m) { const size_t row = (size_t)(row0 + ai * 128 + m * 16);
#pragma unroll
                for (int bj = 0; bj < 2; ++bj) { const int col = col0 + bj * 128; float gt[8]; sig8(ZG + row * 2048 + col, gt);
                    const pg8::f32x4 v0 = acc[ai][bj][m][0], v1 = acc[ai][bj][m][1];
                    *(f32x4*)(T + row * D + col) = (f32x4){gt[0] * v0[0], gt[1] * v0[1], gt[2] * v0[2], gt[3] * v0[3]};
                    *(f32x4*)(T + row * D + col + 4) = (f32x4){gt[4] * v1[0], gt[5] * v1[1], gt[6] * v1[2], gt[7] * v1[3]}; } }
    }
};
struct EpiMergeB {
    static constexpr bool PERM = true, AFTER_DRAIN = false;
    const float* T; const bf16* ZG; bf16* MG;
    __device__ __forceinline__ void operator()(const pg8::f32x4 (&acc)[2][2][4][2], const pg8::Unit& u, int wr, int wc, int fr, int fq) const {
        const int row0 = u.pm * 256 + wr * 64 + fr, col0 = u.pn * 256 + wc * 32 + 8 * fq;
#pragma unroll
        for (int ai = 0; ai < 2; ++ai)
#pragma unroll
            for (int m = 0; m < 4; ++m) { const size_t row = (size_t)(row0 + ai * 128 + m * 16);
#pragma unroll
                for (int bj = 0; bj < 2; ++bj) { const int col = col0 + bj * 128; float gt[8]; sig8(ZG + row * 2048 + 1024 + col, gt);
                    const pg8::f32x4 v0 = acc[ai][bj][m][0], v1 = acc[ai][bj][m][1];
                    const f32x4 t0 = *(const f32x4*)(T + row * D + col), t1 = *(const f32x4*)(T + row * D + col + 4);
                    u32x4 w; w.x = pk2(t0.x + gt[0] * v0[0], t0.y + gt[1] * v0[1]); w.y = pk2(t0.z + gt[2] * v0[2], t0.w + gt[3] * v0[3]);
                    w.z = pk2(t1.x + gt[4] * v1[0], t1.y + gt[5] * v1[1]); w.w = pk2(t1.z + gt[6] * v1[2], t1.w + gt[7] * v1[3]);
                    *(u32x4*)(MG + row * D + col) = w; } }
    }
};
struct EpiX1 {
    static constexpr bool PERM = false, AFTER_DRAIN = false;
    const float* x; const float* gt1; float* out;
    __device__ __forceinline__ void operator()(const pg8::f32x4 (&acc)[2][2][4][2], const pg8::Unit& u, int wr, int wc, int fr, int fq) const {
        const int row0 = u.pm * 256 + wr * 64 + fr, col0 = u.pn * 256 + wc * 32 + 4 * fq;
#pragma unroll
        for (int ai = 0; ai < 2; ++ai)
#pragma unroll
            for (int m = 0; m < 4; ++m) { const size_t row = (size_t)(row0 + ai * 128 + m * 16);
#pragma unroll
                for (int bj = 0; bj < 2; ++bj)
#pragma unroll
                    for (int n = 0; n < 2; ++n) { const int col = col0 + bj * 128 + n * 16;
                        const f32x4 xv = *(const f32x4*)(x + row * D + col), gv = *(const f32x4*)(gt1 + col); const pg8::f32x4 a = acc[ai][bj][m][n];
                        *(f32x4*)(out + row * D + col) = (f32x4){xv.x + gv.x * a[0], xv.y + gv.y * a[1], xv.z + gv.z * a[2], xv.w + gv.w * a[3]}; } }
    }
};

__device__ __forceinline__ void route_decide(const float (&lg)[36], const float* grp_b, const float* exp_b, unsigned* ctl, unsigned* rt) {
    float gl[4]; int grp = 0;
#pragma unroll
    for (int q = 0; q < 4; ++q) gl[q] = lg[q] + grp_b[q];
#pragma unroll
    for (int q = 1; q < 4; ++q) if (gl[q] > gl[grp]) grp = q;
    float den = 0.f;
#pragma unroll
    for (int q = 0; q < 4; ++q) den += __expf(gl[q] - gl[grp]);
    const float pg = 1.0f / den;
    float el[8];
#pragma unroll
    for (int q = 0; q < 8; ++q) { float val = 0.f;
#pragma unroll
        for (int gq = 0; gq < 4; ++gq) val = (grp == gq) ? lg[4 + gq * 8 + q] + exp_b[gq * 8 + q] : val;
        el[q] = val; }
    int i1 = 0;
#pragma unroll
    for (int q = 1; q < 8; ++q) if (el[q] > el[i1]) i1 = q;
    int i2 = (i1 == 0) ? 1 : 0;
#pragma unroll
    for (int q = 0; q < 8; ++q) if (q != i1 && el[q] > el[i2]) i2 = q;
    const float v1 = el[i1], v2 = el[i2];
    const float e2 = __expf(v2 - v1), w1 = pg / (1.0f + e2), w2 = pg * e2 / (1.0f + e2);
    const int e1x = grp * 8 + i1, e2x = grp * 8 + i2;
    const unsigned p1 = atomicAdd(ctl + CW_CNT + 64 * e1x, 1u), p2 = atomicAdd(ctl + CW_CNT + 64 * e2x, 1u);
    rt[0] = (unsigned)e1x; rt[1] = p1; rt[2] = __builtin_bit_cast(unsigned, w1); rt[3] = (unsigned)e2x; rt[4] = p2; rt[5] = __builtin_bit_cast(unsigned, w2);
}
__device__ __forceinline__ void p7_router(Frame& F, const KArgs& A) {
    const int gw = blockIdx.x * 8 + F.wave, NGW = F.G * 8, lane = F.lane;
    const float* mod = F_MOD;
    { const f32x4* src = (const f32x4*)(A.ws() + WS_WRT); LAS f32x4* dst = (LAS f32x4*)F.lds;
      for (int i = F.tid; i < 36 * D / 4; i += 512) dst[i] = src[i]; }
    __syncthreads();
    const LAS f32x4* wl = (const LAS f32x4*)F.lds;
#ifndef ROUTER_REPS
#define ROUTER_REPS 1
#endif
    for (int rrep = 0; rrep < ROUTER_REPS; ++rrep)
    for (int tp = gw; tp < SEQ / 2; tp += NGW) {
        const int t0 = 2 * tp;
        const float* src0 = F_out + (size_t)t0 * D; const float* src1 = src0 + D;
        f32x4 h0[4], h1[4]; float ss0 = 0.f, ss1 = 0.f;
#pragma unroll
        for (int j = 0; j < 4; ++j) { h0[j] = ((const f32x4*)src0)[lane + 64 * j]; h1[j] = ((const f32x4*)src1)[lane + 64 * j];
            ss0 += (h0[j].x * h0[j].x + h0[j].y * h0[j].y) + (h0[j].z * h0[j].z + h0[j].w * h0[j].w); ss1 += (h1[j].x * h1[j].x + h1[j].y * h1[j].y) + (h1[j].z * h1[j].z + h1[j].w * h1[j].w); }
        const float r0 = rsqrtf(wave_sum(ss0) * (1.0f / D) + NORM_EPS), r1 = rsqrtf(wave_sum(ss1) * (1.0f / D) + NORM_EPS);
#pragma unroll
        for (int j = 0; j < 4; ++j) {
            const f32x4 gg = ((const f32x4*)F_norm2_g)[lane + 64 * j], s1 = ((const f32x4*)(mod + 4096))[lane + 64 * j], s0 = ((const f32x4*)(mod + 3072))[lane + 64 * j];
            const f32x4 gs = gg * (1.0f + s1);
            h0[j] = (h0[j] * r0) * gs + s0; h1[j] = (h1[j] * r1) * gs + s0;
            u32x2 o; o.x = pk2(h0[j].x, h0[j].y); o.y = pk2(h0[j].z, h0[j].w); ((u32x2*)(F_H + (size_t)t0 * D))[lane + 64 * j] = o;
            o.x = pk2(h1[j].x, h1[j].y); o.y = pk2(h1[j].z, h1[j].w); ((u32x2*)(F_H + (size_t)(t0 + 1) * D))[lane + 64 * j] = o;
        }
        LAS float* lgs = (LAS float*)(F.lds + 147456 + F.wave * 512);
#pragma unroll 2
        for (int e = 0; e < 36; ++e) {
            float a0 = 0.f, a1 = 0.f;
#pragma unroll
            for (int j = 0; j < 4; ++j) { const f32x4 wv = wl[e * 256 + lane + 64 * j];
                a0 += (h0[j].x * wv.x + h0[j].y * wv.y) + (h0[j].z * wv.z + h0[j].w * wv.w); a1 += (h1[j].x * wv.x + h1[j].y * wv.y) + (h1[j].z * wv.z + h1[j].w * wv.w); }
            const bool lo = lane < 32; float xk = lo ? a0 : a1; const float yk = lo ? a1 : a0;
            xk += __shfl_xor(yk, 32);
            xk += __shfl_xor(xk, 16); xk += __shfl_xor(xk, 8); xk += __shfl_xor(xk, 4); xk += __shfl_xor(xk, 2); xk += __shfl_xor(xk, 1);
            if ((lane & 31) == 0) lgs[(lane >> 5) * 36 + e] = xk;
        }
        LDS_WAIT();
        float lg[36];
        if ((lane & 31) == 0) {
#pragma unroll
            for (int q = 0; q < 9; ++q) { const f32x4 v4 = *(const LAS f32x4*)(lgs + (lane >> 5) * 36 + 4 * q); lg[4 * q] = v4.x; lg[4 * q + 1] = v4.y; lg[4 * q + 2] = v4.z; lg[4 * q + 3] = v4.w; }
        }
        if ((lane & 31) == 0 && rrep == ROUTER_REPS - 1) route_decide(lg, F_grp_b, F_exp_b, F.ctl, F_route + (size_t)(t0 + (lane >> 5)) * 8);
        if (rrep != ROUTER_REPS - 1) { float sink = 0.f; if ((lane & 31) == 0) { for (int q = 0; q < 36; ++q) sink += lg[q]; } asm volatile("" :: "v"(sink)); }
    }
    __syncthreads();
}
__device__ __forceinline__ void p7_moe_convert(Frame& F, const KArgs& A) {
    const int gw = blockIdx.x * 8 + F.wave, NGW = F.G * 8, lane = F.lane;
    {
    LAS float* scr = (LAS float*)(F.lds + F.wave * 16640);
    for (int it = gw; it < NEXP * 384; it += NGW) {
        const int e = it / 384; int r = it % 384;
        if (r < 256) { const bool up = r >= 128; r &= 127; const int kb = r >> 3, nb = r & 7, n0 = 64 * nb;
            const float* W = (up ? F_wu : F_wg) + (size_t)e * D * DEXP;
            transpose_item64(W, D, DEXP, 64 * kb, n0, F_WguT + (size_t)e * 1024 * D, 256 * (n0 >> 7) + (up ? 128 : 0) + (n0 & 127), scr, lane);
        } else { r -= 256; const int kb = r >> 4, nb = r & 15;
            transpose_item64(F_wd + (size_t)e * DEXP * D, DEXP, D, 64 * kb, 64 * nb, F_WdT + (size_t)e * 1024 * DEXP, 64 * nb, scr, lane); }
    }
    }
}

__device__ __forceinline__ int moe_tables(Frame& F, const KArgs& A) {
    LAS int* tab = (LAS int*)(F.lds + TAB_OFF);
    __syncthreads();
    if (F.tid == 0) {
        int off = 0;
        for (int e = 0; e < NEXP; ++e) { const int cnt = (int)__hip_atomic_load(F.ctl + CW_CNT + 64 * e, __ATOMIC_RELAXED, __HIP_MEMORY_SCOPE_AGENT); const int nt = (cnt + 255) >> 8;
            tab[e] = off * 256; tab[64 + e] = cnt; for (int q = 0; q < nt && off + q < MAXTILES; ++q) tab[128 + off + q] = e; off += nt; }
        tab[32] = off < MAXTILES ? off : MAXTILES;
    }
    __syncthreads();
    return tab[32];
}

__device__ __forceinline__ void p8_gather(Frame& F, const KArgs& A) {
    const int ntiles = moe_tables(F, A);
    LAS int* tab = (LAS int*)(F.lds + TAB_OFF);
    const int gw = blockIdx.x * 8 + F.wave, NGW = F.G * 8, lane = F.lane;
    for (int t = gw; t < SEQ; t += NGW) {
        const unsigned* rt = F_route + (size_t)t * 8;
        const u32x4 h0 = ((const u32x4*)(F_H + (size_t)t * D))[lane], h1 = ((const u32x4*)(F_H + (size_t)t * D))[lane + 64];
#pragma unroll
        for (int s = 0; s < 2; ++s) {
            const int e = (int)rt[3 * s], pos = (int)rt[3 * s + 1]; const int row = tab[e] + pos;
            if (row < MAXTILES * 256) {
                ((u32x4*)(F_XG + (size_t)row * D))[lane] = h0; ((u32x4*)(F_XG + (size_t)row * D))[lane + 64] = h1;
                if (lane == 0) { F_rowinfo[row] = 2 * t + s; F_roww[row] = __builtin_bit_cast(float, rt[3 * s + 2]); }
            }
        }
    }
    for (int e = blockIdx.x; e < NEXP; e += F.G) {
        const int cnt = tab[64 + e], r0 = tab[e] + cnt, r1 = tab[e] + (((cnt + 255) >> 8) << 8);
        for (int row = r0 + F.wave; row < r1 && row < MAXTILES * 256; row += 8) {
            ((u32x4*)(F_XG + (size_t)row * D))[lane] = (u32x4){0u, 0u, 0u, 0u}; ((u32x4*)(F_XG + (size_t)row * D))[lane + 64] = (u32x4){0u, 0u, 0u, 0u};
            if (lane == 0) { F_rowinfo[row] = -1; F_roww[row] = 0.f; }
        }
    }
    (void)ntiles;
}

struct MoeOrder {
    const LAS int* tile_e; int T4, G, c;
    __device__ __forceinline__ bool next(int i, pg8::Unit& u) const { const long L = (long)i * G + c; if (L >= T4) return false; const int rt = (int)(L >> 2), j = (int)(L & 3); u.pm = rt; u.pn = tile_e[rt] * 4 + j; return true; }
    __device__ __forceinline__ void a_ready(const pg8::Unit&) const {}
    __device__ __forceinline__ void done(const pg8::Unit&) const {}
};
struct EpiSwiGLU {
    static constexpr bool PERM = true, AFTER_DRAIN = false;
    bf16* HM;
    __device__ __forceinline__ void operator()(const pg8::f32x4 (&acc)[2][2][4][2], const pg8::Unit& u, int wr, int wc, int fr, int fq) const {
        const int row0 = u.pm * 256 + wr * 64 + fr, col0 = (u.pn & 3) * 128 + wc * 32 + 8 * fq;
#pragma unroll
        for (int ai = 0; ai < 2; ++ai)
#pragma unroll
            for (int m = 0; m < 4; ++m) { const size_t row = (size_t)(row0 + ai * 128 + m * 16);
                const pg8::f32x4 g0 = acc[ai][0][m][0], g1 = acc[ai][0][m][1], u0 = acc[ai][1][m][0], u1 = acc[ai][1][m][1];
                u32x4 w; w.x = pk2(siluf_(g0[0]) * u0[0], siluf_(g0[1]) * u0[1]); w.y = pk2(siluf_(g0[2]) * u0[2], siluf_(g0[3]) * u0[3]);
                w.z = pk2(siluf_(g1[0]) * u1[0], siluf_(g1[1]) * u1[1]); w.w = pk2(siluf_(g1[2]) * u1[2], siluf_(g1[3]) * u1[3]);
                *(u32x4*)(HM + row * DEXP + col0) = w; }
    }
};
struct EpiScatter {
    static constexpr bool PERM = true, AFTER_DRAIN = false;
    bf16* YBUF; const int* rowinfo; const float* roww;
    __device__ __forceinline__ void operator()(const pg8::f32x4 (&acc)[2][2][4][2], const pg8::Unit& u, int wr, int wc, int fr, int fq) const {
        const int row0 = u.pm * 256 + wr * 64 + fr, col0 = (u.pn & 3) * 256 + wc * 32 + 8 * fq;
#pragma unroll
        for (int ai = 0; ai < 2; ++ai)
#pragma unroll
            for (int m = 0; m < 4; ++m) { const int row = row0 + ai * 128 + m * 16; const int info = rowinfo[row]; const float wt = roww[row];
                if (info >= 0) {
#pragma unroll
                    for (int bj = 0; bj < 2; ++bj) { const pg8::f32x4 v0 = acc[ai][bj][m][0], v1 = acc[ai][bj][m][1];
                        u32x4 w; w.x = pk2(wt * v0[0], wt * v0[1]); w.y = pk2(wt * v0[2], wt * v0[3]); w.z = pk2(wt * v1[0], wt * v1[1]); w.w = pk2(wt * v1[2], wt * v1[3]);
                        *(u32x4*)(YBUF + (size_t)info * D + col0 + bj * 128) = w; } } }
    }
};

__device__ __forceinline__ void p11_final(Frame& F, const KArgs& A) {
    const int gw = blockIdx.x * 8 + F.wave, NGW = F.G * 8, lane = F.lane;
    const float* gt2 = F_MOD + 5120;
    for (int t = gw; t < SEQ; t += NGW) {
        float* row = F_out + (size_t)t * D;
        f32x4 v[4]; float ss = 0.f;
#pragma unroll
        for (int j = 0; j < 4; ++j) {
            const f32x4 x1 = ((const f32x4*)row)[lane + 64 * j], g2 = ((const f32x4*)gt2)[lane + 64 * j];
            const u32x2 y0 = ((const u32x2*)(F_YBUF + (size_t)(2 * t) * D))[lane + 64 * j], y1 = ((const u32x2*)(F_YBUF + (size_t)(2 * t + 1) * D))[lane + 64 * j];
            f32x4 ys; ys.x = bflo(y0.x) + bflo(y1.x); ys.y = bfhi(y0.x) + bfhi(y1.x); ys.z = bflo(y0.y) + bflo(y1.y); ys.w = bfhi(y0.y) + bfhi(y1.y);
            v[j] = x1 + g2 * ys;
            ss += (v[j].x * v[j].x + v[j].y * v[j].y) + (v[j].z * v[j].z + v[j].w * v[j].w);
        }
        const float rinv = rsqrtf(wave_sum(ss) * (1.0f / D) + NORM_EPS);
#pragma unroll
        for (int j = 0; j < 4; ++j) { const f32x4 fg = ((const f32x4*)F_fin_g)[lane + 64 * j]; ((f32x4*)row)[lane + 64 * j] = v[j] * rinv * fg; }
    }
}


constexpr int SL = 8192;
constexpr int SC_LBUF = 12 * SL;
constexpr int SC_MISC = 19 * SL;

__device__ __forceinline__ int sw_(int r) { return (r ^ (r >> 3)) & 7; }
__device__ __forceinline__ int m_off(int r, int c) { return r * 128 + (((c >> 3) ^ sw_(r)) << 4) + ((c & 7) << 1); }
__device__ __forceinline__ int frag_off(int r, int chunk) { return r * 128 + ((chunk ^ sw_(r)) << 4); }
__device__ __forceinline__ float tanh_fast(float x) { const float e = __expf(2.0f * x); return 1.0f - 2.0f / (e + 1.0f); }

template <bool SWAP> __device__ __forceinline__ void mm_tiles(const LAS unsigned char* X, const LAS unsigned char* Y, int mt, int nt0, int fr, int fq, pg8::f32x4 (&acc)[2]) {
#pragma unroll
    for (int ks = 0; ks < 2; ++ks) {
        const bf16x8 xf = *(const LAS bf16x8*)(X + frag_off(16 * mt + fr, 4 * ks + fq));
#pragma unroll
        for (int n = 0; n < 2; ++n) {
            const bf16x8 yf = *(const LAS bf16x8*)(Y + frag_off(16 * (nt0 + n) + fr, 4 * ks + fq));
            acc[n] = SWAP ? __builtin_amdgcn_mfma_f32_16x16x32_bf16(yf, xf, acc[n], 0, 0, 0) : __builtin_amdgcn_mfma_f32_16x16x32_bf16(xf, yf, acc[n], 0, 0, 0);
        }
    }
}
__device__ __forceinline__ void st4(LAS unsigned char* slot, int r, int c, float a, float b, float cc, float d) { u32x2 o; o.x = pk2(a, b); o.y = pk2(cc, d); *(LAS u32x2*)(slot + m_off(r, c)) = o; }
__device__ __forceinline__ pg8::f32x4 ld4(const LAS unsigned char* slot, int r, int c) { const u32x2 w = *(const LAS u32x2*)(slot + m_off(r, c)); return (pg8::f32x4){bflo(w.x), bfhi(w.x), bflo(w.y), bfhi(w.y)}; }
__device__ __forceinline__ int opq(int x) { asm volatile("" : "+v"(x)); return x; }
#ifndef P1REP
#define P1REP 0
#endif
#define P1R(b) for (int q_ = 0; q_ < (((P1REP >> (b)) & 1) ? 2 : 1); ++q_)
#define ZERO2(a) do { a[0] = (pg8::f32x4){0.f, 0.f, 0.f, 0.f}; a[1] = (pg8::f32x4){0.f, 0.f, 0.f, 0.f}; } while (0)

__device__ __forceinline__ void mix8(const bf16* Z, int col0, const float* mu, int dl, int dr, int du, int dd, bool okl, bool okr, bool oku, bool okd, float (&o)[8]) {
    const u32x4 z = *(const u32x4*)(Z + col0);
    const u32x4 l = *(const u32x4*)(Z + col0 + dl * 2048), r = *(const u32x4*)(Z + col0 + dr * 2048), up = *(const u32x4*)(Z + col0 + du * 2048), dn = *(const u32x4*)(Z + col0 + dd * 2048);
    const f32x4 m0 = *(const f32x4*)(mu + col0), m1 = *(const f32x4*)(mu + col0 + 4);
    float zz[8], nn[8];
    zz[0] = bflo(z.x); zz[1] = bfhi(z.x); zz[2] = bflo(z.y); zz[3] = bfhi(z.y); zz[4] = bflo(z.z); zz[5] = bfhi(z.z); zz[6] = bflo(z.w); zz[7] = bfhi(z.w);
    nn[0] = okl ? bflo(l.x) : 0.f; nn[1] = okr ? bfhi(r.x) : 0.f; nn[2] = oku ? bflo(up.y) : 0.f; nn[3] = okd ? bfhi(dn.y) : 0.f;
    nn[4] = okl ? bflo(l.z) : 0.f; nn[5] = okr ? bfhi(r.z) : 0.f; nn[6] = oku ? bflo(up.w) : 0.f; nn[7] = okd ? bfhi(dn.w) : 0.f;
    const float mm[8] = {m0.x, m0.y, m0.z, m0.w, m1.x, m1.y, m1.z, m1.w};
#pragma unroll
    for (int i = 0; i < 8; ++i) o[i] = zz[i] + mm[i] * (nn[i] - zz[i]);
}
__device__ __forceinline__ void mix4(const bf16* Z, int col0, const float* mu, int dl, int dr, int du, int dd, bool okl, bool okr, bool oku, bool okd, float (&o)[4]) {
    const u32x2 z = *(const u32x2*)(Z + col0);
    const u32x2 l = *(const u32x2*)(Z + col0 + dl * 2048), r = *(const u32x2*)(Z + col0 + dr * 2048), up = *(const u32x2*)(Z + col0 + du * 2048), dn = *(const u32x2*)(Z + col0 + dd * 2048);
    const f32x4 m0 = *(const f32x4*)(mu + col0);
    const float zz[4] = {bflo(z.x), bfhi(z.x), bflo(z.y), bfhi(z.y)};
    const float nn[4] = {okl ? bflo(l.x) : 0.f, okr ? bfhi(r.x) : 0.f, oku ? bflo(up.y) : 0.f, okd ? bfhi(dn.y) : 0.f};
    const float mm[4] = {m0.x, m0.y, m0.z, m0.w};
#pragma unroll
    for (int i = 0; i < 4; ++i) o[i] = zz[i] + mm[i] * (nn[i] - zz[i]);
}

__device__ __forceinline__ void scan_pass1_unit(Frame& F, const KArgs& A, int chain, int scidx) {
    const int d = chain >> 3, h = chain & 7, tid = F.tid, lane = F.lane, w = F.wave, fr = lane & 15, fq = lane >> 4, mt = w >> 1, nt0 = 2 * (w & 1);
    LAS unsigned char* const L = F.lds;
#define S_(i) (L + opq((i) * SL))
    const bool isctx = (scidx == 0); const int sc = scidx - 1;
    const bf16* ZA = F_ZA; const float* mu = F_mu;
    { const int r = tid >> 3, ch = tid & 7; u32x4 idv = (u32x4){0u, 0u, 0u, 0u};
      if ((r >> 3) == ch) { const unsigned one = 0x3f80u; const int e = r & 7; if (e == 0) idv.x = one; else if (e == 1) idv.x = one << 16; else if (e == 2) idv.y = one; else if (e == 3) idv.y = one << 16; else if (e == 4) idv.z = one; else if (e == 5) idv.z = one << 16; else if (e == 6) idv.w = one; else idv.w = one << 16; }
      *(LAS u32x4*)(S_(14) + frag_off(r, ch)) = idv; *(LAS u32x4*)(S_(16) + frag_off(r, ch)) = (u32x4){0u, 0u, 0u, 0u}; }
    int ppc = 14, qpc = 16;
    for (int j = 0; j < 4; ++j) {
        const int ppn = ppc ^ 1, qpn = qpc ^ 1;
        const int t = tid >> 3, cg = tid & 7, x = d ? 63 - t : t;
        int tokchunk; const bf16* Z; int dl, dr, du, dd; bool okl, okr, oku, okd;
        if (isctx) { tokchunk = d ? 3 - j : j; const int tc = tokchunk * 64 + x; Z = ZA + (size_t)(SEQ + tc) * 2048; okl = tc > 0; okr = tc < CTXL - 1; oku = okl; okd = okr; dl = okl ? -1 : 0; dr = okr ? 1 : 0; du = dl; dd = dr; }
        else { tokchunk = d ? 255 - (4 * sc + j) : 4 * sc + j; const int tok = tokchunk * 64 + x; Z = ZA + (size_t)tok * 2048; okl = x > 0; okr = x < 63; oku = tokchunk > 0; okd = tokchunk < GROWS - 1; dl = okl ? -1 : 0; dr = okr ? 1 : 0; du = oku ? -64 : 0; dd = okd ? 64 : 0; }
        float rv[8], kv[8];
        P1R(0) {
            float vv[8], wdv[8], adv[8];
            mix8(Z, h * 64 + 8 * cg, mu, dl, dr, du, dd, okl, okr, oku, okd, rv);
            mix8(Z, 512 + h * 64 + 8 * cg, mu, dl, dr, du, dd, okl, okr, oku, okd, kv);
            mix8(Z, 1024 + h * 64 + 8 * cg, mu, dl, dr, du, dd, okl, okr, oku, okd, vv);
            mix8(Z, 1536 + d * 64 + 8 * cg, mu, dl, dr, du, dd, okl, okr, oku, okd, wdv);
            mix8(Z, 1664 + d * 64 + 8 * cg, mu, dl, dr, du, dd, okl, okr, oku, okd, adv);
#pragma unroll
            for (int i = 0; i < 8; ++i) *(LAS bf16*)(S_(7) + m_off(8 * cg + i, t)) = (bf16)f2bf(vv[i]);
            u32x4 o; o.x = pk2(tanh_fast(wdv[0]), tanh_fast(wdv[1])); o.y = pk2(tanh_fast(wdv[2]), tanh_fast(wdv[3])); o.z = pk2(tanh_fast(wdv[4]), tanh_fast(wdv[5])); o.w = pk2(tanh_fast(wdv[6]), tanh_fast(wdv[7]));
            *(LAS u32x4*)(S_(8) + frag_off(t, cg)) = o;
            o.x = pk2(adv[0], adv[1]); o.y = pk2(adv[2], adv[3]); o.z = pk2(adv[4], adv[5]); o.w = pk2(adv[6], adv[7]);
            *(LAS u32x4*)(S_(9) + frag_off(t, cg)) = o;
            const bf16* wt = (const bf16*)(A.ws() + WS_WUPT) + (size_t)chain * 4096, *at = (const bf16*)(A.ws() + WS_AUPT) + (size_t)chain * 4096;
            *(LAS u32x4*)(S_(10) + frag_off(t, cg)) = *(const u32x4*)(wt + t * 64 + 8 * cg);
            *(LAS u32x4*)(S_(11) + frag_off(t, cg)) = *(const u32x4*)(at + t * 64 + 8 * cg);
        }
        __syncthreads();
        P1R(1) {
            pg8::f32x4 acw[2], aca[2]; ZERO2(acw); ZERO2(aca);
            mm_tiles<true>(S_(8), S_(10), mt, nt0, fr, fq, acw);
            mm_tiles<true>(S_(9), S_(11), mt, nt0, fr, fq, aca);
            const int row = 16 * mt + fr;
#pragma unroll
            for (int n = 0; n < 2; ++n) { const int c0 = 16 * (nt0 + n) + 4 * fq;
                const f32x4 w0v = *(const f32x4*)(F_w0 + d * DR + h * 64 + c0), a0v = *(const f32x4*)(F_a0 + d * DR + h * 64 + c0);
                f32x4 ld; float aa[4];
#pragma unroll
                for (int i = 0; i < 4; ++i) { const float xw = acw[n][i] + w0v[i]; ld[i] = -0.6065306597126334f * sigmoidf_(xw);      aa[i] = sigmoidf_(aca[n][i] + a0v[i]); }
                *(LAS f32x4*)(L + opq(SC_LBUF) + (row * 64 + c0) * 4) = ld;
                st4(S_(18), row, c0, aa[0], aa[1], aa[2], aa[3]); }
        }
        __syncthreads();
        {
            const int c = tid & 63, seg = tid >> 6; LAS float* lb = (LAS float*)(L + opq(SC_LBUF)); LAS float* segtot = (LAS float*)(L + opq(SC_MISC));
            float run = 0.f, loc[8];
#pragma unroll
            for (int i = 0; i < 8; ++i) { run += lb[(8 * seg + i) * 64 + c]; loc[i] = run; }
            segtot[seg * 64 + c] = run;
            __syncthreads();
            float off = 0.f;
#pragma unroll
            for (int s = 0; s < 8; ++s) off += (s < seg) ? segtot[s * 64 + c] : 0.f;
#pragma unroll
            for (int i = 0; i < 8; ++i) lb[(8 * seg + i) * 64 + c] = loc[i] + off;
        }
        __syncthreads();
        P1R(2) {
            const LAS float* lb = (const LAS float*)(L + opq(SC_LBUF));
            float Lt[8], Lp[8], LC[8], av[8];
            { const f32x4 a0 = *(const LAS f32x4*)(lb + t * 64 + 8 * cg), a1 = *(const LAS f32x4*)(lb + t * 64 + 8 * cg + 4);
              const int tp = t > 0 ? t - 1 : 0; const f32x4 b0 = *(const LAS f32x4*)(lb + tp * 64 + 8 * cg), b1 = *(const LAS f32x4*)(lb + tp * 64 + 8 * cg + 4);
              const f32x4 c0 = *(const LAS f32x4*)(lb + 63 * 64 + 8 * cg), c1 = *(const LAS f32x4*)(lb + 63 * 64 + 8 * cg + 4);
#pragma unroll
              for (int i = 0; i < 4; ++i) { Lt[i] = a0[i]; Lt[4 + i] = a1[i]; Lp[i] = t > 0 ? b0[i] : 0.f; Lp[4 + i] = t > 0 ? b1[i] : 0.f; LC[i] = c0[i]; LC[4 + i] = c1[i]; }
              const u32x4 aw = *(const LAS u32x4*)(S_(18) + frag_off(t, cg));
              av[0] = bflo(aw.x); av[1] = bfhi(aw.x); av[2] = bflo(aw.y); av[3] = bfhi(aw.y); av[4] = bflo(aw.z); av[5] = bfhi(aw.z); av[6] = bflo(aw.w); av[7] = bfhi(aw.w); }
            const int cb = h * 64 + 8 * cg;
            const f32x4 kk0 = *(const f32x4*)(F_k_k + cb), kk1 = *(const f32x4*)(F_k_k + cb + 4), ka0 = *(const f32x4*)(F_k_a + cb), ka1 = *(const f32x4*)(F_k_a + cb + 4);
            const float kkc[8] = {kk0.x, kk0.y, kk0.z, kk0.w, kk1.x, kk1.y, kk1.z, kk1.w}, kac[8] = {ka0.x, ka0.y, ka0.z, ka0.w, ka1.x, ka1.y, ka1.z, ka1.w};
            float kkv[8], n2 = 0.f;
#pragma unroll
            for (int i = 0; i < 8; ++i) { kkv[i] = kv[i] * kkc[i]; n2 += kkv[i] * kkv[i]; }
            n2 += __shfl_xor(n2, 1); n2 += __shfl_xor(n2, 2); n2 += __shfl_xor(n2, 4);
            const float inv = 1.0f / fmaxf(sqrtf(n2), 1e-12f);
            float kb[8], rb[8], ah[8], kh[8], ahc[8], khc[8];
#pragma unroll
            for (int i = 0; i < 8; ++i) { const float kk = kkv[i] * inv, al = kk * av[i], kt = kv[i] * (1.0f + (av[i] - 1.0f) * kac[i]);
                const float ep = __expf(Lp[i]), et = __expf(Lt[i]), en = __expf(-Lt[i]), ec = __expf(LC[i] - Lt[i]);
                kb[i] = kk * ep; rb[i] = rv[i] * et; ah[i] = al * en; kh[i] = kt * en; ahc[i] = al * ec; khc[i] = kt * ec; }
            u32x4 o;
            o.x = pk2(kb[0], kb[1]); o.y = pk2(kb[2], kb[3]); o.z = pk2(kb[4], kb[5]); o.w = pk2(kb[6], kb[7]); *(LAS u32x4*)(S_(0) + frag_off(t, cg)) = o;
            o.x = pk2(rb[0], rb[1]); o.y = pk2(rb[2], rb[3]); o.z = pk2(rb[4], rb[5]); o.w = pk2(rb[6], rb[7]); *(LAS u32x4*)(S_(1) + frag_off(t, cg)) = o;
            o.x = pk2(ah[0], ah[1]); o.y = pk2(ah[2], ah[3]); o.z = pk2(ah[4], ah[5]); o.w = pk2(ah[6], ah[7]); *(LAS u32x4*)(S_(2) + frag_off(t, cg)) = o;
            o.x = pk2(kh[0], kh[1]); o.y = pk2(kh[2], kh[3]); o.z = pk2(kh[4], kh[5]); o.w = pk2(kh[6], kh[7]); *(LAS u32x4*)(S_(3) + frag_off(t, cg)) = o;
#pragma unroll
            for (int i = 0; i < 8; ++i) { *(LAS bf16*)(S_(4) + m_off(8 * cg + i, t)) = (bf16)f2bf(kb[i]); *(LAS bf16*)(S_(5) + m_off(8 * cg + i, t)) = (bf16)f2bf(ahc[i]); *(LAS bf16*)(S_(6) + m_off(8 * cg + i, t)) = (bf16)f2bf(khc[i]); }
            if (t == 0) { LAS float* gam = (LAS float*)(L + opq(SC_MISC) + 2048);
#pragma unroll
                for (int i = 0; i < 8; ++i) gam[8 * cg + i] = __expf(LC[i]); }
        }
        __syncthreads();
        P1R(3) {
            pg8::f32x4 a1[2], a2[2]; ZERO2(a1); ZERO2(a2);
            mm_tiles<true>(S_(0), S_(2), mt, nt0, fr, fq, a1);
            mm_tiles<false>(S_(0), S_(2), mt, nt0, fr, fq, a2);
#pragma unroll
            for (int n = 0; n < 2; ++n) {
                { const int tt = 16 * mt + fr, s0 = 16 * (nt0 + n) + 4 * fq; float m[4], t0[4];
#pragma unroll
                  for (int i = 0; i < 4; ++i) { m[i] = (s0 + i < tt) ? -a1[n][i] : 0.f; t0[i] = m[i] + ((s0 + i == tt) ? 1.0f : 0.f); }
                  st4(S_(8), tt, s0, m[0], m[1], m[2], m[3]); st4(S_(18), tt, s0, t0[0], t0[1], t0[2], t0[3]); }
                { const int t0r = 16 * mt + 4 * fq, ss = 16 * (nt0 + n) + fr; float m[4];
#pragma unroll
                  for (int i = 0; i < 4; ++i) m[i] = (ss < t0r + i) ? -a2[n][i] : 0.f;
                  st4(S_(9), ss, t0r, m[0], m[1], m[2], m[3]); }
            }
            ZERO2(a1); ZERO2(a2);
            mm_tiles<true>(S_(0), S_(3), mt, nt0, fr, fq, a1);
            mm_tiles<true>(S_(1), S_(2), mt, nt0, fr, fq, a2);
            pg8::f32x4 a3[2]; ZERO2(a3);
            mm_tiles<true>(S_(1), S_(3), mt, nt0, fr, fq, a3);
#pragma unroll
            for (int n = 0; n < 2; ++n) { const int tt = 16 * mt + fr, s0 = 16 * (nt0 + n) + 4 * fq; float u[4], v2[4], v3[4];
#pragma unroll
                for (int i = 0; i < 4; ++i) { u[i] = (s0 + i < tt) ? a1[n][i] : 0.f; v2[i] = (s0 + i <= tt) ? a2[n][i] : 0.f; v3[i] = (s0 + i <= tt) ? a3[n][i] : 0.f; }
                st4(S_(10), tt, s0, u[0], u[1], u[2], u[3]); st4(S_(11), tt, s0, v2[0], v2[1], v2[2], v2[3]); st4(S_(12), tt, s0, v3[0], v3[1], v3[2], v3[3]); }
        }
        __syncthreads();
        P1R(4) {
            pg8::f32x4 a1[2], a2[2], a3[2]; ZERO2(a1); ZERO2(a2); ZERO2(a3);
            mm_tiles<false>(S_(10), S_(7), mt, nt0, fr, fq, a1);
            mm_tiles<true>(S_(8), S_(9), mt, nt0, fr, fq, a2);
            mm_tiles<false>(S_(8), S_(9), mt, nt0, fr, fq, a3);
#pragma unroll
            for (int n = 0; n < 2; ++n) {
                st4(S_(13), 16 * (nt0 + n) + fr, 16 * mt + 4 * fq, a1[n][0], a1[n][1], a1[n][2], a1[n][3]);
                st4(S_(0), 16 * mt + fr, 16 * (nt0 + n) + 4 * fq, a2[n][0], a2[n][1], a2[n][2], a2[n][3]);
                st4(S_(2), 16 * (nt0 + n) + fr, 16 * mt + 4 * fq, a3[n][0], a3[n][1], a3[n][2], a3[n][3]); }
        }
        __syncthreads();
#pragma unroll
        for (int k = 1; k <= 5; ++k) {
            const int pc = (k & 1) ? 0 : 8, pct = (k & 1) ? 2 : 9, pn = (k & 1) ? 8 : 0, pnt = (k & 1) ? 9 : 2, tc = (k & 1) ? 18 : 10, tn = (k & 1) ? 10 : 18;
            P1R(5) {
            pg8::f32x4 a1[2], a2[2], a3[2];
#pragma unroll
            for (int n = 0; n < 2; ++n) a1[n] = ld4(S_(tc), 16 * mt + fr, 16 * (nt0 + n) + 4 * fq);
            mm_tiles<true>(S_(tc), S_(pct), mt, nt0, fr, fq, a1);
            if (k < 5) { ZERO2(a2); ZERO2(a3); mm_tiles<true>(S_(pc), S_(pct), mt, nt0, fr, fq, a2); mm_tiles<false>(S_(pc), S_(pct), mt, nt0, fr, fq, a3); }
#pragma unroll
            for (int n = 0; n < 2; ++n) {
                st4(S_(tn), 16 * mt + fr, 16 * (nt0 + n) + 4 * fq, a1[n][0], a1[n][1], a1[n][2], a1[n][3]);
                if (k < 5) { st4(S_(pn), 16 * mt + fr, 16 * (nt0 + n) + 4 * fq, a2[n][0], a2[n][1], a2[n][2], a2[n][3]);
                             st4(S_(pnt), 16 * (nt0 + n) + fr, 16 * mt + 4 * fq, a3[n][0], a3[n][1], a3[n][2], a3[n][3]); } }
            __syncthreads();
            }
        }
        P1R(6) {
            pg8::f32x4 a1[2], a2[2]; ZERO2(a1); ZERO2(a2);
            mm_tiles<false>(S_(10), S_(4), mt, nt0, fr, fq, a1);
            mm_tiles<false>(S_(10), S_(13), mt, nt0, fr, fq, a2);
#pragma unroll
            for (int n = 0; n < 2; ++n) {
                st4(S_(8), 16 * (nt0 + n) + fr, 16 * mt + 4 * fq, -a1[n][0], -a1[n][1], -a1[n][2], -a1[n][3]);
                st4(S_(9), 16 * (nt0 + n) + fr, 16 * mt + 4 * fq, -a2[n][0], -a2[n][1], -a2[n][2], -a2[n][3]); }
        }
        __syncthreads();
        pg8::f32x4 accY[2];
        P1R(7) {
            pg8::f32x4 a1[2], a2[2], a3[2];
#pragma unroll
            for (int n = 0; n < 2; ++n) a1[n] = ld4(S_(1), 16 * mt + fr, 16 * (nt0 + n) + 4 * fq);
            mm_tiles<true>(S_(11), S_(8), mt, nt0, fr, fq, a1);
            ZERO2(accY); mm_tiles<true>(S_(12), S_(7), mt, nt0, fr, fq, accY); mm_tiles<true>(S_(11), S_(9), mt, nt0, fr, fq, accY);
            ZERO2(a2); mm_tiles<true>(S_(5), S_(8), mt, nt0, fr, fq, a2);
            ZERO2(a3); mm_tiles<true>(S_(7), S_(6), mt, nt0, fr, fq, a3); mm_tiles<true>(S_(9), S_(5), mt, nt0, fr, fq, a3);
            const LAS float* gam = (const LAS float*)(L + opq(SC_MISC) + 2048);
#pragma unroll
            for (int n = 0; n < 2; ++n) { const int rr = 16 * mt + fr, c0 = 16 * (nt0 + n) + 4 * fq;
                st4(S_(0), rr, c0, a1[n][0], a1[n][1], a1[n][2], a1[n][3]);
                const float gj = gam[rr];
                st4(S_(2), rr, c0, a2[n][0] + (c0 + 0 == rr ? gj : 0.f), a2[n][1] + (c0 + 1 == rr ? gj : 0.f), a2[n][2] + (c0 + 2 == rr ? gj : 0.f), a2[n][3] + (c0 + 3 == rr ? gj : 0.f));
                st4(S_(3), rr, c0, a3[n][0], a3[n][1], a3[n][2], a3[n][3]); }
        }
        __syncthreads();
        {
            pg8::f32x4 a1[2], a2[2], a3[2]; ZERO2(a1);
            mm_tiles<true>(S_(0), S_(ppc), mt, nt0, fr, fq, a1);
            mm_tiles<true>(S_(0), S_(qpc), mt, nt0, fr, fq, accY);
            ZERO2(a2); mm_tiles<true>(S_(ppc), S_(2), mt, nt0, fr, fq, a2);
#pragma unroll
            for (int n = 0; n < 2; ++n) a3[n] = ld4(S_(3), 16 * mt + fr, 16 * (nt0 + n) + 4 * fq);
            mm_tiles<true>(S_(qpc), S_(2), mt, nt0, fr, fq, a3);
            if (!isctx) {
                const int tt = 16 * mt + fr, xr = d ? 63 - tt : tt;
                bf16* gy = (bf16*)(A.ws() + WS_GY) + ((size_t)chain * 256 + tokchunk) * 8192;
#pragma unroll
                for (int n = 0; n < 2; ++n) { const int c0 = 16 * (nt0 + n) + 4 * fq; u32x2 o;
                    o.x = pk2(a1[n][0], a1[n][1]); o.y = pk2(a1[n][2], a1[n][3]); *(u32x2*)(gy + xr * 64 + c0) = o;
                    o.x = pk2(accY[n][0], accY[n][1]); o.y = pk2(accY[n][2], accY[n][3]); *(u32x2*)(gy + 4096 + xr * 64 + c0) = o; }
            }
            if (j < 3) {
#pragma unroll
                for (int n = 0; n < 2; ++n) { const int rr = 16 * mt + fr, c0 = 16 * (nt0 + n) + 4 * fq;
                    st4(S_(ppn), rr, c0, a2[n][0], a2[n][1], a2[n][2], a2[n][3]); st4(S_(qpn), rr, c0, a3[n][0], a3[n][1], a3[n][2], a3[n][3]); }
            } else {
                pg8::f32x4 a4[2]; ZERO2(a4); mm_tiles<false>(S_(ppc), S_(2), mt, nt0, fr, fq, a4);
                bf16* pq = (bf16*)(A.ws() + WS_PQ) + ((size_t)chain * 65 + scidx) * 8192;
#pragma unroll
                for (int n = 0; n < 2; ++n) { u32x2 o;
                    o.x = pk2(a4[n][0], a4[n][1]); o.y = pk2(a4[n][2], a4[n][3]); *(u32x2*)(pq + (16 * (nt0 + n) + fr) * 64 + 16 * mt + 4 * fq) = o;
                    o.x = pk2(a3[n][0], a3[n][1]); o.y = pk2(a3[n][2], a3[n][3]); *(u32x2*)(pq + 4096 + (16 * mt + fr) * 64 + 16 * (nt0 + n) + 4 * fq) = o; }
            }
        }
        __syncthreads();
        ppc = ppn; qpc = qpn;
    }
#undef S_
}

__device__ __forceinline__ void scan_chain(Frame& F, const KArgs& A, int chain) {
    const int w = F.wave, lane = F.lane, fr = lane & 15, fq = lane >> 4;
    const bf16* pq = (const bf16*)(A.ws() + WS_PQ) + (size_t)chain * 65 * 8192;
    bf16* s0 = (bf16*)(A.ws() + WS_S0) + (size_t)chain * 64 * 4096;
    LAS unsigned char* const L = F.lds;
    const int vb = w & 3, v = 16 * vb + fr;
    pg8::f32x4 st[4];
    if (w < 4) {
#pragma unroll
        for (int it = 0; it < 4; ++it) { const u32x2 q = *(const u32x2*)(pq + 4096 + v * 64 + 16 * it + 4 * fq); st[it] = (pg8::f32x4){bflo(q.x), bfhi(q.x), bflo(q.y), bfhi(q.y)}; }
    } else {
        const bf16* src = pq + (size_t)(1 + (w - 4)) * 8192; LAS unsigned char* dst = L + (w - 4) * 16384;
#pragma unroll
        for (int i = 0; i < 16; ++i) { const int ci = i * 64 + lane, half = ci >> 9, row = (ci >> 3) & 63, ch = ci & 7;
            *(LAS u32x4*)(dst + half * 8192 + frag_off(row, ch)) = *(const u32x4*)(src + ci * 8); }
    }
    __syncthreads();
    for (int b = 0; b < 16; ++b) {
        if (w >= 4) {
            if (b + 1 < 16) { const bf16* src = pq + (size_t)(1 + 4 * (b + 1) + (w - 4)) * 8192; LAS unsigned char* dst = L + ((b + 1) & 1) * 65536 + (w - 4) * 16384;
                u32x4 tmp[16];
#pragma unroll
                for (int i = 0; i < 16; ++i) tmp[i] = *(const u32x4*)(src + (i * 64 + lane) * 8);
#pragma unroll
                for (int i = 0; i < 16; ++i) { const int ci = i * 64 + lane, half = ci >> 9, row = (ci >> 3) & 63, ch = ci & 7; *(LAS u32x4*)(dst + half * 8192 + frag_off(row, ch)) = tmp[i]; } }
        } else {
#pragma unroll 1
            for (int s = 0; s < 4; ++s) {
                const int sc = 4 * b + s;
#pragma unroll
                for (int it = 0; it < 4; ++it) { u32x2 o; o.x = pk2(st[it][0], st[it][1]); o.y = pk2(st[it][2], st[it][3]); *(u32x2*)(s0 + (size_t)sc * 4096 + v * 64 + 16 * it + 4 * fq) = o; }
                if (sc < 63) {
                    const LAS unsigned char* P = L + (b & 1) * 65536 + s * 16384; const LAS unsigned char* Q = P + 8192;
                    bf16x8 bfrag[2];
#pragma unroll
                    for (int ks = 0; ks < 2; ++ks) { u32x4 bb; bb.x = pk2(st[2 * ks][0], st[2 * ks][1]); bb.y = pk2(st[2 * ks][2], st[2 * ks][3]); bb.z = pk2(st[2 * ks + 1][0], st[2 * ks + 1][1]); bb.w = pk2(st[2 * ks + 1][2], st[2 * ks + 1][3]); bfrag[ks] = __builtin_bit_cast(bf16x8, bb); }
                    pg8::f32x4 nw[4];
#pragma unroll
                    for (int jt = 0; jt < 4; ++jt) { nw[jt] = ld4(Q, v, 16 * jt + 4 * fq);
#pragma unroll
                        for (int ks = 0; ks < 2; ++ks) { const u32x2 a0 = *(const LAS u32x2*)(P + m_off(16 * jt + fr, 32 * ks + 4 * fq)), a1 = *(const LAS u32x2*)(P + m_off(16 * jt + fr, 32 * ks + 16 + 4 * fq));
                            u32x4 a; a.x = a0.x; a.y = a0.y; a.z = a1.x; a.w = a1.y;
                            nw[jt] = __builtin_amdgcn_mfma_f32_16x16x32_bf16(__builtin_bit_cast(bf16x8, a), bfrag[ks], nw[jt], 0, 0, 0); } }
#pragma unroll
                    for (int jt = 0; jt < 4; ++jt) st[jt] = nw[jt];
                }
            }
        }
        __syncthreads();
    }
}

__device__ __forceinline__ void scan_pass2_unit(Frame& F, const KArgs& A, int h, int c) {
    const int tid = F.tid, lane = F.lane, w = F.wave, fr = lane & 15, fq = lane >> 4;
    LAS unsigned char* const L = F.lds;
#define S_(i) (L + opq((i) * SL))
    const bf16* gyf = (const bf16*)(A.ws() + WS_GY) + ((size_t)(0 * 8 + h) * 256 + c) * 8192;
    const bf16* gyb = (const bf16*)(A.ws() + WS_GY) + ((size_t)(1 * 8 + h) * 256 + c) * 8192;
    const bf16* s0f = (const bf16*)(A.ws() + WS_S0) + ((size_t)(0 * 8 + h) * 64 + (c >> 2)) * 4096;
    const bf16* s0b = (const bf16*)(A.ws() + WS_S0) + ((size_t)(1 * 8 + h) * 64 + ((255 - c) >> 2)) * 4096;
    const bf16* gut = (const bf16*)(A.ws() + WS_GUPT) + (size_t)h * 8192;
    const bf16* ZA = F_ZA; const float* mu = F_mu;
    {
        const int r = tid >> 3, ch = tid & 7;
        *(LAS u32x4*)(S_(0) + frag_off(r, ch)) = *(const u32x4*)(gyf + r * 64 + 8 * ch);
        *(LAS u32x4*)(S_(1) + frag_off(r, ch)) = *(const u32x4*)(gyb + r * 64 + 8 * ch);
        *(LAS u32x4*)(S_(2) + frag_off(r, ch)) = *(const u32x4*)(s0f + r * 64 + 8 * ch);
        *(LAS u32x4*)(S_(3) + frag_off(r, ch)) = *(const u32x4*)(s0b + r * 64 + 8 * ch);
        *(LAS u32x4*)(S_(4) + frag_off(r, ch)) = *(const u32x4*)(gut + r * 128 + 8 * ch);
        *(LAS u32x4*)(S_(5) + frag_off(r, ch)) = *(const u32x4*)(gut + r * 128 + 64 + 8 * ch);
        const int tok = c * 64 + r; const bf16* Z = ZA + (size_t)tok * 2048;
        const bool okl = r > 0, okr = r < 63, oku = c > 0, okd = c < GROWS - 1; const int dl = okl ? -1 : 0, dr = okr ? 1 : 0, du = oku ? -64 : 0, dd = okd ? 64 : 0;
#pragma unroll
        for (int half = 0; half < 2; ++half) { float g8[8]; const int col = 16 * ch + 8 * half; mix8(Z, 1792 + col, mu, dl, dr, du, dd, okl, okr, oku, okd, g8);
            u32x4 o; o.x = pk2(sigmoidf_(g8[0]), sigmoidf_(g8[1])); o.y = pk2(sigmoidf_(g8[2]), sigmoidf_(g8[3])); o.z = pk2(sigmoidf_(g8[4]), sigmoidf_(g8[5])); o.w = pk2(sigmoidf_(g8[6]), sigmoidf_(g8[7]));
            *(LAS u32x4*)(S_(6 + (col >> 6)) + frag_off(r, (col & 63) >> 3)) = o; }
    }
    __syncthreads();
    if (w >= 4) {
        const int mt = w - 4;
#pragma unroll
        for (int np = 0; np < 2; ++np) { pg8::f32x4 g[2]; ZERO2(g);
            mm_tiles<true>(S_(6), S_(4), mt, 2 * np, fr, fq, g); mm_tiles<true>(S_(7), S_(5), mt, 2 * np, fr, fq, g);
#pragma unroll
            for (int n = 0; n < 2; ++n) *(LAS f32x4*)(L + opq(8 * SL) + ((16 * mt + fr) * 64 + 16 * (2 * np + n) + 4 * fq) * 4) = (f32x4){g[n][0], g[n][1], g[n][2], g[n][3]}; }
    }
    pg8::f32x4 y[4];
    const int mt2 = w & 3, tt = 16 * mt2 + fr, tok = c * 64 + tt;
    if (w < 4) {
#pragma unroll
        for (int np = 0; np < 2; ++np) { pg8::f32x4 a[2];
#pragma unroll
            for (int n = 0; n < 2; ++n) { const int c0 = 16 * (2 * np + n) + 4 * fq; const u32x2 yf = *(const u32x2*)(gyf + 4096 + tt * 64 + c0), yb = *(const u32x2*)(gyb + 4096 + tt * 64 + c0);
                a[n] = (pg8::f32x4){bflo(yf.x) + bflo(yb.x), bfhi(yf.x) + bfhi(yb.x), bflo(yf.y) + bflo(yb.y), bfhi(yf.y) + bfhi(yb.y)}; }
            mm_tiles<true>(S_(0), S_(2), mt2, 2 * np, fr, fq, a); mm_tiles<true>(S_(1), S_(3), mt2, 2 * np, fr, fq, a);
            y[2 * np] = a[0]; y[2 * np + 1] = a[1]; }
    }
    __syncthreads();
    if (w < 4) {
        float s = 0.f;
#pragma unroll
        for (int n = 0; n < 4; ++n) s += (y[n][0] + y[n][1]) + (y[n][2] + y[n][3]);
        s += __shfl_xor(s, 16); s += __shfl_xor(s, 32);
        const float mean = s * (1.0f / 64.0f); float s2 = 0.f;
#pragma unroll
        for (int n = 0; n < 4; ++n)
#pragma unroll
            for (int i = 0; i < 4; ++i) { const float dlt = y[n][i] - mean; s2 += dlt * dlt; }
        s2 += __shfl_xor(s2, 16); s2 += __shfl_xor(s2, 32);
        const float rstd = rsqrtf(s2 * (1.0f / 64.0f) + GN_EPS);
        const bf16* Z = ZA + (size_t)tok * 2048;
        const bool okl = tt > 0, okr = tt < 63, oku = c > 0, okd = c < GROWS - 1; const int dl = okl ? -1 : 0, dr = okr ? 1 : 0, du = oku ? -64 : 0, dd = okd ? 64 : 0;
        float rr[4][4], kk[4][4], vv[4][4]; float dp = 0.f;
#pragma unroll
        for (int n = 0; n < 4; ++n) { const int cc = h * 64 + 16 * n + 4 * fq;
            mix4(Z, cc, mu, dl, dr, du, dd, okl, okr, oku, okd, rr[n]); mix4(Z, 512 + cc, mu, dl, dr, du, dd, okl, okr, oku, okd, kk[n]); mix4(Z, 1024 + cc, mu, dl, dr, du, dd, okl, okr, oku, okd, vv[n]);
            const f32x4 rk = *(const f32x4*)(F_r_k + cc);
            dp += rr[n][0] * kk[n][0] * rk.x + rr[n][1] * kk[n][1] * rk.y + rr[n][2] * kk[n][2] * rk.z + rr[n][3] * kk[n][3] * rk.w; }
        dp += __shfl_xor(dp, 16); dp += __shfl_xor(dp, 32);
#pragma unroll
        for (int n = 0; n < 4; ++n) { const int cl = 16 * n + 4 * fq, cc = h * 64 + cl;
            const f32x4 lw = *(const f32x4*)(F_ln_w + cc), lb = *(const f32x4*)(F_ln_b + cc);
            const f32x4 g = *(const LAS f32x4*)(L + opq(8 * SL) + (tt * 64 + cl) * 4);
            float o[4];
#pragma unroll
            for (int i = 0; i < 4; ++i) { const float yn = (y[n][i] - mean) * rstd * lw[i] + lb[i]; o[i] = (yn + dp * vv[n][i]) * g[i]; }
            u32x2 pk; pk.x = pk2(o[0], o[1]); pk.y = pk2(o[2], o[3]);
            *(u32x2*)(F_YA + (size_t)tok * DR + cc) = pk; }
    }
    __syncthreads();
#undef S_
}

__global__ void __launch_bounds__(512, 2) fwd(Args AA) {
    extern __shared__ __attribute__((aligned(16))) unsigned char lds_raw[];
    Frame F;
    F.lds = (LAS unsigned char*)lds_raw;
    F.tid = threadIdx.x; F.lane = F.tid & 63; F.wave = __builtin_amdgcn_readfirstlane(F.tid >> 6); F.G = gridDim.x;
    F.ws = AA.ws; F.in = nullptr; F.ctl = (unsigned*)(AA.ws + WS_CTL);

    for (int u = F.tid; u < (LDS_BYTES - MISC_OFF) / 4; u += 512) ((LAS unsigned*)(F.lds + MISC_OFF))[u] = 0u;
    __syncthreads();
    XcdBarrier bar; bar.bar = F.ctl + CW_BAR; bar.x = 0; bar.st = nullptr;
    if (!MK_LAUNCH_PER_PHASE) bar = xcd_barrier_post(F.ctl + CW_BAR, (volatile LAS unsigned*)(F.lds + MISC_OFF));
    const int lo = AA.ph_lo, hi = AA.ph_hi;
#ifndef ONLY_PHASE
#define ONLY_PHASE -1
#endif
#define IN(k) ((ONLY_PHASE < 0 || ONLY_PHASE == (k)) && lo <= (k) && (k) < hi)
#define FRESH() do { int t_ = threadIdx.x; asm volatile("" : "+v"(t_)); F.tid = t_; F.lane = t_ & 63; } while (0)
#ifndef REP_MASK
#define REP_MASK 0
#endif
#define REPS(k) (((REP_MASK >> (k)) & 1) ? 2 : 1)
#define SEAM(k) do { if (!MK_LAUNCH_PER_PHASE && IN(k) && IN((k) + 1)) xcd_barrier(bar); } while (0)

    if (IN(0)) for (int rep_ = 0; rep_ < REPS(0); ++rep_) { FRESH(); FRESH_KA(A); p0_prologue(F, A); } SEAM(0);
    if (IN(1)) for (int rep_ = 0; rep_ < REPS(1); ++rep_) { FRESH(); FRESH_KA(A); p1_norm1(F, A); } SEAM(1);
    if (IN(2)) for (int rep_ = 0; rep_ < REPS(2); ++rep_) { FRESH(); FRESH_KA(A);
        pg8::Gemm g{F_H, F_WinT, MTOT, NPAD, D}; Sched1 S{F.G, (int)blockIdx.x}; EpiZ E{F_ZA, F_ZB, F_ZG};
        pg8::gemm_phase<EpiZ, Sched1, true, true>(F.lds, g, S, E);
    } SEAM(2);
#ifndef SCAN_NAIVE
#define SCAN_NAIVE 0
#endif
    if (IN(3)) for (int rep_ = 0; rep_ < REPS(3); ++rep_) { FRESH(); FRESH_KA(A);
#if SCAN_NAIVE
        if (blockIdx.x < 16) p3_scan_naive(F, A, (int)blockIdx.x);
        else for (int ch = (int)blockIdx.x - 16; ch < SEQ / 128; ch += F.G - 16) p3_mixer_b(F, A, ch);
#else
        for (int u = (int)blockIdx.x; u < 16 * 64; u += F.G) scan_pass1_unit(F, A, u & 15, 1 + (u >> 4));
#endif
    } SEAM(3);
    if (IN(4)) for (int rep_ = 0; rep_ < REPS(4); ++rep_) { FRESH(); FRESH_KA(A);
#if !SCAN_NAIVE
#ifndef P4REP
#define P4REP 0
#endif
        if (blockIdx.x < 16) { scan_pass1_unit(F, A, (int)blockIdx.x, 0); VM_WAIT(); __syncthreads();
            for (int q_ = 0; q_ < ((P4REP & 1) ? 2 : 1); ++q_) scan_chain(F, A, (int)blockIdx.x); }
        else for (int q_ = 0; q_ < ((P4REP & 2) ? 2 : 1); ++q_) for (int ch = (int)blockIdx.x - 16; ch < SEQ / 128; ch += F.G - 16) p3_mixer_b(F, A, ch);
#endif
    } SEAM(4);
    if (IN(5)) for (int rep_ = 0; rep_ < REPS(5); ++rep_) { FRESH(); FRESH_KA(A);
#if SCAN_NAIVE
        p4_rwkv_out(F, A);
#else
        for (int u = (int)blockIdx.x; u < 8 * 256; u += F.G) scan_pass2_unit(F, A, u & 7, u >> 3);
#endif
    } SEAM(5);
    if (IN(6)) for (int rep_ = 0; rep_ < REPS(6); ++rep_) { FRESH(); FRESH_KA(A);
        SchedStd S{64, 4, F.G, (int)blockIdx.x};
        { pg8::Gemm g{F_YA, F_WaT, SEQ, D, DR}; EpiMergeA E{F_Y, F_ZG}; pg8::gemm_phase<EpiMergeA, SchedStd, true, true>(F.lds, g, S, E); }
        __syncthreads();
        { pg8::Gemm g{F_YB, F_WbT, SEQ, D, DR}; EpiMergeB E{F_Y, F_ZG, F_MG}; pg8::gemm_phase<EpiMergeB, SchedStd, true, true>(F.lds, g, S, E); }
    } SEAM(6);
    if (IN(7)) for (int rep_ = 0; rep_ < REPS(7); ++rep_) { FRESH(); FRESH_KA(A);
        SchedStd S{64, 4, F.G, (int)blockIdx.x};
        pg8::Gemm g{F_MG, F_WoutT, SEQ, D, D}; EpiX1 E{F_x, F_MOD + 2048, F_out}; pg8::gemm_phase<EpiX1, SchedStd, true, true>(F.lds, g, S, E);
    } SEAM(7);
#ifndef CONV_REPS
#define CONV_REPS 1
#endif
    if (IN(8)) { FRESH(); FRESH_KA(A); p7_router(F, A); for (int rep_ = 0; rep_ < CONV_REPS; ++rep_) { p7_moe_convert(F, A); __syncthreads(); } } SEAM(8);
    if (IN(9)) for (int rep_ = 0; rep_ < REPS(9); ++rep_) { FRESH(); FRESH_KA(A); p8_gather(F, A); } SEAM(9);
    if (IN(10)) for (int rep_ = 0; rep_ < REPS(10); ++rep_) { FRESH(); FRESH_KA(A);
        const int ntiles = moe_tables(F, A);
        MoeOrder S{(const LAS int*)(F.lds + TAB_OFF) + 128, ntiles * 4, F.G, (int)blockIdx.x};
        pg8::Gemm g{F_XG, F_WguT, MAXTILES * 256, NEXP * 1024, D}; EpiSwiGLU E{F_HMID};
        pg8::gemm_phase<EpiSwiGLU, MoeOrder, true, true>(F.lds, g, S, E);
    } SEAM(10);
    if (IN(11)) for (int rep_ = 0; rep_ < REPS(11); ++rep_) { FRESH(); FRESH_KA(A);
        const int ntiles = moe_tables(F, A);
        MoeOrder S{(const LAS int*)(F.lds + TAB_OFF) + 128, ntiles * 4, F.G, (int)blockIdx.x};
        pg8::Gemm g{F_HMID, F_WdT, MAXTILES * 256, NEXP * 1024, DEXP}; EpiScatter E{F_YBUF, F_rowinfo, F_roww};
        pg8::gemm_phase<EpiScatter, MoeOrder, true, true>(F.lds, g, S, E);
    } SEAM(11);
    if (IN(12)) for (int rep_ = 0; rep_ < REPS(12); ++rep_) { FRESH(); FRESH_KA(A); p11_final(F, A); }
#undef IN
#undef SEAM
}

extern "C" void kernel_launch(void* const* d_in, const int* in_sizes, int n_in, void* d_out, int out_size, void* d_ws, size_t ws_size, hipStream_t stream) {
    static int grid = 0;
    if (grid == 0) {
        if (n_in != 35 || in_sizes[0] != SEQ * D || out_size != SEQ * D || ws_size < WS_END) {
            fprintf(stderr, "kernel_launch: unexpected shapes: n_in %d in0 %d out %d ws %zu (need %zu); nothing launched\n", n_in, n_in > 0 ? in_sizes[0] : -1, out_size, ws_size, (size_t)WS_END); grid = -1; return; }
        int dev = 0, cus = 0, per_cu = 0;
        if (hipGetDevice(&dev) != hipSuccess || hipDeviceGetAttribute(&cus, hipDeviceAttributeMultiprocessorCount, dev) != hipSuccess) { grid = -1; return; }
        if (hipFuncSetAttribute((const void*)fwd, hipFuncAttributeMaxDynamicSharedMemorySize, LDS_BYTES) != hipSuccess) { fprintf(stderr, "kernel_launch: hipFuncSetAttribute failed\n"); grid = -1; return; }
        if (hipOccupancyMaxActiveBlocksPerMultiprocessor(&per_cu, (const void*)fwd, 512, LDS_BYTES) != hipSuccess || per_cu < 1) fprintf(stderr, "kernel_launch: occupancy query says %d\n", per_cu);
        (void)hipGetLastError();
        grid = cus;
    }
    if (grid < 0) return;
    if (hipMemsetAsync((char*)d_ws + WS_CTL, 0, CTL_ZERO_BYTES, stream) != hipSuccess) return;
    Args a{};
    for (int i = 0; i < 35; ++i) a.in[i] = (const float*)d_in[i];
    a.out = (float*)d_out; a.ws = (unsigned char*)d_ws;
#if MK_LAUNCH_PER_PHASE
    for (int p = 0; p < NPHASE; ++p) { a.ph_lo = p; a.ph_hi = p + 1; hipLaunchKernelGGL(fwd, dim3(grid), dim3(512), LDS_BYTES, stream, a); }
#else
#ifndef MK_PH_HI
#define MK_PH_HI NPHASE
#endif
    a.ph_lo = 0; a.ph_hi = MK_PH_HI;
    hipLaunchKernelGGL(fwd, dim3(grid), dim3(512), LDS_BYTES, stream, a);
#endif
}
```

```cpp
#include <hip/hip_runtime.h>
#include <cstdio>
#include <cstdint>
namespace pg8 {
#define PG8_LAS __attribute__((address_space(3)))
typedef unsigned short bf16_t;
typedef short bf16x8 __attribute__((ext_vector_type(8)));
typedef float f32x4 __attribute__((ext_vector_type(4)));
typedef unsigned u32x4 __attribute__((ext_vector_type(4)));
constexpr int BM = 256, BK = 64, HALF = 128, HTB = HALF * BK * 2  , STAGE_BYTES = 8 * HTB, NXCD = 8, WGM = 8;

__host__ __device__ __forceinline__ int lds_byte(int r, int c) { const int st = (r >> 4) * 2 + (c >> 5), rr = r & 15, cc = c & 31, ob = rr * 64 + cc * 2; return st * 1024 + (ob ^ (((ob >> 9) & 1) << 5)); }
__host__ __device__ __forceinline__ void stage_rc(int b, int& R, int& C) { const int st = b / 1024, sb = b % 1024, swz = sb ^ (((sb >> 9) & 1) << 5); R = (st >> 1) * 16 + swz / 64; C = (st & 1) * 32 + (swz % 64) / 2; }
__host__ __device__ __forceinline__ int perm32(int rho) { const int n = rho >> 4, i = rho & 15; return 8 * (i >> 2) + 4 * n + (i & 3); }

struct Unit { int pm, pn; };
struct Gemm { const bf16_t* A; const bf16_t* Bt; int M, N, K; };

struct StaticOrder {
    int nM, nN, nwg, G, c;
    __host__ __device__ void init(int M, int N, int G_, int c_) { nM = M / BM; nN = N / BM; nwg = nM * nN; G = G_; c = c_; }
    __host__ __device__ bool next(int i, Unit& u) const {
        const long L = (long)i * G + c; if (L >= nwg) return false;
        int wgid = (int)L; { const int q = nwg / NXCD, r = nwg % NXCD, xcd = wgid % NXCD, off = wgid / NXCD; wgid = (xcd < r ? xcd * (q + 1) : r * (q + 1) + (xcd - r) * q) + off; }
        const int nig = WGM * nN, gid = wgid / nig, fm = gid * WGM, gsz = (nM - fm) < WGM ? (nM - fm) : WGM;
        u.pm = fm + ((wgid % nig) % gsz); u.pn = (wgid % nig) / gsz; return true;
    }
    __device__ __forceinline__ void a_ready(const Unit&) const {}
    __device__ __forceinline__ void done(const Unit&) const {}
};

__device__ __forceinline__ unsigned cvt_pk_bf16(float lo, float hi) { unsigned r; asm volatile("v_cvt_pk_bf16_f32 %0, %1, %2" : "=v"(r) : "v"(lo), "v"(hi)); return r; }
template <class Epi, class Sched, bool ALIGN_EPI = false, bool SP2 = false>
__device__ __forceinline__ void gemm_phase(PG8_LAS unsigned char* lds, const Gemm g, const Sched& S, const Epi& E) {
    int tid_ = threadIdx.x; asm volatile("" : "+v"(tid_));
    const int tid = tid_, wid = __builtin_amdgcn_readfirstlane(tid >> 6), lane = tid & 63, wr = wid >> 2, wc = wid & 3, fr = lane & 15, fq = lane >> 4;
    const int K = g.K, nt = K / BK;
    unsigned voffA[2], voffB[2];
#pragma unroll
    for (int i = 0; i < 2; ++i) { int R, C; stage_rc(tid * 16 + i * 8192, R, C); const int Rb = Epi::PERM ? ((R & ~31) + perm32(R & 31)) : R;
        voffA[i] = (unsigned)(R * K + C) * 2u; voffB[i] = (unsigned)(Rb * K + C) * 2u; }
    const size_t kstep = (size_t)(BK * 2);
    const size_t hstep = (size_t)HALF * K * 2;
    const size_t tstep = 2 * hstep;
    const unsigned ldsw = (unsigned)wid * 1024u;
    const int aoff = lds_byte(wr * 64 + fr, fq * 8), boff = lds_byte(wc * 32 + fr, fq * 8);
#define PG8_SA(b, h) (((b) * 2 + (h)) * HTB)
#define PG8_SB(b, h) ((4 + (b) * 2 + (h)) * HTB)
#define PG8_STAGE(bufoff, gbase, voff) do { _Pragma("unroll") for (int _i = 0; _i < 2; ++_i) \
        __builtin_amdgcn_global_load_lds((const unsigned*)((const char*)(gbase) + (voff)[_i]), (PG8_LAS unsigned*)(lds + (bufoff) + ldsw + _i * 8192), 16, 0, 0); } while (0)
#define PG8_LDA(dst, b, h) do { _Pragma("unroll") for (int m = 0; m < 4; ++m) _Pragma("unroll") for (int k = 0; k < 2; ++k) dst[m][k] = *(const PG8_LAS bf16x8*)(lds + PG8_SA(b, h) + aoff + m * 2048 + k * 1024); } while (0)
#define PG8_LDB(dst, b, h) do { _Pragma("unroll") for (int n = 0; n < 2; ++n) _Pragma("unroll") for (int k = 0; k < 2; ++k) dst[n][k] = *(const PG8_LAS bf16x8*)(lds + PG8_SB(b, h) + boff + n * 2048 + k * 1024); } while (0)
#define PG8_MMA(ai, bj, At, Bt) do { __builtin_amdgcn_s_setprio(1); _Pragma("unroll") for (int m = 0; m < 4; ++m) _Pragma("unroll") for (int n = 0; n < 2; ++n) _Pragma("unroll") for (int k = 0; k < 2; ++k) \
        acc[ai][bj][m][n] = __builtin_amdgcn_mfma_f32_16x16x32_bf16(Bt[n][k], At[m][k], acc[ai][bj][m][n], 0, 0, 0); __builtin_amdgcn_s_setprio(0); } while (0)
#define PG8_WAIT_V(n) asm volatile("s_waitcnt vmcnt(" #n ")" ::: "memory")
#define PG8_WAIT_L(n) asm volatile("s_waitcnt lgkmcnt(" #n ")" ::: "memory")
#define PG8_BAR __builtin_amdgcn_s_barrier()
#define PG8_SCHED __builtin_amdgcn_sched_barrier(0)
    Unit cur, nxt; int ui = 0;
    if (!S.next(0, cur)) return;
    f32x4 acc[2][2][4][2];
#pragma unroll
    for (int a = 0; a < 2; ++a)
#pragma unroll
        for (int b = 0; b < 2; ++b)
#pragma unroll
            for (int m = 0; m < 4; ++m)
#pragma unroll
                for (int n = 0; n < 2; ++n) acc[a][b][m][n] = (f32x4){0.f, 0.f, 0.f, 0.f};
    bf16x8 At[4][2], B0[2][2], B1[2][2];
    const char* cA = (const char*)g.A + (size_t)cur.pm * tstep; const char* cB = (const char*)g.Bt + (size_t)cur.pn * tstep;
    S.a_ready(cur);
    if constexpr (SP2) {
        PG8_STAGE(PG8_SB(0, 0), cB, voffB); PG8_STAGE(PG8_SB(0, 1), cB + hstep, voffB); PG8_STAGE(PG8_SA(0, 0), cA, voffA); PG8_STAGE(PG8_SA(0, 1), cA + hstep, voffA);
        if (wr == 1) PG8_BAR;
        PG8_WAIT_V(2); PG8_BAR;
        PG8_STAGE(PG8_SB(1, 0), cB + kstep, voffB); PG8_STAGE(PG8_SA(1, 0), cA + kstep, voffA); PG8_STAGE(PG8_SB(1, 1), cB + hstep + kstep, voffB);
        PG8_WAIT_V(6); PG8_BAR;
    } else {
        PG8_STAGE(PG8_SB(0, 0), cB, voffB); PG8_STAGE(PG8_SA(0, 0), cA, voffA); PG8_STAGE(PG8_SB(0, 1), cB + hstep, voffB); PG8_STAGE(PG8_SA(0, 1), cA + hstep, voffA);
        if (wr == 1) PG8_BAR;
        PG8_WAIT_V(4); PG8_BAR;
        PG8_STAGE(PG8_SB(1, 0), cB + kstep, voffB); PG8_STAGE(PG8_SA(1, 0), cA + kstep, voffA); PG8_STAGE(PG8_SB(1, 1), cB + hstep + kstep, voffB);
        PG8_WAIT_V(6); PG8_BAR;
    }
    for (;;) {
        const bool has_next = S.next(ui + 1, nxt);
        const char* nA = has_next ? (const char*)g.A + (size_t)nxt.pm * tstep : cA; const char* nB = has_next ? (const char*)g.Bt + (size_t)nxt.pn * tstep : cB;
        for (int t = 0; t < nt; t += 2) {
            const bool last = (t == nt - 2);
            const char* a1 = cA + (size_t)(t + 1) * kstep;
            const char* a2 = last ? nA : cA + (size_t)(t + 2) * kstep; const char* b2 = last ? nB : cB + (size_t)(t + 2) * kstep;
            const char* a3 = a2 + kstep; const char* b3 = b2 + kstep;
            if (last && has_next) S.a_ready(nxt);
            if constexpr (SP2) {
            PG8_LDB(B0, 0, 0); PG8_LDB(B1, 0, 1); PG8_SCHED; PG8_LDA(At, 0, 0); PG8_STAGE(PG8_SA(1, 1), a1 + hstep, voffA);
            PG8_WAIT_V(8); PG8_WAIT_L(0); PG8_BAR; PG8_MMA(0, 0, At, B0); PG8_MMA(0, 1, At, B1); PG8_BAR; PG8_SCHED;
            PG8_LDA(At, 0, 1); PG8_STAGE(PG8_SB(0, 0), b2, voffB); PG8_STAGE(PG8_SB(0, 1), b2 + hstep, voffB); PG8_STAGE(PG8_SA(0, 0), a2, voffA);
            PG8_WAIT_V(8); PG8_WAIT_L(0); PG8_BAR; PG8_MMA(1, 0, At, B0); PG8_MMA(1, 1, At, B1); PG8_BAR; PG8_SCHED;
            PG8_LDB(B0, 1, 0); PG8_LDB(B1, 1, 1); PG8_SCHED; PG8_LDA(At, 1, 0); PG8_STAGE(PG8_SA(0, 1), a2 + hstep, voffA);
            PG8_WAIT_V(8); PG8_WAIT_L(0); PG8_BAR; PG8_MMA(0, 0, At, B0); PG8_MMA(0, 1, At, B1); PG8_BAR; PG8_SCHED;
            PG8_LDA(At, 1, 1); PG8_STAGE(PG8_SB(1, 0), b3, voffB); PG8_STAGE(PG8_SB(1, 1), b3 + hstep, voffB); PG8_STAGE(PG8_SA(1, 0), a3, voffA);
            PG8_WAIT_V(8); PG8_WAIT_L(0); PG8_BAR; PG8_MMA(1, 0, At, B0); PG8_MMA(1, 1, At, B1); PG8_BAR; PG8_SCHED;
            } else {
            PG8_LDB(B0, 0, 0); PG8_SCHED; PG8_LDA(At, 0, 0); PG8_STAGE(PG8_SA(1, 1), a1 + hstep, voffA);
            PG8_WAIT_L(8); PG8_BAR; PG8_WAIT_L(0); PG8_MMA(0, 0, At, B0); PG8_BAR; PG8_SCHED;
            PG8_LDB(B1, 0, 1); PG8_STAGE(PG8_SB(0, 0), b2, voffB);
            PG8_BAR; PG8_WAIT_L(0); PG8_MMA(0, 1, At, B1); PG8_BAR;
            PG8_LDA(At, 0, 1); PG8_STAGE(PG8_SA(0, 0), a2, voffA);
            PG8_BAR; PG8_WAIT_L(0); PG8_MMA(1, 0, At, B0); PG8_BAR; PG8_SCHED;
            PG8_STAGE(PG8_SB(0, 1), b2 + hstep, voffB);
            PG8_WAIT_V(6); PG8_BAR; PG8_MMA(1, 1, At, B1); PG8_BAR;
            PG8_LDB(B0, 1, 0); PG8_SCHED; PG8_LDA(At, 1, 0); PG8_STAGE(PG8_SA(0, 1), a2 + hstep, voffA);
            PG8_WAIT_L(8); PG8_BAR; PG8_WAIT_L(0); PG8_MMA(0, 0, At, B0); PG8_BAR; PG8_SCHED;
            PG8_LDB(B1, 1, 1); PG8_STAGE(PG8_SB(1, 0), b3, voffB);
            PG8_BAR; PG8_WAIT_L(0); PG8_MMA(0, 1, At, B1); PG8_BAR;
            PG8_LDA(At, 1, 1); PG8_STAGE(PG8_SA(1, 0), a3, voffA);
            PG8_BAR; PG8_WAIT_L(0); PG8_MMA(1, 0, At, B0); PG8_BAR; PG8_SCHED;
            PG8_STAGE(PG8_SB(1, 1), b3 + hstep, voffB);
            PG8_WAIT_V(6); PG8_BAR; PG8_MMA(1, 1, At, B1); PG8_BAR;
            }
        }
        if constexpr (ALIGN_EPI) { if (wr == 0) PG8_BAR; }
        if constexpr (!Epi::AFTER_DRAIN) { E(acc, cur, wr, wc, fr, fq); S.done(cur); }
        if (!has_next) break;
#pragma unroll
        for (int a = 0; a < 2; ++a)
#pragma unroll
            for (int b = 0; b < 2; ++b)
#pragma unroll
                for (int m = 0; m < 4; ++m)
#pragma unroll
                    for (int n = 0; n < 2; ++n) acc[a][b][m][n] = (f32x4){0.f, 0.f, 0.f, 0.f};
        cur = nxt; cA = nA; cB = nB; ++ui;
        if constexpr (ALIGN_EPI) { if (wr == 1) PG8_BAR; }
    }
    PG8_WAIT_V(0);
    if constexpr (!ALIGN_EPI) { if (wr == 0) PG8_BAR; }
    PG8_BAR;
    if constexpr (Epi::AFTER_DRAIN) { E.fused(acc, cur, wr, wc, fr, fq, lds, wid, lane); S.done(cur); }
#undef PG8_SA
#undef PG8_SB
#undef PG8_STAGE
#undef PG8_LDA
#undef PG8_LDB
#undef PG8_MMA
#undef PG8_WAIT_V
#undef PG8_WAIT_L
#undef PG8_BAR
#undef PG8_SCHED
}
}

#ifndef MK_LAUNCH_PER_PHASE
#define MK_LAUNCH_PER_PHASE 0
#endif
constexpr int D = 1024, SEQ = 16384, CTXL = 256, MTOT = SEQ + CTXL, GW = 64, GROWS = SEQ / GW;
constexpr int DR = 512, NH = 8, HD = 64, PA = 1920, WINC = 4992, NPAD = 5120;
constexpr int NEXP = 32, DEXP = 512;
constexpr float NORM_EPS = 1e-6f, GN_EPS = 64e-5f;
constexpr int NPHASE = 13;

constexpr size_t MiB = 1u << 20;
constexpr size_t WS_CTL = 0, CTL_ZERO_BYTES = 64 * 1024;
constexpr size_t WS_MOD = 1 * MiB;
constexpr size_t WS_ROWINFO = WS_MOD + 64 * 1024;
constexpr size_t WS_ROWW = WS_MOD + 256 * 1024;
constexpr size_t WS_ROUTE = WS_MOD + 512 * 1024;
constexpr size_t WS_WIN = 2 * MiB;
constexpr size_t WS_WA = 12 * MiB, WS_WB = 13 * MiB, WS_WOUT = 14 * MiB;
constexpr size_t WS_H = 16 * MiB;
constexpr size_t WS_ZA = 49 * MiB;
constexpr size_t WS_ZB = 114 * MiB;
constexpr size_t WS_ZG = 146 * MiB;
constexpr size_t WS_YB = 210 * MiB;
constexpr size_t WS_YA = 226 * MiB;
constexpr size_t WS_Y = 242 * MiB;
constexpr size_t WS_END = 306 * MiB;
constexpr size_t WS_WGU = 49 * MiB;
constexpr size_t WS_WD = 113 * MiB;
constexpr size_t WS_XG = 145 * MiB;
constexpr size_t WS_HMID = 225 * MiB;
constexpr size_t WS_WUPT = 512 * 1024, WS_AUPT = 640 * 1024, WS_GUPT = 768 * 1024;
constexpr size_t WS_PQ = 16 * MiB;
constexpr size_t WS_PQC = 33 * MiB;
constexpr size_t WS_S0 = 34 * MiB;
constexpr size_t WS_GY = 242 * MiB;
constexpr size_t WS_WRT = 48 * MiB + 512 * 1024;
constexpr int MAXTILES = 160;
constexpr int CW_TMO = 0, CW_BAR = 4096, CW_CNT = 8192;

constexpr int RING_BYTES = 131072, MISC_OFF = 159744, TAB_OFF = MISC_OFF + 256, LDS_BYTES = 163840;

#define GAS __attribute__((address_space(1)))
#define LAS __attribute__((address_space(3)))
typedef unsigned short bf16;
typedef float f32x4 __attribute__((ext_vector_type(4)));
typedef unsigned u32x4 __attribute__((ext_vector_type(4)));
typedef unsigned u32x2 __attribute__((ext_vector_type(2)));
typedef short bf16x8 __attribute__((ext_vector_type(8)));
#define LDS_WAIT() asm volatile("s_waitcnt lgkmcnt(0)" ::: "memory")
#define VM_WAIT() asm volatile("s_waitcnt vmcnt(0)" ::: "memory")

typedef __bf16 bf2_t __attribute__((ext_vector_type(2)));
__device__ __forceinline__ unsigned f2bf(float f) { return (unsigned)__builtin_bit_cast(unsigned short, (__bf16)f); }
__device__ __forceinline__ unsigned pk2(float lo, float hi) { bf2_t v; v.x = (__bf16)lo; v.y = (__bf16)hi; return __builtin_bit_cast(unsigned, v); }
__device__ __forceinline__ float bf2f(unsigned b) { return __builtin_bit_cast(float, b << 16); }
__device__ __forceinline__ float bflo(unsigned w) { return __builtin_bit_cast(float, w << 16); }
__device__ __forceinline__ float bfhi(unsigned w) { return __builtin_bit_cast(float, w & 0xffff0000u); }
__device__ __forceinline__ float sigmoidf_(float x) { return __builtin_amdgcn_rcpf(1.0f + __expf(-x)); }
__device__ __forceinline__ float siluf_(float x) { return x * __builtin_amdgcn_rcpf(1.0f + __expf(-x)); }
__device__ __forceinline__ float softplusf_(float x) { return fmaxf(x, 0.f) + log1pf(__expf(-fabsf(x))); }
__device__ __forceinline__ float gelu_tanh(float x) { const float u = 0.7978845608028654f * (x + 0.044715f * x * x * x); return x * __builtin_amdgcn_rcpf(1.0f + __expf(-2.0f * u)); }
__device__ __forceinline__ float wave_sum(float v) {
#pragma unroll
    for (int o = 1; o < 64; o <<= 1) v += __shfl_xor(v, o);
    return v;
}

#define XB_TMO      128
#define XB_XCNT(j)  (256  + 64 * (j))
#define XB_XSUB(j)  (1280 + 64 * (j))
#define XB_XGEN(j)  (2304 + 64 * (j))
#define XB_TOP      3328
#define XB_TOPGEN   3392
#define XCD_BAR_WORDS 3456
#define XB_SPIN_CAP (1u << 26)
#define LAS __attribute__((address_space(3)))

__device__ __forceinline__ unsigned xb_ld(unsigned* p)              { return __hip_atomic_load(p, __ATOMIC_RELAXED, __HIP_MEMORY_SCOPE_AGENT); }
__device__ __forceinline__ unsigned xb_add(unsigned* p, unsigned v) { return __hip_atomic_fetch_add(p, v, __ATOMIC_RELAXED, __HIP_MEMORY_SCOPE_AGENT); }
__device__ __forceinline__ unsigned xb_xcc_id() { return (unsigned)__builtin_amdgcn_s_getreg((3 << 11) | 20) & 0xFu; }
#define XB_SPIN(cond, bar) do { unsigned _sp = 0; while (cond) { __builtin_amdgcn_s_sleep(1); \
    if ((++_sp & 255u) == 0u) { if (xb_ld(&(bar)[XB_TMO])) break; if (_sp > XB_SPIN_CAP) { atomicAdd(&(bar)[XB_TMO], 1u); break; } } } } while (0)

struct XcdBarrier {
    unsigned* bar; unsigned x;
    volatile LAS unsigned* st;
};

__device__ __forceinline__ XcdBarrier xcd_barrier_post(unsigned* bar, volatile LAS unsigned* st) {
    XcdBarrier b; b.bar = bar; b.x = xb_xcc_id(); b.st = st;
    if (threadIdx.x == 0) (void)xb_add(&bar[XB_XCNT(b.x)], 1u);
    return b;
}
__device__ __forceinline__ void xcd_barrier_complete(unsigned* bar, unsigned x, unsigned& nloc, unsigned& nx) {
    const unsigned G = gridDim.x * gridDim.y * gridDim.z;
    unsigned sum, cnt, mine, sp = 0u;
    for (;;) {
        sum = 0u; cnt = 0u; mine = 0u;
#pragma unroll
        for (unsigned j = 0; j < 16; ++j) { const unsigned c = xb_ld(&bar[XB_XCNT(j)]); sum += c; cnt += (c > 0u) ? 1u : 0u; mine = (j == x) ? c : mine; }
        if (sum == G) break;
        __builtin_amdgcn_s_sleep(1);
        if ((++sp & 255u) == 0u) { if (xb_ld(&bar[XB_TMO])) break; if (sp > XB_SPIN_CAP) { atomicAdd(&bar[XB_TMO], 1u); break; } }
    }
    nloc = mine > 0u ? mine : 1u; nx = cnt > 0u ? cnt : 1u;
}

__device__ __forceinline__ void xcd_barrier(const XcdBarrier& b) {
    asm volatile("s_waitcnt vmcnt(0)" ::: "memory");
    __syncthreads();
    if (threadIdx.x == 0) {
        unsigned* bar = b.bar;
        __builtin_amdgcn_s_waitcnt(0);
        unsigned nloc = b.st[0], nx = b.st[1];
        if (nloc == 0u) { xcd_barrier_complete(bar, b.x, nloc, nx); b.st[0] = nloc; b.st[1] = nx; }
        const unsigned old = xb_add(&bar[XB_XSUB(b.x)], 1u);
        const unsigned gen = old / nloc;
        if (old + 1u == (gen + 1u) * nloc) {
            __builtin_amdgcn_fence(__ATOMIC_RELEASE, "agent");
            asm volatile("s_waitcnt vmcnt(0)" ::: "memory");
            const unsigned og = xb_add(&bar[XB_TOP], 1u);
            const unsigned tg = og / nx;
            if (og + 1u == (tg + 1u) * nx) xb_add(&bar[XB_TOPGEN], 1u);
            else XB_SPIN(xb_ld(&bar[XB_TOPGEN]) == tg, bar);
            __builtin_amdgcn_fence(__ATOMIC_ACQUIRE, "agent");
            xb_add(&bar[XB_XGEN(b.x)], 1u);
            asm volatile("s_waitcnt vmcnt(0)" ::: "memory");
        } else {
            XB_SPIN(xb_ld(&bar[XB_XGEN(b.x)]) == gen, bar);
            __builtin_amdgcn_fence(__ATOMIC_ACQUIRE, "agent");
            asm volatile("s_waitcnt vmcnt(0)" ::: "memory");
        }
    }
    __syncthreads();
}

struct Args { const float* in[35]; float* out; unsigned char* ws; int ph_lo, ph_hi; };

typedef const __attribute__((address_space(4))) unsigned char* kptr_t;
struct KArgs {
    kptr_t p;
    __device__ __forceinline__ const float* in(int i) const { return *(const float* const __attribute__((address_space(4)))*)(p + 8 * i); }
    __device__ __forceinline__ float* out() const { return *(float* const __attribute__((address_space(4)))*)(p + 280); }
    __device__ __forceinline__ unsigned char* ws() const { return *(unsigned char* const __attribute__((address_space(4)))*)(p + 288); }
};
#define FRESH_KA(name) KArgs name; { kptr_t q_ = (kptr_t)__builtin_amdgcn_kernarg_segment_ptr(); asm volatile("" : "+s"(q_)); name.p = q_; }
#define F_x (A.in(0))
#define F_c (A.in(1))
#define F_ctx (A.in(2))
#define F_cctx (A.in(3))
#define F_ada_w (A.in(4))
#define F_ada_b (A.in(5))
#define F_norm1_g (A.in(6))
#define F_norm2_g (A.in(7))
#define F_w_in (A.in(8))
#define F_mu (A.in(9))
#define F_w0 (A.in(10))
#define F_w_up (A.in(11))
#define F_a0 (A.in(12))
#define F_a_up (A.in(13))
#define F_g_up (A.in(14))
#define F_k_k (A.in(15))
#define F_k_a (A.in(16))
#define F_r_k (A.in(17))
#define F_ln_w (A.in(18))
#define F_ln_b (A.in(19))
#define F_w_ba (A.in(20))
#define F_sg_ln_w (A.in(21))
#define F_sg_ln_b (A.in(22))
#define F_sg_w (A.in(23))
#define F_sg_b (A.in(24))
#define F_w_bb (A.in(25))
#define F_w_out (A.in(26))
#define F_grp_w (A.in(27))
#define F_grp_b (A.in(28))
#define F_exp_w (A.in(29))
#define F_exp_b (A.in(30))
#define F_wg (A.in(31))
#define F_wu (A.in(32))
#define F_wd (A.in(33))
#define F_fin_g (A.in(34))
#define F_MOD ((float*)(A.ws() + WS_MOD))
#define F_rowinfo ((int*)(A.ws() + WS_ROWINFO))
#define F_roww ((float*)(A.ws() + WS_ROWW))
#define F_route ((unsigned*)(A.ws() + WS_ROUTE))
#define F_WinT ((bf16*)(A.ws() + WS_WIN))
#define F_WaT ((bf16*)(A.ws() + WS_WA))
#define F_WbT ((bf16*)(A.ws() + WS_WB))
#define F_WoutT ((bf16*)(A.ws() + WS_WOUT))
#define F_H ((bf16*)(A.ws() + WS_H))
#define F_ZA ((bf16*)(A.ws() + WS_ZA))
#define F_ZB ((bf16*)(A.ws() + WS_ZB))
#define F_ZG ((bf16*)(A.ws() + WS_ZG))
#define F_YB ((bf16*)(A.ws() + WS_YB))
#define F_YA ((bf16*)(A.ws() + WS_YA))
#define F_WguT ((bf16*)(A.ws() + WS_WGU))
#define F_WdT ((bf16*)(A.ws() + WS_WD))
#define F_XG ((bf16*)(A.ws() + WS_XG))
#define F_HMID ((bf16*)(A.ws() + WS_HMID))
#define F_YBUF ((bf16*)(A.ws() + WS_XG))
#define F_MG ((bf16*)(A.ws() + WS_ZB))
#define F_Y ((float*)(A.ws() + WS_Y))
#define F_out (A.out())
struct Frame {
    LAS unsigned char* lds;
    unsigned* ctl;
    unsigned char* ws;
    const float* const* in;
    int tid, lane, wave, G;
};


__device__ __forceinline__ void static_tile(int wgid, int nM, int nN, pg8::Unit& u) {
    const int nwg = nM * nN;
    { const int q = nwg / 8, r = nwg % 8, xcd = wgid % 8, off = wgid / 8; wgid = (xcd < r ? xcd * (q + 1) : r * (q + 1) + (xcd - r) * q) + off; }
    const int nig = 8 * nN, gid = wgid / nig, fm = gid * 8, gsz = (nM - fm) < 8 ? (nM - fm) : 8;
    u.pm = fm + ((wgid % nig) % gsz); u.pn = (wgid % nig) / gsz;
}

__device__ __forceinline__ void transpose_item(const float* W, int K, int N, int k0, int n0, bf16* WT, int dst_row0, LAS float* scr, int lane) {
#pragma unroll 8
    for (int i = 0; i < 32; ++i) { const int kk = 2 * i + (lane >> 5); scr[kk * 33 + (lane & 31)] = W[(size_t)(k0 + kk) * N + n0 + (lane & 31)]; }
    LDS_WAIT(); asm volatile("" ::: "memory");
    const int c = lane & 7;
#pragma unroll
    for (int j = 0; j < 4; ++j) { const int n = (lane >> 3) + 8 * j; const LAS float* s = scr + (8 * c) * 33 + n;
        u32x4 o; o.x = pk2(s[0 * 33], s[1 * 33]); o.y = pk2(s[2 * 33], s[3 * 33]); o.z = pk2(s[4 * 33], s[5 * 33]); o.w = pk2(s[6 * 33], s[7 * 33]);
        *(u32x4*)(WT + (size_t)(dst_row0 + n) * K + k0 + 8 * c) = o; }
    LDS_WAIT(); asm volatile("" ::: "memory");
}

__device__ __forceinline__ void transpose_item64(const float* W, int K, int N, int k0, int n0, bf16* WT, int dst_row0, LAS float* scr, int lane) {
    const int c16 = lane & 15, r4 = lane >> 4;
    f32x4 v[16];
#pragma unroll
    for (int i = 0; i < 16; ++i) v[i] = *(const f32x4*)(W + (size_t)(k0 + 4 * i + r4) * N + n0 + 4 * c16);
#pragma unroll
    for (int i = 0; i < 16; ++i) { LAS float* p = scr + (4 * c16) * 65 + 4 * i + r4; p[0] = v[i].x; p[65] = v[i].y; p[130] = v[i].z; p[195] = v[i].w; }
    LDS_WAIT(); asm volatile("" ::: "memory");
    const int c = lane & 7;
#pragma unroll
    for (int j = 0; j < 8; ++j) { const int n = (lane >> 3) + 8 * j; const LAS float* s = scr + n * 65 + 8 * c;
        u32x4 o; o.x = pk2(s[0], s[1]); o.y = pk2(s[2], s[3]); o.z = pk2(s[4], s[5]); o.w = pk2(s[6], s[7]);
        *(u32x4*)(WT + (size_t)(dst_row0 + n) * K + k0 + 8 * c) = o; }
    LDS_WAIT(); asm volatile("" ::: "memory");
}

__device__ __forceinline__ void p0_prologue(Frame& F, const KArgs& A) {
    {
        LAS float* red = (LAS float*)F.lds;
        const int cl = F.tid & 31, kg = F.tid >> 5;
        for (int cb = blockIdx.x; cb < 256; cb += F.G) {
            const int col = cb * 24 + cl; float a0 = 0.f, a1 = 0.f;
            if (cl < 24) for (int k = kg; k < D; k += 16) { const float w = F_ada_w[(size_t)k * 6144 + col]; a0 += siluf_(F_c[k]) * w; a1 += siluf_(F_cctx[k]) * w; }
            red[(kg * 32 + cl) * 2] = a0; red[(kg * 32 + cl) * 2 + 1] = a1;
            __syncthreads();
            if (F.tid < 48) { const int cc = F.tid % 24, i = F.tid / 24; float s = 0.f; for (int g = 0; g < 16; ++g) s += red[(g * 32 + cc) * 2 + i]; F_MOD[i * 6144 + cb * 24 + cc] = s + F_ada_b[cb * 24 + cc]; }
            __syncthreads();
        }
    }
    LAS float* scr = (LAS float*)(F.lds + F.wave * 16640);
    const int gw = blockIdx.x * 8 + F.wave, NGW = F.G * 8;
    constexpr int I_IN = 16 * 78, I_A = 8 * 16, I_B = 8 * 16, I_O = 16 * 16, NIT = I_IN + I_A + I_B + I_O;
    for (int it = gw; it < NIT; it += NGW) {
        int r = it;
        if (r < I_IN) { const int kb = r / 78, nb = r % 78, n0 = 64 * nb; transpose_item64(F_w_in, D, WINC, 64 * kb, n0, F_WinT, n0 + (n0 >= PA ? 128 : 0), scr, F.lane); continue; } r -= I_IN;
        if (r < I_A) { const int kb = r / 16, nb = r % 16; transpose_item64(F_w_ba, DR, D, 64 * kb, 64 * nb, F_WaT, 64 * nb, scr, F.lane); continue; } r -= I_A;
        if (r < I_B) { const int kb = r / 16, nb = r % 16; transpose_item64(F_w_bb, DR, D, 64 * kb, 64 * nb, F_WbT, 64 * nb, scr, F.lane); continue; } r -= I_B;
        { const int kb = r / 16, nb = r % 16; transpose_item64(F_w_out, D, D, 64 * kb, 64 * nb, F_WoutT, 64 * nb, scr, F.lane); }
    }
    for (int i = blockIdx.x * 512 + F.tid; i < 65536; i += F.G * 512) {
        const int ch = i >> 12, c = (i >> 6) & 63, r = i & 63, dd = ch >> 3, hh = ch & 7;
        ((bf16*)(A.ws() + WS_WUPT))[i] = (bf16)f2bf(F_w_up[(size_t)(dd * 64 + r) * DR + hh * 64 + c]);
        ((bf16*)(A.ws() + WS_AUPT))[i] = (bf16)f2bf(F_a_up[(size_t)(dd * 64 + r) * DR + hh * 64 + c]);
        const int hg = i >> 13, cg = (i >> 7) & 63, rg = i & 127;
        ((bf16*)(A.ws() + WS_GUPT))[i] = (bf16)f2bf(F_g_up[(size_t)rg * DR + hg * 64 + cg]);
    }
    for (int i = blockIdx.x * 512 + F.tid; i < 36 * D; i += F.G * 512) { const int ee = i >> 10, k = i & 1023;
        ((float*)(A.ws() + WS_WRT))[i] = ee < 4 ? F_grp_w[k * 4 + ee] : F_exp_w[k * 32 + ee - 4]; }
    for (int i = blockIdx.x * 512 + F.tid; i < 16384; i += F.G * 512) ((u32x4*)(F_WinT + (size_t)PA * D))[i] = (u32x4){0u, 0u, 0u, 0u};
}

__device__ __forceinline__ void norm_row_bf16(const float* src, const float* g, const float* sh, const float* sc, bf16* dst, int lane) {
    f32x4 v[4]; float ss = 0.f;
#pragma unroll
    for (int j = 0; j < 4; ++j) { v[j] = ((const f32x4*)src)[lane + 64 * j]; ss += (v[j].x * v[j].x + v[j].y * v[j].y) + (v[j].z * v[j].z + v[j].w * v[j].w); }
    const float rinv = rsqrtf(wave_sum(ss) * (1.0f / D) + NORM_EPS);
#pragma unroll
    for (int j = 0; j < 4; ++j) {
        const f32x4 gg = ((const f32x4*)g)[lane + 64 * j], s1 = ((const f32x4*)sc)[lane + 64 * j], s0 = ((const f32x4*)sh)[lane + 64 * j];
        const f32x4 hv = (v[j] * rinv * gg) * (1.0f + s1) + s0;
        u32x2 o; o.x = pk2(hv.x, hv.y); o.y = pk2(hv.z, hv.w);
        ((u32x2*)dst)[lane + 64 * j] = o;
    }
}
__device__ __forceinline__ void p1_norm1(Frame& F, const KArgs& A) {
    const int gw = blockIdx.x * 8 + F.wave, NGW = F.G * 8;
    for (int row = gw; row < MTOT; row += NGW) {
        const bool isctx = row >= SEQ;
        const float* src = isctx ? F_ctx + (size_t)(row - SEQ) * D : F_x + (size_t)row * D;
        const float* mod = F_MOD + (isctx ? 6144 : 0);
        norm_row_bf16(src, F_norm1_g, mod, mod + 1024, F_H + (size_t)row * D, F.lane);
    }
}

struct Sched1 {
    int G, c;
    __device__ __forceinline__ bool next(int i, pg8::Unit& u) const {
        long L = (long)i * G + c; if (L < 8) { u.pm = 64; u.pn = (int)L; return true; }
        L -= 8; if (L >= 1280) return false; static_tile((int)L, 64, 20, u); return true;
    }
    __device__ __forceinline__ void a_ready(const pg8::Unit&) const {}
    __device__ __forceinline__ void done(const pg8::Unit&) const {}
};
struct EpiZ {
    static constexpr bool PERM = true, AFTER_DRAIN = false;
    bf16 *ZA, *ZB, *ZG;
    __device__ __forceinline__ void operator()(const pg8::f32x4 (&acc)[2][2][4][2], const pg8::Unit& u, int wr, int wc, int fr, int fq) const {
        const int row0 = u.pm * 256 + wr * 64 + fr;
        bf16* base; int ld, colt;
        if (u.pn < 8) { base = ZA; ld = 2048; colt = u.pn * 256; } else if (u.pn < 12) { base = ZB; ld = 1024; colt = (u.pn - 8) * 256; } else { base = ZG; ld = 2048; colt = (u.pn - 12) * 256; }
        const int col0 = colt + wc * 32 + 8 * fq;
#pragma unroll
        for (int ai = 0; ai < 2; ++ai)
#pragma unroll
            for (int m = 0; m < 4; ++m) { bf16* rowp = base + (size_t)(row0 + ai * 128 + m * 16) * ld + col0;
#pragma unroll
                for (int bj = 0; bj < 2; ++bj) { const pg8::f32x4 v0 = acc[ai][bj][m][0], v1 = acc[ai][bj][m][1];
                    u32x4 w; w.x = pg8::cvt_pk_bf16(v0[0], v0[1]); w.y = pg8::cvt_pk_bf16(v0[2], v0[3]); w.z = pg8::cvt_pk_bf16(v1[0], v1[1]); w.w = pg8::cvt_pk_bf16(v1[2], v1[3]);
                    *(u32x4*)(rowp + bj * 128) = w; } }
    }
};

__device__ __forceinline__ float mixed_val(const bf16* ZA, bool isctx, int t, int col, float mu) {
    const int row = isctx ? SEQ + t : t;
    const bf16* Z = ZA + (size_t)row * 2048;
    int dr; bool ok;
    if (isctx) { const bool ev = (col & 1) == 0; dr = ev ? -1 : 1; ok = ev ? (t > 0) : (t < CTXL - 1); }
    else { const int s = col & 3, gx = t & 63, gy = t >> 6;
        dr = (s == 0) ? -1 : (s == 1) ? 1 : (s == 2) ? -64 : 64;
        ok = (s == 0) ? (gx > 0) : (s == 1) ? (gx < 63) : (s == 2) ? (gy > 0) : (gy < GROWS - 1); }
    const int dsafe = ok ? dr : 0;
    const float z = bf2f(Z[col]);
    const float nbv = bf2f(Z[col + dsafe * 2048]);
    const float nb = ok ? nbv : 0.f;
    return z + mu * (nb - z);
}
__device__ __forceinline__ void mixed8(const bf16* ZA, int t, int col0, const float* mu, float (&o)[8]) {
    const bf16* Z = ZA + (size_t)t * 2048 + col0;
    const int gx = t & 63, gy = t >> 6;
    const u32x4 z = *(const u32x4*)Z;
    const u32x4 zero = (u32x4){0u, 0u, 0u, 0u};
    const u32x4 l = gx > 0 ? *(const u32x4*)(Z - 2048) : zero, r = gx < 63 ? *(const u32x4*)(Z + 2048) : zero;
    const u32x4 up = gy > 0 ? *(const u32x4*)(Z - 64 * 2048) : zero, dn = gy < GROWS - 1 ? *(const u32x4*)(Z + 64 * 2048) : zero;
    const f32x4 m0 = *(const f32x4*)(mu + col0), m1 = *(const f32x4*)(mu + col0 + 4);
    float zz[8], nn[8];
    zz[0] = bflo(z.x); zz[1] = bfhi(z.x); zz[2] = bflo(z.y); zz[3] = bfhi(z.y); zz[4] = bflo(z.z); zz[5] = bfhi(z.z); zz[6] = bflo(z.w); zz[7] = bfhi(z.w);
    nn[0] = bflo(l.x); nn[1] = bfhi(r.x); nn[2] = bflo(up.y); nn[3] = bfhi(dn.y); nn[4] = bflo(l.z); nn[5] = bfhi(r.z); nn[6] = bflo(up.w); nn[7] = bfhi(dn.w);
    const float mm[8] = {m0.x, m0.y, m0.z, m0.w, m1.x, m1.y, m1.z, m1.w};
#pragma unroll
    for (int i = 0; i < 8; ++i) o[i] = zz[i] + mm[i] * (nn[i] - zz[i]);
}

__device__ __forceinline__ void p3_scan_naive(Frame& F, const KArgs& A, int chain) {
    const int d = chain >> 3, h = chain & 7, j = F.lane, c = h * 64 + j, w = F.wave;
    float wup[64], aup[64];
#pragma unroll
    for (int r = 0; r < 64; ++r) { wup[r] = F_w_up[(size_t)(d * 64 + r) * DR + c]; aup[r] = F_a_up[(size_t)(d * 64 + r) * DR + c]; }
    const float w0 = F_w0[d * DR + c], a0 = F_a0[d * DR + c], kkc = F_k_k[c], kac = F_k_a[c];
    const int col_w = 1536 + d * 64 + j, col_a = 1664 + d * 64 + j;
    const float mu_r = F_mu[c], mu_k = F_mu[512 + c], mu_v = F_mu[1024 + c], mu_w = F_mu[col_w], mu_a = F_mu[col_a];
    float S[8];
#pragma unroll
    for (int i = 0; i < 8; ++i) S[i] = 0.f;
    float* Yd = F_Y + (size_t)d * SEQ * DR;
    const int NSTEP = CTXL + SEQ;
    float nr, nk, nv, nwd, nad;
    { const bool ic = true; const int t = d ? CTXL - 1 : 0;
      nr = mixed_val(F_ZA, ic, t, c, mu_r); nk = mixed_val(F_ZA, ic, t, 512 + c, mu_k); nv = mixed_val(F_ZA, ic, t, 1024 + c, mu_v); nwd = mixed_val(F_ZA, ic, t, col_w, mu_w); nad = mixed_val(F_ZA, ic, t, col_a, mu_a); }
    for (int step = 0; step < NSTEP; ++step) {
        const bool isctx = step < CTXL;
        const int t = isctx ? (d ? CTXL - 1 - step : step) : (d ? SEQ - 1 - (step - CTXL) : step - CTXL);
        const float r = nr, k = nk, v = nv, wd = nwd, ad = nad;
        if (step + 1 < NSTEP) { const int s2 = step + 1; const bool ic = s2 < CTXL; const int t2 = ic ? (d ? CTXL - 1 - s2 : s2) : (d ? SEQ - 1 - (s2 - CTXL) : s2 - CTXL);
            nr = mixed_val(F_ZA, ic, t2, c, mu_r); nk = mixed_val(F_ZA, ic, t2, 512 + c, mu_k); nv = mixed_val(F_ZA, ic, t2, 1024 + c, mu_v); nwd = mixed_val(F_ZA, ic, t2, col_w, mu_w); nad = mixed_val(F_ZA, ic, t2, col_a, mu_a); }
        const float twd = tanhf(wd);
        float wl = w0, al = a0;
#pragma unroll
        for (int rr = 0; rr < 64; ++rr) { const float tw = __builtin_bit_cast(float, __builtin_amdgcn_readlane(__builtin_bit_cast(int, twd), rr)); const float ta = __builtin_bit_cast(float, __builtin_amdgcn_readlane(__builtin_bit_cast(int, ad), rr));
            wl += tw * wup[rr]; al += ta * aup[rr]; }
        const float wv = -softplusf_(-wl) - 0.5f, dec = __expf(-__expf(wv)), a = sigmoidf_(al);
        float kk = k * kkc; const float n2 = wave_sum(kk * kk); kk = kk / fmaxf(sqrtf(n2), 1e-12f);
        const float kd = k * (1.0f + (a - 1.0f) * kac), kka = kk * a;
        float yv = 0.f;
#pragma unroll
        for (int i = 0; i < 8; ++i) {
            const float sa = wave_sum(S[i] * kk);
            const float vi = __builtin_bit_cast(float, __builtin_amdgcn_readlane(__builtin_bit_cast(int, v), 8 * w + i));
            S[i] = S[i] * dec - sa * kka + vi * kd;
            const float y = wave_sum(S[i] * r);
            yv = (j == i) ? y : yv;
        }
        if (!isctx && j < 8) Yd[(size_t)t * DR + h * 64 + 8 * w + j] = yv;
    }
}

constexpr int MB_LD = 136;
__device__ __forceinline__ void p3_mixer_b(Frame& F, const KArgs& A, int chunk) {
    LAS float* stats = (LAS float*)F.lds;
    LAS bf16* Wl = (LAS bf16*)(F.lds + 1024);
    LAS bf16* VT = (LAS bf16*)(F.lds + 1024 + 128 * MB_LD * 2);
    const int tok0 = chunk * 128, lane = F.lane, w = F.wave;
    for (int rr = 0; rr < 16; ++rr) {
        const int q = w * 16 + rr;
        const u32x4 raw = *(const u32x4*)(F_ZB + (size_t)(tok0 + q) * 1024 + 512 + 8 * lane);
        float g[8]; g[0] = gelu_tanh(bflo(raw.x)); g[1] = gelu_tanh(bfhi(raw.x)); g[2] = gelu_tanh(bflo(raw.y)); g[3] = gelu_tanh(bfhi(raw.y));
        g[4] = gelu_tanh(bflo(raw.z)); g[5] = gelu_tanh(bfhi(raw.z)); g[6] = gelu_tanh(bflo(raw.w)); g[7] = gelu_tanh(bfhi(raw.w));
        float s = 0.f;
#pragma unroll
        for (int i = 0; i < 8; ++i) s += g[i];
        const float mean = wave_sum(s) * (1.0f / 512.0f); float s2 = 0.f;
#pragma unroll
        for (int i = 0; i < 8; ++i) { const float dlt = g[i] - mean; s2 += dlt * dlt; }
        const float rstd = rsqrtf(wave_sum(s2) * (1.0f / 512.0f) + 1e-5f);
        if (lane == 0) { stats[q * 2] = mean; stats[q * 2 + 1] = rstd; }
    }
    __syncthreads();
    for (int g = 0; g < 4; ++g) {
        for (int i = F.tid; i < 128 * 32; i += 512) { const int p = i >> 5, q4 = (i & 31) * 4; const f32x4 wv = *(const f32x4*)(F_sg_w + (size_t)(g * 128 + p) * 128 + q4);
            u32x2 o; o.x = pk2(wv.x, wv.y); o.y = pk2(wv.z, wv.w); *(LAS u32x2*)(Wl + p * MB_LD + q4) = o; }
        for (int rr = 0; rr < 16; ++rr) {
            const int q = w * 16 + rr; const float mean = stats[q * 2], rstd = stats[q * 2 + 1];
            const unsigned raw = *(const unsigned*)(F_ZB + (size_t)(tok0 + q) * 1024 + 512 + g * 128 + 2 * lane);
            const int c0 = 2 * lane;
            const float v0 = (gelu_tanh(bflo(raw)) - mean) * rstd * F_sg_ln_w[g * 128 + c0] + F_sg_ln_b[g * 128 + c0];
            const float v1 = (gelu_tanh(bfhi(raw)) - mean) * rstd * F_sg_ln_w[g * 128 + c0 + 1] + F_sg_ln_b[g * 128 + c0 + 1];
            VT[c0 * MB_LD + q] = (bf16)f2bf(v0); VT[(c0 + 1) * MB_LD + q] = (bf16)f2bf(v1);
        }
        __syncthreads();
        const int fr = lane & 15, fq = lane >> 4;
        pg8::f32x4 acc[8];
#pragma unroll
        for (int ct = 0; ct < 8; ++ct) acc[ct] = (pg8::f32x4){0.f, 0.f, 0.f, 0.f};
#pragma unroll
        for (int ks = 0; ks < 4; ++ks) {
            const bf16x8 bfrag = *(const LAS bf16x8*)(Wl + (16 * w + fr) * MB_LD + 32 * ks + 8 * fq);
#pragma unroll
            for (int ct = 0; ct < 8; ++ct) { const bf16x8 afrag = *(const LAS bf16x8*)(VT + (16 * ct + fr) * MB_LD + 32 * ks + 8 * fq);
                acc[ct] = __builtin_amdgcn_mfma_f32_16x16x32_bf16(afrag, bfrag, acc[ct], 0, 0, 0); }
        }
        const int p = 16 * w + fr; const float sb = F_sg_b[g * 128 + p];
#pragma unroll
        for (int ct = 0; ct < 8; ++ct) {
            const int c0 = 16 * ct + 4 * fq;
            const u32x2 uraw = *(const u32x2*)(F_ZB + (size_t)(tok0 + p) * 1024 + g * 128 + c0);
            const float u0 = gelu_tanh(bflo(uraw.x)), u1 = gelu_tanh(bfhi(uraw.x)), u2 = gelu_tanh(bflo(uraw.y)), u3 = gelu_tanh(bfhi(uraw.y));
            u32x2 o; o.x = pk2(u0 * (acc[ct][0] + sb), u1 * (acc[ct][1] + sb)); o.y = pk2(u2 * (acc[ct][2] + sb), u3 * (acc[ct][3] + sb));
            *(u32x2*)(F_YB + (size_t)(tok0 + p) * DR + g * 128 + c0) = o;
        }
        __syncthreads();
    }
}

__device__ __forceinline__ void p4_rwkv_out(Frame& F, const KArgs& A) {
    const int gw = blockIdx.x * 8 + F.wave, NGW = F.G * 8, l = F.lane, h = l >> 3;
    for (int t = gw; t < SEQ; t += NGW) {
        float y[8];
        { const f32x4 a0 = *(const f32x4*)(F_Y + (size_t)t * DR + 8 * l), a1 = *(const f32x4*)(F_Y + (size_t)t * DR + 8 * l + 4);
          const f32x4 b0 = *(const f32x4*)(F_Y + (size_t)(SEQ + t) * DR + 8 * l), b1 = *(const f32x4*)(F_Y + (size_t)(SEQ + t) * DR + 8 * l + 4);
          y[0] = a0.x + b0.x; y[1] = a0.y + b0.y; y[2] = a0.z + b0.z; y[3] = a0.w + b0.w; y[4] = a1.x + b1.x; y[5] = a1.y + b1.y; y[6] = a1.z + b1.z; y[7] = a1.w + b1.w; }
        float s = 0.f;
#pragma unroll
        for (int i = 0; i < 8; ++i) s += y[i];
        s += __shfl_xor(s, 1); s += __shfl_xor(s, 2); s += __shfl_xor(s, 4);
        const float mean = s * (1.0f / 64.0f); float s2 = 0.f;
#pragma unroll
        for (int i = 0; i < 8; ++i) { const float dlt = y[i] - mean; s2 += dlt * dlt; }
        s2 += __shfl_xor(s2, 1); s2 += __shfl_xor(s2, 2); s2 += __shfl_xor(s2, 4);
        const float rstd = rsqrtf(s2 * (1.0f / 64.0f) + GN_EPS);
        float r[8], k[8], v[8];
        mixed8(F_ZA, t, 8 * l, F_mu, r); mixed8(F_ZA, t, 512 + 8 * l, F_mu, k); mixed8(F_ZA, t, 1024 + 8 * l, F_mu, v);
        float dp = 0.f;
#pragma unroll
        for (int i = 0; i < 8; ++i) dp += r[i] * k[i] * F_r_k[8 * l + i];
        dp += __shfl_xor(dp, 1); dp += __shfl_xor(dp, 2); dp += __shfl_xor(dp, 4);
        const float sg0 = sigmoidf_(mixed_val(F_ZA, false, t, 1792 + 2 * l, F_mu[1792 + 2 * l])), sg1 = sigmoidf_(mixed_val(F_ZA, false, t, 1793 + 2 * l, F_mu[1793 + 2 * l]));
        float g[8];
#pragma unroll
        for (int i = 0; i < 8; ++i) g[i] = 0.f;
        for (int rr = 0; rr < 64; ++rr) {
            const float s0 = __shfl(sg0, rr), s1 = __shfl(sg1, rr);
            const f32x4 u0 = *(const f32x4*)(F_g_up + (size_t)(2 * rr) * DR + 8 * l), u1 = *(const f32x4*)(F_g_up + (size_t)(2 * rr) * DR + 8 * l + 4);
            const f32x4 w0 = *(const f32x4*)(F_g_up + (size_t)(2 * rr + 1) * DR + 8 * l), w1 = *(const f32x4*)(F_g_up + (size_t)(2 * rr + 1) * DR + 8 * l + 4);
            g[0] += s0 * u0.x + s1 * w0.x; g[1] += s0 * u0.y + s1 * w0.y; g[2] += s0 * u0.z + s1 * w0.z; g[3] += s0 * u0.w + s1 * w0.w;
            g[4] += s0 * u1.x + s1 * w1.x; g[5] += s0 * u1.y + s1 * w1.y; g[6] += s0 * u1.z + s1 * w1.z; g[7] += s0 * u1.w + s1 * w1.w;
        }
        float o[8];
#pragma unroll
        for (int i = 0; i < 8; ++i) { const float yn = (y[i] - mean) * rstd * F_ln_w[8 * l + i] + F_ln_b[8 * l + i]; o[i] = (yn + dp * v[i]) * g[i]; }
        u32x4 pk; pk.x = pk2(o[0], o[1]); pk.y = pk2(o[2], o[3]); pk.z = pk2(o[4], o[5]); pk.w = pk2(o[6], o[7]);
        *(u32x4*)(F_YA + (size_t)t * DR + 8 * l) = pk;
        (void)h;
    }
}

struct SchedStd {
    int nM, nN, G, c;
    __device__ __forceinline__ bool next(int i, pg8::Unit& u) const { const long L = (long)i * G + c; if (L >= (long)nM * nN) return false; static_tile((int)L, nM, nN, u); return true; }
    __device__ __forceinline__ void a_ready(const pg8::Unit&) const {}
    __device__ __forceinline__ void done(const pg8::Unit&) const {}
};
__device__ __forceinline__ void sig8(const bf16* p, float (&o)[8]) {
    const u32x4 raw = *(const u32x4*)p;
    o[0] = sigmoidf_(bflo(raw.x)); o[1] = sigmoidf_(bfhi(raw.x)); o[2] = sigmoidf_(bflo(raw.y)); o[3] = sigmoidf_(bfhi(raw.y));
    o[4] = sigmoidf_(bflo(raw.z)); o[5] = sigmoidf_(bfhi(raw.z)); o[6] = sigmoidf_(bflo(raw.w)); o[7] = sigmoidf_(bfhi(raw.w));
}
struct EpiMergeA {
    static constexpr bool PERM = true, AFTER_DRAIN = false;
    float* T; const bf16* ZG;
    __device__ __forceinline__ void operator()(const pg8::f32x4 (&acc)[2][2][4][2], const pg8::Unit& u, int wr, int wc, int fr, int fq) const {
        const int row0 = u.pm * 256 + wr * 64 + fr, col0 = u.pn * 256 + wc * 32 + 8 * fq;
#pragma unroll
        for (int ai = 0; ai < 2; ++ai)
#pragma unroll
            for (int m = 0; m < 4; ++m) { const size_t row = (size_t)(row0 + ai * 128 + m * 16);
#pragma unroll
                for (int bj = 0; bj < 2; ++bj) { const int col = col0 + bj * 128; float gt[8]; sig8(ZG + row * 2048 + col, gt);
                    const pg8::f32x4 v0 = acc[ai][bj][m][0], v1 = acc[ai][bj][m][1];
                    *(f32x4*)(T + row * D + col) = (f32x4){gt[0] * v0[0], gt[1] * v0[1], gt[2] * v0[2], gt[3] * v0[3]};
                    *(f32x4*)(T + row * D + col + 4) = (f32x4){gt[4] * v1[0], gt[5] * v1[1], gt[6] * v1[2], gt[7] * v1[3]}; } }
    }
};
struct EpiMergeB {
    static constexpr bool PERM = true, AFTER_DRAIN = false;
    const float* T; const bf16* ZG; bf16* MG;
    __device__ __forceinline__ void operator()(const pg8::f32x4 (&acc)[2][2][4][2], const pg8::Unit& u, int wr, int wc, int fr, int fq) const {
        const int row0 = u.pm * 256 + wr * 64 + fr, col0 = u.pn * 256 + wc * 32 + 8 * fq;
#pragma unroll
        for (int ai = 0; ai < 2; ++ai)
#pragma unroll
            for (int m = 0; m < 4; ++m) { const size_t row = (size_t)(row0 + ai * 128 + m * 16);
#pragma unroll
                for (int bj = 0; bj < 2; ++bj) { const int col = col0 + bj * 128; float gt[8]; sig8(ZG + row * 2048 + 1024 + col, gt);
                    const pg8::f32x4 v0 = acc[ai][bj][m][0], v1 = acc[ai][bj][m][1];
                    const f32x4 t0 = *(const f32x4*)(T + row * D + col), t1 = *(const f32x4*)(T + row * D + col + 4);
                    u32x4 w; w.x = pk2(t0.x + gt[0] * v0[0], t0.y + gt[1] * v0[1]); w.y = pk2(t0.z + gt[2] * v0[2], t0.w + gt[3] * v0[3]);
                    w.z = pk2(t1.x + gt[4] * v1[0], t1.y + gt[5] * v1[1]); w.w = pk2(t1.z + gt[6] * v1[2], t1.w + gt[7] * v1[3]);
                    *(u32x4*)(MG + row * D + col) = w; } }
    }
};
struct EpiX1 {
    static constexpr bool PERM = false, AFTER_DRAIN = false;
    const float* x; const float* gt1; float* out;
    __device__ __forceinline__ void operator()(const pg8::f32x4 (&acc)[2][2][4][2], const pg8::Unit& u, int wr, int wc, int fr, int fq) const {
        const int row0 = u.pm * 256 + wr * 64 + fr, col0 = u.pn * 256 + wc * 32 + 4 * fq;
#pragma unroll
        for (int ai = 0; ai < 2; ++ai)
#pragma unroll
            for (int m = 0; m < 4; ++m) { const size_t row = (size_t)(row0 + ai * 128 + m * 16);
#pragma unroll
                for (int bj = 0; bj < 2; ++bj)
#pragma unroll
                    for (int n = 0; n < 2; ++n) { const int col = col0 + bj * 128 + n * 16;
                        const f32x4 xv = *(const f32x4*)(x + row * D + col), gv = *(const f32x4*)(gt1 + col); const pg8::f32x4 a = acc[ai][bj][m][n];
                        *(f32x4*)(out + row * D + col) = (f32x4){xv.x + gv.x * a[0], xv.y + gv.y * a[1], xv.z + gv.z * a[2], xv.w + gv.w * a[3]}; } }
    }
};

__device__ __forceinline__ void route_decide(const float (&lg)[36], const float* grp_b, const float* exp_b, unsigned* ctl, unsigned* rt) {
    float gl[4]; int grp = 0;
#pragma unroll
    for (int q = 0; q < 4; ++q) gl[q] = lg[q] + grp_b[q];
#pragma unroll
    for (int q = 1; q < 4; ++q) if (gl[q] > gl[grp]) grp = q;
    float den = 0.f;
#pragma unroll
    for (int q = 0; q < 4; ++q) den += __expf(gl[q] - gl[grp]);
    const float pg = 1.0f / den;
    float el[8];
#pragma unroll
    for (int q = 0; q < 8; ++q) { float val = 0.f;
#pragma unroll
        for (int gq = 0; gq < 4; ++gq) val = (grp == gq) ? lg[4 + gq * 8 + q] + exp_b[gq * 8 + q] : val;
        el[q] = val; }
    int i1 = 0;
#pragma unroll
    for (int q = 1; q < 8; ++q) if (el[q] > el[i1]) i1 = q;
    int i2 = (i1 == 0) ? 1 : 0;
#pragma unroll
    for (int q = 0; q < 8; ++q) if (q != i1 && el[q] > el[i2]) i2 = q;
    const float v1 = el[i1], v2 = el[i2];
    const float e2 = __expf(v2 - v1), w1 = pg / (1.0f + e2), w2 = pg * e2 / (1.0f + e2);
    const int e1x = grp * 8 + i1, e2x = grp * 8 + i2;
    const unsigned p1 = atomicAdd(ctl + CW_CNT + 64 * e1x, 1u), p2 = atomicAdd(ctl + CW_CNT + 64 * e2x, 1u);
    rt[0] = (unsigned)e1x; rt[1] = p1; rt[2] = __builtin_bit_cast(unsigned, w1); rt[3] = (unsigned)e2x; rt[4] = p2; rt[5] = __builtin_bit_cast(unsigned, w2);
}
__device__ __forceinline__ void p7_router(Frame& F, const KArgs& A) {
    const int gw = blockIdx.x * 8 + F.wave, NGW = F.G * 8, lane = F.lane;
    const float* mod = F_MOD;
    { const f32x4* src = (const f32x4*)(A.ws() + WS_WRT); LAS f32x4* dst = (LAS f32x4*)F.lds;
      for (int i = F.tid; i < 36 * D / 4; i += 512) dst[i] = src[i]; }
    __syncthreads();
    const LAS f32x4* wl = (const LAS f32x4*)F.lds;
#ifndef ROUTER_REPS
#define ROUTER_REPS 1
#endif
    for (int rrep = 0; rrep < ROUTER_REPS; ++rrep)
    for (int tp = gw; tp < SEQ / 2; tp += NGW) {
        const int t0 = 2 * tp;
        const float* src0 = F_out + (size_t)t0 * D; const float* src1 = src0 + D;
        f32x4 h0[4], h1[4]; float ss0 = 0.f, ss1 = 0.f;
#pragma unroll
        for (int j = 0; j < 4; ++j) { h0[j] = ((const f32x4*)src0)[lane + 64 * j]; h1[j] = ((const f32x4*)src1)[lane + 64 * j];
            ss0 += (h0[j].x * h0[j].x + h0[j].y * h0[j].y) + (h0[j].z * h0[j].z + h0[j].w * h0[j].w); ss1 += (h1[j].x * h1[j].x + h1[j].y * h1[j].y) + (h1[j].z * h1[j].z + h1[j].w * h1[j].w); }
        const float r0 = rsqrtf(wave_sum(ss0) * (1.0f / D) + NORM_EPS), r1 = rsqrtf(wave_sum(ss1) * (1.0f / D) + NORM_EPS);
#pragma unroll
        for (int j = 0; j < 4; ++j) {
            const f32x4 gg = ((const f32x4*)F_norm2_g)[lane + 64 * j], s1 = ((const f32x4*)(mod + 4096))[lane + 64 * j], s0 = ((const f32x4*)(mod + 3072))[lane + 64 * j];
            const f32x4 gs = gg * (1.0f + s1);
            h0[j] = (h0[j] * r0) * gs + s0; h1[j] = (h1[j] * r1) * gs + s0;
            u32x2 o; o.x = pk2(h0[j].x, h0[j].y); o.y = pk2(h0[j].z, h0[j].w); ((u32x2*)(F_H + (size_t)t0 * D))[lane + 64 * j] = o;
            o.x = pk2(h1[j].x, h1[j].y); o.y = pk2(h1[j].z, h1[j].w); ((u32x2*)(F_H + (size_t)(t0 + 1) * D))[lane + 64 * j] = o;
        }
        LAS float* lgs = (LAS float*)(F.lds + 147456 + F.wave * 512);
#pragma unroll 2
        for (int e = 0; e < 36; ++e) {
            float a0 = 0.f, a1 = 0.f;
#pragma unroll
            for (int j = 0; j < 4; ++j) { const f32x4 wv = wl[e * 256 + lane + 64 * j];
                a0 += (h0[j].x * wv.x + h0[j].y * wv.y) + (h0[j].z * wv.z + h0[j].w * wv.w); a1 += (h1[j].x * wv.x + h1[j].y * wv.y) + (h1[j].z * wv.z + h1[j].w * wv.w); }
            const bool lo = lane < 32; float xk = lo ? a0 : a1; const float yk = lo ? a1 : a0;
            xk += __shfl_xor(yk, 32);
            xk += __shfl_xor(xk, 16); xk += __shfl_xor(xk, 8); xk += __shfl_xor(xk, 4); xk += __shfl_xor(xk, 2); xk += __shfl_xor(xk, 1);
            if ((lane & 31) == 0) lgs[(lane >> 5) * 36 + e] = xk;
        }
        LDS_WAIT();
        float lg[36];
        if ((lane & 31) == 0) {
#pragma unroll
            for (int q = 0; q < 9; ++q) { const f32x4 v4 = *(const LAS f32x4*)(lgs + (lane >> 5) * 36 + 4 * q); lg[4 * q] = v4.x; lg[4 * q + 1] = v4.y; lg[4 * q + 2] = v4.z; lg[4 * q + 3] = v4.w; }
        }
        if ((lane & 31) == 0 && rrep == ROUTER_REPS - 1) route_decide(lg, F_grp_b, F_exp_b, F.ctl, F_route + (size_t)(t0 + (lane >> 5)) * 8);
        if (rrep != ROUTER_REPS - 1) { float sink = 0.f; if ((lane & 31) == 0) { for (int q = 0; q < 36; ++q) sink += lg[q]; } asm volatile("" :: "v"(sink)); }
    }
    __syncthreads();
}
__device__ __forceinline__ void p7_moe_convert(Frame& F, const KArgs& A) {
    const int gw = blockIdx.x * 8 + F.wave, NGW = F.G * 8, lane = F.lane;
    {
    LAS float* scr = (LAS float*)(F.lds + F.wave * 16640);
    for (int it = gw; it < NEXP * 384; it += NGW) {
        const int e = it / 384; int r = it % 384;
        if (r < 256) { const bool up = r >= 128; r &= 127; const int kb = r >> 3, nb = r & 7, n0 = 64 * nb;
            const float* W = (up ? F_wu : F_wg) + (size_t)e * D * DEXP;
            transpose_item64(W, D, DEXP, 64 * kb, n0, F_WguT + (size_t)e * 1024 * D, 256 * (n0 >> 7) + (up ? 128 : 0) + (n0 & 127), scr, lane);
        } else { r -= 256; const int kb = r >> 4, nb = r & 15;
            transpose_item64(F_wd + (size_t)e * DEXP * D, DEXP, D, 64 * kb, 64 * nb, F_WdT + (size_t)e * 1024 * DEXP, 64 * nb, scr, lane); }
    }
    }
}

__device__ __forceinline__ int moe_tables(Frame& F, const KArgs& A) {
    LAS int* tab = (LAS int*)(F.lds + TAB_OFF);
    __syncthreads();
    if (F.tid < 64) {
        const int e = F.tid & 31;
        const int cnt = (int)__hip_atomic_load(F.ctl + CW_CNT + 64 * e, __ATOMIC_RELAXED, __HIP_MEMORY_SCOPE_AGENT);
        const int nt = (cnt + 255) >> 8;
        int incl = nt;
#pragma unroll
        for (int o = 1; o < 32; o <<= 1) { const int up = __shfl_up(incl, o); if (e >= o) incl += up; }
        const int off = incl - nt;
        if (F.tid < 32) { tab[e] = off * 256; tab[64 + e] = cnt; for (int q = 0; q < nt && off + q < MAXTILES; ++q) tab[128 + off + q] = e; if (e == 31) tab[32] = incl < MAXTILES ? incl : MAXTILES; }
    }
    __syncthreads();
    return tab[32];
}

__device__ __forceinline__ void p8_gather(Frame& F, const KArgs& A) {
    const int ntiles = moe_tables(F, A);
    LAS int* tab = (LAS int*)(F.lds + TAB_OFF);
    const int gw = blockIdx.x * 8 + F.wave, NGW = F.G * 8, lane = F.lane;
    for (int t = gw; t < SEQ; t += NGW) {
        const unsigned* rt = F_route + (size_t)t * 8;
        const u32x4 h0 = ((const u32x4*)(F_H + (size_t)t * D))[lane], h1 = ((const u32x4*)(F_H + (size_t)t * D))[lane + 64];
#pragma unroll
        for (int s = 0; s < 2; ++s) {
            const int e = (int)rt[3 * s], pos = (int)rt[3 * s + 1]; const int row = tab[e] + pos;
            if (row < MAXTILES * 256) {
                ((u32x4*)(F_XG + (size_t)row * D))[lane] = h0; ((u32x4*)(F_XG + (size_t)row * D))[lane + 64] = h1;
                if (lane == 0) { F_rowinfo[row] = 2 * t + s; F_roww[row] = __builtin_bit_cast(float, rt[3 * s + 2]); }
            }
        }
    }
    for (int e = blockIdx.x; e < NEXP; e += F.G) {
        const int cnt = tab[64 + e], r0 = tab[e] + cnt, r1 = tab[e] + (((cnt + 255) >> 8) << 8);
        for (int row = r0 + F.wave; row < r1 && row < MAXTILES * 256; row += 8) {
            ((u32x4*)(F_XG + (size_t)row * D))[lane] = (u32x4){0u, 0u, 0u, 0u}; ((u32x4*)(F_XG + (size_t)row * D))[lane + 64] = (u32x4){0u, 0u, 0u, 0u};
            if (lane == 0) { F_rowinfo[row] = -1; F_roww[row] = 0.f; }
        }
    }
    (void)ntiles;
}

struct MoeOrder {
    const LAS int* tile_e; int T4, G, c;
    __device__ __forceinline__ bool next(int i, pg8::Unit& u) const { const long L = (long)i * G + c; if (L >= T4) return false; const int rt = (int)(L >> 2), j = (int)(L & 3); u.pm = rt; u.pn = tile_e[rt] * 4 + j; return true; }
    __device__ __forceinline__ void a_ready(const pg8::Unit&) const {}
    __device__ __forceinline__ void done(const pg8::Unit&) const {}
};
struct EpiSwiGLU {
    static constexpr bool PERM = true, AFTER_DRAIN = false;
    bf16* HM;
    __device__ __forceinline__ void operator()(const pg8::f32x4 (&acc)[2][2][4][2], const pg8::Unit& u, int wr, int wc, int fr, int fq) const {
        const int row0 = u.pm * 256 + wr * 64 + fr, col0 = (u.pn & 3) * 128 + wc * 32 + 8 * fq;
#pragma unroll
        for (int ai = 0; ai < 2; ++ai)
#pragma unroll
            for (int m = 0; m < 4; ++m) { const size_t row = (size_t)(row0 + ai * 128 + m * 16);
                const pg8::f32x4 g0 = acc[ai][0][m][0], g1 = acc[ai][0][m][1], u0 = acc[ai][1][m][0], u1 = acc[ai][1][m][1];
                u32x4 w; w.x = pk2(siluf_(g0[0]) * u0[0], siluf_(g0[1]) * u0[1]); w.y = pk2(siluf_(g0[2]) * u0[2], siluf_(g0[3]) * u0[3]);
                w.z = pk2(siluf_(g1[0]) * u1[0], siluf_(g1[1]) * u1[1]); w.w = pk2(siluf_(g1[2]) * u1[2], siluf_(g1[3]) * u1[3]);
                *(u32x4*)(HM + row * DEXP + col0) = w; }
    }
};
struct EpiScatter {
    static constexpr bool PERM = true, AFTER_DRAIN = false;
    bf16* YBUF; const int* rowinfo; const float* roww;
    __device__ __forceinline__ void operator()(const pg8::f32x4 (&acc)[2][2][4][2], const pg8::Unit& u, int wr, int wc, int fr, int fq) const {
        const int row0 = u.pm * 256 + wr * 64 + fr, col0 = (u.pn & 3) * 256 + wc * 32 + 8 * fq;
#pragma unroll
        for (int ai = 0; ai < 2; ++ai)
#pragma unroll
            for (int m = 0; m < 4; ++m) { const int row = row0 + ai * 128 + m * 16; const int info = rowinfo[row]; const float wt = roww[row];
                if (info >= 0) {
#pragma unroll
                    for (int bj = 0; bj < 2; ++bj) { const pg8::f32x4 v0 = acc[ai][bj][m][0], v1 = acc[ai][bj][m][1];
                        u32x4 w; w.x = pk2(wt * v0[0], wt * v0[1]); w.y = pk2(wt * v0[2], wt * v0[3]); w.z = pk2(wt * v1[0], wt * v1[1]); w.w = pk2(wt * v1[2], wt * v1[3]);
                        *(u32x4*)(YBUF + (size_t)info * D + col0 + bj * 128) = w; } } }
    }
};

__device__ __forceinline__ void p11_final(Frame& F, const KArgs& A) {
    const int gw = blockIdx.x * 8 + F.wave, NGW = F.G * 8, lane = F.lane;
    const float* gt2 = F_MOD + 5120;
    for (int t = gw; t < SEQ; t += NGW) {
        float* row = F_out + (size_t)t * D;
        f32x4 v[4]; float ss = 0.f;
#pragma unroll
        for (int j = 0; j < 4; ++j) {
            const f32x4 x1 = ((const f32x4*)row)[lane + 64 * j], g2 = ((const f32x4*)gt2)[lane + 64 * j];
            const u32x2 y0 = ((const u32x2*)(F_YBUF + (size_t)(2 * t) * D))[lane + 64 * j], y1 = ((const u32x2*)(F_YBUF + (size_t)(2 * t + 1) * D))[lane + 64 * j];
            f32x4 ys; ys.x = bflo(y0.x) + bflo(y1.x); ys.y = bfhi(y0.x) + bfhi(y1.x); ys.z = bflo(y0.y) + bflo(y1.y); ys.w = bfhi(y0.y) + bfhi(y1.y);
            v[j] = x1 + g2 * ys;
            ss += (v[j].x * v[j].x + v[j].y * v[j].y) + (v[j].z * v[j].z + v[j].w * v[j].w);
        }
        const float rinv = rsqrtf(wave_sum(ss) * (1.0f / D) + NORM_EPS);
#pragma unroll
        for (int j = 0; j < 4; ++j) { const f32x4 fg = ((const f32x4*)F_fin_g)[lane + 64 * j]; ((f32x4*)row)[lane + 64 * j] = v[j] * rinv * fg; }
    }
}


constexpr int SL = 8192;
constexpr int SC_LBUF = 12 * SL;
constexpr int SC_MISC = 19 * SL;

__device__ __forceinline__ int sw_(int r) { return (r ^ (r >> 3)) & 7; }
__device__ __forceinline__ int m_off(int r, int c) { return r * 128 + (((c >> 3) ^ sw_(r)) << 4) + ((c & 7) << 1); }
__device__ __forceinline__ int frag_off(int r, int chunk) { return r * 128 + ((chunk ^ sw_(r)) << 4); }
__device__ __forceinline__ float tanh_fast(float x) { const float e = __expf(2.0f * x); return 1.0f - 2.0f * __builtin_amdgcn_rcpf(e + 1.0f); }

template <bool SWAP> __device__ __forceinline__ void mm_tiles(const LAS unsigned char* X, const LAS unsigned char* Y, int mt, int nt0, int fr, int fq, pg8::f32x4 (&acc)[2]) {
#pragma unroll
    for (int ks = 0; ks < 2; ++ks) {
        const bf16x8 xf = *(const LAS bf16x8*)(X + frag_off(16 * mt + fr, 4 * ks + fq));
#pragma unroll
        for (int n = 0; n < 2; ++n) {
            const bf16x8 yf = *(const LAS bf16x8*)(Y + frag_off(16 * (nt0 + n) + fr, 4 * ks + fq));
            acc[n] = SWAP ? __builtin_amdgcn_mfma_f32_16x16x32_bf16(yf, xf, acc[n], 0, 0, 0) : __builtin_amdgcn_mfma_f32_16x16x32_bf16(xf, yf, acc[n], 0, 0, 0);
        }
    }
}
__device__ __forceinline__ void st4(LAS unsigned char* slot, int r, int c, float a, float b, float cc, float d) { u32x2 o; o.x = pk2(a, b); o.y = pk2(cc, d); *(LAS u32x2*)(slot + m_off(r, c)) = o; }
__device__ __forceinline__ pg8::f32x4 ld4(const LAS unsigned char* slot, int r, int c) { const u32x2 w = *(const LAS u32x2*)(slot + m_off(r, c)); return (pg8::f32x4){bflo(w.x), bfhi(w.x), bflo(w.y), bfhi(w.y)}; }
__device__ __forceinline__ int opq(int x) { asm volatile("" : "+v"(x)); return x; }
#ifndef P1REP
#define P1REP 0
#endif
#define P1R(b) for (int q_ = 0; q_ < (((P1REP >> (b)) & 1) ? 2 : 1); ++q_)
#define ZERO2(a) do { a[0] = (pg8::f32x4){0.f, 0.f, 0.f, 0.f}; a[1] = (pg8::f32x4){0.f, 0.f, 0.f, 0.f}; } while (0)

__device__ __forceinline__ void mix8(const bf16* Z, int col0, const float* mu, int dl, int dr, int du, int dd, bool okl, bool okr, bool oku, bool okd, float (&o)[8]) {
    const u32x4 z = *(const u32x4*)(Z + col0);
    const u32x4 l = *(const u32x4*)(Z + col0 + dl * 2048), r = *(const u32x4*)(Z + col0 + dr * 2048), up = *(const u32x4*)(Z + col0 + du * 2048), dn = *(const u32x4*)(Z + col0 + dd * 2048);
    const f32x4 m0 = *(const f32x4*)(mu + col0), m1 = *(const f32x4*)(mu + col0 + 4);
    float zz[8], nn[8];
    zz[0] = bflo(z.x); zz[1] = bfhi(z.x); zz[2] = bflo(z.y); zz[3] = bfhi(z.y); zz[4] = bflo(z.z); zz[5] = bfhi(z.z); zz[6] = bflo(z.w); zz[7] = bfhi(z.w);
    nn[0] = okl ? bflo(l.x) : 0.f; nn[1] = okr ? bfhi(r.x) : 0.f; nn[2] = oku ? bflo(up.y) : 0.f; nn[3] = okd ? bfhi(dn.y) : 0.f;
    nn[4] = okl ? bflo(l.z) : 0.f; nn[5] = okr ? bfhi(r.z) : 0.f; nn[6] = oku ? bflo(up.w) : 0.f; nn[7] = okd ? bfhi(dn.w) : 0.f;
    const float mm[8] = {m0.x, m0.y, m0.z, m0.w, m1.x, m1.y, m1.z, m1.w};
#pragma unroll
    for (int i = 0; i < 8; ++i) o[i] = zz[i] + mm[i] * (nn[i] - zz[i]);
}
__device__ __forceinline__ void mix4(const bf16* Z, int col0, const float* mu, int dl, int dr, int du, int dd, bool okl, bool okr, bool oku, bool okd, float (&o)[4]) {
    const u32x2 z = *(const u32x2*)(Z + col0);
    const u32x2 l = *(const u32x2*)(Z + col0 + dl * 2048), r = *(const u32x2*)(Z + col0 + dr * 2048), up = *(const u32x2*)(Z + col0 + du * 2048), dn = *(const u32x2*)(Z + col0 + dd * 2048);
    const f32x4 m0 = *(const f32x4*)(mu + col0);
    const float zz[4] = {bflo(z.x), bfhi(z.x), bflo(z.y), bfhi(z.y)};
    const float nn[4] = {okl ? bflo(l.x) : 0.f, okr ? bfhi(r.x) : 0.f, oku ? bflo(up.y) : 0.f, okd ? bfhi(dn.y) : 0.f};
    const float mm[4] = {m0.x, m0.y, m0.z, m0.w};
#pragma unroll
    for (int i = 0; i < 4; ++i) o[i] = zz[i] + mm[i] * (nn[i] - zz[i]);
}

__device__ __forceinline__ void scan_pass1_unit(Frame& F, const KArgs& A, int chain, int scidx, int cj) {
    const int d = chain >> 3, h = chain & 7, tid = F.tid, lane = F.lane, w = F.wave, fr = lane & 15, fq = lane >> 4, mt = w >> 1, nt0 = 2 * (w & 1);
    LAS unsigned char* const L = F.lds;
#define S_(i) (L + opq((i) * SL))
    const bool isctx = (scidx == 0); const int sc = scidx - 1;
    const bf16* ZA = F_ZA; const float* mu = F_mu;
    { const int r = tid >> 3, ch = tid & 7; u32x4 idv = (u32x4){0u, 0u, 0u, 0u};
      if ((r >> 3) == ch) { const unsigned one = 0x3f80u; const int e = r & 7; if (e == 0) idv.x = one; else if (e == 1) idv.x = one << 16; else if (e == 2) idv.y = one; else if (e == 3) idv.y = one << 16; else if (e == 4) idv.z = one; else if (e == 5) idv.z = one << 16; else if (e == 6) idv.w = one; else idv.w = one << 16; }
      *(LAS u32x4*)(S_(14) + frag_off(r, ch)) = idv; *(LAS u32x4*)(S_(16) + frag_off(r, ch)) = (u32x4){0u, 0u, 0u, 0u}; }
    int ppc = 14, qpc = 16;
    const int jbeg = isctx ? cj : 0, jend = isctx ? cj + 1 : 4;
    for (int j = jbeg; j < jend; ++j) {
        const int ppn = ppc ^ 1, qpn = qpc ^ 1;
        const int t = tid >> 3, cg = tid & 7, x = d ? 63 - t : t;
        int tokchunk; const bf16* Z; int dl, dr, du, dd; bool okl, okr, oku, okd;
        if (isctx) { tokchunk = d ? 3 - j : j; const int tc = tokchunk * 64 + x; Z = ZA + (size_t)(SEQ + tc) * 2048; okl = tc > 0; okr = tc < CTXL - 1; oku = okl; okd = okr; dl = okl ? -1 : 0; dr = okr ? 1 : 0; du = dl; dd = dr; }
        else { tokchunk = d ? 255 - (4 * sc + j) : 4 * sc + j; const int tok = tokchunk * 64 + x; Z = ZA + (size_t)tok * 2048; okl = x > 0; okr = x < 63; oku = tokchunk > 0; okd = tokchunk < GROWS - 1; dl = okl ? -1 : 0; dr = okr ? 1 : 0; du = oku ? -64 : 0; dd = okd ? 64 : 0; }
        float rv[8], kv[8];
        P1R(0) {
            float vv[8], wdv[8], adv[8];
            mix8(Z, h * 64 + 8 * cg, mu, dl, dr, du, dd, okl, okr, oku, okd, rv);
            mix8(Z, 512 + h * 64 + 8 * cg, mu, dl, dr, du, dd, okl, okr, oku, okd, kv);
            mix8(Z, 1024 + h * 64 + 8 * cg, mu, dl, dr, du, dd, okl, okr, oku, okd, vv);
            mix8(Z, 1536 + d * 64 + 8 * cg, mu, dl, dr, du, dd, okl, okr, oku, okd, wdv);
            mix8(Z, 1664 + d * 64 + 8 * cg, mu, dl, dr, du, dd, okl, okr, oku, okd, adv);
#pragma unroll
            for (int i = 0; i < 8; ++i) *(LAS bf16*)(S_(7) + m_off(8 * cg + i, t)) = (bf16)f2bf(vv[i]);
            u32x4 o; o.x = pk2(tanh_fast(wdv[0]), tanh_fast(wdv[1])); o.y = pk2(tanh_fast(wdv[2]), tanh_fast(wdv[3])); o.z = pk2(tanh_fast(wdv[4]), tanh_fast(wdv[5])); o.w = pk2(tanh_fast(wdv[6]), tanh_fast(wdv[7]));
            *(LAS u32x4*)(S_(8) + frag_off(t, cg)) = o;
            o.x = pk2(adv[0], adv[1]); o.y = pk2(adv[2], adv[3]); o.z = pk2(adv[4], adv[5]); o.w = pk2(adv[6], adv[7]);
            *(LAS u32x4*)(S_(9) + frag_off(t, cg)) = o;
            const bf16* wt = (const bf16*)(A.ws() + WS_WUPT) + (size_t)chain * 4096, *at = (const bf16*)(A.ws() + WS_AUPT) + (size_t)chain * 4096;
            *(LAS u32x4*)(S_(10) + frag_off(t, cg)) = *(const u32x4*)(wt + t * 64 + 8 * cg);
            *(LAS u32x4*)(S_(11) + frag_off(t, cg)) = *(const u32x4*)(at + t * 64 + 8 * cg);
        }
        __syncthreads();
        P1R(1) {
            pg8::f32x4 acw[2], aca[2]; ZERO2(acw); ZERO2(aca);
            mm_tiles<false>(S_(8), S_(10), mt, nt0, fr, fq, acw);
            mm_tiles<true>(S_(9), S_(11), mt, nt0, fr, fq, aca);
            const int row = 16 * mt + fr;
            LAS float* lb = (LAS float*)(L + opq(SC_LBUF)); LAS float* tot = (LAS float*)(L + opq(SC_MISC));
#pragma unroll
            for (int n = 0; n < 2; ++n) {
                const int cc = 16 * (nt0 + n) + fr; const float w0c = F_w0[d * DR + h * 64 + cc];
                float p[4];
#pragma unroll
                for (int i = 0; i < 4; ++i) p[i] = -0.6065306597126334f * sigmoidf_(acw[n][i] + w0c);
                p[1] += p[0]; p[2] += p[1]; p[3] += p[2];
                float inc = p[3]; { const float u1 = __shfl_up(inc, 16); inc += (fq >= 1) ? u1 : 0.f; const float u2 = __shfl_up(inc, 32); inc += (fq >= 2) ? u2 : 0.f; }
                const float exc = inc - p[3];
#pragma unroll
                for (int i = 0; i < 4; ++i) lb[(16 * mt + 4 * fq + i) * 64 + cc] = p[i] + exc;
                if (fq == 3) tot[mt * 64 + cc] = inc;
                const int c0 = 16 * (nt0 + n) + 4 * fq; const f32x4 a0v = *(const f32x4*)(F_a0 + d * DR + h * 64 + c0);
                st4(S_(18), row, c0, sigmoidf_(aca[n][0] + a0v[0]), sigmoidf_(aca[n][1] + a0v[1]), sigmoidf_(aca[n][2] + a0v[2]), sigmoidf_(aca[n][3] + a0v[3]));
            }
        }
        __syncthreads();
        P1R(2) {
            const LAS float* lb = (const LAS float*)(L + opq(SC_LBUF));
            float Lt[8], Lp[8], LC[8], av[8];
            { const LAS float* tot = (const LAS float*)(L + opq(SC_MISC));
              f32x4 tb[4][2];
#pragma unroll
              for (int m = 0; m < 4; ++m) { tb[m][0] = *(const LAS f32x4*)(tot + m * 64 + 8 * cg); tb[m][1] = *(const LAS f32x4*)(tot + m * 64 + 8 * cg + 4); }
              const int mtt = t >> 4;
              const f32x4 a0 = *(const LAS f32x4*)(lb + t * 64 + 8 * cg), a1 = *(const LAS f32x4*)(lb + t * 64 + 8 * cg + 4);
              const int tp = t > 0 ? t - 1 : 0; const f32x4 b0 = *(const LAS f32x4*)(lb + tp * 64 + 8 * cg), b1 = *(const LAS f32x4*)(lb + tp * 64 + 8 * cg + 4);
              const bool first = (t & 15) == 0;
#pragma unroll
              for (int i = 0; i < 4; ++i) {
                  const float o0 = (mtt > 0 ? tb[0][0][i] : 0.f) + (mtt > 1 ? tb[1][0][i] : 0.f) + (mtt > 2 ? tb[2][0][i] : 0.f), o1 = (mtt > 0 ? tb[0][1][i] : 0.f) + (mtt > 1 ? tb[1][1][i] : 0.f) + (mtt > 2 ? tb[2][1][i] : 0.f);
                  Lt[i] = a0[i] + o0; Lt[4 + i] = a1[i] + o1; Lp[i] = first ? o0 : b0[i] + o0; Lp[4 + i] = first ? o1 : b1[i] + o1;
                  LC[i] = (tb[0][0][i] + tb[1][0][i]) + (tb[2][0][i] + tb[3][0][i]); LC[4 + i] = (tb[0][1][i] + tb[1][1][i]) + (tb[2][1][i] + tb[3][1][i]); }
              const u32x4 aw = *(const LAS u32x4*)(S_(18) + frag_off(t, cg));
              av[0] = bflo(aw.x); av[1] = bfhi(aw.x); av[2] = bflo(aw.y); av[3] = bfhi(aw.y); av[4] = bflo(aw.z); av[5] = bfhi(aw.z); av[6] = bflo(aw.w); av[7] = bfhi(aw.w); }
            const int cb = h * 64 + 8 * cg;
            const f32x4 kk0 = *(const f32x4*)(F_k_k + cb), kk1 = *(const f32x4*)(F_k_k + cb + 4), ka0 = *(const f32x4*)(F_k_a + cb), ka1 = *(const f32x4*)(F_k_a + cb + 4);
            const float kkc[8] = {kk0.x, kk0.y, kk0.z, kk0.w, kk1.x, kk1.y, kk1.z, kk1.w}, kac[8] = {ka0.x, ka0.y, ka0.z, ka0.w, ka1.x, ka1.y, ka1.z, ka1.w};
            float kkv[8], n2 = 0.f;
#pragma unroll
            for (int i = 0; i < 8; ++i) { kkv[i] = kv[i] * kkc[i]; n2 += kkv[i] * kkv[i]; }
            n2 += __shfl_xor(n2, 1); n2 += __shfl_xor(n2, 2); n2 += __shfl_xor(n2, 4);
            const float inv = __builtin_amdgcn_rcpf(fmaxf(__builtin_amdgcn_sqrtf(n2), 1e-12f));
            float kb[8], rb[8], ah[8], kh[8], ahc[8], khc[8];
#pragma unroll
            for (int i = 0; i < 8; ++i) { const float kk = kkv[i] * inv, al = kk * av[i], kt = kv[i] * (1.0f + (av[i] - 1.0f) * kac[i]);
                const float ep = __expf(Lp[i]), et = __expf(Lt[i]), en = __expf(-Lt[i]), ec = __expf(LC[i] - Lt[i]);
                kb[i] = kk * ep; rb[i] = rv[i] * et; ah[i] = al * en; kh[i] = kt * en; ahc[i] = al * ec; khc[i] = kt * ec; }
            u32x4 o;
            o.x = pk2(kb[0], kb[1]); o.y = pk2(kb[2], kb[3]); o.z = pk2(kb[4], kb[5]); o.w = pk2(kb[6], kb[7]); *(LAS u32x4*)(S_(0) + frag_off(t, cg)) = o;
            o.x = pk2(rb[0], rb[1]); o.y = pk2(rb[2], rb[3]); o.z = pk2(rb[4], rb[5]); o.w = pk2(rb[6], rb[7]); *(LAS u32x4*)(S_(1) + frag_off(t, cg)) = o;
            o.x = pk2(ah[0], ah[1]); o.y = pk2(ah[2], ah[3]); o.z = pk2(ah[4], ah[5]); o.w = pk2(ah[6], ah[7]); *(LAS u32x4*)(S_(2) + frag_off(t, cg)) = o;
            o.x = pk2(kh[0], kh[1]); o.y = pk2(kh[2], kh[3]); o.z = pk2(kh[4], kh[5]); o.w = pk2(kh[6], kh[7]); *(LAS u32x4*)(S_(3) + frag_off(t, cg)) = o;
#pragma unroll
            for (int i = 0; i < 8; ++i) { *(LAS bf16*)(S_(4) + m_off(8 * cg + i, t)) = (bf16)f2bf(kb[i]); *(LAS bf16*)(S_(5) + m_off(8 * cg + i, t)) = (bf16)f2bf(ahc[i]); *(LAS bf16*)(S_(6) + m_off(8 * cg + i, t)) = (bf16)f2bf(khc[i]); }
            if (t == 0) { LAS float* gam = (LAS float*)(L + opq(SC_MISC) + 2048);
#pragma unroll
                for (int i = 0; i < 8; ++i) gam[8 * cg + i] = __expf(LC[i]); }
        }
        __syncthreads();
        P1R(3) {
            pg8::f32x4 a1[2], a2[2]; ZERO2(a1); ZERO2(a2);
            mm_tiles<true>(S_(0), S_(2), mt, nt0, fr, fq, a1);
            mm_tiles<false>(S_(0), S_(2), mt, nt0, fr, fq, a2);
#pragma unroll
            for (int n = 0; n < 2; ++n) {
                { const int tt = 16 * mt + fr, s0 = 16 * (nt0 + n) + 4 * fq; float m[4], t0[4];
#pragma unroll
                  for (int i = 0; i < 4; ++i) { m[i] = (s0 + i < tt) ? -a1[n][i] : 0.f; t0[i] = m[i] + ((s0 + i == tt) ? 1.0f : 0.f); }
                  st4(S_(8), tt, s0, m[0], m[1], m[2], m[3]); st4(S_(18), tt, s0, t0[0], t0[1], t0[2], t0[3]); }
                { const int t0r = 16 * mt + 4 * fq, ss = 16 * (nt0 + n) + fr; float m[4];
#pragma unroll
                  for (int i = 0; i < 4; ++i) m[i] = (ss < t0r + i) ? -a2[n][i] : 0.f;
                  st4(S_(9), ss, t0r, m[0], m[1], m[2], m[3]); }
            }
            ZERO2(a1); ZERO2(a2);
            mm_tiles<true>(S_(0), S_(3), mt, nt0, fr, fq, a1);
            mm_tiles<true>(S_(1), S_(2), mt, nt0, fr, fq, a2);
            pg8::f32x4 a3[2]; ZERO2(a3);
            mm_tiles<true>(S_(1), S_(3), mt, nt0, fr, fq, a3);
#pragma unroll
            for (int n = 0; n < 2; ++n) { const int tt = 16 * mt + fr, s0 = 16 * (nt0 + n) + 4 * fq; float u[4], v2[4], v3[4];
#pragma unroll
                for (int i = 0; i < 4; ++i) { u[i] = (s0 + i < tt) ? a1[n][i] : 0.f; v2[i] = (s0 + i <= tt) ? a2[n][i] : 0.f; v3[i] = (s0 + i <= tt) ? a3[n][i] : 0.f; }
                st4(S_(10), tt, s0, u[0], u[1], u[2], u[3]); st4(S_(11), tt, s0, v2[0], v2[1], v2[2], v2[3]); st4(S_(12), tt, s0, v3[0], v3[1], v3[2], v3[3]); }
        }
        __syncthreads();
        P1R(4) {
            pg8::f32x4 a1[2], a2[2], a3[2]; ZERO2(a1); ZERO2(a2); ZERO2(a3);
            mm_tiles<false>(S_(10), S_(7), mt, nt0, fr, fq, a1);
            mm_tiles<true>(S_(8), S_(9), mt, nt0, fr, fq, a2);
            mm_tiles<false>(S_(8), S_(9), mt, nt0, fr, fq, a3);
#pragma unroll
            for (int n = 0; n < 2; ++n) {
                st4(S_(13), 16 * (nt0 + n) + fr, 16 * mt + 4 * fq, a1[n][0], a1[n][1], a1[n][2], a1[n][3]);
                st4(S_(0), 16 * mt + fr, 16 * (nt0 + n) + 4 * fq, a2[n][0], a2[n][1], a2[n][2], a2[n][3]);
                st4(S_(2), 16 * (nt0 + n) + fr, 16 * mt + 4 * fq, a3[n][0], a3[n][1], a3[n][2], a3[n][3]); }
        }
        __syncthreads();
#pragma unroll
        for (int k = 1; k <= 5; ++k) {
            const int pc = (k & 1) ? 0 : 8, pct = (k & 1) ? 2 : 9, pn = (k & 1) ? 8 : 0, pnt = (k & 1) ? 9 : 2, tc = (k & 1) ? 18 : 10, tn = (k & 1) ? 10 : 18;
            P1R(5) {
            pg8::f32x4 a1[2], a2[2], a3[2];
#pragma unroll
            for (int n = 0; n < 2; ++n) a1[n] = ld4(S_(tc), 16 * mt + fr, 16 * (nt0 + n) + 4 * fq);
            mm_tiles<true>(S_(tc), S_(pct), mt, nt0, fr, fq, a1);
            if (k < 5) { ZERO2(a2); ZERO2(a3); mm_tiles<true>(S_(pc), S_(pct), mt, nt0, fr, fq, a2); mm_tiles<false>(S_(pc), S_(pct), mt, nt0, fr, fq, a3); }
#pragma unroll
            for (int n = 0; n < 2; ++n) {
                st4(S_(tn), 16 * mt + fr, 16 * (nt0 + n) + 4 * fq, a1[n][0], a1[n][1], a1[n][2], a1[n][3]);
                if (k < 5) { st4(S_(pn), 16 * mt + fr, 16 * (nt0 + n) + 4 * fq, a2[n][0], a2[n][1], a2[n][2], a2[n][3]);
                             st4(S_(pnt), 16 * (nt0 + n) + fr, 16 * mt + 4 * fq, a3[n][0], a3[n][1], a3[n][2], a3[n][3]); } }
            __syncthreads();
            }
        }
        P1R(6) {
            pg8::f32x4 a1[2], a2[2]; ZERO2(a1); ZERO2(a2);
            mm_tiles<false>(S_(10), S_(4), mt, nt0, fr, fq, a1);
            mm_tiles<false>(S_(10), S_(13), mt, nt0, fr, fq, a2);
#pragma unroll
            for (int n = 0; n < 2; ++n) {
                st4(S_(8), 16 * (nt0 + n) + fr, 16 * mt + 4 * fq, -a1[n][0], -a1[n][1], -a1[n][2], -a1[n][3]);
                st4(S_(9), 16 * (nt0 + n) + fr, 16 * mt + 4 * fq, -a2[n][0], -a2[n][1], -a2[n][2], -a2[n][3]); }
        }
        __syncthreads();
        pg8::f32x4 accY[2];
        P1R(7) {
            pg8::f32x4 a1[2], a2[2], a3[2];
#pragma unroll
            for (int n = 0; n < 2; ++n) a1[n] = ld4(S_(1), 16 * mt + fr, 16 * (nt0 + n) + 4 * fq);
            mm_tiles<true>(S_(11), S_(8), mt, nt0, fr, fq, a1);
            ZERO2(accY); mm_tiles<true>(S_(12), S_(7), mt, nt0, fr, fq, accY); mm_tiles<true>(S_(11), S_(9), mt, nt0, fr, fq, accY);
            ZERO2(a2); mm_tiles<true>(S_(5), S_(8), mt, nt0, fr, fq, a2);
            ZERO2(a3); mm_tiles<true>(S_(7), S_(6), mt, nt0, fr, fq, a3); mm_tiles<true>(S_(9), S_(5), mt, nt0, fr, fq, a3);
            const LAS float* gam = (const LAS float*)(L + opq(SC_MISC) + 2048);
#pragma unroll
            for (int n = 0; n < 2; ++n) { const int rr = 16 * mt + fr, c0 = 16 * (nt0 + n) + 4 * fq;
                st4(S_(0), rr, c0, a1[n][0], a1[n][1], a1[n][2], a1[n][3]);
                const float gj = gam[rr];
                st4(S_(2), rr, c0, a2[n][0] + (c0 + 0 == rr ? gj : 0.f), a2[n][1] + (c0 + 1 == rr ? gj : 0.f), a2[n][2] + (c0 + 2 == rr ? gj : 0.f), a2[n][3] + (c0 + 3 == rr ? gj : 0.f));
                st4(S_(3), rr, c0, a3[n][0], a3[n][1], a3[n][2], a3[n][3]); }
        }
        __syncthreads();
        {
            pg8::f32x4 a1[2], a2[2], a3[2]; ZERO2(a1);
            mm_tiles<true>(S_(0), S_(ppc), mt, nt0, fr, fq, a1);
            mm_tiles<true>(S_(0), S_(qpc), mt, nt0, fr, fq, accY);
            ZERO2(a2); mm_tiles<true>(S_(ppc), S_(2), mt, nt0, fr, fq, a2);
#pragma unroll
            for (int n = 0; n < 2; ++n) a3[n] = ld4(S_(3), 16 * mt + fr, 16 * (nt0 + n) + 4 * fq);
            mm_tiles<true>(S_(qpc), S_(2), mt, nt0, fr, fq, a3);
            if (!isctx) {
                const int tt = 16 * mt + fr, xr = d ? 63 - tt : tt;
                bf16* gy = (bf16*)(A.ws() + WS_GY) + ((size_t)chain * 256 + tokchunk) * 8192;
#pragma unroll
                for (int n = 0; n < 2; ++n) { const int c0 = 16 * (nt0 + n) + 4 * fq; u32x2 o;
                    o.x = pk2(a1[n][0], a1[n][1]); o.y = pk2(a1[n][2], a1[n][3]); *(u32x2*)(gy + xr * 64 + c0) = o;
                    o.x = pk2(accY[n][0], accY[n][1]); o.y = pk2(accY[n][2], accY[n][3]); *(u32x2*)(gy + 4096 + xr * 64 + c0) = o; }
            }
            if (j < jend - 1) {
#pragma unroll
                for (int n = 0; n < 2; ++n) { const int rr = 16 * mt + fr, c0 = 16 * (nt0 + n) + 4 * fq;
                    st4(S_(ppn), rr, c0, a2[n][0], a2[n][1], a2[n][2], a2[n][3]); st4(S_(qpn), rr, c0, a3[n][0], a3[n][1], a3[n][2], a3[n][3]); }
            } else {
                pg8::f32x4 a4[2]; ZERO2(a4); mm_tiles<false>(S_(ppc), S_(2), mt, nt0, fr, fq, a4);
                bf16* pq = isctx ? (bf16*)(A.ws() + WS_PQC) + ((size_t)chain * 4 + cj) * 8192 : (bf16*)(A.ws() + WS_PQ) + ((size_t)chain * 65 + scidx) * 8192;
#pragma unroll
                for (int n = 0; n < 2; ++n) { u32x2 o;
                    o.x = pk2(a4[n][0], a4[n][1]); o.y = pk2(a4[n][2], a4[n][3]); *(u32x2*)(pq + (16 * (nt0 + n) + fr) * 64 + 16 * mt + 4 * fq) = o;
                    o.x = pk2(a3[n][0], a3[n][1]); o.y = pk2(a3[n][2], a3[n][3]); *(u32x2*)(pq + 4096 + (16 * mt + fr) * 64 + 16 * (nt0 + n) + 4 * fq) = o; }
            }
        }
        __syncthreads();
        ppc = ppn; qpc = qpn;
    }
#undef S_
}

__device__ __forceinline__ void scan_chain(Frame& F, const KArgs& A, int chain) {
    const int w = F.wave, lane = F.lane, fr = lane & 15, fq = lane >> 4;
    const bf16* pq = (const bf16*)(A.ws() + WS_PQ) + (size_t)chain * 65 * 8192;
    const bf16* pqc = (const bf16*)(A.ws() + WS_PQC) + (size_t)chain * 4 * 8192;
    bf16* s0 = (bf16*)(A.ws() + WS_S0) + (size_t)chain * 64 * 4096;
    LAS unsigned char* const L = F.lds;
    const int vb = w & 3, v = 16 * vb + fr;
    pg8::f32x4 st[4];
#pragma unroll
    for (int it = 0; it < 4; ++it) st[it] = (pg8::f32x4){0.f, 0.f, 0.f, 0.f};
    if (w >= 4) {
        const bf16* src = pqc + (size_t)(w - 4) * 8192; LAS unsigned char* dst = L + (w - 4) * 16384;
#pragma unroll
        for (int i = 0; i < 16; ++i) { const int ci = i * 64 + lane, half = ci >> 9, row = (ci >> 3) & 63, ch = ci & 7;
            *(LAS u32x4*)(dst + half * 8192 + frag_off(row, ch)) = *(const u32x4*)(src + ci * 8); }
    }
    __syncthreads();
    for (int b = 0; b < 17; ++b) {
        if (w >= 4) {
            if (b + 1 < 17) { const bf16* src = pq + (size_t)(1 + 4 * b + (w - 4)) * 8192; LAS unsigned char* dst = L + ((b + 1) & 1) * 65536 + (w - 4) * 16384;
                u32x4 tmp[16];
#pragma unroll
                for (int i = 0; i < 16; ++i) tmp[i] = *(const u32x4*)(src + (i * 64 + lane) * 8);
#pragma unroll
                for (int i = 0; i < 16; ++i) { const int ci = i * 64 + lane, half = ci >> 9, row = (ci >> 3) & 63, ch = ci & 7; *(LAS u32x4*)(dst + half * 8192 + frag_off(row, ch)) = tmp[i]; } }
        } else {
#pragma unroll 1
            for (int s = 0; s < 4; ++s) {
                const int g = 4 * b + s, sc = g - 4;
                if (sc >= 0) {
#pragma unroll
                    for (int it = 0; it < 4; ++it) { u32x2 o; o.x = pk2(st[it][0], st[it][1]); o.y = pk2(st[it][2], st[it][3]); *(u32x2*)(s0 + (size_t)sc * 4096 + v * 64 + 16 * it + 4 * fq) = o; }
                }
                if (g < 67) {
                    const LAS unsigned char* P = L + (b & 1) * 65536 + s * 16384; const LAS unsigned char* Q = P + 8192;
                    bf16x8 bfrag[2];
#pragma unroll
                    for (int ks = 0; ks < 2; ++ks) { u32x4 bb; bb.x = pk2(st[2 * ks][0], st[2 * ks][1]); bb.y = pk2(st[2 * ks][2], st[2 * ks][3]); bb.z = pk2(st[2 * ks + 1][0], st[2 * ks + 1][1]); bb.w = pk2(st[2 * ks + 1][2], st[2 * ks + 1][3]); bfrag[ks] = __builtin_bit_cast(bf16x8, bb); }
                    pg8::f32x4 nw[4];
#pragma unroll
                    for (int jt = 0; jt < 4; ++jt) { nw[jt] = ld4(Q, v, 16 * jt + 4 * fq);
#pragma unroll
                        for (int ks = 0; ks < 2; ++ks) { const u32x2 a0 = *(const LAS u32x2*)(P + m_off(16 * jt + fr, 32 * ks + 4 * fq)), a1 = *(const LAS u32x2*)(P + m_off(16 * jt + fr, 32 * ks + 16 + 4 * fq));
                            u32x4 a; a.x = a0.x; a.y = a0.y; a.z = a1.x; a.w = a1.y;
                            nw[jt] = __builtin_amdgcn_mfma_f32_16x16x32_bf16(__builtin_bit_cast(bf16x8, a), bfrag[ks], nw[jt], 0, 0, 0); } }
#pragma unroll
                    for (int jt = 0; jt < 4; ++jt) st[jt] = nw[jt];
                }
            }
        }
        __syncthreads();
    }
}

__device__ __forceinline__ void scan_pass2_unit(Frame& F, const KArgs& A, int h, int c) {
    const int tid = F.tid, lane = F.lane, w = F.wave, fr = lane & 15, fq = lane >> 4;
    LAS unsigned char* const L = F.lds;
#define S_(i) (L + opq((i) * SL))
    const bf16* gyf = (const bf16*)(A.ws() + WS_GY) + ((size_t)(0 * 8 + h) * 256 + c) * 8192;
    const bf16* gyb = (const bf16*)(A.ws() + WS_GY) + ((size_t)(1 * 8 + h) * 256 + c) * 8192;
    const bf16* s0f = (const bf16*)(A.ws() + WS_S0) + ((size_t)(0 * 8 + h) * 64 + (c >> 2)) * 4096;
    const bf16* s0b = (const bf16*)(A.ws() + WS_S0) + ((size_t)(1 * 8 + h) * 64 + ((255 - c) >> 2)) * 4096;
    const bf16* gut = (const bf16*)(A.ws() + WS_GUPT) + (size_t)h * 8192;
    const bf16* ZA = F_ZA; const float* mu = F_mu;
    {
        const int r = tid >> 3, ch = tid & 7;
        *(LAS u32x4*)(S_(0) + frag_off(r, ch)) = *(const u32x4*)(gyf + r * 64 + 8 * ch);
        *(LAS u32x4*)(S_(1) + frag_off(r, ch)) = *(const u32x4*)(gyb + r * 64 + 8 * ch);
        *(LAS u32x4*)(S_(2) + frag_off(r, ch)) = *(const u32x4*)(s0f + r * 64 + 8 * ch);
        *(LAS u32x4*)(S_(3) + frag_off(r, ch)) = *(const u32x4*)(s0b + r * 64 + 8 * ch);
        *(LAS u32x4*)(S_(4) + frag_off(r, ch)) = *(const u32x4*)(gut + r * 128 + 8 * ch);
        *(LAS u32x4*)(S_(5) + frag_off(r, ch)) = *(const u32x4*)(gut + r * 128 + 64 + 8 * ch);
        const int tok = c * 64 + r; const bf16* Z = ZA + (size_t)tok * 2048;
        const bool okl = r > 0, okr = r < 63, oku = c > 0, okd = c < GROWS - 1; const int dl = okl ? -1 : 0, dr = okr ? 1 : 0, du = oku ? -64 : 0, dd = okd ? 64 : 0;
#pragma unroll
        for (int half = 0; half < 2; ++half) { float g8[8]; const int col = 16 * ch + 8 * half; mix8(Z, 1792 + col, mu, dl, dr, du, dd, okl, okr, oku, okd, g8);
            u32x4 o; o.x = pk2(sigmoidf_(g8[0]), sigmoidf_(g8[1])); o.y = pk2(sigmoidf_(g8[2]), sigmoidf_(g8[3])); o.z = pk2(sigmoidf_(g8[4]), sigmoidf_(g8[5])); o.w = pk2(sigmoidf_(g8[6]), sigmoidf_(g8[7]));
            *(LAS u32x4*)(S_(6 + (col >> 6)) + frag_off(r, (col & 63) >> 3)) = o; }
    }
    __syncthreads();
    if (w >= 4) {
        const int mt = w - 4;
#pragma unroll
        for (int np = 0; np < 2; ++np) { pg8::f32x4 g[2]; ZERO2(g);
            mm_tiles<true>(S_(6), S_(4), mt, 2 * np, fr, fq, g); mm_tiles<true>(S_(7), S_(5), mt, 2 * np, fr, fq, g);
#pragma unroll
            for (int n = 0; n < 2; ++n) *(LAS f32x4*)(L + opq(8 * SL) + ((16 * mt + fr) * 64 + 16 * (2 * np + n) + 4 * fq) * 4) = (f32x4){g[n][0], g[n][1], g[n][2], g[n][3]}; }
    }
    pg8::f32x4 y[4];
    const int mt2 = w & 3, tt = 16 * mt2 + fr, tok = c * 64 + tt;
    if (w < 4) {
#pragma unroll
        for (int np = 0; np < 2; ++np) { pg8::f32x4 a[2];
#pragma unroll
            for (int n = 0; n < 2; ++n) { const int c0 = 16 * (2 * np + n) + 4 * fq; const u32x2 yf = *(const u32x2*)(gyf + 4096 + tt * 64 + c0), yb = *(const u32x2*)(gyb + 4096 + tt * 64 + c0);
                a[n] = (pg8::f32x4){bflo(yf.x) + bflo(yb.x), bfhi(yf.x) + bfhi(yb.x), bflo(yf.y) + bflo(yb.y), bfhi(yf.y) + bfhi(yb.y)}; }
            mm_tiles<true>(S_(0), S_(2), mt2, 2 * np, fr, fq, a); mm_tiles<true>(S_(1), S_(3), mt2, 2 * np, fr, fq, a);
            y[2 * np] = a[0]; y[2 * np + 1] = a[1]; }
    }
    __syncthreads();
    if (w < 4) {
        float s = 0.f;
#pragma unroll
        for (int n = 0; n < 4; ++n) s += (y[n][0] + y[n][1]) + (y[n][2] + y[n][3]);
        s += __shfl_xor(s, 16); s += __shfl_xor(s, 32);
        const float mean = s * (1.0f / 64.0f); float s2 = 0.f;
#pragma unroll
        for (int n = 0; n < 4; ++n)
#pragma unroll
            for (int i = 0; i < 4; ++i) { const float dlt = y[n][i] - mean; s2 += dlt * dlt; }
        s2 += __shfl_xor(s2, 16); s2 += __shfl_xor(s2, 32);
        const float rstd = rsqrtf(s2 * (1.0f / 64.0f) + GN_EPS);
        const bf16* Z = ZA + (size_t)tok * 2048;
        const bool okl = tt > 0, okr = tt < 63, oku = c > 0, okd = c < GROWS - 1; const int dl = okl ? -1 : 0, dr = okr ? 1 : 0, du = oku ? -64 : 0, dd = okd ? 64 : 0;
        float rr[4][4], kk[4][4], vv[4][4]; float dp = 0.f;
#pragma unroll
        for (int n = 0; n < 4; ++n) { const int cc = h * 64 + 16 * n + 4 * fq;
            mix4(Z, cc, mu, dl, dr, du, dd, okl, okr, oku, okd, rr[n]); mix4(Z, 512 + cc, mu, dl, dr, du, dd, okl, okr, oku, okd, kk[n]); mix4(Z, 1024 + cc, mu, dl, dr, du, dd, okl, okr, oku, okd, vv[n]);
            const f32x4 rk = *(const f32x4*)(F_r_k + cc);
            dp += rr[n][0] * kk[n][0] * rk.x + rr[n][1] * kk[n][1] * rk.y + rr[n][2] * kk[n][2] * rk.z + rr[n][3] * kk[n][3] * rk.w; }
        dp += __shfl_xor(dp, 16); dp += __shfl_xor(dp, 32);
#pragma unroll
        for (int n = 0; n < 4; ++n) { const int cl = 16 * n + 4 * fq, cc = h * 64 + cl;
            const f32x4 lw = *(const f32x4*)(F_ln_w + cc), lb = *(const f32x4*)(F_ln_b + cc);
            const f32x4 g = *(const LAS f32x4*)(L + opq(8 * SL) + (tt * 64 + cl) * 4);
            float o[4];
#pragma unroll
            for (int i = 0; i < 4; ++i) { const float yn = (y[n][i] - mean) * rstd * lw[i] + lb[i]; o[i] = (yn + dp * vv[n][i]) * g[i]; }
            u32x2 pk; pk.x = pk2(o[0], o[1]); pk.y = pk2(o[2], o[3]);
            *(u32x2*)(F_YA + (size_t)tok * DR + cc) = pk; }
    }
    __syncthreads();
#undef S_
}

__global__ void __launch_bounds__(512, 2) fwd(Args AA) {
    extern __shared__ __attribute__((aligned(16))) unsigned char lds_raw[];
    Frame F;
    F.lds = (LAS unsigned char*)lds_raw;
    F.tid = threadIdx.x; F.lane = F.tid & 63; F.wave = __builtin_amdgcn_readfirstlane(F.tid >> 6); F.G = gridDim.x;
    F.ws = AA.ws; F.in = nullptr; F.ctl = (unsigned*)(AA.ws + WS_CTL);

    for (int u = F.tid; u < (LDS_BYTES - MISC_OFF) / 4; u += 512) ((LAS unsigned*)(F.lds + MISC_OFF))[u] = 0u;
    __syncthreads();
    XcdBarrier bar; bar.bar = F.ctl + CW_BAR; bar.x = 0; bar.st = nullptr;
    if (!MK_LAUNCH_PER_PHASE) bar = xcd_barrier_post(F.ctl + CW_BAR, (volatile LAS unsigned*)(F.lds + MISC_OFF));
    const int lo = AA.ph_lo, hi = AA.ph_hi;
#ifndef ONLY_PHASE
#define ONLY_PHASE -1
#endif
#define IN(k) ((ONLY_PHASE < 0 || ONLY_PHASE == (k)) && lo <= (k) && (k) < hi)
#define FRESH() do { int t_ = threadIdx.x; asm volatile("" : "+v"(t_)); F.tid = t_; F.lane = t_ & 63; } while (0)
#ifndef REP_MASK
#define REP_MASK 0
#endif
#define REPS(k) (((REP_MASK >> (k)) & 1) ? 2 : 1)
#define SEAM(k) do { if (!MK_LAUNCH_PER_PHASE && IN(k) && IN((k) + 1)) xcd_barrier(bar); } while (0)

    if (IN(0)) for (int rep_ = 0; rep_ < REPS(0); ++rep_) { FRESH(); FRESH_KA(A); p0_prologue(F, A); } SEAM(0);
    if (IN(1)) for (int rep_ = 0; rep_ < REPS(1); ++rep_) { FRESH(); FRESH_KA(A); p1_norm1(F, A); } SEAM(1);
    if (IN(2)) for (int rep_ = 0; rep_ < REPS(2); ++rep_) { FRESH(); FRESH_KA(A);
        pg8::Gemm g{F_H, F_WinT, MTOT, NPAD, D}; Sched1 S{F.G, (int)blockIdx.x}; EpiZ E{F_ZA, F_ZB, F_ZG};
        pg8::gemm_phase<EpiZ, Sched1, true, true>(F.lds, g, S, E);
    } SEAM(2);
#ifndef SCAN_NAIVE
#define SCAN_NAIVE 0
#endif
    if (IN(3)) for (int rep_ = 0; rep_ < REPS(3); ++rep_) { FRESH(); FRESH_KA(A);
#if SCAN_NAIVE
        if (blockIdx.x < 16) p3_scan_naive(F, A, (int)blockIdx.x);
        else for (int ch = (int)blockIdx.x - 16; ch < SEQ / 128; ch += F.G - 16) p3_mixer_b(F, A, ch);
#else
        for (int u = (int)blockIdx.x; u < 16 * 64; u += F.G) scan_pass1_unit(F, A, u & 15, 1 + (u >> 4), -1);
        if (blockIdx.x >= F.G - 64) { const int u = (int)blockIdx.x - (F.G - 64); scan_pass1_unit(F, A, u & 15, 0, u >> 4); }
#endif
    } SEAM(3);
    if (IN(4)) for (int rep_ = 0; rep_ < REPS(4); ++rep_) { FRESH(); FRESH_KA(A);
#if !SCAN_NAIVE
#ifndef P4REP
#define P4REP 0
#endif
        if (blockIdx.x < 16) {
            for (int q_ = 0; q_ < ((P4REP & 1) ? 2 : 1); ++q_) scan_chain(F, A, (int)blockIdx.x); }
        else for (int q_ = 0; q_ < ((P4REP & 2) ? 2 : 1); ++q_) for (int ch = (int)blockIdx.x - 16; ch < SEQ / 128; ch += F.G - 16) p3_mixer_b(F, A, ch);
#endif
    } SEAM(4);
    if (IN(5)) for (int rep_ = 0; rep_ < REPS(5); ++rep_) { FRESH(); FRESH_KA(A);
#if SCAN_NAIVE
        p4_rwkv_out(F, A);
#else
        for (int u = (int)blockIdx.x; u < 8 * 256; u += F.G) scan_pass2_unit(F, A, u & 7, u >> 3);
#endif
    } SEAM(5);
    if (IN(6)) for (int rep_ = 0; rep_ < REPS(6); ++rep_) { FRESH(); FRESH_KA(A);
        SchedStd S{64, 4, F.G, (int)blockIdx.x};
        { pg8::Gemm g{F_YA, F_WaT, SEQ, D, DR}; EpiMergeA E{F_Y, F_ZG}; pg8::gemm_phase<EpiMergeA, SchedStd, true, true>(F.lds, g, S, E); }
        __syncthreads();
        { pg8::Gemm g{F_YB, F_WbT, SEQ, D, DR}; EpiMergeB E{F_Y, F_ZG, F_MG}; pg8::gemm_phase<EpiMergeB, SchedStd, true, true>(F.lds, g, S, E); }
    } SEAM(6);
    if (IN(7)) for (int rep_ = 0; rep_ < REPS(7); ++rep_) { FRESH(); FRESH_KA(A);
        SchedStd S{64, 4, F.G, (int)blockIdx.x};
        pg8::Gemm g{F_MG, F_WoutT, SEQ, D, D}; EpiX1 E{F_x, F_MOD + 2048, F_out}; pg8::gemm_phase<EpiX1, SchedStd, true, true>(F.lds, g, S, E);
    } SEAM(7);
#ifndef CONV_REPS
#define CONV_REPS 1
#endif
    if (IN(8)) { FRESH(); FRESH_KA(A); p7_router(F, A); for (int rep_ = 0; rep_ < CONV_REPS; ++rep_) { p7_moe_convert(F, A); __syncthreads(); } } SEAM(8);
    if (IN(9)) for (int rep_ = 0; rep_ < REPS(9); ++rep_) { FRESH(); FRESH_KA(A); p8_gather(F, A); } SEAM(9);
    if (IN(10)) for (int rep_ = 0; rep_ < REPS(10); ++rep_) { FRESH(); FRESH_KA(A);
        const int ntiles = moe_tables(F, A);
        MoeOrder S{(const LAS int*)(F.lds + TAB_OFF) + 128, ntiles * 4, F.G, (int)blockIdx.x};
        pg8::Gemm g{F_XG, F_WguT, MAXTILES * 256, NEXP * 1024, D}; EpiSwiGLU E{F_HMID};
        pg8::gemm_phase<EpiSwiGLU, MoeOrder, true, true>(F.lds, g, S, E);
    } SEAM(10);
    if (IN(11)) for (int rep_ = 0; rep_ < REPS(11); ++rep_) { FRESH(); FRESH_KA(A);
        const int ntiles = moe_tables(F, A);
        MoeOrder S{(const LAS int*)(F.lds + TAB_OFF) + 128, ntiles * 4, F.G, (int)blockIdx.x};
        pg8::Gemm g{F_HMID, F_WdT, MAXTILES * 256, NEXP * 1024, DEXP}; EpiScatter E{F_YBUF, F_rowinfo, F_roww};
        pg8::gemm_phase<EpiScatter, MoeOrder, true, true>(F.lds, g, S, E);
    } SEAM(11);
    if (IN(12)) for (int rep_ = 0; rep_ < REPS(12); ++rep_) { FRESH(); FRESH_KA(A); p11_final(F, A); }
#undef IN
#undef SEAM
}

extern "C" void kernel_launch(void* const* d_in, const int* in_sizes, int n_in, void* d_out, int out_size, void* d_ws, size_t ws_size, hipStream_t stream) {
    static int grid = 0;
    if (grid == 0) {
        if (n_in != 35 || in_sizes[0] != SEQ * D || out_size != SEQ * D || ws_size < WS_END) {
            fprintf(stderr, "kernel_launch: unexpected shapes: n_in %d in0 %d out %d ws %zu (need %zu); nothing launched\n", n_in, n_in > 0 ? in_sizes[0] : -1, out_size, ws_size, (size_t)WS_END); grid = -1; return; }
        int dev = 0, cus = 0, per_cu = 0;
        if (hipGetDevice(&dev) != hipSuccess || hipDeviceGetAttribute(&cus, hipDeviceAttributeMultiprocessorCount, dev) != hipSuccess) { grid = -1; return; }
        if (hipFuncSetAttribute((const void*)fwd, hipFuncAttributeMaxDynamicSharedMemorySize, LDS_BYTES) != hipSuccess) { fprintf(stderr, "kernel_launch: hipFuncSetAttribute failed\n"); grid = -1; return; }
        if (hipOccupancyMaxActiveBlocksPerMultiprocessor(&per_cu, (const void*)fwd, 512, LDS_BYTES) != hipSuccess || per_cu < 1) fprintf(stderr, "kernel_launch: occupancy query says %d\n", per_cu);
        (void)hipGetLastError();
        grid = cus;
    }
    if (grid < 0) return;
    if (hipMemsetAsync((char*)d_ws + WS_CTL, 0, CTL_ZERO_BYTES, stream) != hipSuccess) return;
    Args a{};
    for (int i = 0; i < 35; ++i) a.in[i] = (const float*)d_in[i];
    a.out = (float*)d_out; a.ws = (unsigned char*)d_ws;
#if MK_LAUNCH_PER_PHASE
    for (int p = 0; p < NPHASE; ++p) { a.ph_lo = p; a.ph_hi = p + 1; hipLaunchKernelGGL(fwd, dim3(grid), dim3(512), LDS_BYTES, stream, a); }
#else
#ifndef MK_PH_HI
#define MK_PH_HI NPHASE
#endif
    a.ph_lo = 0; a.ph_hi = MK_PH_HI;
    hipLaunchKernelGGL(fwd, dim3(grid), dim3(512), LDS_BYTES, stream, a);
#endif
}
```

```cpp
#include <hip/hip_runtime.h>
#include <cstdio>
#include <cstdint>
namespace pg8 {
#define PG8_LAS __attribute__((address_space(3)))
typedef unsigned short bf16_t;
typedef short bf16x8 __attribute__((ext_vector_type(8)));
typedef float f32x4 __attribute__((ext_vector_type(4)));
typedef unsigned u32x4 __attribute__((ext_vector_type(4)));
constexpr int BM = 256, BK = 64, HALF = 128, HTB = HALF * BK * 2  , STAGE_BYTES = 8 * HTB, NXCD = 8, WGM = 8;

__host__ __device__ __forceinline__ int lds_byte(int r, int c) { const int st = (r >> 4) * 2 + (c >> 5), rr = r & 15, cc = c & 31, ob = rr * 64 + cc * 2; return st * 1024 + (ob ^ (((ob >> 9) & 1) << 5)); }
__host__ __device__ __forceinline__ void stage_rc(int b, int& R, int& C) { const int st = b / 1024, sb = b % 1024, swz = sb ^ (((sb >> 9) & 1) << 5); R = (st >> 1) * 16 + swz / 64; C = (st & 1) * 32 + (swz % 64) / 2; }
__host__ __device__ __forceinline__ int perm32(int rho) { const int n = rho >> 4, i = rho & 15; return 8 * (i >> 2) + 4 * n + (i & 3); }

struct Unit { int pm, pn; };
struct Gemm { const bf16_t* A; const bf16_t* Bt; int M, N, K; };

struct StaticOrder {
    int nM, nN, nwg, G, c;
    __host__ __device__ void init(int M, int N, int G_, int c_) { nM = M / BM; nN = N / BM; nwg = nM * nN; G = G_; c = c_; }
    __host__ __device__ bool next(int i, Unit& u) const {
        const long L = (long)i * G + c; if (L >= nwg) return false;
        int wgid = (int)L; { const int q = nwg / NXCD, r = nwg % NXCD, xcd = wgid % NXCD, off = wgid / NXCD; wgid = (xcd < r ? xcd * (q + 1) : r * (q + 1) + (xcd - r) * q) + off; }
        const int nig = WGM * nN, gid = wgid / nig, fm = gid * WGM, gsz = (nM - fm) < WGM ? (nM - fm) : WGM;
        u.pm = fm + ((wgid % nig) % gsz); u.pn = (wgid % nig) / gsz; return true;
    }
    __device__ __forceinline__ void a_ready(const Unit&) const {}
    __device__ __forceinline__ void done(const Unit&) const {}
};

__device__ __forceinline__ unsigned cvt_pk_bf16(float lo, float hi) { unsigned r; asm volatile("v_cvt_pk_bf16_f32 %0, %1, %2" : "=v"(r) : "v"(lo), "v"(hi)); return r; }
template <class Epi, class Sched, bool ALIGN_EPI = false, bool SP2 = false>
__device__ __forceinline__ void gemm_phase(PG8_LAS unsigned char* lds, const Gemm g, const Sched& S, const Epi& E) {
    int tid_ = threadIdx.x; asm volatile("" : "+v"(tid_));
    const int tid = tid_, wid = __builtin_amdgcn_readfirstlane(tid >> 6), lane = tid & 63, wr = wid >> 2, wc = wid & 3, fr = lane & 15, fq = lane >> 4;
    const int K = g.K, nt = K / BK;
    unsigned voffA[2], voffB[2];
#pragma unroll
    for (int i = 0; i < 2; ++i) { int R, C; stage_rc(tid * 16 + i * 8192, R, C); const int Rb = Epi::PERM ? ((R & ~31) + perm32(R & 31)) : R;
        voffA[i] = (unsigned)(R * K + C) * 2u; voffB[i] = (unsigned)(Rb * K + C) * 2u; }
    const size_t kstep = (size_t)(BK * 2);
    const size_t hstep = (size_t)HALF * K * 2;
    const size_t tstep = 2 * hstep;
    const unsigned ldsw = (unsigned)wid * 1024u;
    const int aoff = lds_byte(wr * 64 + fr, fq * 8), boff = lds_byte(wc * 32 + fr, fq * 8);
#define PG8_SA(b, h) (((b) * 2 + (h)) * HTB)
#define PG8_SB(b, h) ((4 + (b) * 2 + (h)) * HTB)
#define PG8_STAGE(bufoff, gbase, voff) do { _Pragma("unroll") for (int _i = 0; _i < 2; ++_i) \
        __builtin_amdgcn_global_load_lds((const unsigned*)((const char*)(gbase) + (voff)[_i]), (PG8_LAS unsigned*)(lds + (bufoff) + ldsw + _i * 8192), 16, 0, 0); } while (0)
#define PG8_LDA(dst, b, h) do { _Pragma("unroll") for (int m = 0; m < 4; ++m) _Pragma("unroll") for (int k = 0; k < 2; ++k) dst[m][k] = *(const PG8_LAS bf16x8*)(lds + PG8_SA(b, h) + aoff + m * 2048 + k * 1024); } while (0)
#define PG8_LDB(dst, b, h) do { _Pragma("unroll") for (int n = 0; n < 2; ++n) _Pragma("unroll") for (int k = 0; k < 2; ++k) dst[n][k] = *(const PG8_LAS bf16x8*)(lds + PG8_SB(b, h) + boff + n * 2048 + k * 1024); } while (0)
#define PG8_MMA(ai, bj, At, Bt) do { __builtin_amdgcn_s_setprio(1); _Pragma("unroll") for (int m = 0; m < 4; ++m) _Pragma("unroll") for (int n = 0; n < 2; ++n) _Pragma("unroll") for (int k = 0; k < 2; ++k) \
        acc[ai][bj][m][n] = __builtin_amdgcn_mfma_f32_16x16x32_bf16(Bt[n][k], At[m][k], acc[ai][bj][m][n], 0, 0, 0); __builtin_amdgcn_s_setprio(0); } while (0)
#define PG8_WAIT_V(n) asm volatile("s_waitcnt vmcnt(" #n ")" ::: "memory")
#define PG8_WAIT_L(n) asm volatile("s_waitcnt lgkmcnt(" #n ")" ::: "memory")
#define PG8_BAR __builtin_amdgcn_s_barrier()
#define PG8_SCHED __builtin_amdgcn_sched_barrier(0)
    Unit cur, nxt; int ui = 0;
    if (!S.next(0, cur)) return;
    f32x4 acc[2][2][4][2];
#pragma unroll
    for (int a = 0; a < 2; ++a)
#pragma unroll
        for (int b = 0; b < 2; ++b)
#pragma unroll
            for (int m = 0; m < 4; ++m)
#pragma unroll
                for (int n = 0; n < 2; ++n) acc[a][b][m][n] = (f32x4){0.f, 0.f, 0.f, 0.f};
    bf16x8 At[4][2], B0[2][2], B1[2][2];
    const char* cA = (const char*)g.A + (size_t)cur.pm * tstep; const char* cB = (const char*)g.Bt + (size_t)cur.pn * tstep;
    S.a_ready(cur);
    if constexpr (SP2) {
        PG8_STAGE(PG8_SB(0, 0), cB, voffB); PG8_STAGE(PG8_SB(0, 1), cB + hstep, voffB); PG8_STAGE(PG8_SA(0, 0), cA, voffA); PG8_STAGE(PG8_SA(0, 1), cA + hstep, voffA);
        if (wr == 1) PG8_BAR;
        PG8_WAIT_V(2); PG8_BAR;
        PG8_STAGE(PG8_SB(1, 0), cB + kstep, voffB); PG8_STAGE(PG8_SA(1, 0), cA + kstep, voffA); PG8_STAGE(PG8_SB(1, 1), cB + hstep + kstep, voffB);
        PG8_WAIT_V(6); PG8_BAR;
    } else {
        PG8_STAGE(PG8_SB(0, 0), cB, voffB); PG8_STAGE(PG8_SA(0, 0), cA, voffA); PG8_STAGE(PG8_SB(0, 1), cB + hstep, voffB); PG8_STAGE(PG8_SA(0, 1), cA + hstep, voffA);
        if (wr == 1) PG8_BAR;
        PG8_WAIT_V(4); PG8_BAR;
        PG8_STAGE(PG8_SB(1, 0), cB + kstep, voffB); PG8_STAGE(PG8_SA(1, 0), cA + kstep, voffA); PG8_STAGE(PG8_SB(1, 1), cB + hstep + kstep, voffB);
        PG8_WAIT_V(6); PG8_BAR;
    }
    for (;;) {
        const bool has_next = S.next(ui + 1, nxt);
        const char* nA = has_next ? (const char*)g.A + (size_t)nxt.pm * tstep : cA; const char* nB = has_next ? (const char*)g.Bt + (size_t)nxt.pn * tstep : cB;
        for (int t = 0; t < nt; t += 2) {
            const bool last = (t == nt - 2);
            const char* a1 = cA + (size_t)(t + 1) * kstep;
            const char* a2 = last ? nA : cA + (size_t)(t + 2) * kstep; const char* b2 = last ? nB : cB + (size_t)(t + 2) * kstep;
            const char* a3 = a2 + kstep; const char* b3 = b2 + kstep;
            if (last && has_next) S.a_ready(nxt);
            if constexpr (SP2) {
            PG8_LDB(B0, 0, 0); PG8_LDB(B1, 0, 1); PG8_SCHED; PG8_LDA(At, 0, 0); PG8_STAGE(PG8_SA(1, 1), a1 + hstep, voffA);
            PG8_WAIT_V(8); PG8_WAIT_L(0); PG8_BAR; PG8_MMA(0, 0, At, B0); PG8_MMA(0, 1, At, B1); PG8_BAR; PG8_SCHED;
            PG8_LDA(At, 0, 1); PG8_STAGE(PG8_SB(0, 0), b2, voffB); PG8_STAGE(PG8_SB(0, 1), b2 + hstep, voffB); PG8_STAGE(PG8_SA(0, 0), a2, voffA);
            PG8_WAIT_V(8); PG8_WAIT_L(0); PG8_BAR; PG8_MMA(1, 0, At, B0); PG8_MMA(1, 1, At, B1); PG8_BAR; PG8_SCHED;
            PG8_LDB(B0, 1, 0); PG8_LDB(B1, 1, 1); PG8_SCHED; PG8_LDA(At, 1, 0); PG8_STAGE(PG8_SA(0, 1), a2 + hstep, voffA);
            PG8_WAIT_V(8); PG8_WAIT_L(0); PG8_BAR; PG8_MMA(0, 0, At, B0); PG8_MMA(0, 1, At, B1); PG8_BAR; PG8_SCHED;
            PG8_LDA(At, 1, 1); PG8_STAGE(PG8_SB(1, 0), b3, voffB); PG8_STAGE(PG8_SB(1, 1), b3 + hstep, voffB); PG8_STAGE(PG8_SA(1, 0), a3, voffA);
            PG8_WAIT_V(8); PG8_WAIT_L(0); PG8_BAR; PG8_MMA(1, 0, At, B0); PG8_MMA(1, 1, At, B1); PG8_BAR; PG8_SCHED;
            } else {
            PG8_LDB(B0, 0, 0); PG8_SCHED; PG8_LDA(At, 0, 0); PG8_STAGE(PG8_SA(1, 1), a1 + hstep, voffA);
            PG8_WAIT_L(8); PG8_BAR; PG8_WAIT_L(0); PG8_MMA(0, 0, At, B0); PG8_BAR; PG8_SCHED;
            PG8_LDB(B1, 0, 1); PG8_STAGE(PG8_SB(0, 0), b2, voffB);
            PG8_BAR; PG8_WAIT_L(0); PG8_MMA(0, 1, At, B1); PG8_BAR;
            PG8_LDA(At, 0, 1); PG8_STAGE(PG8_SA(0, 0), a2, voffA);
            PG8_BAR; PG8_WAIT_L(0); PG8_MMA(1, 0, At, B0); PG8_BAR; PG8_SCHED;
            PG8_STAGE(PG8_SB(0, 1), b2 + hstep, voffB);
            PG8_WAIT_V(6); PG8_BAR; PG8_MMA(1, 1, At, B1); PG8_BAR;
            PG8_LDB(B0, 1, 0); PG8_SCHED; PG8_LDA(At, 1, 0); PG8_STAGE(PG8_SA(0, 1), a2 + hstep, voffA);
            PG8_WAIT_L(8); PG8_BAR; PG8_WAIT_L(0); PG8_MMA(0, 0, At, B0); PG8_BAR; PG8_SCHED;
            PG8_LDB(B1, 1, 1); PG8_STAGE(PG8_SB(1, 0), b3, voffB);
            PG8_BAR; PG8_WAIT_L(0); PG8_MMA(0, 1, At, B1); PG8_BAR;
            PG8_LDA(At, 1, 1); PG8_STAGE(PG8_SA(1, 0), a3, voffA);
            PG8_BAR; PG8_WAIT_L(0); PG8_MMA(1, 0, At, B0); PG8_BAR; PG8_SCHED;
            PG8_STAGE(PG8_SB(1, 1), b3 + hstep, voffB);
            PG8_WAIT_V(6); PG8_BAR; PG8_MMA(1, 1, At, B1); PG8_BAR;
            }
        }
        if constexpr (ALIGN_EPI) { if (wr == 0) PG8_BAR; }
        if constexpr (!Epi::AFTER_DRAIN) { E(acc, cur, wr, wc, fr, fq); S.done(cur); }
        if (!has_next) break;
#pragma unroll
        for (int a = 0; a < 2; ++a)
#pragma unroll
            for (int b = 0; b < 2; ++b)
#pragma unroll
                for (int m = 0; m < 4; ++m)
#pragma unroll
                    for (int n = 0; n < 2; ++n) acc[a][b][m][n] = (f32x4){0.f, 0.f, 0.f, 0.f};
        cur = nxt; cA = nA; cB = nB; ++ui;
        if constexpr (ALIGN_EPI) { if (wr == 1) PG8_BAR; }
    }
    PG8_WAIT_V(0);
    if constexpr (!ALIGN_EPI) { if (wr == 0) PG8_BAR; }
    PG8_BAR;
    if constexpr (Epi::AFTER_DRAIN) { E.fused(acc, cur, wr, wc, fr, fq, lds, wid, lane); S.done(cur); }
#undef PG8_SA
#undef PG8_SB
#undef PG8_STAGE
#undef PG8_LDA
#undef PG8_LDB
#undef PG8_MMA
#undef PG8_WAIT_V
#undef PG8_WAIT_L
#undef PG8_BAR
#undef PG8_SCHED
}
}

#ifndef MK_LAUNCH_PER_PHASE
#define MK_LAUNCH_PER_PHASE 0
#endif
constexpr int D = 1024, SEQ = 16384, CTXL = 256, MTOT = SEQ + CTXL, GW = 64, GROWS = SEQ / GW;
constexpr int DR = 512, NH = 8, HD = 64, PA = 1920, WINC = 4992, NPAD = 5120;
constexpr int NEXP = 32, DEXP = 512;
constexpr float NORM_EPS = 1e-6f, GN_EPS = 64e-5f;
constexpr int NPHASE = 13;

constexpr size_t MiB = 1u << 20;
constexpr size_t WS_CTL = 0, CTL_ZERO_BYTES = 64 * 1024;
constexpr size_t WS_MOD = 1 * MiB;
constexpr size_t WS_ROWINFO = WS_MOD + 64 * 1024;
constexpr size_t WS_ROWW = WS_MOD + 256 * 1024;
constexpr size_t WS_ROUTE = WS_MOD + 512 * 1024;
constexpr size_t WS_WIN = 2 * MiB;
constexpr size_t WS_WA = 12 * MiB, WS_WB = 13 * MiB, WS_WOUT = 14 * MiB;
constexpr size_t WS_H = 16 * MiB;
constexpr size_t WS_ZA = 49 * MiB;
constexpr size_t WS_ZB = 114 * MiB;
constexpr size_t WS_ZG = 146 * MiB;
constexpr size_t WS_YB = 210 * MiB;
constexpr size_t WS_YA = 226 * MiB;
constexpr size_t WS_Y = 242 * MiB;
constexpr size_t WS_END = 306 * MiB;
constexpr size_t WS_WGU = 49 * MiB;
constexpr size_t WS_WD = 113 * MiB;
constexpr size_t WS_XG = 145 * MiB;
constexpr size_t WS_HMID = 225 * MiB;
constexpr size_t WS_WUPT = 512 * 1024, WS_AUPT = 640 * 1024, WS_GUPT = 768 * 1024;
constexpr size_t WS_PQ = 16 * MiB;
constexpr size_t WS_PQC = 33 * MiB;
constexpr size_t WS_S0 = 34 * MiB;
constexpr size_t WS_GY = 242 * MiB;
constexpr size_t WS_WRT = 48 * MiB + 512 * 1024;
constexpr size_t WS_SGW = 896 * 1024;
constexpr int MAXTILES = 160;
constexpr int CW_TMO = 0, CW_BAR = 4096, CW_CNT = 8192;

constexpr int RING_BYTES = 131072, MISC_OFF = 159744, TAB_OFF = MISC_OFF + 256, LDS_BYTES = 163840;

#define GAS __attribute__((address_space(1)))
#define LAS __attribute__((address_space(3)))
typedef unsigned short bf16;
typedef float f32x4 __attribute__((ext_vector_type(4)));
typedef unsigned u32x4 __attribute__((ext_vector_type(4)));
typedef unsigned u32x2 __attribute__((ext_vector_type(2)));
typedef short bf16x8 __attribute__((ext_vector_type(8)));
#define LDS_WAIT() asm volatile("s_waitcnt lgkmcnt(0)" ::: "memory")
#define VM_WAIT() asm volatile("s_waitcnt vmcnt(0)" ::: "memory")

typedef __bf16 bf2_t __attribute__((ext_vector_type(2)));
__device__ __forceinline__ unsigned f2bf(float f) { return (unsigned)__builtin_bit_cast(unsigned short, (__bf16)f); }
__device__ __forceinline__ unsigned pk2(float lo, float hi) { bf2_t v; v.x = (__bf16)lo; v.y = (__bf16)hi; return __builtin_bit_cast(unsigned, v); }
__device__ __forceinline__ float bf2f(unsigned b) { return __builtin_bit_cast(float, b << 16); }
__device__ __forceinline__ float bflo(unsigned w) { return __builtin_bit_cast(float, w << 16); }
__device__ __forceinline__ float bfhi(unsigned w) { return __builtin_bit_cast(float, w & 0xffff0000u); }
__device__ __forceinline__ float sigmoidf_(float x) { return __builtin_amdgcn_rcpf(1.0f + __expf(-x)); }
__device__ __forceinline__ float siluf_(float x) { return x * __builtin_amdgcn_rcpf(1.0f + __expf(-x)); }
__device__ __forceinline__ float softplusf_(float x) { return fmaxf(x, 0.f) + log1pf(__expf(-fabsf(x))); }
__device__ __forceinline__ float gelu_tanh(float x) { const float u = 0.7978845608028654f * (x + 0.044715f * x * x * x); return x * __builtin_amdgcn_rcpf(1.0f + __expf(-2.0f * u)); }
__device__ __forceinline__ float wave_sum(float v) {
#pragma unroll
    for (int o = 1; o < 64; o <<= 1) v += __shfl_xor(v, o);
    return v;
}

#define XB_TMO      128
#define XB_XCNT(j)  (256  + 64 * (j))
#define XB_XSUB(j)  (1280 + 64 * (j))
#define XB_XGEN(j)  (2304 + 64 * (j))
#define XB_TOP      3328
#define XB_TOPGEN   3392
#define XCD_BAR_WORDS 3456
#define XB_SPIN_CAP (1u << 26)
#define LAS __attribute__((address_space(3)))

__device__ __forceinline__ unsigned xb_ld(unsigned* p)              { return __hip_atomic_load(p, __ATOMIC_RELAXED, __HIP_MEMORY_SCOPE_AGENT); }
__device__ __forceinline__ unsigned xb_add(unsigned* p, unsigned v) { return __hip_atomic_fetch_add(p, v, __ATOMIC_RELAXED, __HIP_MEMORY_SCOPE_AGENT); }
__device__ __forceinline__ unsigned xb_xcc_id() { return (unsigned)__builtin_amdgcn_s_getreg((3 << 11) | 20) & 0xFu; }
#define XB_SPIN(cond, bar) do { unsigned _sp = 0; while (cond) { __builtin_amdgcn_s_sleep(1); \
    if ((++_sp & 255u) == 0u) { if (xb_ld(&(bar)[XB_TMO])) break; if (_sp > XB_SPIN_CAP) { atomicAdd(&(bar)[XB_TMO], 1u); break; } } } } while (0)

struct XcdBarrier {
    unsigned* bar; unsigned x;
    volatile LAS unsigned* st;
};

__device__ __forceinline__ XcdBarrier xcd_barrier_post(unsigned* bar, volatile LAS unsigned* st) {
    XcdBarrier b; b.bar = bar; b.x = xb_xcc_id(); b.st = st;
    if (threadIdx.x == 0) (void)xb_add(&bar[XB_XCNT(b.x)], 1u);
    return b;
}
__device__ __forceinline__ void xcd_barrier_complete(unsigned* bar, unsigned x, unsigned& nloc, unsigned& nx) {
    const unsigned G = gridDim.x * gridDim.y * gridDim.z;
    unsigned sum, cnt, mine, sp = 0u;
    for (;;) {
        sum = 0u; cnt = 0u; mine = 0u;
#pragma unroll
        for (unsigned j = 0; j < 16; ++j) { const unsigned c = xb_ld(&bar[XB_XCNT(j)]); sum += c; cnt += (c > 0u) ? 1u : 0u; mine = (j == x) ? c : mine; }
        if (sum == G) break;
        __builtin_amdgcn_s_sleep(1);
        if ((++sp & 255u) == 0u) { if (xb_ld(&bar[XB_TMO])) break; if (sp > XB_SPIN_CAP) { atomicAdd(&bar[XB_TMO], 1u); break; } }
    }
    nloc = mine > 0u ? mine : 1u; nx = cnt > 0u ? cnt : 1u;
}

__device__ __forceinline__ void xcd_barrier(const XcdBarrier& b) {
    asm volatile("s_waitcnt vmcnt(0)" ::: "memory");
    __syncthreads();
    if (threadIdx.x == 0) {
        unsigned* bar = b.bar;
        __builtin_amdgcn_s_waitcnt(0);
        unsigned nloc = b.st[0], nx = b.st[1];
        if (nloc == 0u) { xcd_barrier_complete(bar, b.x, nloc, nx); b.st[0] = nloc; b.st[1] = nx; }
        const unsigned old = xb_add(&bar[XB_XSUB(b.x)], 1u);
        const unsigned gen = old / nloc;
        if (old + 1u == (gen + 1u) * nloc) {
            __builtin_amdgcn_fence(__ATOMIC_RELEASE, "agent");
            asm volatile("s_waitcnt vmcnt(0)" ::: "memory");
            const unsigned og = xb_add(&bar[XB_TOP], 1u);
            const unsigned tg = og / nx;
            if (og + 1u == (tg + 1u) * nx) xb_add(&bar[XB_TOPGEN], 1u);
            else XB_SPIN(xb_ld(&bar[XB_TOPGEN]) == tg, bar);
            __builtin_amdgcn_fence(__ATOMIC_ACQUIRE, "agent");
            xb_add(&bar[XB_XGEN(b.x)], 1u);
            asm volatile("s_waitcnt vmcnt(0)" ::: "memory");
        } else {
            XB_SPIN(xb_ld(&bar[XB_XGEN(b.x)]) == gen, bar);
            __builtin_amdgcn_fence(__ATOMIC_ACQUIRE, "agent");
            asm volatile("s_waitcnt vmcnt(0)" ::: "memory");
        }
    }
    __syncthreads();
}

struct Args { const float* in[35]; float* out; unsigned char* ws; int ph_lo, ph_hi; };

typedef const __attribute__((address_space(4))) unsigned char* kptr_t;
struct KArgs {
    kptr_t p;
    __device__ __forceinline__ const float* in(int i) const { return *(const float* const __attribute__((address_space(4)))*)(p + 8 * i); }
    __device__ __forceinline__ float* out() const { return *(float* const __attribute__((address_space(4)))*)(p + 280); }
    __device__ __forceinline__ unsigned char* ws() const { return *(unsigned char* const __attribute__((address_space(4)))*)(p + 288); }
};
#define FRESH_KA(name) KArgs name; { kptr_t q_ = (kptr_t)__builtin_amdgcn_kernarg_segment_ptr(); asm volatile("" : "+s"(q_)); name.p = q_; }
#define F_x (A.in(0))
#define F_c (A.in(1))
#define F_ctx (A.in(2))
#define F_cctx (A.in(3))
#define F_ada_w (A.in(4))
#define F_ada_b (A.in(5))
#define F_norm1_g (A.in(6))
#define F_norm2_g (A.in(7))
#define F_w_in (A.in(8))
#define F_mu (A.in(9))
#define F_w0 (A.in(10))
#define F_w_up (A.in(11))
#define F_a0 (A.in(12))
#define F_a_up (A.in(13))
#define F_g_up (A.in(14))
#define F_k_k (A.in(15))
#define F_k_a (A.in(16))
#define F_r_k (A.in(17))
#define F_ln_w (A.in(18))
#define F_ln_b (A.in(19))
#define F_w_ba (A.in(20))
#define F_sg_ln_w (A.in(21))
#define F_sg_ln_b (A.in(22))
#define F_sg_w (A.in(23))
#define F_sg_b (A.in(24))
#define F_w_bb (A.in(25))
#define F_w_out (A.in(26))
#define F_grp_w (A.in(27))
#define F_grp_b (A.in(28))
#define F_exp_w (A.in(29))
#define F_exp_b (A.in(30))
#define F_wg (A.in(31))
#define F_wu (A.in(32))
#define F_wd (A.in(33))
#define F_fin_g (A.in(34))
#define F_MOD ((float*)(A.ws() + WS_MOD))
#define F_rowinfo ((int*)(A.ws() + WS_ROWINFO))
#define F_roww ((float*)(A.ws() + WS_ROWW))
#define F_route ((unsigned*)(A.ws() + WS_ROUTE))
#define F_WinT ((bf16*)(A.ws() + WS_WIN))
#define F_WaT ((bf16*)(A.ws() + WS_WA))
#define F_WbT ((bf16*)(A.ws() + WS_WB))
#define F_WoutT ((bf16*)(A.ws() + WS_WOUT))
#define F_H ((bf16*)(A.ws() + WS_H))
#define F_ZA ((bf16*)(A.ws() + WS_ZA))
#define F_ZB ((bf16*)(A.ws() + WS_ZB))
#define F_ZG ((bf16*)(A.ws() + WS_ZG))
#define F_YB ((bf16*)(A.ws() + WS_YB))
#define F_YA ((bf16*)(A.ws() + WS_YA))
#define F_WguT ((bf16*)(A.ws() + WS_WGU))
#define F_WdT ((bf16*)(A.ws() + WS_WD))
#define F_XG ((bf16*)(A.ws() + WS_XG))
#define F_HMID ((bf16*)(A.ws() + WS_HMID))
#define F_YBUF ((bf16*)(A.ws() + WS_XG))
#define F_MG ((bf16*)(A.ws() + WS_ZB))
#define F_Y ((float*)(A.ws() + WS_Y))
#define F_out (A.out())
struct Frame {
    LAS unsigned char* lds;
    unsigned* ctl;
    unsigned char* ws;
    const float* const* in;
    int tid, lane, wave, G;
};


__device__ __forceinline__ void static_tile(int wgid, int nM, int nN, pg8::Unit& u) {
    const int nwg = nM * nN;
    { const int q = nwg / 8, r = nwg % 8, xcd = wgid % 8, off = wgid / 8; wgid = (xcd < r ? xcd * (q + 1) : r * (q + 1) + (xcd - r) * q) + off; }
    const int nig = 8 * nN, gid = wgid / nig, fm = gid * 8, gsz = (nM - fm) < 8 ? (nM - fm) : 8;
    u.pm = fm + ((wgid % nig) % gsz); u.pn = (wgid % nig) / gsz;
}

__device__ __forceinline__ void transpose_item(const float* W, int K, int N, int k0, int n0, bf16* WT, int dst_row0, LAS float* scr, int lane) {
#pragma unroll 8
    for (int i = 0; i < 32; ++i) { const int kk = 2 * i + (lane >> 5); scr[kk * 33 + (lane & 31)] = W[(size_t)(k0 + kk) * N + n0 + (lane & 31)]; }
    LDS_WAIT(); asm volatile("" ::: "memory");
    const int c = lane & 7;
#pragma unroll
    for (int j = 0; j < 4; ++j) { const int n = (lane >> 3) + 8 * j; const LAS float* s = scr + (8 * c) * 33 + n;
        u32x4 o; o.x = pk2(s[0 * 33], s[1 * 33]); o.y = pk2(s[2 * 33], s[3 * 33]); o.z = pk2(s[4 * 33], s[5 * 33]); o.w = pk2(s[6 * 33], s[7 * 33]);
        *(u32x4*)(WT + (size_t)(dst_row0 + n) * K + k0 + 8 * c) = o; }
    LDS_WAIT(); asm volatile("" ::: "memory");
}

__device__ __forceinline__ void transpose_item64(const float* W, int K, int N, int k0, int n0, bf16* WT, int dst_row0, LAS float* scr, int lane) {
    const int c16 = lane & 15, r4 = lane >> 4;
    f32x4 v[16];
#pragma unroll
    for (int i = 0; i < 16; ++i) v[i] = *(const f32x4*)(W + (size_t)(k0 + 4 * i + r4) * N + n0 + 4 * c16);
#pragma unroll
    for (int i = 0; i < 16; ++i) { LAS float* p = scr + (4 * c16) * 65 + 4 * i + r4; p[0] = v[i].x; p[65] = v[i].y; p[130] = v[i].z; p[195] = v[i].w; }
    LDS_WAIT(); asm volatile("" ::: "memory");
    const int c = lane & 7;
#pragma unroll
    for (int j = 0; j < 8; ++j) { const int n = (lane >> 3) + 8 * j; const LAS float* s = scr + n * 65 + 8 * c;
        u32x4 o; o.x = pk2(s[0], s[1]); o.y = pk2(s[2], s[3]); o.z = pk2(s[4], s[5]); o.w = pk2(s[6], s[7]);
        *(u32x4*)(WT + (size_t)(dst_row0 + n) * K + k0 + 8 * c) = o; }
    LDS_WAIT(); asm volatile("" ::: "memory");
}

__device__ __forceinline__ void p0_prologue(Frame& F, const KArgs& A) {
    {
        LAS float* red = (LAS float*)F.lds;
        const int cl = F.tid & 31, kg = F.tid >> 5;
        for (int cb = blockIdx.x; cb < 256; cb += F.G) {
            const int col = cb * 24 + cl; float a0 = 0.f, a1 = 0.f;
            if (cl < 24) for (int k = kg; k < D; k += 16) { const float w = F_ada_w[(size_t)k * 6144 + col]; a0 += siluf_(F_c[k]) * w; a1 += siluf_(F_cctx[k]) * w; }
            red[(kg * 32 + cl) * 2] = a0; red[(kg * 32 + cl) * 2 + 1] = a1;
            __syncthreads();
            if (F.tid < 48) { const int cc = F.tid % 24, i = F.tid / 24; float s = 0.f; for (int g = 0; g < 16; ++g) s += red[(g * 32 + cc) * 2 + i]; F_MOD[i * 6144 + cb * 24 + cc] = s + F_ada_b[cb * 24 + cc]; }
            __syncthreads();
        }
    }
    LAS float* scr = (LAS float*)(F.lds + F.wave * 16640);
    const int gw = blockIdx.x * 8 + F.wave, NGW = F.G * 8;
    constexpr int I_IN = 16 * 78, I_A = 8 * 16, I_B = 8 * 16, I_O = 16 * 16, NIT = I_IN + I_A + I_B + I_O;
    for (int it = gw; it < NIT; it += NGW) {
        int r = it;
        if (r < I_IN) { const int kb = r / 78, nb = r % 78, n0 = 64 * nb; transpose_item64(F_w_in, D, WINC, 64 * kb, n0, F_WinT, n0 + (n0 >= PA ? 128 : 0), scr, F.lane); continue; } r -= I_IN;
        if (r < I_A) { const int kb = r / 16, nb = r % 16; transpose_item64(F_w_ba, DR, D, 64 * kb, 64 * nb, F_WaT, 64 * nb, scr, F.lane); continue; } r -= I_A;
        if (r < I_B) { const int kb = r / 16, nb = r % 16; transpose_item64(F_w_bb, DR, D, 64 * kb, 64 * nb, F_WbT, 64 * nb, scr, F.lane); continue; } r -= I_B;
        { const int kb = r / 16, nb = r % 16; transpose_item64(F_w_out, D, D, 64 * kb, 64 * nb, F_WoutT, 64 * nb, scr, F.lane); }
    }
    for (int i = blockIdx.x * 512 + F.tid; i < 65536; i += F.G * 512) {
        const int ch = i >> 12, c = (i >> 6) & 63, r = i & 63, dd = ch >> 3, hh = ch & 7;
        ((bf16*)(A.ws() + WS_WUPT))[i] = (bf16)f2bf(F_w_up[(size_t)(dd * 64 + r) * DR + hh * 64 + c]);
        ((bf16*)(A.ws() + WS_AUPT))[i] = (bf16)f2bf(F_a_up[(size_t)(dd * 64 + r) * DR + hh * 64 + c]);
        const int hg = i >> 13, cg = (i >> 7) & 63, rg = i & 127;
        ((bf16*)(A.ws() + WS_GUPT))[i] = (bf16)f2bf(F_g_up[(size_t)rg * DR + hg * 64 + cg]);
    }
    for (int i = blockIdx.x * 512 + F.tid; i < 4 * 128 * 128; i += F.G * 512) ((bf16*)(A.ws() + WS_SGW))[i] = (bf16)f2bf(F_sg_w[i]);
    for (int i = blockIdx.x * 512 + F.tid; i < 36 * D; i += F.G * 512) { const int ee = i >> 10, k = i & 1023;
        ((float*)(A.ws() + WS_WRT))[i] = ee < 4 ? F_grp_w[k * 4 + ee] : F_exp_w[k * 32 + ee - 4]; }
    for (int i = blockIdx.x * 512 + F.tid; i < 16384; i += F.G * 512) ((u32x4*)(F_WinT + (size_t)PA * D))[i] = (u32x4){0u, 0u, 0u, 0u};
}

__device__ __forceinline__ void norm_row_bf16(const float* src, const float* g, const float* sh, const float* sc, bf16* dst, int lane) {
    f32x4 v[4]; float ss = 0.f;
#pragma unroll
    for (int j = 0; j < 4; ++j) { v[j] = ((const f32x4*)src)[lane + 64 * j]; ss += (v[j].x * v[j].x + v[j].y * v[j].y) + (v[j].z * v[j].z + v[j].w * v[j].w); }
    const float rinv = rsqrtf(wave_sum(ss) * (1.0f / D) + NORM_EPS);
#pragma unroll
    for (int j = 0; j < 4; ++j) {
        const f32x4 gg = ((const f32x4*)g)[lane + 64 * j], s1 = ((const f32x4*)sc)[lane + 64 * j], s0 = ((const f32x4*)sh)[lane + 64 * j];
        const f32x4 hv = (v[j] * rinv * gg) * (1.0f + s1) + s0;
        u32x2 o; o.x = pk2(hv.x, hv.y); o.y = pk2(hv.z, hv.w);
        ((u32x2*)dst)[lane + 64 * j] = o;
    }
}
__device__ __forceinline__ void p1_norm1(Frame& F, const KArgs& A) {
    const int gw = blockIdx.x * 8 + F.wave, NGW = F.G * 8;
    for (int row = gw; row < MTOT; row += NGW) {
        const bool isctx = row >= SEQ;
        const float* src = isctx ? F_ctx + (size_t)(row - SEQ) * D : F_x + (size_t)row * D;
        const float* mod = F_MOD + (isctx ? 6144 : 0);
        norm_row_bf16(src, F_norm1_g, mod, mod + 1024, F_H + (size_t)row * D, F.lane);
    }
}

struct Sched1 {
    int G, c;
    __device__ __forceinline__ bool next(int i, pg8::Unit& u) const {
        long L = (long)i * G + c; if (L < 8) { u.pm = 64; u.pn = (int)L; return true; }
        L -= 8; if (L >= 1280) return false; static_tile((int)L, 64, 20, u); return true;
    }
    __device__ __forceinline__ void a_ready(const pg8::Unit&) const {}
    __device__ __forceinline__ void done(const pg8::Unit&) const {}
};
struct EpiZ {
    static constexpr bool PERM = true, AFTER_DRAIN = false;
    bf16 *ZA, *ZB, *ZG;
    __device__ __forceinline__ void operator()(const pg8::f32x4 (&acc)[2][2][4][2], const pg8::Unit& u, int wr, int wc, int fr, int fq) const {
        const int row0 = u.pm * 256 + wr * 64 + fr;
        bf16* base; int ld, colt;
        if (u.pn < 8) { base = ZA; ld = 2048; colt = u.pn * 256; } else if (u.pn < 12) { base = ZB; ld = 1024; colt = (u.pn - 8) * 256; } else { base = ZG; ld = 2048; colt = (u.pn - 12) * 256; }
        const int col0 = colt + wc * 32 + 8 * fq;
#pragma unroll
        for (int ai = 0; ai < 2; ++ai)
#pragma unroll
            for (int m = 0; m < 4; ++m) { bf16* rowp = base + (size_t)(row0 + ai * 128 + m * 16) * ld + col0;
#pragma unroll
                for (int bj = 0; bj < 2; ++bj) { const pg8::f32x4 v0 = acc[ai][bj][m][0], v1 = acc[ai][bj][m][1];
                    u32x4 w; w.x = pg8::cvt_pk_bf16(v0[0], v0[1]); w.y = pg8::cvt_pk_bf16(v0[2], v0[3]); w.z = pg8::cvt_pk_bf16(v1[0], v1[1]); w.w = pg8::cvt_pk_bf16(v1[2], v1[3]);
                    *(u32x4*)(rowp + bj * 128) = w; } }
    }
};

__device__ __forceinline__ float mixed_val(const bf16* ZA, bool isctx, int t, int col, float mu) {
    const int row = isctx ? SEQ + t : t;
    const bf16* Z = ZA + (size_t)row * 2048;
    int dr; bool ok;
    if (isctx) { const bool ev = (col & 1) == 0; dr = ev ? -1 : 1; ok = ev ? (t > 0) : (t < CTXL - 1); }
    else { const int s = col & 3, gx = t & 63, gy = t >> 6;
        dr = (s == 0) ? -1 : (s == 1) ? 1 : (s == 2) ? -64 : 64;
        ok = (s == 0) ? (gx > 0) : (s == 1) ? (gx < 63) : (s == 2) ? (gy > 0) : (gy < GROWS - 1); }
    const int dsafe = ok ? dr : 0;
    const float z = bf2f(Z[col]);
    const float nbv = bf2f(Z[col + dsafe * 2048]);
    const float nb = ok ? nbv : 0.f;
    return z + mu * (nb - z);
}
__device__ __forceinline__ void mixed8(const bf16* ZA, int t, int col0, const float* mu, float (&o)[8]) {
    const bf16* Z = ZA + (size_t)t * 2048 + col0;
    const int gx = t & 63, gy = t >> 6;
    const u32x4 z = *(const u32x4*)Z;
    const u32x4 zero = (u32x4){0u, 0u, 0u, 0u};
    const u32x4 l = gx > 0 ? *(const u32x4*)(Z - 2048) : zero, r = gx < 63 ? *(const u32x4*)(Z + 2048) : zero;
    const u32x4 up = gy > 0 ? *(const u32x4*)(Z - 64 * 2048) : zero, dn = gy < GROWS - 1 ? *(const u32x4*)(Z + 64 * 2048) : zero;
    const f32x4 m0 = *(const f32x4*)(mu + col0), m1 = *(const f32x4*)(mu + col0 + 4);
    float zz[8], nn[8];
    zz[0] = bflo(z.x); zz[1] = bfhi(z.x); zz[2] = bflo(z.y); zz[3] = bfhi(z.y); zz[4] = bflo(z.z); zz[5] = bfhi(z.z); zz[6] = bflo(z.w); zz[7] = bfhi(z.w);
    nn[0] = bflo(l.x); nn[1] = bfhi(r.x); nn[2] = bflo(up.y); nn[3] = bfhi(dn.y); nn[4] = bflo(l.z); nn[5] = bfhi(r.z); nn[6] = bflo(up.w); nn[7] = bfhi(dn.w);
    const float mm[8] = {m0.x, m0.y, m0.z, m0.w, m1.x, m1.y, m1.z, m1.w};
#pragma unroll
    for (int i = 0; i < 8; ++i) o[i] = zz[i] + mm[i] * (nn[i] - zz[i]);
}

__device__ __forceinline__ void p3_scan_naive(Frame& F, const KArgs& A, int chain) {
    const int d = chain >> 3, h = chain & 7, j = F.lane, c = h * 64 + j, w = F.wave;
    float wup[64], aup[64];
#pragma unroll
    for (int r = 0; r < 64; ++r) { wup[r] = F_w_up[(size_t)(d * 64 + r) * DR + c]; aup[r] = F_a_up[(size_t)(d * 64 + r) * DR + c]; }
    const float w0 = F_w0[d * DR + c], a0 = F_a0[d * DR + c], kkc = F_k_k[c], kac = F_k_a[c];
    const int col_w = 1536 + d * 64 + j, col_a = 1664 + d * 64 + j;
    const float mu_r = F_mu[c], mu_k = F_mu[512 + c], mu_v = F_mu[1024 + c], mu_w = F_mu[col_w], mu_a = F_mu[col_a];
    float S[8];
#pragma unroll
    for (int i = 0; i < 8; ++i) S[i] = 0.f;
    float* Yd = F_Y + (size_t)d * SEQ * DR;
    const int NSTEP = CTXL + SEQ;
    float nr, nk, nv, nwd, nad;
    { const bool ic = true; const int t = d ? CTXL - 1 : 0;
      nr = mixed_val(F_ZA, ic, t, c, mu_r); nk = mixed_val(F_ZA, ic, t, 512 + c, mu_k); nv = mixed_val(F_ZA, ic, t, 1024 + c, mu_v); nwd = mixed_val(F_ZA, ic, t, col_w, mu_w); nad = mixed_val(F_ZA, ic, t, col_a, mu_a); }
    for (int step = 0; step < NSTEP; ++step) {
        const bool isctx = step < CTXL;
        const int t = isctx ? (d ? CTXL - 1 - step : step) : (d ? SEQ - 1 - (step - CTXL) : step - CTXL);
        const float r = nr, k = nk, v = nv, wd = nwd, ad = nad;
        if (step + 1 < NSTEP) { const int s2 = step + 1; const bool ic = s2 < CTXL; const int t2 = ic ? (d ? CTXL - 1 - s2 : s2) : (d ? SEQ - 1 - (s2 - CTXL) : s2 - CTXL);
            nr = mixed_val(F_ZA, ic, t2, c, mu_r); nk = mixed_val(F_ZA, ic, t2, 512 + c, mu_k); nv = mixed_val(F_ZA, ic, t2, 1024 + c, mu_v); nwd = mixed_val(F_ZA, ic, t2, col_w, mu_w); nad = mixed_val(F_ZA, ic, t2, col_a, mu_a); }
        const float twd = tanhf(wd);
        float wl = w0, al = a0;
#pragma unroll
        for (int rr = 0; rr < 64; ++rr) { const float tw = __builtin_bit_cast(float, __builtin_amdgcn_readlane(__builtin_bit_cast(int, twd), rr)); const float ta = __builtin_bit_cast(float, __builtin_amdgcn_readlane(__builtin_bit_cast(int, ad), rr));
            wl += tw * wup[rr]; al += ta * aup[rr]; }
        const float wv = -softplusf_(-wl) - 0.5f, dec = __expf(-__expf(wv)), a = sigmoidf_(al);
        float kk = k * kkc; const float n2 = wave_sum(kk * kk); kk = kk / fmaxf(sqrtf(n2), 1e-12f);
        const float kd = k * (1.0f + (a - 1.0f) * kac), kka = kk * a;
        float yv = 0.f;
#pragma unroll
        for (int i = 0; i < 8; ++i) {
            const float sa = wave_sum(S[i] * kk);
            const float vi = __builtin_bit_cast(float, __builtin_amdgcn_readlane(__builtin_bit_cast(int, v), 8 * w + i));
            S[i] = S[i] * dec - sa * kka + vi * kd;
            const float y = wave_sum(S[i] * r);
            yv = (j == i) ? y : yv;
        }
        if (!isctx && j < 8) Yd[(size_t)t * DR + h * 64 + 8 * w + j] = yv;
    }
}

__device__ __forceinline__ int mb_off(int row, int ch) { return row * 1024 + ((ch ^ (((row & 3) << 1) | (((row >> 3) & 1) << 3))) << 4); }
__device__ __forceinline__ void p3_mixer_b(Frame& F, const KArgs& A, int chunk) {
    const int tok0 = chunk * 128, lane = F.lane, w = F.wave, fr = lane & 15, fq = lane >> 4;
    LAS unsigned char* const L = F.lds;
    const bf16* ZB = F_ZB;
    bf16x8 wf[4][4];
    { const bf16* sw = (const bf16*)(A.ws() + WS_SGW);
#pragma unroll
      for (int g = 0; g < 4; ++g)
#pragma unroll
          for (int ks = 0; ks < 4; ++ks) wf[g][ks] = *(const bf16x8*)(sw + (size_t)(g * 128 + 16 * w + fr) * 128 + 32 * ks + 8 * fq); }
    {
        const f32x4 lw0 = *(const f32x4*)(F_sg_ln_w + 8 * lane), lw1 = *(const f32x4*)(F_sg_ln_w + 8 * lane + 4), lb0 = *(const f32x4*)(F_sg_ln_b + 8 * lane), lb1 = *(const f32x4*)(F_sg_ln_b + 8 * lane + 4);
        const float lwv[8] = {lw0.x, lw0.y, lw0.z, lw0.w, lw1.x, lw1.y, lw1.z, lw1.w}, lbv[8] = {lb0.x, lb0.y, lb0.z, lb0.w, lb1.x, lb1.y, lb1.z, lb1.w};
#pragma unroll 4
        for (int rr = 0; rr < 16; ++rr) {
            const int q = w * 16 + rr;
            const u32x4 raw = *(const u32x4*)(ZB + (size_t)(tok0 + q) * 1024 + 512 + 8 * lane);
            float g[8]; g[0] = gelu_tanh(bflo(raw.x)); g[1] = gelu_tanh(bfhi(raw.x)); g[2] = gelu_tanh(bflo(raw.y)); g[3] = gelu_tanh(bfhi(raw.y));
            g[4] = gelu_tanh(bflo(raw.z)); g[5] = gelu_tanh(bfhi(raw.z)); g[6] = gelu_tanh(bflo(raw.w)); g[7] = gelu_tanh(bfhi(raw.w));
            float s = 0.f;
#pragma unroll
            for (int i = 0; i < 8; ++i) s += g[i];
            const float mean = wave_sum(s) * (1.0f / 512.0f); float s2 = 0.f;
#pragma unroll
            for (int i = 0; i < 8; ++i) { g[i] -= mean; s2 += g[i] * g[i]; }
            const float rstd = rsqrtf(wave_sum(s2) * (1.0f / 512.0f) + 1e-5f);
#pragma unroll
            for (int i = 0; i < 8; ++i) g[i] = g[i] * rstd * lwv[i] + lbv[i];
            u32x4 o; o.x = pk2(g[0], g[1]); o.y = pk2(g[2], g[3]); o.z = pk2(g[4], g[5]); o.w = pk2(g[6], g[7]);
            *(LAS u32x4*)(L + mb_off(q, lane)) = o;
        }
    }
    __syncthreads();
    const int qq = fr >> 2, pp = fr & 3;
#pragma unroll
    for (int g = 0; g < 4; ++g) {
        const int p = 16 * w + fr; const float sb = F_sg_b[g * 128 + p];
#pragma unroll 2
        for (int ct = 0; ct < 8; ++ct) {
            u32x2 tr[4][2];
            { unsigned ad[4][2];
#pragma unroll
              for (int ks = 0; ks < 4; ++ks)
#pragma unroll
                  for (int t = 0; t < 2; ++t) ad[ks][t] = (unsigned)mb_off(32 * ks + 8 * fq + 4 * t + qq, g * 16 + 2 * ct + (pp >> 1)) + 8u * (pp & 1);
              asm volatile("ds_read_b64_tr_b16 %0, %8\n\tds_read_b64_tr_b16 %1, %9\n\tds_read_b64_tr_b16 %2, %10\n\tds_read_b64_tr_b16 %3, %11\n\t"
                           "ds_read_b64_tr_b16 %4, %12\n\tds_read_b64_tr_b16 %5, %13\n\tds_read_b64_tr_b16 %6, %14\n\tds_read_b64_tr_b16 %7, %15\n\ts_waitcnt lgkmcnt(0)"
                           : "=&v"(tr[0][0]), "=&v"(tr[0][1]), "=&v"(tr[1][0]), "=&v"(tr[1][1]), "=&v"(tr[2][0]), "=&v"(tr[2][1]), "=&v"(tr[3][0]), "=&v"(tr[3][1])
                           : "v"(ad[0][0]), "v"(ad[0][1]), "v"(ad[1][0]), "v"(ad[1][1]), "v"(ad[2][0]), "v"(ad[2][1]), "v"(ad[3][0]), "v"(ad[3][1]) : "memory"); }
            pg8::f32x4 acc = (pg8::f32x4){0.f, 0.f, 0.f, 0.f};
#pragma unroll
            for (int ks = 0; ks < 4; ++ks) { u32x4 a; a.x = tr[ks][0].x; a.y = tr[ks][0].y; a.z = tr[ks][1].x; a.w = tr[ks][1].y;
                acc = __builtin_amdgcn_mfma_f32_16x16x32_bf16(__builtin_bit_cast(bf16x8, a), wf[g][ks], acc, 0, 0, 0); }
            const int c0 = 16 * ct + 4 * fq;
            const u32x2 uraw = *(const u32x2*)(ZB + (size_t)(tok0 + p) * 1024 + g * 128 + c0);
            const float u0 = gelu_tanh(bflo(uraw.x)), u1 = gelu_tanh(bfhi(uraw.x)), u2 = gelu_tanh(bflo(uraw.y)), u3 = gelu_tanh(bfhi(uraw.y));
            u32x2 o; o.x = pk2(u0 * (acc[0] + sb), u1 * (acc[1] + sb)); o.y = pk2(u2 * (acc[2] + sb), u3 * (acc[3] + sb));
            *(u32x2*)(F_YB + (size_t)(tok0 + p) * DR + g * 128 + c0) = o;
        }
    }
    __syncthreads();
}

__device__ __forceinline__ void p4_rwkv_out(Frame& F, const KArgs& A) {
    const int gw = blockIdx.x * 8 + F.wave, NGW = F.G * 8, l = F.lane, h = l >> 3;
    for (int t = gw; t < SEQ; t += NGW) {
        float y[8];
        { const f32x4 a0 = *(const f32x4*)(F_Y + (size_t)t * DR + 8 * l), a1 = *(const f32x4*)(F_Y + (size_t)t * DR + 8 * l + 4);
          const f32x4 b0 = *(const f32x4*)(F_Y + (size_t)(SEQ + t) * DR + 8 * l), b1 = *(const f32x4*)(F_Y + (size_t)(SEQ + t) * DR + 8 * l + 4);
          y[0] = a0.x + b0.x; y[1] = a0.y + b0.y; y[2] = a0.z + b0.z; y[3] = a0.w + b0.w; y[4] = a1.x + b1.x; y[5] = a1.y + b1.y; y[6] = a1.z + b1.z; y[7] = a1.w + b1.w; }
        float s = 0.f;
#pragma unroll
        for (int i = 0; i < 8; ++i) s += y[i];
        s += __shfl_xor(s, 1); s += __shfl_xor(s, 2); s += __shfl_xor(s, 4);
        const float mean = s * (1.0f / 64.0f); float s2 = 0.f;
#pragma unroll
        for (int i = 0; i < 8; ++i) { const float dlt = y[i] - mean; s2 += dlt * dlt; }
        s2 += __shfl_xor(s2, 1); s2 += __shfl_xor(s2, 2); s2 += __shfl_xor(s2, 4);
        const float rstd = rsqrtf(s2 * (1.0f / 64.0f) + GN_EPS);
        float r[8], k[8], v[8];
        mixed8(F_ZA, t, 8 * l, F_mu, r); mixed8(F_ZA, t, 512 + 8 * l, F_mu, k); mixed8(F_ZA, t, 1024 + 8 * l, F_mu, v);
        float dp = 0.f;
#pragma unroll
        for (int i = 0; i < 8; ++i) dp += r[i] * k[i] * F_r_k[8 * l + i];
        dp += __shfl_xor(dp, 1); dp += __shfl_xor(dp, 2); dp += __shfl_xor(dp, 4);
        const float sg0 = sigmoidf_(mixed_val(F_ZA, false, t, 1792 + 2 * l, F_mu[1792 + 2 * l])), sg1 = sigmoidf_(mixed_val(F_ZA, false, t, 1793 + 2 * l, F_mu[1793 + 2 * l]));
        float g[8];
#pragma unroll
        for (int i = 0; i < 8; ++i) g[i] = 0.f;
        for (int rr = 0; rr < 64; ++rr) {
            const float s0 = __shfl(sg0, rr), s1 = __shfl(sg1, rr);
            const f32x4 u0 = *(const f32x4*)(F_g_up + (size_t)(2 * rr) * DR + 8 * l), u1 = *(const f32x4*)(F_g_up + (size_t)(2 * rr) * DR + 8 * l + 4);
            const f32x4 w0 = *(const f32x4*)(F_g_up + (size_t)(2 * rr + 1) * DR + 8 * l), w1 = *(const f32x4*)(F_g_up + (size_t)(2 * rr + 1) * DR + 8 * l + 4);
            g[0] += s0 * u0.x + s1 * w0.x; g[1] += s0 * u0.y + s1 * w0.y; g[2] += s0 * u0.z + s1 * w0.z; g[3] += s0 * u0.w + s1 * w0.w;
            g[4] += s0 * u1.x + s1 * w1.x; g[5] += s0 * u1.y + s1 * w1.y; g[6] += s0 * u1.z + s1 * w1.z; g[7] += s0 * u1.w + s1 * w1.w;
        }
        float o[8];
#pragma unroll
        for (int i = 0; i < 8; ++i) { const float yn = (y[i] - mean) * rstd * F_ln_w[8 * l + i] + F_ln_b[8 * l + i]; o[i] = (yn + dp * v[i]) * g[i]; }
        u32x4 pk; pk.x = pk2(o[0], o[1]); pk.y = pk2(o[2], o[3]); pk.z = pk2(o[4], o[5]); pk.w = pk2(o[6], o[7]);
        *(u32x4*)(F_YA + (size_t)t * DR + 8 * l) = pk;
        (void)h;
    }
}

struct SchedStd {
    int nM, nN, G, c;
    __device__ __forceinline__ bool next(int i, pg8::Unit& u) const { const long L = (long)i * G + c; if (L >= (long)nM * nN) return false; static_tile((int)L, nM, nN, u); return true; }
    __device__ __forceinline__ void a_ready(const pg8::Unit&) const {}
    __device__ __forceinline__ void done(const pg8::Unit&) const {}
};
__device__ __forceinline__ void sig8(const bf16* p, float (&o)[8]) {
    const u32x4 raw = *(const u32x4*)p;
    o[0] = sigmoidf_(bflo(raw.x)); o[1] = sigmoidf_(bfhi(raw.x)); o[2] = sigmoidf_(bflo(raw.y)); o[3] = sigmoidf_(bfhi(raw.y));
    o[4] = sigmoidf_(bflo(raw.z)); o[5] = sigmoidf_(bfhi(raw.z)); o[6] = sigmoidf_(bflo(raw.w)); o[7] = sigmoidf_(bfhi(raw.w));
}
struct EpiMergeA {
    static constexpr bool PERM = true, AFTER_DRAIN = false;
    float* T; const bf16* ZG;
    __device__ __forceinline__ void operator()(const pg8::f32x4 (&acc)[2][2][4][2], const pg8::Unit& u, int wr, int wc, int fr, int fq) const {
        const int row0 = u.pm * 256 + wr * 64 + fr, col0 = u.pn * 256 + wc * 32 + 8 * fq;
#pragma unroll
        for (int ai = 0; ai < 2; ++ai)
#pragma unroll
            for (int m = 0; m < 4; ++m) { const size_t row = (size_t)(row0 + ai * 128 + m * 16);
#pragma unroll
                for (int bj = 0; bj < 2; ++bj) { const int col = col0 + bj * 128; float gt[8]; sig8(ZG + row * 2048 + col, gt);
                    const pg8::f32x4 v0 = acc[ai][bj][m][0], v1 = acc[ai][bj][m][1];
                    *(f32x4*)(T + row * D + col) = (f32x4){gt[0] * v0[0], gt[1] * v0[1], gt[2] * v0[2], gt[3] * v0[3]};
                    *(f32x4*)(T + row * D + col + 4) = (f32x4){gt[4] * v1[0], gt[5] * v1[1], gt[6] * v1[2], gt[7] * v1[3]}; } }
    }
};
struct EpiMergeB {
    static constexpr bool PERM = true, AFTER_DRAIN = false;
    const float* T; const bf16* ZG; bf16* MG;
    __device__ __forceinline__ void operator()(const pg8::f32x4 (&acc)[2][2][4][2], const pg8::Unit& u, int wr, int wc, int fr, int fq) const {
        const int row0 = u.pm * 256 + wr * 64 + fr, col0 = u.pn * 256 + wc * 32 + 8 * fq;
#pragma unroll
        for (int ai = 0; ai < 2; ++ai)
#pragma unroll
            for (int m = 0; m < 4; ++m) { const size_t row = (size_t)(row0 + ai * 128 + m * 16);
#pragma unroll
                for (int bj = 0; bj < 2; ++bj) { const int col = col0 + bj * 128; float gt[8]; sig8(ZG + row * 2048 + 1024 + col, gt);
                    const pg8::f32x4 v0 = acc[ai][bj][m][0], v1 = acc[ai][bj][m][1];
                    const f32x4 t0 = *(const f32x4*)(T + row * D + col), t1 = *(const f32x4*)(T + row * D + col + 4);
                    u32x4 w; w.x = pk2(t0.x + gt[0] * v0[0], t0.y + gt[1] * v0[1]); w.y = pk2(t0.z + gt[2] * v0[2], t0.w + gt[3] * v0[3]);
                    w.z = pk2(t1.x + gt[4] * v1[0], t1.y + gt[5] * v1[1]); w.w = pk2(t1.z + gt[6] * v1[2], t1.w + gt[7] * v1[3]);
                    *(u32x4*)(MG + row * D + col) = w; } }
    }
};
struct EpiX1 {
    static constexpr bool PERM = false, AFTER_DRAIN = false;
    const float* x; const float* gt1; float* out;
    __device__ __forceinline__ void operator()(const pg8::f32x4 (&acc)[2][2][4][2], const pg8::Unit& u, int wr, int wc, int fr, int fq) const {
        const int row0 = u.pm * 256 + wr * 64 + fr, col0 = u.pn * 256 + wc * 32 + 4 * fq;
#pragma unroll
        for (int ai = 0; ai < 2; ++ai)
#pragma unroll
            for (int m = 0; m < 4; ++m) { const size_t row = (size_t)(row0 + ai * 128 + m * 16);
#pragma unroll
                for (int bj = 0; bj < 2; ++bj)
#pragma unroll
                    for (int n = 0; n < 2; ++n) { const int col = col0 + bj * 128 + n * 16;
                        const f32x4 xv = *(const f32x4*)(x + row * D + col), gv = *(const f32x4*)(gt1 + col); const pg8::f32x4 a = acc[ai][bj][m][n];
                        *(f32x4*)(out + row * D + col) = (f32x4){xv.x + gv.x * a[0], xv.y + gv.y * a[1], xv.z + gv.z * a[2], xv.w + gv.w * a[3]}; } }
    }
};

__device__ __forceinline__ void route_decide(const float (&lg)[36], const float* grp_b, const float* exp_b, unsigned* ctl, unsigned* rt) {
    float gl[4]; int grp = 0;
#pragma unroll
    for (int q = 0; q < 4; ++q) gl[q] = lg[q] + grp_b[q];
#pragma unroll
    for (int q = 1; q < 4; ++q) if (gl[q] > gl[grp]) grp = q;
    float den = 0.f;
#pragma unroll
    for (int q = 0; q < 4; ++q) den += __expf(gl[q] - gl[grp]);
    const float pg = 1.0f / den;
    float el[8];
#pragma unroll
    for (int q = 0; q < 8; ++q) { float val = 0.f;
#pragma unroll
        for (int gq = 0; gq < 4; ++gq) val = (grp == gq) ? lg[4 + gq * 8 + q] + exp_b[gq * 8 + q] : val;
        el[q] = val; }
    int i1 = 0;
#pragma unroll
    for (int q = 1; q < 8; ++q) if (el[q] > el[i1]) i1 = q;
    int i2 = (i1 == 0) ? 1 : 0;
#pragma unroll
    for (int q = 0; q < 8; ++q) if (q != i1 && el[q] > el[i2]) i2 = q;
    const float v1 = el[i1], v2 = el[i2];
    const float e2 = __expf(v2 - v1), w1 = pg / (1.0f + e2), w2 = pg * e2 / (1.0f + e2);
    const int e1x = grp * 8 + i1, e2x = grp * 8 + i2;
    const unsigned p1 = atomicAdd(ctl + CW_CNT + 64 * e1x, 1u), p2 = atomicAdd(ctl + CW_CNT + 64 * e2x, 1u);
    rt[0] = (unsigned)e1x; rt[1] = p1; rt[2] = __builtin_bit_cast(unsigned, w1); rt[3] = (unsigned)e2x; rt[4] = p2; rt[5] = __builtin_bit_cast(unsigned, w2);
}
__device__ __forceinline__ void p7_router(Frame& F, const KArgs& A) {
    const int gw = blockIdx.x * 8 + F.wave, NGW = F.G * 8, lane = F.lane;
    const float* mod = F_MOD;
    { const f32x4* src = (const f32x4*)(A.ws() + WS_WRT); LAS f32x4* dst = (LAS f32x4*)F.lds;
      for (int i = F.tid; i < 36 * D / 4; i += 512) dst[i] = src[i]; }
    __syncthreads();
    const LAS f32x4* wl = (const LAS f32x4*)F.lds;
#ifndef ROUTER_REPS
#define ROUTER_REPS 1
#endif
    for (int rrep = 0; rrep < ROUTER_REPS; ++rrep)
    for (int tp = gw; tp < SEQ / 2; tp += NGW) {
        const int t0 = 2 * tp;
        const float* src0 = F_out + (size_t)t0 * D; const float* src1 = src0 + D;
        f32x4 h0[4], h1[4]; float ss0 = 0.f, ss1 = 0.f;
#pragma unroll
        for (int j = 0; j < 4; ++j) { h0[j] = ((const f32x4*)src0)[lane + 64 * j]; h1[j] = ((const f32x4*)src1)[lane + 64 * j];
            ss0 += (h0[j].x * h0[j].x + h0[j].y * h0[j].y) + (h0[j].z * h0[j].z + h0[j].w * h0[j].w); ss1 += (h1[j].x * h1[j].x + h1[j].y * h1[j].y) + (h1[j].z * h1[j].z + h1[j].w * h1[j].w); }
        const float r0 = rsqrtf(wave_sum(ss0) * (1.0f / D) + NORM_EPS), r1 = rsqrtf(wave_sum(ss1) * (1.0f / D) + NORM_EPS);
#pragma unroll
        for (int j = 0; j < 4; ++j) {
            const f32x4 gg = ((const f32x4*)F_norm2_g)[lane + 64 * j], s1 = ((const f32x4*)(mod + 4096))[lane + 64 * j], s0 = ((const f32x4*)(mod + 3072))[lane + 64 * j];
            const f32x4 gs = gg * (1.0f + s1);
            h0[j] = (h0[j] * r0) * gs + s0; h1[j] = (h1[j] * r1) * gs + s0;
            u32x2 o; o.x = pk2(h0[j].x, h0[j].y); o.y = pk2(h0[j].z, h0[j].w); ((u32x2*)(F_H + (size_t)t0 * D))[lane + 64 * j] = o;
            o.x = pk2(h1[j].x, h1[j].y); o.y = pk2(h1[j].z, h1[j].w); ((u32x2*)(F_H + (size_t)(t0 + 1) * D))[lane + 64 * j] = o;
        }
        LAS float* lgs = (LAS float*)(F.lds + 147456 + F.wave * 512);
#pragma unroll 2
        for (int e = 0; e < 36; ++e) {
            float a0 = 0.f, a1 = 0.f;
#pragma unroll
            for (int j = 0; j < 4; ++j) { const f32x4 wv = wl[e * 256 + lane + 64 * j];
                a0 += (h0[j].x * wv.x + h0[j].y * wv.y) + (h0[j].z * wv.z + h0[j].w * wv.w); a1 += (h1[j].x * wv.x + h1[j].y * wv.y) + (h1[j].z * wv.z + h1[j].w * wv.w); }
            const bool lo = lane < 32; float xk = lo ? a0 : a1; const float yk = lo ? a1 : a0;
            xk += __shfl_xor(yk, 32);
            xk += __shfl_xor(xk, 16); xk += __shfl_xor(xk, 8); xk += __shfl_xor(xk, 4); xk += __shfl_xor(xk, 2); xk += __shfl_xor(xk, 1);
            if ((lane & 31) == 0) lgs[(lane >> 5) * 36 + e] = xk;
        }
        LDS_WAIT();
        float lg[36];
        if ((lane & 31) == 0) {
#pragma unroll
            for (int q = 0; q < 9; ++q) { const f32x4 v4 = *(const LAS f32x4*)(lgs + (lane >> 5) * 36 + 4 * q); lg[4 * q] = v4.x; lg[4 * q + 1] = v4.y; lg[4 * q + 2] = v4.z; lg[4 * q + 3] = v4.w; }
        }
        if ((lane & 31) == 0 && rrep == ROUTER_REPS - 1) route_decide(lg, F_grp_b, F_exp_b, F.ctl, F_route + (size_t)(t0 + (lane >> 5)) * 8);
        if (rrep != ROUTER_REPS - 1) { float sink = 0.f; if ((lane & 31) == 0) { for (int q = 0; q < 36; ++q) sink += lg[q]; } asm volatile("" :: "v"(sink)); }
    }
    __syncthreads();
}
__device__ __forceinline__ void p7_moe_convert(Frame& F, const KArgs& A) {
    const int gw = blockIdx.x * 8 + F.wave, NGW = F.G * 8, lane = F.lane;
    {
    LAS float* scr = (LAS float*)(F.lds + F.wave * 16640);
    for (int it = gw; it < NEXP * 384; it += NGW) {
        const int e = it / 384; int r = it % 384;
        if (r < 256) { const bool up = r >= 128; r &= 127; const int kb = r >> 3, nb = r & 7, n0 = 64 * nb;
            const float* W = (up ? F_wu : F_wg) + (size_t)e * D * DEXP;
            transpose_item64(W, D, DEXP, 64 * kb, n0, F_WguT + (size_t)e * 1024 * D, 256 * (n0 >> 7) + (up ? 128 : 0) + (n0 & 127), scr, lane);
        } else { r -= 256; const int kb = r >> 4, nb = r & 15;
            transpose_item64(F_wd + (size_t)e * DEXP * D, DEXP, D, 64 * kb, 64 * nb, F_WdT + (size_t)e * 1024 * DEXP, 64 * nb, scr, lane); }
    }
    }
}

__device__ __forceinline__ int moe_tables(Frame& F, const KArgs& A) {
    LAS int* tab = (LAS int*)(F.lds + TAB_OFF);
    __syncthreads();
    if (F.tid < 64) {
        const int e = F.tid & 31;
        const int cnt = (int)__hip_atomic_load(F.ctl + CW_CNT + 64 * e, __ATOMIC_RELAXED, __HIP_MEMORY_SCOPE_AGENT);
        const int nt = (cnt + 255) >> 8;
        int incl = nt;
#pragma unroll
        for (int o = 1; o < 32; o <<= 1) { const int up = __shfl_up(incl, o); if (e >= o) incl += up; }
        const int off = incl - nt;
        if (F.tid < 32) { tab[e] = off * 256; tab[64 + e] = cnt; for (int q = 0; q < nt && off + q < MAXTILES; ++q) tab[128 + off + q] = e; if (e == 31) tab[32] = incl < MAXTILES ? incl : MAXTILES; }
    }
    __syncthreads();
    return tab[32];
}

__device__ __forceinline__ void p8_gather(Frame& F, const KArgs& A) {
    const int ntiles = moe_tables(F, A);
    LAS int* tab = (LAS int*)(F.lds + TAB_OFF);
    const int gw = blockIdx.x * 8 + F.wave, NGW = F.G * 8, lane = F.lane;
    for (int t = gw; t < SEQ; t += NGW) {
        const unsigned* rt = F_route + (size_t)t * 8;
        const u32x4 h0 = ((const u32x4*)(F_H + (size_t)t * D))[lane], h1 = ((const u32x4*)(F_H + (size_t)t * D))[lane + 64];
#pragma unroll
        for (int s = 0; s < 2; ++s) {
            const int e = (int)rt[3 * s], pos = (int)rt[3 * s + 1]; const int row = tab[e] + pos;
            if (row < MAXTILES * 256) {
                ((u32x4*)(F_XG + (size_t)row * D))[lane] = h0; ((u32x4*)(F_XG + (size_t)row * D))[lane + 64] = h1;
                if (lane == 0) { F_rowinfo[row] = 2 * t + s; F_roww[row] = __builtin_bit_cast(float, rt[3 * s + 2]); }
            }
        }
    }
    for (int e = blockIdx.x; e < NEXP; e += F.G) {
        const int cnt = tab[64 + e], r0 = tab[e] + cnt, r1 = tab[e] + (((cnt + 255) >> 8) << 8);
        for (int row = r0 + F.wave; row < r1 && row < MAXTILES * 256; row += 8) {
            ((u32x4*)(F_XG + (size_t)row * D))[lane] = (u32x4){0u, 0u, 0u, 0u}; ((u32x4*)(F_XG + (size_t)row * D))[lane + 64] = (u32x4){0u, 0u, 0u, 0u};
            if (lane == 0) { F_rowinfo[row] = -1; F_roww[row] = 0.f; }
        }
    }
    (void)ntiles;
}

struct MoeOrder {
    const LAS int* tile_e; int T4, G, c;
    __device__ __forceinline__ bool next(int i, pg8::Unit& u) const { const long L = (long)i * G + c; if (L >= T4) return false; const int rt = (int)(L >> 2), j = (int)(L & 3); u.pm = rt; u.pn = tile_e[rt] * 4 + j; return true; }
    __device__ __forceinline__ void a_ready(const pg8::Unit&) const {}
    __device__ __forceinline__ void done(const pg8::Unit&) const {}
};
struct EpiSwiGLU {
    static constexpr bool PERM = true, AFTER_DRAIN = false;
    bf16* HM;
    __device__ __forceinline__ void operator()(const pg8::f32x4 (&acc)[2][2][4][2], const pg8::Unit& u, int wr, int wc, int fr, int fq) const {
        const int row0 = u.pm * 256 + wr * 64 + fr, col0 = (u.pn & 3) * 128 + wc * 32 + 8 * fq;
#pragma unroll
        for (int ai = 0; ai < 2; ++ai)
#pragma unroll
            for (int m = 0; m < 4; ++m) { const size_t row = (size_t)(row0 + ai * 128 + m * 16);
                const pg8::f32x4 g0 = acc[ai][0][m][0], g1 = acc[ai][0][m][1], u0 = acc[ai][1][m][0], u1 = acc[ai][1][m][1];
                u32x4 w; w.x = pk2(siluf_(g0[0]) * u0[0], siluf_(g0[1]) * u0[1]); w.y = pk2(siluf_(g0[2]) * u0[2], siluf_(g0[3]) * u0[3]);
                w.z = pk2(siluf_(g1[0]) * u1[0], siluf_(g1[1]) * u1[1]); w.w = pk2(siluf_(g1[2]) * u1[2], siluf_(g1[3]) * u1[3]);
                *(u32x4*)(HM + row * DEXP + col0) = w; }
    }
};
struct EpiScatter {
    static constexpr bool PERM = true, AFTER_DRAIN = false;
    bf16* YBUF; const int* rowinfo; const float* roww;
    __device__ __forceinline__ void operator()(const pg8::f32x4 (&acc)[2][2][4][2], const pg8::Unit& u, int wr, int wc, int fr, int fq) const {
        const int row0 = u.pm * 256 + wr * 64 + fr, col0 = (u.pn & 3) * 256 + wc * 32 + 8 * fq;
#pragma unroll
        for (int ai = 0; ai < 2; ++ai)
#pragma unroll
            for (int m = 0; m < 4; ++m) { const int row = row0 + ai * 128 + m * 16; const int info = rowinfo[row]; const float wt = roww[row];
                if (info >= 0) {
#pragma unroll
                    for (int bj = 0; bj < 2; ++bj) { const pg8::f32x4 v0 = acc[ai][bj][m][0], v1 = acc[ai][bj][m][1];
                        u32x4 w; w.x = pk2(wt * v0[0], wt * v0[1]); w.y = pk2(wt * v0[2], wt * v0[3]); w.z = pk2(wt * v1[0], wt * v1[1]); w.w = pk2(wt * v1[2], wt * v1[3]);
                        *(u32x4*)(YBUF + (size_t)info * D + col0 + bj * 128) = w; } } }
    }
};

__device__ __forceinline__ void p11_final(Frame& F, const KArgs& A) {
    const int gw = blockIdx.x * 8 + F.wave, NGW = F.G * 8, lane = F.lane;
    const float* gt2 = F_MOD + 5120;
    for (int t = gw; t < SEQ; t += NGW) {
        float* row = F_out + (size_t)t * D;
        f32x4 v[4]; float ss = 0.f;
#pragma unroll
        for (int j = 0; j < 4; ++j) {
            const f32x4 x1 = ((const f32x4*)row)[lane + 64 * j], g2 = ((const f32x4*)gt2)[lane + 64 * j];
            const u32x2 y0 = ((const u32x2*)(F_YBUF + (size_t)(2 * t) * D))[lane + 64 * j], y1 = ((const u32x2*)(F_YBUF + (size_t)(2 * t + 1) * D))[lane + 64 * j];
            f32x4 ys; ys.x = bflo(y0.x) + bflo(y1.x); ys.y = bfhi(y0.x) + bfhi(y1.x); ys.z = bflo(y0.y) + bflo(y1.y); ys.w = bfhi(y0.y) + bfhi(y1.y);
            v[j] = x1 + g2 * ys;
            ss += (v[j].x * v[j].x + v[j].y * v[j].y) + (v[j].z * v[j].z + v[j].w * v[j].w);
        }
        const float rinv = rsqrtf(wave_sum(ss) * (1.0f / D) + NORM_EPS);
#pragma unroll
        for (int j = 0; j < 4; ++j) { const f32x4 fg = ((const f32x4*)F_fin_g)[lane + 64 * j]; ((f32x4*)row)[lane + 64 * j] = v[j] * rinv * fg; }
    }
}


constexpr int SL = 8192;
constexpr int SC_LBUF = 12 * SL;
constexpr int SC_MISC = 19 * SL;

__device__ __forceinline__ int sw_(int r) { return (r ^ (r >> 3)) & 7; }
__device__ __forceinline__ int m_off(int r, int c) { return r * 128 + (((c >> 3) ^ sw_(r)) << 4) + ((c & 7) << 1); }
__device__ __forceinline__ int frag_off(int r, int chunk) { return r * 128 + ((chunk ^ sw_(r)) << 4); }
__device__ __forceinline__ float tanh_fast(float x) { const float e = __expf(2.0f * x); return 1.0f - 2.0f * __builtin_amdgcn_rcpf(e + 1.0f); }

template <bool SWAP> __device__ __forceinline__ void mm_tiles(const LAS unsigned char* X, const LAS unsigned char* Y, int mt, int nt0, int fr, int fq, pg8::f32x4 (&acc)[2]) {
#pragma unroll
    for (int ks = 0; ks < 2; ++ks) {
        const bf16x8 xf = *(const LAS bf16x8*)(X + frag_off(16 * mt + fr, 4 * ks + fq));
#pragma unroll
        for (int n = 0; n < 2; ++n) {
            const bf16x8 yf = *(const LAS bf16x8*)(Y + frag_off(16 * (nt0 + n) + fr, 4 * ks + fq));
            acc[n] = SWAP ? __builtin_amdgcn_mfma_f32_16x16x32_bf16(yf, xf, acc[n], 0, 0, 0) : __builtin_amdgcn_mfma_f32_16x16x32_bf16(xf, yf, acc[n], 0, 0, 0);
        }
    }
}
__device__ __forceinline__ void st4(LAS unsigned char* slot, int r, int c, float a, float b, float cc, float d) { u32x2 o; o.x = pk2(a, b); o.y = pk2(cc, d); *(LAS u32x2*)(slot + m_off(r, c)) = o; }
__device__ __forceinline__ pg8::f32x4 ld4(const LAS unsigned char* slot, int r, int c) { const u32x2 w = *(const LAS u32x2*)(slot + m_off(r, c)); return (pg8::f32x4){bflo(w.x), bfhi(w.x), bflo(w.y), bfhi(w.y)}; }
__device__ __forceinline__ int opq(int x) { asm volatile("" : "+v"(x)); return x; }
struct LanePat { int x[2], y[2][2], nat[2], tr[2]; };
__device__ __forceinline__ void lane_pat(LanePat& P, int mt, int nt0, int fr, int fq) {
#pragma unroll
    for (int ks = 0; ks < 2; ++ks) { P.x[ks] = frag_off(16 * mt + fr, 4 * ks + fq);
#pragma unroll
        for (int n = 0; n < 2; ++n) P.y[n][ks] = frag_off(16 * (nt0 + n) + fr, 4 * ks + fq); }
#pragma unroll
    for (int n = 0; n < 2; ++n) { P.nat[n] = m_off(16 * mt + fr, 16 * (nt0 + n) + 4 * fq); P.tr[n] = m_off(16 * (nt0 + n) + fr, 16 * mt + 4 * fq); }
}
template <bool SWAP> __device__ __forceinline__ void mm_o(const LAS unsigned char* X, const LAS unsigned char* Y, const LanePat& P, pg8::f32x4 (&acc)[2]) {
#pragma unroll
    for (int ks = 0; ks < 2; ++ks) {
        const bf16x8 xf = *(const LAS bf16x8*)(X + P.x[ks]);
#pragma unroll
        for (int n = 0; n < 2; ++n) {
            const bf16x8 yf = *(const LAS bf16x8*)(Y + P.y[n][ks]);
            acc[n] = SWAP ? __builtin_amdgcn_mfma_f32_16x16x32_bf16(yf, xf, acc[n], 0, 0, 0) : __builtin_amdgcn_mfma_f32_16x16x32_bf16(xf, yf, acc[n], 0, 0, 0);
        }
    }
}
__device__ __forceinline__ void st4o(LAS unsigned char* slot, int off, float a, float b, float cc, float d) { u32x2 o; o.x = pk2(a, b); o.y = pk2(cc, d); *(LAS u32x2*)(slot + off) = o; }
__device__ __forceinline__ pg8::f32x4 ld4o(const LAS unsigned char* slot, int off) { const u32x2 w = *(const LAS u32x2*)(slot + off); return (pg8::f32x4){bflo(w.x), bfhi(w.x), bflo(w.y), bfhi(w.y)}; }
#ifndef P1REP
#define P1REP 0
#endif
#define P1R(b) for (int q_ = 0; q_ < (((P1REP >> (b)) & 1) ? 2 : 1); ++q_)
#define ZERO2(a) do { a[0] = (pg8::f32x4){0.f, 0.f, 0.f, 0.f}; a[1] = (pg8::f32x4){0.f, 0.f, 0.f, 0.f}; } while (0)

__device__ __forceinline__ void mix8(const bf16* Z, int col0, const float* mu, int dl, int dr, int du, int dd, bool okl, bool okr, bool oku, bool okd, float (&o)[8]) {
    const u32x4 z = *(const u32x4*)(Z + col0);
    const u32x4 l = *(const u32x4*)(Z + col0 + dl * 2048), r = *(const u32x4*)(Z + col0 + dr * 2048), up = *(const u32x4*)(Z + col0 + du * 2048), dn = *(const u32x4*)(Z + col0 + dd * 2048);
    const f32x4 m0 = *(const f32x4*)(mu + col0), m1 = *(const f32x4*)(mu + col0 + 4);
    float zz[8], nn[8];
    zz[0] = bflo(z.x); zz[1] = bfhi(z.x); zz[2] = bflo(z.y); zz[3] = bfhi(z.y); zz[4] = bflo(z.z); zz[5] = bfhi(z.z); zz[6] = bflo(z.w); zz[7] = bfhi(z.w);
    nn[0] = okl ? bflo(l.x) : 0.f; nn[1] = okr ? bfhi(r.x) : 0.f; nn[2] = oku ? bflo(up.y) : 0.f; nn[3] = okd ? bfhi(dn.y) : 0.f;
    nn[4] = okl ? bflo(l.z) : 0.f; nn[5] = okr ? bfhi(r.z) : 0.f; nn[6] = oku ? bflo(up.w) : 0.f; nn[7] = okd ? bfhi(dn.w) : 0.f;
    const float mm[8] = {m0.x, m0.y, m0.z, m0.w, m1.x, m1.y, m1.z, m1.w};
#pragma unroll
    for (int i = 0; i < 8; ++i) o[i] = zz[i] + mm[i] * (nn[i] - zz[i]);
}
__device__ __forceinline__ void mix4(const bf16* Z, int col0, const float* mu, int dl, int dr, int du, int dd, bool okl, bool okr, bool oku, bool okd, float (&o)[4]) {
    const u32x2 z = *(const u32x2*)(Z + col0);
    const u32x2 l = *(const u32x2*)(Z + col0 + dl * 2048), r = *(const u32x2*)(Z + col0 + dr * 2048), up = *(const u32x2*)(Z + col0 + du * 2048), dn = *(const u32x2*)(Z + col0 + dd * 2048);
    const f32x4 m0 = *(const f32x4*)(mu + col0);
    const float zz[4] = {bflo(z.x), bfhi(z.x), bflo(z.y), bfhi(z.y)};
    const float nn[4] = {okl ? bflo(l.x) : 0.f, okr ? bfhi(r.x) : 0.f, oku ? bflo(up.y) : 0.f, okd ? bfhi(dn.y) : 0.f};
    const float mm[4] = {m0.x, m0.y, m0.z, m0.w};
#pragma unroll
    for (int i = 0; i < 4; ++i) o[i] = zz[i] + mm[i] * (nn[i] - zz[i]);
}

__device__ __forceinline__ void scan_pass1_unit(Frame& F, const KArgs& A, int chain, int scidx, int cj) {
    const int d = chain >> 3, h = chain & 7, tid = F.tid, lane = F.lane, w = F.wave, fr = lane & 15, fq = lane >> 4, mt = w >> 1, nt0 = 2 * (w & 1);
    LAS unsigned char* const L = F.lds;
    LanePat P; lane_pat(P, mt, nt0, fr, fq);
#define S_(i) (L + opq((i) * SL))
    const bool isctx = (scidx == 0); const int sc = scidx - 1;
    const bf16* ZA = F_ZA; const float* mu = F_mu;
    { const int r = tid >> 3, ch = tid & 7; u32x4 idv = (u32x4){0u, 0u, 0u, 0u};
      if ((r >> 3) == ch) { const unsigned one = 0x3f80u; const int e = r & 7; if (e == 0) idv.x = one; else if (e == 1) idv.x = one << 16; else if (e == 2) idv.y = one; else if (e == 3) idv.y = one << 16; else if (e == 4) idv.z = one; else if (e == 5) idv.z = one << 16; else if (e == 6) idv.w = one; else idv.w = one << 16; }
      *(LAS u32x4*)(S_(14) + frag_off(r, ch)) = idv; *(LAS u32x4*)(S_(16) + frag_off(r, ch)) = (u32x4){0u, 0u, 0u, 0u}; }
    int ppc = 14, qpc = 16;
    const int jbeg = isctx ? cj : 0, jend = isctx ? cj + 1 : 4;
    for (int j = jbeg; j < jend; ++j) {
        const int ppn = ppc ^ 1, qpn = qpc ^ 1;
        const int t = tid >> 3, cg = tid & 7, x = d ? 63 - t : t;
        int tokchunk; const bf16* Z; int dl, dr, du, dd; bool okl, okr, oku, okd;
        if (isctx) { tokchunk = d ? 3 - j : j; const int tc = tokchunk * 64 + x; Z = ZA + (size_t)(SEQ + tc) * 2048; okl = tc > 0; okr = tc < CTXL - 1; oku = okl; okd = okr; dl = okl ? -1 : 0; dr = okr ? 1 : 0; du = dl; dd = dr; }
        else { tokchunk = d ? 255 - (4 * sc + j) : 4 * sc + j; const int tok = tokchunk * 64 + x; Z = ZA + (size_t)tok * 2048; okl = x > 0; okr = x < 63; oku = tokchunk > 0; okd = tokchunk < GROWS - 1; dl = okl ? -1 : 0; dr = okr ? 1 : 0; du = oku ? -64 : 0; dd = okd ? 64 : 0; }
        float rv[8], kv[8];
        P1R(0) {
            float vv[8], wdv[8], adv[8];
            mix8(Z, h * 64 + 8 * cg, mu, dl, dr, du, dd, okl, okr, oku, okd, rv);
            mix8(Z, 512 + h * 64 + 8 * cg, mu, dl, dr, du, dd, okl, okr, oku, okd, kv);
            mix8(Z, 1024 + h * 64 + 8 * cg, mu, dl, dr, du, dd, okl, okr, oku, okd, vv);
            mix8(Z, 1536 + d * 64 + 8 * cg, mu, dl, dr, du, dd, okl, okr, oku, okd, wdv);
            mix8(Z, 1664 + d * 64 + 8 * cg, mu, dl, dr, du, dd, okl, okr, oku, okd, adv);
#pragma unroll
            for (int i = 0; i < 8; ++i) *(LAS bf16*)(S_(7) + m_off(8 * cg + i, t)) = (bf16)f2bf(vv[i]);
            u32x4 o; o.x = pk2(tanh_fast(wdv[0]), tanh_fast(wdv[1])); o.y = pk2(tanh_fast(wdv[2]), tanh_fast(wdv[3])); o.z = pk2(tanh_fast(wdv[4]), tanh_fast(wdv[5])); o.w = pk2(tanh_fast(wdv[6]), tanh_fast(wdv[7]));
            *(LAS u32x4*)(S_(8) + frag_off(t, cg)) = o;
            o.x = pk2(adv[0], adv[1]); o.y = pk2(adv[2], adv[3]); o.z = pk2(adv[4], adv[5]); o.w = pk2(adv[6], adv[7]);
            *(LAS u32x4*)(S_(9) + frag_off(t, cg)) = o;
            const bf16* wt = (const bf16*)(A.ws() + WS_WUPT) + (size_t)chain * 4096, *at = (const bf16*)(A.ws() + WS_AUPT) + (size_t)chain * 4096;
            *(LAS u32x4*)(S_(10) + frag_off(t, cg)) = *(const u32x4*)(wt + t * 64 + 8 * cg);
            *(LAS u32x4*)(S_(11) + frag_off(t, cg)) = *(const u32x4*)(at + t * 64 + 8 * cg);
        }
        __syncthreads();
        P1R(1) {
            pg8::f32x4 acw[2], aca[2]; ZERO2(acw); ZERO2(aca);
            mm_o<false>(S_(8), S_(10), P, acw);
            mm_o<true>(S_(9), S_(11), P, aca);
            const int row = 16 * mt + fr;
            LAS float* lb = (LAS float*)(L + opq(SC_LBUF)); LAS float* tot = (LAS float*)(L + opq(SC_MISC));
#pragma unroll
            for (int n = 0; n < 2; ++n) {
                const int cc = 16 * (nt0 + n) + fr; const float w0c = F_w0[d * DR + h * 64 + cc];
                float p[4];
#pragma unroll
                for (int i = 0; i < 4; ++i) p[i] = -0.6065306597126334f * sigmoidf_(acw[n][i] + w0c);
                p[1] += p[0]; p[2] += p[1]; p[3] += p[2];
                float inc = p[3]; { const float u1 = __shfl_up(inc, 16); inc += (fq >= 1) ? u1 : 0.f; const float u2 = __shfl_up(inc, 32); inc += (fq >= 2) ? u2 : 0.f; }
                const float exc = inc - p[3];
#pragma unroll
                for (int i = 0; i < 4; ++i) lb[(16 * mt + 4 * fq + i) * 64 + cc] = p[i] + exc;
                if (fq == 3) tot[mt * 64 + cc] = inc;
                const int c0 = 16 * (nt0 + n) + 4 * fq; const f32x4 a0v = *(const f32x4*)(F_a0 + d * DR + h * 64 + c0);
                st4o(S_(18), P.nat[n], sigmoidf_(aca[n][0] + a0v[0]), sigmoidf_(aca[n][1] + a0v[1]), sigmoidf_(aca[n][2] + a0v[2]), sigmoidf_(aca[n][3] + a0v[3]));
            }
        }
        __syncthreads();
        P1R(2) {
            const LAS float* lb = (const LAS float*)(L + opq(SC_LBUF));
            float Lt[8], Lp[8], LC[8], av[8];
            { const LAS float* tot = (const LAS float*)(L + opq(SC_MISC));
              f32x4 tb[4][2];
#pragma unroll
              for (int m = 0; m < 4; ++m) { tb[m][0] = *(const LAS f32x4*)(tot + m * 64 + 8 * cg); tb[m][1] = *(const LAS f32x4*)(tot + m * 64 + 8 * cg + 4); }
              const int mtt = t >> 4;
              const f32x4 a0 = *(const LAS f32x4*)(lb + t * 64 + 8 * cg), a1 = *(const LAS f32x4*)(lb + t * 64 + 8 * cg + 4);
              const int tp = t > 0 ? t - 1 : 0; const f32x4 b0 = *(const LAS f32x4*)(lb + tp * 64 + 8 * cg), b1 = *(const LAS f32x4*)(lb + tp * 64 + 8 * cg + 4);
              const bool first = (t & 15) == 0;
#pragma unroll
              for (int i = 0; i < 4; ++i) {
                  const float o0 = (mtt > 0 ? tb[0][0][i] : 0.f) + (mtt > 1 ? tb[1][0][i] : 0.f) + (mtt > 2 ? tb[2][0][i] : 0.f), o1 = (mtt > 0 ? tb[0][1][i] : 0.f) + (mtt > 1 ? tb[1][1][i] : 0.f) + (mtt > 2 ? tb[2][1][i] : 0.f);
                  Lt[i] = a0[i] + o0; Lt[4 + i] = a1[i] + o1; Lp[i] = first ? o0 : b0[i] + o0; Lp[4 + i] = first ? o1 : b1[i] + o1;
                  LC[i] = (tb[0][0][i] + tb[1][0][i]) + (tb[2][0][i] + tb[3][0][i]); LC[4 + i] = (tb[0][1][i] + tb[1][1][i]) + (tb[2][1][i] + tb[3][1][i]); }
              const u32x4 aw = *(const LAS u32x4*)(S_(18) + frag_off(t, cg));
              av[0] = bflo(aw.x); av[1] = bfhi(aw.x); av[2] = bflo(aw.y); av[3] = bfhi(aw.y); av[4] = bflo(aw.z); av[5] = bfhi(aw.z); av[6] = bflo(aw.w); av[7] = bfhi(aw.w); }
            const int cb = h * 64 + 8 * cg;
            const f32x4 kk0 = *(const f32x4*)(F_k_k + cb), kk1 = *(const f32x4*)(F_k_k + cb + 4), ka0 = *(const f32x4*)(F_k_a + cb), ka1 = *(const f32x4*)(F_k_a + cb + 4);
            const float kkc[8] = {kk0.x, kk0.y, kk0.z, kk0.w, kk1.x, kk1.y, kk1.z, kk1.w}, kac[8] = {ka0.x, ka0.y, ka0.z, ka0.w, ka1.x, ka1.y, ka1.z, ka1.w};
            float kkv[8], n2 = 0.f;
#pragma unroll
            for (int i = 0; i < 8; ++i) { kkv[i] = kv[i] * kkc[i]; n2 += kkv[i] * kkv[i]; }
            n2 += __shfl_xor(n2, 1); n2 += __shfl_xor(n2, 2); n2 += __shfl_xor(n2, 4);
            const float inv = __builtin_amdgcn_rcpf(fmaxf(__builtin_amdgcn_sqrtf(n2), 1e-12f));
            float kb[8], rb[8], ah[8], kh[8], ahc[8], khc[8];
#pragma unroll
            for (int i = 0; i < 8; ++i) { const float kk = kkv[i] * inv, al = kk * av[i], kt = kv[i] * (1.0f + (av[i] - 1.0f) * kac[i]);
                const float ep = __expf(Lp[i]), et = __expf(Lt[i]), en = __expf(-Lt[i]), ec = __expf(LC[i] - Lt[i]);
                kb[i] = kk * ep; rb[i] = rv[i] * et; ah[i] = al * en; kh[i] = kt * en; ahc[i] = al * ec; khc[i] = kt * ec; }
            u32x4 o;
            o.x = pk2(kb[0], kb[1]); o.y = pk2(kb[2], kb[3]); o.z = pk2(kb[4], kb[5]); o.w = pk2(kb[6], kb[7]); *(LAS u32x4*)(S_(0) + frag_off(t, cg)) = o;
            o.x = pk2(rb[0], rb[1]); o.y = pk2(rb[2], rb[3]); o.z = pk2(rb[4], rb[5]); o.w = pk2(rb[6], rb[7]); *(LAS u32x4*)(S_(1) + frag_off(t, cg)) = o;
            o.x = pk2(ah[0], ah[1]); o.y = pk2(ah[2], ah[3]); o.z = pk2(ah[4], ah[5]); o.w = pk2(ah[6], ah[7]); *(LAS u32x4*)(S_(2) + frag_off(t, cg)) = o;
            o.x = pk2(kh[0], kh[1]); o.y = pk2(kh[2], kh[3]); o.z = pk2(kh[4], kh[5]); o.w = pk2(kh[6], kh[7]); *(LAS u32x4*)(S_(3) + frag_off(t, cg)) = o;
#pragma unroll
            for (int i = 0; i < 8; ++i) { *(LAS bf16*)(S_(4) + m_off(8 * cg + i, t)) = (bf16)f2bf(kb[i]); *(LAS bf16*)(S_(5) + m_off(8 * cg + i, t)) = (bf16)f2bf(ahc[i]); *(LAS bf16*)(S_(6) + m_off(8 * cg + i, t)) = (bf16)f2bf(khc[i]); }
            if (t == 0) { LAS float* gam = (LAS float*)(L + opq(SC_MISC) + 2048);
#pragma unroll
                for (int i = 0; i < 8; ++i) gam[8 * cg + i] = __expf(LC[i]); }
        }
        __syncthreads();
        P1R(3) {
            pg8::f32x4 a1[2], a2[2]; ZERO2(a1); ZERO2(a2);
            mm_o<true>(S_(0), S_(2), P, a1);
            mm_o<false>(S_(0), S_(2), P, a2);
#pragma unroll
            for (int n = 0; n < 2; ++n) {
                { const int tt = 16 * mt + fr, s0 = 16 * (nt0 + n) + 4 * fq; float m[4], t0[4];
#pragma unroll
                  for (int i = 0; i < 4; ++i) { m[i] = (s0 + i < tt) ? -a1[n][i] : 0.f; t0[i] = m[i] + ((s0 + i == tt) ? 1.0f : 0.f); }
                  st4o(S_(8), P.nat[n], m[0], m[1], m[2], m[3]); st4o(S_(18), P.nat[n], t0[0], t0[1], t0[2], t0[3]); }
                { const int t0r = 16 * mt + 4 * fq, ss = 16 * (nt0 + n) + fr; float m[4];
#pragma unroll
                  for (int i = 0; i < 4; ++i) m[i] = (ss < t0r + i) ? -a2[n][i] : 0.f;
                  st4o(S_(9), P.tr[n], m[0], m[1], m[2], m[3]); }
            }
            ZERO2(a1); ZERO2(a2);
            mm_o<true>(S_(0), S_(3), P, a1);
            mm_o<true>(S_(1), S_(2), P, a2);
            pg8::f32x4 a3[2]; ZERO2(a3);
            mm_o<true>(S_(1), S_(3), P, a3);
#pragma unroll
            for (int n = 0; n < 2; ++n) { const int tt = 16 * mt + fr, s0 = 16 * (nt0 + n) + 4 * fq; float u[4], v2[4], v3[4];
#pragma unroll
                for (int i = 0; i < 4; ++i) { u[i] = (s0 + i < tt) ? a1[n][i] : 0.f; v2[i] = (s0 + i <= tt) ? a2[n][i] : 0.f; v3[i] = (s0 + i <= tt) ? a3[n][i] : 0.f; }
                st4o(S_(10), P.nat[n], u[0], u[1], u[2], u[3]); st4o(S_(11), P.nat[n], v2[0], v2[1], v2[2], v2[3]); st4o(S_(12), P.nat[n], v3[0], v3[1], v3[2], v3[3]); }
        }
        __syncthreads();
        P1R(4) {
            pg8::f32x4 a1[2], a2[2], a3[2]; ZERO2(a1); ZERO2(a2); ZERO2(a3);
            mm_o<false>(S_(10), S_(7), P, a1);
            mm_o<true>(S_(8), S_(9), P, a2);
            mm_o<false>(S_(8), S_(9), P, a3);
#pragma unroll
            for (int n = 0; n < 2; ++n) {
                st4o(S_(13), P.tr[n], a1[n][0], a1[n][1], a1[n][2], a1[n][3]);
                st4o(S_(0), P.nat[n], a2[n][0], a2[n][1], a2[n][2], a2[n][3]);
                st4o(S_(2), P.tr[n], a3[n][0], a3[n][1], a3[n][2], a3[n][3]); }
        }
        __syncthreads();
#pragma unroll
        for (int k = 1; k <= 5; ++k) {
            const int pc = (k & 1) ? 0 : 8, pct = (k & 1) ? 2 : 9, pn = (k & 1) ? 8 : 0, pnt = (k & 1) ? 9 : 2, tc = (k & 1) ? 18 : 10, tn = (k & 1) ? 10 : 18;
            P1R(5) {
            pg8::f32x4 a1[2], a2[2], a3[2];
#pragma unroll
            for (int n = 0; n < 2; ++n) a1[n] = ld4o(S_(tc), P.nat[n]);
            mm_o<true>(S_(tc), S_(pct), P, a1);
            if (k < 5) { ZERO2(a2); ZERO2(a3); mm_o<true>(S_(pc), S_(pct), P, a2); mm_o<false>(S_(pc), S_(pct), P, a3); }
#pragma unroll
            for (int n = 0; n < 2; ++n) {
                st4o(S_(tn), P.nat[n], a1[n][0], a1[n][1], a1[n][2], a1[n][3]);
                if (k < 5) { st4o(S_(pn), P.nat[n], a2[n][0], a2[n][1], a2[n][2], a2[n][3]);
                             st4o(S_(pnt), P.tr[n], a3[n][0], a3[n][1], a3[n][2], a3[n][3]); } }
            __syncthreads();
            }
        }
        P1R(6) {
            pg8::f32x4 a1[2], a2[2]; ZERO2(a1); ZERO2(a2);
            mm_o<false>(S_(10), S_(4), P, a1);
            mm_o<false>(S_(10), S_(13), P, a2);
#pragma unroll
            for (int n = 0; n < 2; ++n) {
                st4o(S_(8), P.tr[n], -a1[n][0], -a1[n][1], -a1[n][2], -a1[n][3]);
                st4o(S_(9), P.tr[n], -a2[n][0], -a2[n][1], -a2[n][2], -a2[n][3]); }
        }
        __syncthreads();
        pg8::f32x4 accY[2];
        P1R(7) {
            pg8::f32x4 a1[2], a2[2], a3[2];
#pragma unroll
            for (int n = 0; n < 2; ++n) a1[n] = ld4o(S_(1), P.nat[n]);
            mm_o<true>(S_(11), S_(8), P, a1);
            ZERO2(accY); mm_o<true>(S_(12), S_(7), P, accY); mm_o<true>(S_(11), S_(9), P, accY);
            ZERO2(a2); mm_o<true>(S_(5), S_(8), P, a2);
            ZERO2(a3); mm_o<true>(S_(7), S_(6), P, a3); mm_o<true>(S_(9), S_(5), P, a3);
            const LAS float* gam = (const LAS float*)(L + opq(SC_MISC) + 2048);
#pragma unroll
            for (int n = 0; n < 2; ++n) { const int rr = 16 * mt + fr, c0 = 16 * (nt0 + n) + 4 * fq;
                st4o(S_(0), P.nat[n], a1[n][0], a1[n][1], a1[n][2], a1[n][3]);
                const float gj = gam[rr];
                st4o(S_(2), P.nat[n], a2[n][0] + (c0 + 0 == rr ? gj : 0.f), a2[n][1] + (c0 + 1 == rr ? gj : 0.f), a2[n][2] + (c0 + 2 == rr ? gj : 0.f), a2[n][3] + (c0 + 3 == rr ? gj : 0.f));
                st4o(S_(3), P.nat[n], a3[n][0], a3[n][1], a3[n][2], a3[n][3]); }
        }
        __syncthreads();
        {
            pg8::f32x4 a1[2], a2[2], a3[2]; ZERO2(a1);
            mm_o<true>(S_(0), S_(ppc), P, a1);
            mm_o<true>(S_(0), S_(qpc), P, accY);
            ZERO2(a2); mm_o<true>(S_(ppc), S_(2), P, a2);
#pragma unroll
            for (int n = 0; n < 2; ++n) a3[n] = ld4o(S_(3), P.nat[n]);
            mm_o<true>(S_(qpc), S_(2), P, a3);
            if (!isctx) {
                const int tt = 16 * mt + fr, xr = d ? 63 - tt : tt;
                bf16* gy = (bf16*)(A.ws() + WS_GY) + ((size_t)chain * 256 + tokchunk) * 8192;
#pragma unroll
                for (int n = 0; n < 2; ++n) { const int c0 = 16 * (nt0 + n) + 4 * fq; u32x2 o;
                    o.x = pk2(a1[n][0], a1[n][1]); o.y = pk2(a1[n][2], a1[n][3]); *(u32x2*)(gy + xr * 64 + c0) = o;
                    o.x = pk2(accY[n][0], accY[n][1]); o.y = pk2(accY[n][2], accY[n][3]); *(u32x2*)(gy + 4096 + xr * 64 + c0) = o; }
            }
            if (j < jend - 1) {
#pragma unroll
                for (int n = 0; n < 2; ++n) { const int rr = 16 * mt + fr, c0 = 16 * (nt0 + n) + 4 * fq;
                    st4o(S_(ppn), P.nat[n], a2[n][0], a2[n][1], a2[n][2], a2[n][3]); st4o(S_(qpn), P.nat[n], a3[n][0], a3[n][1], a3[n][2], a3[n][3]); }
            } else {
                pg8::f32x4 a4[2]; ZERO2(a4); mm_o<false>(S_(ppc), S_(2), P, a4);
                bf16* pq = isctx ? (bf16*)(A.ws() + WS_PQC) + ((size_t)chain * 4 + cj) * 8192 : (bf16*)(A.ws() + WS_PQ) + ((size_t)chain * 65 + scidx) * 8192;
#pragma unroll
                for (int n = 0; n < 2; ++n) { u32x2 o;
                    o.x = pk2(a4[n][0], a4[n][1]); o.y = pk2(a4[n][2], a4[n][3]); *(u32x2*)(pq + (16 * (nt0 + n) + fr) * 64 + 16 * mt + 4 * fq) = o;
                    o.x = pk2(a3[n][0], a3[n][1]); o.y = pk2(a3[n][2], a3[n][3]); *(u32x2*)(pq + 4096 + (16 * mt + fr) * 64 + 16 * (nt0 + n) + 4 * fq) = o; }
            }
        }
        __syncthreads();
        ppc = ppn; qpc = qpn;
    }
#undef S_
}

__device__ __forceinline__ void scan_chain(Frame& F, const KArgs& A, int chain) {
    const int w = F.wave, lane = F.lane, fr = lane & 15, fq = lane >> 4;
    const bf16* pq = (const bf16*)(A.ws() + WS_PQ) + (size_t)chain * 65 * 8192;
    const bf16* pqc = (const bf16*)(A.ws() + WS_PQC) + (size_t)chain * 4 * 8192;
    bf16* s0 = (bf16*)(A.ws() + WS_S0) + (size_t)chain * 64 * 4096;
    LAS unsigned char* const L = F.lds;
    const int vb = w & 3, v = 16 * vb + fr;
    pg8::f32x4 st[4];
#pragma unroll
    for (int it = 0; it < 4; ++it) st[it] = (pg8::f32x4){0.f, 0.f, 0.f, 0.f};
    if (w >= 4) {
        const bf16* src = pqc + (size_t)(w - 4) * 8192; LAS unsigned char* dst = L + (w - 4) * 16384;
#pragma unroll
        for (int i = 0; i < 16; ++i) { const int ci = i * 64 + lane, half = ci >> 9, row = (ci >> 3) & 63, ch = ci & 7;
            *(LAS u32x4*)(dst + half * 8192 + frag_off(row, ch)) = *(const u32x4*)(src + ci * 8); }
    }
    __syncthreads();
    for (int b = 0; b < 17; ++b) {
        if (w >= 4) {
            if (b + 1 < 17) { const bf16* src = pq + (size_t)(1 + 4 * b + (w - 4)) * 8192; LAS unsigned char* dst = L + ((b + 1) & 1) * 65536 + (w - 4) * 16384;
                u32x4 tmp[16];
#pragma unroll
                for (int i = 0; i < 16; ++i) tmp[i] = *(const u32x4*)(src + (i * 64 + lane) * 8);
#pragma unroll
                for (int i = 0; i < 16; ++i) { const int ci = i * 64 + lane, half = ci >> 9, row = (ci >> 3) & 63, ch = ci & 7; *(LAS u32x4*)(dst + half * 8192 + frag_off(row, ch)) = tmp[i]; } }
        } else {
#pragma unroll 1
            for (int s = 0; s < 4; ++s) {
                const int g = 4 * b + s, sc = g - 4;
                if (sc >= 0) {
#pragma unroll
                    for (int it = 0; it < 4; ++it) { u32x2 o; o.x = pk2(st[it][0], st[it][1]); o.y = pk2(st[it][2], st[it][3]); *(u32x2*)(s0 + (size_t)sc * 4096 + v * 64 + 16 * it + 4 * fq) = o; }
                }
                if (g < 67) {
                    const LAS unsigned char* P = L + (b & 1) * 65536 + s * 16384; const LAS unsigned char* Q = P + 8192;
                    bf16x8 bfrag[2];
#pragma unroll
                    for (int ks = 0; ks < 2; ++ks) { u32x4 bb; bb.x = pk2(st[2 * ks][0], st[2 * ks][1]); bb.y = pk2(st[2 * ks][2], st[2 * ks][3]); bb.z = pk2(st[2 * ks + 1][0], st[2 * ks + 1][1]); bb.w = pk2(st[2 * ks + 1][2], st[2 * ks + 1][3]); bfrag[ks] = __builtin_bit_cast(bf16x8, bb); }
                    pg8::f32x4 nw[4];
#pragma unroll
                    for (int jt = 0; jt < 4; ++jt) { nw[jt] = ld4(Q, v, 16 * jt + 4 * fq);
#pragma unroll
                        for (int ks = 0; ks < 2; ++ks) { const u32x2 a0 = *(const LAS u32x2*)(P + m_off(16 * jt + fr, 32 * ks + 4 * fq)), a1 = *(const LAS u32x2*)(P + m_off(16 * jt + fr, 32 * ks + 16 + 4 * fq));
                            u32x4 a; a.x = a0.x; a.y = a0.y; a.z = a1.x; a.w = a1.y;
                            nw[jt] = __builtin_amdgcn_mfma_f32_16x16x32_bf16(__builtin_bit_cast(bf16x8, a), bfrag[ks], nw[jt], 0, 0, 0); } }
#pragma unroll
                    for (int jt = 0; jt < 4; ++jt) st[jt] = nw[jt];
                }
            }
        }
        __syncthreads();
    }
}

__device__ __forceinline__ void scan_pass2_chunk(Frame& F, const KArgs& A, int c) {
    const int tid = F.tid, lane = F.lane, w = F.wave, fr = lane & 15, fq = lane >> 4;
    LAS unsigned char* const L = F.lds;
#define S_(i) (L + opq((i) * SL))
    const bf16* ZA = F_ZA; const float* mu = F_mu;
    const bf16* gy0 = (const bf16*)(A.ws() + WS_GY) + (size_t)c * 8192;
    const bf16* s0f0 = (const bf16*)(A.ws() + WS_S0) + (size_t)(c >> 2) * 4096;
    const bf16* s0b0 = (const bf16*)(A.ws() + WS_S0) + (size_t)(8 * 64 + ((255 - c) >> 2)) * 4096;
    const bf16* gut0 = (const bf16*)(A.ws() + WS_GUPT);
    const int r = tid >> 3, ch = tid & 7;
    {
        const int tok = c * 64 + r; const bf16* Z = ZA + (size_t)tok * 2048;
        const bool okl = r > 0, okr = r < 63, oku = c > 0, okd = c < GROWS - 1; const int dl = okl ? -1 : 0, dr = okr ? 1 : 0, du = oku ? -64 : 0, dd = okd ? 64 : 0;
#pragma unroll
        for (int half = 0; half < 2; ++half) { float g8[8]; const int col = 16 * ch + 8 * half; mix8(Z, 1792 + col, mu, dl, dr, du, dd, okl, okr, oku, okd, g8);
            u32x4 o; o.x = pk2(sigmoidf_(g8[0]), sigmoidf_(g8[1])); o.y = pk2(sigmoidf_(g8[2]), sigmoidf_(g8[3])); o.z = pk2(sigmoidf_(g8[4]), sigmoidf_(g8[5])); o.w = pk2(sigmoidf_(g8[6]), sigmoidf_(g8[7]));
            *(LAS u32x4*)(S_(6 + (col >> 6)) + frag_off(r, (col & 63) >> 3)) = o; }
    }
    u32x4 pf[6];
#define P2_LOAD(hh) do { const bf16* gf = gy0 + (size_t)(hh) * 256 * 8192, *gb = gy0 + (size_t)(8 + (hh)) * 256 * 8192; \
        pf[0] = *(const u32x4*)(gf + r * 64 + 8 * ch); pf[1] = *(const u32x4*)(gb + r * 64 + 8 * ch); \
        pf[2] = *(const u32x4*)(s0f0 + (size_t)(hh) * 64 * 4096 + r * 64 + 8 * ch); pf[3] = *(const u32x4*)(s0b0 + (size_t)(hh) * 64 * 4096 + r * 64 + 8 * ch); \
        pf[4] = *(const u32x4*)(gut0 + (size_t)(hh) * 8192 + r * 128 + 8 * ch); pf[5] = *(const u32x4*)(gut0 + (size_t)(hh) * 8192 + r * 128 + 64 + 8 * ch); } while (0)
    P2_LOAD(0);
    const int mt2 = w & 3, tt = 16 * mt2 + fr, tok = c * 64 + tt;
#pragma unroll 1
    for (int h = 0; h < 8; ++h) {
#pragma unroll
        for (int i = 0; i < 6; ++i) *(LAS u32x4*)(S_(i) + frag_off(r, ch)) = pf[i];
        __syncthreads();
        if (h < 7) P2_LOAD(h + 1);
        pg8::f32x4 y[4];
        if (w >= 4) {
            const int mt = w - 4;
#pragma unroll
            for (int np = 0; np < 2; ++np) { pg8::f32x4 g[2]; ZERO2(g);
                mm_tiles<true>(S_(6), S_(4), mt, 2 * np, fr, fq, g); mm_tiles<true>(S_(7), S_(5), mt, 2 * np, fr, fq, g);
#pragma unroll
                for (int n = 0; n < 2; ++n) *(LAS f32x4*)(L + opq(8 * SL) + ((16 * mt + fr) * 64 + 16 * (2 * np + n) + 4 * fq) * 4) = (f32x4){g[n][0], g[n][1], g[n][2], g[n][3]}; }
            const int t2 = tid - 256, tq = t2 >> 2, qc = t2 & 3, tk = c * 64 + tq; const bf16* Z = ZA + (size_t)tk * 2048;
            const bool okl = tq > 0, okr = tq < 63, oku = c > 0, okd = c < GROWS - 1; const int dl = okl ? -1 : 0, dr = okr ? 1 : 0, du = oku ? -64 : 0, dd = okd ? 64 : 0;
            float dp = 0.f;
#pragma unroll
            for (int half = 0; half < 2; ++half) { const int cc = h * 64 + 16 * qc + 8 * half; float r8[8], k8[8], v8[8];
                mix8(Z, cc, mu, dl, dr, du, dd, okl, okr, oku, okd, r8); mix8(Z, 512 + cc, mu, dl, dr, du, dd, okl, okr, oku, okd, k8); mix8(Z, 1024 + cc, mu, dl, dr, du, dd, okl, okr, oku, okd, v8);
                const f32x4 rk0 = *(const f32x4*)(F_r_k + cc), rk1 = *(const f32x4*)(F_r_k + cc + 4);
                dp += r8[0] * k8[0] * rk0.x + r8[1] * k8[1] * rk0.y + r8[2] * k8[2] * rk0.z + r8[3] * k8[3] * rk0.w + r8[4] * k8[4] * rk1.x + r8[5] * k8[5] * rk1.y + r8[6] * k8[6] * rk1.z + r8[7] * k8[7] * rk1.w;
                u32x4 o; o.x = pk2(v8[0], v8[1]); o.y = pk2(v8[2], v8[3]); o.z = pk2(v8[4], v8[5]); o.w = pk2(v8[6], v8[7]);
                *(LAS u32x4*)(S_(10) + frag_off(tq, 2 * qc + half)) = o; }
            dp += __shfl_xor(dp, 1); dp += __shfl_xor(dp, 2);
            if (qc == 0) ((LAS float*)(L + opq(SC_MISC)))[tq] = dp;
        } else {
            const bf16* gyf = gy0 + (size_t)h * 256 * 8192, *gyb = gy0 + (size_t)(8 + h) * 256 * 8192;
#pragma unroll
            for (int np = 0; np < 2; ++np) { pg8::f32x4 a[2];
#pragma unroll
                for (int n = 0; n < 2; ++n) { const int c0 = 16 * (2 * np + n) + 4 * fq; const u32x2 yf = *(const u32x2*)(gyf + 4096 + tt * 64 + c0), yb = *(const u32x2*)(gyb + 4096 + tt * 64 + c0);
                    a[n] = (pg8::f32x4){bflo(yf.x) + bflo(yb.x), bfhi(yf.x) + bfhi(yb.x), bflo(yf.y) + bflo(yb.y), bfhi(yf.y) + bfhi(yb.y)}; }
                mm_tiles<true>(S_(0), S_(2), mt2, 2 * np, fr, fq, a); mm_tiles<true>(S_(1), S_(3), mt2, 2 * np, fr, fq, a);
                y[2 * np] = a[0]; y[2 * np + 1] = a[1]; }
        }
        __syncthreads();
        if (w < 4) {
            float s = 0.f;
#pragma unroll
            for (int n = 0; n < 4; ++n) s += (y[n][0] + y[n][1]) + (y[n][2] + y[n][3]);
            s += __shfl_xor(s, 16); s += __shfl_xor(s, 32);
            const float mean = s * (1.0f / 64.0f); float s2 = 0.f;
#pragma unroll
            for (int n = 0; n < 4; ++n)
#pragma unroll
                for (int i = 0; i < 4; ++i) { const float dlt = y[n][i] - mean; s2 += dlt * dlt; }
            s2 += __shfl_xor(s2, 16); s2 += __shfl_xor(s2, 32);
            const float rstd = rsqrtf(s2 * (1.0f / 64.0f) + GN_EPS);
            const float dp = ((const LAS float*)(L + opq(SC_MISC)))[tt];
#pragma unroll
            for (int n = 0; n < 4; ++n) { const int cl = 16 * n + 4 * fq, cc = h * 64 + cl;
                const f32x4 lw = *(const f32x4*)(F_ln_w + cc), lb = *(const f32x4*)(F_ln_b + cc);
                const f32x4 g = *(const LAS f32x4*)(L + opq(8 * SL) + (tt * 64 + cl) * 4);
                const pg8::f32x4 vv = ld4(S_(10), tt, cl);
                float o[4];
#pragma unroll
                for (int i = 0; i < 4; ++i) { const float yn = (y[n][i] - mean) * rstd * lw[i] + lb[i]; o[i] = (yn + dp * vv[i]) * g[i]; }
                u32x2 pk; pk.x = pk2(o[0], o[1]); pk.y = pk2(o[2], o[3]);
                *(u32x2*)(F_YA + (size_t)tok * DR + cc) = pk; }
        }
    }
    __syncthreads();
#undef P2_LOAD
#undef S_
}

__global__ void __launch_bounds__(512, 2) fwd(Args AA) {
    extern __shared__ __attribute__((aligned(16))) unsigned char lds_raw[];
    Frame F;
    F.lds = (LAS unsigned char*)lds_raw;
    F.tid = threadIdx.x; F.lane = F.tid & 63; F.wave = __builtin_amdgcn_readfirstlane(F.tid >> 6); F.G = gridDim.x;
    F.ws = AA.ws; F.in = nullptr; F.ctl = (unsigned*)(AA.ws + WS_CTL);

    for (int u = F.tid; u < (LDS_BYTES - MISC_OFF) / 4; u += 512) ((LAS unsigned*)(F.lds + MISC_OFF))[u] = 0u;
    __syncthreads();
    XcdBarrier bar; bar.bar = F.ctl + CW_BAR; bar.x = 0; bar.st = nullptr;
    if (!MK_LAUNCH_PER_PHASE) bar = xcd_barrier_post(F.ctl + CW_BAR, (volatile LAS unsigned*)(F.lds + MISC_OFF));
    const int lo = AA.ph_lo, hi = AA.ph_hi;
#ifndef ONLY_PHASE
#define ONLY_PHASE -1
#endif
#define IN(k) ((ONLY_PHASE < 0 || ONLY_PHASE == (k)) && lo <= (k) && (k) < hi)
#define FRESH() do { int t_ = threadIdx.x; asm volatile("" : "+v"(t_)); F.tid = t_; F.lane = t_ & 63; } while (0)
#ifndef REP_MASK
#define REP_MASK 0
#endif
#define REPS(k) (((REP_MASK >> (k)) & 1) ? 2 : 1)
#define SEAM(k) do { if (!MK_LAUNCH_PER_PHASE && IN(k) && IN((k) + 1)) xcd_barrier(bar); } while (0)

    if (IN(0)) for (int rep_ = 0; rep_ < REPS(0); ++rep_) { FRESH(); FRESH_KA(A); p0_prologue(F, A); } SEAM(0);
    if (IN(1)) for (int rep_ = 0; rep_ < REPS(1); ++rep_) { FRESH(); FRESH_KA(A); p1_norm1(F, A); } SEAM(1);
    if (IN(2)) for (int rep_ = 0; rep_ < REPS(2); ++rep_) { FRESH(); FRESH_KA(A);
        pg8::Gemm g{F_H, F_WinT, MTOT, NPAD, D}; Sched1 S{F.G, (int)blockIdx.x}; EpiZ E{F_ZA, F_ZB, F_ZG};
        pg8::gemm_phase<EpiZ, Sched1, true, true>(F.lds, g, S, E);
    } SEAM(2);
#ifndef SCAN_NAIVE
#define SCAN_NAIVE 0
#endif
    if (IN(3)) for (int rep_ = 0; rep_ < REPS(3); ++rep_) { FRESH(); FRESH_KA(A);
#if SCAN_NAIVE
        if (blockIdx.x < 16) p3_scan_naive(F, A, (int)blockIdx.x);
        else for (int ch = (int)blockIdx.x - 16; ch < SEQ / 128; ch += F.G - 16) p3_mixer_b(F, A, ch);
#else
        if (F.G == 256) {
            const int xcd = (int)blockIdx.x & 7, slot = (int)blockIdx.x >> 3, chain = slot & 15;
            for (int r = 0; r < 4; ++r) { const int tsc = 16 * r + 2 * xcd + (slot >> 4); scan_pass1_unit(F, A, chain, 1 + ((chain >> 3) ? 63 - tsc : tsc), -1); }
        } else for (int u = (int)blockIdx.x; u < 16 * 64; u += F.G) scan_pass1_unit(F, A, u & 15, 1 + (u >> 4), -1);
        if (blockIdx.x >= F.G - 64) { const int u = (int)blockIdx.x - (F.G - 64); scan_pass1_unit(F, A, u & 15, 0, u >> 4); }
#endif
    } SEAM(3);
    if (IN(4)) for (int rep_ = 0; rep_ < REPS(4); ++rep_) { FRESH(); FRESH_KA(A);
#if !SCAN_NAIVE
#ifndef P4REP
#define P4REP 0
#endif
        if (blockIdx.x < 16) {
            for (int q_ = 0; q_ < ((P4REP & 1) ? 2 : 1); ++q_) scan_chain(F, A, (int)blockIdx.x); }
        else for (int q_ = 0; q_ < ((P4REP & 2) ? 2 : 1); ++q_) for (int ch = (int)blockIdx.x - 16; ch < SEQ / 128; ch += F.G - 16) p3_mixer_b(F, A, ch);
#endif
    } SEAM(4);
    if (IN(5)) for (int rep_ = 0; rep_ < REPS(5); ++rep_) { FRESH(); FRESH_KA(A);
#if SCAN_NAIVE
        p4_rwkv_out(F, A);
#else
        for (int c = (int)blockIdx.x; c < 256; c += F.G) scan_pass2_chunk(F, A, c);
#endif
    } SEAM(5);
    if (IN(6)) for (int rep_ = 0; rep_ < REPS(6); ++rep_) { FRESH(); FRESH_KA(A);
        SchedStd S{64, 4, F.G, (int)blockIdx.x};
        { pg8::Gemm g{F_YA, F_WaT, SEQ, D, DR}; EpiMergeA E{F_Y, F_ZG}; pg8::gemm_phase<EpiMergeA, SchedStd, true, true>(F.lds, g, S, E); }
        __syncthreads();
        { pg8::Gemm g{F_YB, F_WbT, SEQ, D, DR}; EpiMergeB E{F_Y, F_ZG, F_MG}; pg8::gemm_phase<EpiMergeB, SchedStd, true, true>(F.lds, g, S, E); }
    } SEAM(6);
    if (IN(7)) for (int rep_ = 0; rep_ < REPS(7); ++rep_) { FRESH(); FRESH_KA(A);
        SchedStd S{64, 4, F.G, (int)blockIdx.x};
        pg8::Gemm g{F_MG, F_WoutT, SEQ, D, D}; EpiX1 E{F_x, F_MOD + 2048, F_out}; pg8::gemm_phase<EpiX1, SchedStd, true, true>(F.lds, g, S, E);
    } SEAM(7);
#ifndef CONV_REPS
#define CONV_REPS 1
#endif
    if (IN(8)) { FRESH(); FRESH_KA(A); p7_router(F, A); for (int rep_ = 0; rep_ < CONV_REPS; ++rep_) { p7_moe_convert(F, A); __syncthreads(); } } SEAM(8);
    if (IN(9)) for (int rep_ = 0; rep_ < REPS(9); ++rep_) { FRESH(); FRESH_KA(A); p8_gather(F, A); } SEAM(9);
    if (IN(10)) for (int rep_ = 0; rep_ < REPS(10); ++rep_) { FRESH(); FRESH_KA(A);
        const int ntiles = moe_tables(F, A);
        MoeOrder S{(const LAS int*)(F.lds + TAB_OFF) + 128, ntiles * 4, F.G, (int)blockIdx.x};
        pg8::Gemm g{F_XG, F_WguT, MAXTILES * 256, NEXP * 1024, D}; EpiSwiGLU E{F_HMID};
        pg8::gemm_phase<EpiSwiGLU, MoeOrder, true, true>(F.lds, g, S, E);
    } SEAM(10);
    if (IN(11)) for (int rep_ = 0; rep_ < REPS(11); ++rep_) { FRESH(); FRESH_KA(A);
        const int ntiles = moe_tables(F, A);
        MoeOrder S{(const LAS int*)(F.lds + TAB_OFF) + 128, ntiles * 4, F.G, (int)blockIdx.x};
        pg8::Gemm g{F_HMID, F_WdT, MAXTILES * 256, NEXP * 1024, DEXP}; EpiScatter E{F_YBUF, F_rowinfo, F_roww};
        pg8::gemm_phase<EpiScatter, MoeOrder, true, true>(F.lds, g, S, E);
    } SEAM(11);
    if (IN(12)) for (int rep_ = 0; rep_ < REPS(12); ++rep_) { FRESH(); FRESH_KA(A); p11_final(F, A); }
#undef IN
#undef SEAM
}

extern "C" void kernel_launch(void* const* d_in, const int* in_sizes, int n_in, void* d_out, int out_size, void* d_ws, size_t ws_size, hipStream_t stream) {
    static int grid = 0;
    if (grid == 0) {
        if (n_in != 35 || in_sizes[0] != SEQ * D || out_size != SEQ * D || ws_size < WS_END) {
            fprintf(stderr, "kernel_launch: unexpected shapes: n_in %d in0 %d out %d ws %zu (need %zu); nothing launched\n", n_in, n_in > 0 ? in_sizes[0] : -1, out_size, ws_size, (size_t)WS_END); grid = -1; return; }
        int dev = 0, cus = 0, per_cu = 0;
        if (hipGetDevice(&dev) != hipSuccess || hipDeviceGetAttribute(&cus, hipDeviceAttributeMultiprocessorCount, dev) != hipSuccess) { grid = -1; return; }
        if (hipFuncSetAttribute((const void*)fwd, hipFuncAttributeMaxDynamicSharedMemorySize, LDS_BYTES) != hipSuccess) { fprintf(stderr, "kernel_launch: hipFuncSetAttribute failed\n"); grid = -1; return; }
        if (hipOccupancyMaxActiveBlocksPerMultiprocessor(&per_cu, (const void*)fwd, 512, LDS_BYTES) != hipSuccess || per_cu < 1) fprintf(stderr, "kernel_launch: occupancy query says %d\n", per_cu);
        (void)hipGetLastError();
        grid = cus;
    }
    if (grid < 0) return;
    if (hipMemsetAsync((char*)d_ws + WS_CTL, 0, CTL_ZERO_BYTES, stream) != hipSuccess) return;
    Args a{};
    for (int i = 0; i < 35; ++i) a.in[i] = (const float*)d_in[i];
    a.out = (float*)d_out; a.ws = (unsigned char*)d_ws;
#if MK_LAUNCH_PER_PHASE
    for (int p = 0; p < NPHASE; ++p) { a.ph_lo = p; a.ph_hi = p + 1; hipLaunchKernelGGL(fwd, dim3(grid), dim3(512), LDS_BYTES, stream, a); }
#else
#ifndef MK_PH_HI
#define MK_PH_HI NPHASE
#endif
    a.ph_lo = 0; a.ph_hi = MK_PH_HI;
    hipLaunchKernelGGL(fwd, dim3(grid), dim3(512), LDS_BYTES, stream, a);
#endif
}
```

```cpp
#include <hip/hip_runtime.h>
#include <cstdio>
#include <cstdint>
namespace pg8 {
#define PG8_LAS __attribute__((address_space(3)))
typedef unsigned short bf16_t;
typedef short bf16x8 __attribute__((ext_vector_type(8)));
typedef float f32x4 __attribute__((ext_vector_type(4)));
typedef unsigned u32x4 __attribute__((ext_vector_type(4)));
constexpr int BM = 256, BK = 64, HALF = 128, HTB = HALF * BK * 2  , STAGE_BYTES = 8 * HTB, NXCD = 8, WGM = 8;

__host__ __device__ __forceinline__ int lds_byte(int r, int c) { const int st = (r >> 4) * 2 + (c >> 5), rr = r & 15, cc = c & 31, ob = rr * 64 + cc * 2; return st * 1024 + (ob ^ (((ob >> 9) & 1) << 5)); }
__host__ __device__ __forceinline__ void stage_rc(int b, int& R, int& C) { const int st = b / 1024, sb = b % 1024, swz = sb ^ (((sb >> 9) & 1) << 5); R = (st >> 1) * 16 + swz / 64; C = (st & 1) * 32 + (swz % 64) / 2; }
__host__ __device__ __forceinline__ int perm32(int rho) { const int n = rho >> 4, i = rho & 15; return 8 * (i >> 2) + 4 * n + (i & 3); }

struct Unit { int pm, pn; };
struct Gemm { const bf16_t* A; const bf16_t* Bt; int M, N, K; };

struct StaticOrder {
    int nM, nN, nwg, G, c;
    __host__ __device__ void init(int M, int N, int G_, int c_) { nM = M / BM; nN = N / BM; nwg = nM * nN; G = G_; c = c_; }
    __host__ __device__ bool next(int i, Unit& u) const {
        const long L = (long)i * G + c; if (L >= nwg) return false;
        int wgid = (int)L; { const int q = nwg / NXCD, r = nwg % NXCD, xcd = wgid % NXCD, off = wgid / NXCD; wgid = (xcd < r ? xcd * (q + 1) : r * (q + 1) + (xcd - r) * q) + off; }
        const int nig = WGM * nN, gid = wgid / nig, fm = gid * WGM, gsz = (nM - fm) < WGM ? (nM - fm) : WGM;
        u.pm = fm + ((wgid % nig) % gsz); u.pn = (wgid % nig) / gsz; return true;
    }
    __device__ __forceinline__ void a_ready(const Unit&) const {}
    __device__ __forceinline__ void done(const Unit&) const {}
};

__device__ __forceinline__ unsigned cvt_pk_bf16(float lo, float hi) { unsigned r; asm volatile("v_cvt_pk_bf16_f32 %0, %1, %2" : "=v"(r) : "v"(lo), "v"(hi)); return r; }
template <class Epi, class Sched, bool ALIGN_EPI = false, bool SP2 = false>
__device__ __forceinline__ void gemm_phase(PG8_LAS unsigned char* lds, const Gemm g, const Sched& S, const Epi& E) {
    int tid_ = threadIdx.x; asm volatile("" : "+v"(tid_));
    const int tid = tid_, wid = __builtin_amdgcn_readfirstlane(tid >> 6), lane = tid & 63, wr = wid >> 2, wc = wid & 3, fr = lane & 15, fq = lane >> 4;
    const int K = g.K, nt = K / BK;
    unsigned voffA[2], voffB[2];
#pragma unroll
    for (int i = 0; i < 2; ++i) { int R, C; stage_rc(tid * 16 + i * 8192, R, C); const int Rb = Epi::PERM ? ((R & ~31) + perm32(R & 31)) : R;
        voffA[i] = (unsigned)(R * K + C) * 2u; voffB[i] = (unsigned)(Rb * K + C) * 2u; }
    const size_t kstep = (size_t)(BK * 2);
    const size_t hstep = (size_t)HALF * K * 2;
    const size_t tstep = 2 * hstep;
    const unsigned ldsw = (unsigned)wid * 1024u;
    const int aoff = lds_byte(wr * 64 + fr, fq * 8), boff = lds_byte(wc * 32 + fr, fq * 8);
#define PG8_SA(b, h) (((b) * 2 + (h)) * HTB)
#define PG8_SB(b, h) ((4 + (b) * 2 + (h)) * HTB)
#define PG8_STAGE(bufoff, gbase, voff) do { _Pragma("unroll") for (int _i = 0; _i < 2; ++_i) \
        __builtin_amdgcn_global_load_lds((const unsigned*)((const char*)(gbase) + (voff)[_i]), (PG8_LAS unsigned*)(lds + (bufoff) + ldsw + _i * 8192), 16, 0, 0); } while (0)
#define PG8_LDA(dst, b, h) do { _Pragma("unroll") for (int m = 0; m < 4; ++m) _Pragma("unroll") for (int k = 0; k < 2; ++k) dst[m][k] = *(const PG8_LAS bf16x8*)(lds + PG8_SA(b, h) + aoff + m * 2048 + k * 1024); } while (0)
#define PG8_LDB(dst, b, h) do { _Pragma("unroll") for (int n = 0; n < 2; ++n) _Pragma("unroll") for (int k = 0; k < 2; ++k) dst[n][k] = *(const PG8_LAS bf16x8*)(lds + PG8_SB(b, h) + boff + n * 2048 + k * 1024); } while (0)
#define PG8_MMA(ai, bj, At, Bt) do { __builtin_amdgcn_s_setprio(1); _Pragma("unroll") for (int m = 0; m < 4; ++m) _Pragma("unroll") for (int n = 0; n < 2; ++n) _Pragma("unroll") for (int k = 0; k < 2; ++k) \
        acc[ai][bj][m][n] = __builtin_amdgcn_mfma_f32_16x16x32_bf16(Bt[n][k], At[m][k], acc[ai][bj][m][n], 0, 0, 0); __builtin_amdgcn_s_setprio(0); } while (0)
#define PG8_WAIT_V(n) asm volatile("s_waitcnt vmcnt(" #n ")" ::: "memory")
#define PG8_WAIT_L(n) asm volatile("s_waitcnt lgkmcnt(" #n ")" ::: "memory")
#define PG8_BAR __builtin_amdgcn_s_barrier()
#define PG8_SCHED __builtin_amdgcn_sched_barrier(0)
    Unit cur, nxt; int ui = 0;
    if (!S.next(0, cur)) return;
    f32x4 acc[2][2][4][2];
#pragma unroll
    for (int a = 0; a < 2; ++a)
#pragma unroll
        for (int b = 0; b < 2; ++b)
#pragma unroll
            for (int m = 0; m < 4; ++m)
#pragma unroll
                for (int n = 0; n < 2; ++n) acc[a][b][m][n] = (f32x4){0.f, 0.f, 0.f, 0.f};
    bf16x8 At[4][2], B0[2][2], B1[2][2];
    const char* cA = (const char*)g.A + (size_t)cur.pm * tstep; const char* cB = (const char*)g.Bt + (size_t)cur.pn * tstep;
    S.a_ready(cur);
    if constexpr (SP2) {
        PG8_STAGE(PG8_SB(0, 0), cB, voffB); PG8_STAGE(PG8_SB(0, 1), cB + hstep, voffB); PG8_STAGE(PG8_SA(0, 0), cA, voffA); PG8_STAGE(PG8_SA(0, 1), cA + hstep, voffA);
        if (wr == 1) PG8_BAR;
        PG8_WAIT_V(2); PG8_BAR;
        PG8_STAGE(PG8_SB(1, 0), cB + kstep, voffB); PG8_STAGE(PG8_SA(1, 0), cA + kstep, voffA); PG8_STAGE(PG8_SB(1, 1), cB + hstep + kstep, voffB);
        PG8_WAIT_V(6); PG8_BAR;
    } else {
        PG8_STAGE(PG8_SB(0, 0), cB, voffB); PG8_STAGE(PG8_SA(0, 0), cA, voffA); PG8_STAGE(PG8_SB(0, 1), cB + hstep, voffB); PG8_STAGE(PG8_SA(0, 1), cA + hstep, voffA);
        if (wr == 1) PG8_BAR;
        PG8_WAIT_V(4); PG8_BAR;
        PG8_STAGE(PG8_SB(1, 0), cB + kstep, voffB); PG8_STAGE(PG8_SA(1, 0), cA + kstep, voffA); PG8_STAGE(PG8_SB(1, 1), cB + hstep + kstep, voffB);
        PG8_WAIT_V(6); PG8_BAR;
    }
    for (;;) {
        const bool has_next = S.next(ui + 1, nxt);
        const char* nA = has_next ? (const char*)g.A + (size_t)nxt.pm * tstep : cA; const char* nB = has_next ? (const char*)g.Bt + (size_t)nxt.pn * tstep : cB;
        for (int t = 0; t < nt; t += 2) {
            const bool last = (t == nt - 2);
            const char* a1 = cA + (size_t)(t + 1) * kstep;
            const char* a2 = last ? nA : cA + (size_t)(t + 2) * kstep; const char* b2 = last ? nB : cB + (size_t)(t + 2) * kstep;
            const char* a3 = a2 + kstep; const char* b3 = b2 + kstep;
            if (last && has_next) S.a_ready(nxt);
            if constexpr (SP2) {
            PG8_LDB(B0, 0, 0); PG8_LDB(B1, 0, 1); PG8_SCHED; PG8_LDA(At, 0, 0); PG8_STAGE(PG8_SA(1, 1), a1 + hstep, voffA);
            PG8_WAIT_V(8); PG8_WAIT_L(0); PG8_BAR; PG8_MMA(0, 0, At, B0); PG8_MMA(0, 1, At, B1); PG8_BAR; PG8_SCHED;
            PG8_LDA(At, 0, 1); PG8_STAGE(PG8_SB(0, 0), b2, voffB); PG8_STAGE(PG8_SB(0, 1), b2 + hstep, voffB); PG8_STAGE(PG8_SA(0, 0), a2, voffA);
            PG8_WAIT_V(8); PG8_WAIT_L(0); PG8_BAR; PG8_MMA(1, 0, At, B0); PG8_MMA(1, 1, At, B1); PG8_BAR; PG8_SCHED;
            PG8_LDB(B0, 1, 0); PG8_LDB(B1, 1, 1); PG8_SCHED; PG8_LDA(At, 1, 0); PG8_STAGE(PG8_SA(0, 1), a2 + hstep, voffA);
            PG8_WAIT_V(8); PG8_WAIT_L(0); PG8_BAR; PG8_MMA(0, 0, At, B0); PG8_MMA(0, 1, At, B1); PG8_BAR; PG8_SCHED;
            PG8_LDA(At, 1, 1); PG8_STAGE(PG8_SB(1, 0), b3, voffB); PG8_STAGE(PG8_SB(1, 1), b3 + hstep, voffB); PG8_STAGE(PG8_SA(1, 0), a3, voffA);
            PG8_WAIT_V(8); PG8_WAIT_L(0); PG8_BAR; PG8_MMA(1, 0, At, B0); PG8_MMA(1, 1, At, B1); PG8_BAR; PG8_SCHED;
            } else {
            PG8_LDB(B0, 0, 0); PG8_SCHED; PG8_LDA(At, 0, 0); PG8_STAGE(PG8_SA(1, 1), a1 + hstep, voffA);
            PG8_WAIT_L(8); PG8_BAR; PG8_WAIT_L(0); PG8_MMA(0, 0, At, B0); PG8_BAR; PG8_SCHED;
            PG8_LDB(B1, 0, 1); PG8_STAGE(PG8_SB(0, 0), b2, voffB);
            PG8_BAR; PG8_WAIT_L(0); PG8_MMA(0, 1, At, B1); PG8_BAR;
            PG8_LDA(At, 0, 1); PG8_STAGE(PG8_SA(0, 0), a2, voffA);
            PG8_BAR; PG8_WAIT_L(0); PG8_MMA(1, 0, At, B0); PG8_BAR; PG8_SCHED;
            PG8_STAGE(PG8_SB(0, 1), b2 + hstep, voffB);
            PG8_WAIT_V(6); PG8_BAR; PG8_MMA(1, 1, At, B1); PG8_BAR;
            PG8_LDB(B0, 1, 0); PG8_SCHED; PG8_LDA(At, 1, 0); PG8_STAGE(PG8_SA(0, 1), a2 + hstep, voffA);
            PG8_WAIT_L(8); PG8_BAR; PG8_WAIT_L(0); PG8_MMA(0, 0, At, B0); PG8_BAR; PG8_SCHED;
            PG8_LDB(B1, 1, 1); PG8_STAGE(PG8_SB(1, 0), b3, voffB);
            PG8_BAR; PG8_WAIT_L(0); PG8_MMA(0, 1, At, B1); PG8_BAR;
            PG8_LDA(At, 1, 1); PG8_STAGE(PG8_SA(1, 0), a3, voffA);
            PG8_BAR; PG8_WAIT_L(0); PG8_MMA(1, 0, At, B0); PG8_BAR; PG8_SCHED;
            PG8_STAGE(PG8_SB(1, 1), b3 + hstep, voffB);
            PG8_WAIT_V(6); PG8_BAR; PG8_MMA(1, 1, At, B1); PG8_BAR;
            }
        }
        if constexpr (ALIGN_EPI) { if (wr == 0) PG8_BAR; }
        if constexpr (!Epi::AFTER_DRAIN) { E(acc, cur, wr, wc, fr, fq); S.done(cur); }
        if (!has_next) break;
#pragma unroll
        for (int a = 0; a < 2; ++a)
#pragma unroll
            for (int b = 0; b < 2; ++b)
#pragma unroll
                for (int m = 0; m < 4; ++m)
#pragma unroll
                    for (int n = 0; n < 2; ++n) acc[a][b][m][n] = (f32x4){0.f, 0.f, 0.f, 0.f};
        cur = nxt; cA = nA; cB = nB; ++ui;
        if constexpr (ALIGN_EPI) { if (wr == 1) PG8_BAR; }
    }
    PG8_WAIT_V(0);
    if constexpr (!ALIGN_EPI) { if (wr == 0) PG8_BAR; }
    PG8_BAR;
    if constexpr (Epi::AFTER_DRAIN) { E.fused(acc, cur, wr, wc, fr, fq, lds, wid, lane); S.done(cur); }
#undef PG8_SA
#undef PG8_SB
#undef PG8_STAGE
#undef PG8_LDA
#undef PG8_LDB
#undef PG8_MMA
#undef PG8_WAIT_V
#undef PG8_WAIT_L
#undef PG8_BAR
#undef PG8_SCHED
}
}
namespace pg8 {
template <class Epi, class Sched>
__device__ __forceinline__ void gemm_phase_g(PG8_LAS unsigned char* lds, const Gemm g, const Sched& S, const Epi& E) {
    int tid_ = threadIdx.x; asm volatile("" : "+v"(tid_));
    const int tid = tid_, wid = __builtin_amdgcn_readfirstlane(tid >> 6), lane = tid & 63, wr = wid >> 2, wc = wid & 3, fr = lane & 15, fq = lane >> 4;
    const int K = g.K, nt = K / BK;
    unsigned voffA[2], voffB[2];
#pragma unroll
    for (int i = 0; i < 2; ++i) { int R, C; stage_rc(tid * 16 + i * 8192, R, C); const int Rb = Epi::PERM ? ((R & ~31) + perm32(R & 31)) : R;
        voffA[i] = (unsigned)(R * K + C) * 2u; voffB[i] = (unsigned)(Rb * K + C) * 2u; }
    unsigned cvA0[2], cvA1[2], nvA0[2], nvA1[2];
#define PG8_GVA(u_, v0_, v1_) do { _Pragma("unroll") for (int _i = 0; _i < 2; ++_i) { int R_, C_; stage_rc(tid * 16 + _i * 8192, R_, C_); \
        v0_[_i] = (unsigned)(S.a_row(u_, R_) * K + C_) * 2u; v1_[_i] = (unsigned)(S.a_row(u_, 128 + R_) * K + C_) * 2u; } } while (0)
    const size_t kstep = (size_t)(BK * 2);
    const size_t hstep = (size_t)HALF * K * 2;
    const size_t tstep = 2 * hstep;
    const unsigned ldsw = (unsigned)wid * 1024u;
    const int aoff = lds_byte(wr * 64 + fr, fq * 8), boff = lds_byte(wc * 32 + fr, fq * 8);
#define PG8_SA(b, h) (((b) * 2 + (h)) * HTB)
#define PG8_SB(b, h) ((4 + (b) * 2 + (h)) * HTB)
#define PG8_STAGE(bufoff, gbase, voff) do { _Pragma("unroll") for (int _i = 0; _i < 2; ++_i) \
        __builtin_amdgcn_global_load_lds((const unsigned*)((const char*)(gbase) + (voff)[_i]), (PG8_LAS unsigned*)(lds + (bufoff) + ldsw + _i * 8192), 16, 0, 0); } while (0)
#define PG8_LDA(dst, b, h) do { _Pragma("unroll") for (int m = 0; m < 4; ++m) _Pragma("unroll") for (int k = 0; k < 2; ++k) dst[m][k] = *(const PG8_LAS bf16x8*)(lds + PG8_SA(b, h) + aoff + m * 2048 + k * 1024); } while (0)
#define PG8_LDB(dst, b, h) do { _Pragma("unroll") for (int n = 0; n < 2; ++n) _Pragma("unroll") for (int k = 0; k < 2; ++k) dst[n][k] = *(const PG8_LAS bf16x8*)(lds + PG8_SB(b, h) + boff + n * 2048 + k * 1024); } while (0)
#define PG8_MMA(ai, bj, At, Bt) do { __builtin_amdgcn_s_setprio(1); _Pragma("unroll") for (int m = 0; m < 4; ++m) _Pragma("unroll") for (int n = 0; n < 2; ++n) _Pragma("unroll") for (int k = 0; k < 2; ++k) \
        acc[ai][bj][m][n] = __builtin_amdgcn_mfma_f32_16x16x32_bf16(Bt[n][k], At[m][k], acc[ai][bj][m][n], 0, 0, 0); __builtin_amdgcn_s_setprio(0); } while (0)
#define PG8_WAIT_V(n) asm volatile("s_waitcnt vmcnt(" #n ")" ::: "memory")
#define PG8_WAIT_L(n) asm volatile("s_waitcnt lgkmcnt(" #n ")" ::: "memory")
#define PG8_BAR __builtin_amdgcn_s_barrier()
#define PG8_SCHED __builtin_amdgcn_sched_barrier(0)
    Unit cur, nxt; int ui = 0;
    if (!S.next(0, cur)) return;
    f32x4 acc[2][2][4][2];
#pragma unroll
    for (int a = 0; a < 2; ++a)
#pragma unroll
        for (int b = 0; b < 2; ++b)
#pragma unroll
            for (int m = 0; m < 4; ++m)
#pragma unroll
                for (int n = 0; n < 2; ++n) acc[a][b][m][n] = (f32x4){0.f, 0.f, 0.f, 0.f};
    bf16x8 At[4][2], B0[2][2], B1[2][2];
    const char* cA = (const char*)g.A; PG8_GVA(cur, cvA0, cvA1); const char* cB = (const char*)g.Bt + (size_t)cur.pn * tstep;
    S.a_ready(cur);
    if constexpr (true) {
        PG8_STAGE(PG8_SB(0, 0), cB, voffB); PG8_STAGE(PG8_SB(0, 1), cB + hstep, voffB); PG8_STAGE(PG8_SA(0, 0), cA, cvA0); PG8_STAGE(PG8_SA(0, 1), cA, cvA1);
        if (wr == 1) PG8_BAR;
        PG8_WAIT_V(2); PG8_BAR;
        PG8_STAGE(PG8_SB(1, 0), cB + kstep, voffB); PG8_STAGE(PG8_SA(1, 0), cA + kstep, cvA0); PG8_STAGE(PG8_SB(1, 1), cB + hstep + kstep, voffB);
        PG8_WAIT_V(6); PG8_BAR;
    } else {
        PG8_STAGE(PG8_SB(0, 0), cB, voffB); PG8_STAGE(PG8_SA(0, 0), cA, voffA); PG8_STAGE(PG8_SB(0, 1), cB + hstep, voffB); PG8_STAGE(PG8_SA(0, 1), cA + hstep, voffA);
        if (wr == 1) PG8_BAR;
        PG8_WAIT_V(4); PG8_BAR;
        PG8_STAGE(PG8_SB(1, 0), cB + kstep, voffB); PG8_STAGE(PG8_SA(1, 0), cA + kstep, voffA); PG8_STAGE(PG8_SB(1, 1), cB + hstep + kstep, voffB);
        PG8_WAIT_V(6); PG8_BAR;
    }
    for (;;) {
        const bool has_next = S.next(ui + 1, nxt);
        const char* nA = cA; if (has_next) PG8_GVA(nxt, nvA0, nvA1); else { nvA0[0] = cvA0[0]; nvA0[1] = cvA0[1]; nvA1[0] = cvA1[0]; nvA1[1] = cvA1[1]; } const char* nB = has_next ? (const char*)g.Bt + (size_t)nxt.pn * tstep : cB;
        for (int t = 0; t < nt; t += 2) {
            const bool last = (t == nt - 2);
            const char* a1 = cA + (size_t)(t + 1) * kstep;
            const char* a2 = last ? nA : cA + (size_t)(t + 2) * kstep; const char* b2 = last ? nB : cB + (size_t)(t + 2) * kstep;
            const char* a3 = a2 + kstep; const char* b3 = b2 + kstep;
            if (last && has_next) S.a_ready(nxt);
            const unsigned sA0[2] = {last ? nvA0[0] : cvA0[0], last ? nvA0[1] : cvA0[1]}, sA1[2] = {last ? nvA1[0] : cvA1[0], last ? nvA1[1] : cvA1[1]};
            if constexpr (true) {
            PG8_LDB(B0, 0, 0); PG8_LDB(B1, 0, 1); PG8_SCHED; PG8_LDA(At, 0, 0); PG8_STAGE(PG8_SA(1, 1), a1, cvA1);
            PG8_WAIT_V(8); PG8_WAIT_L(0); PG8_BAR; PG8_MMA(0, 0, At, B0); PG8_MMA(0, 1, At, B1); PG8_BAR; PG8_SCHED;
            PG8_LDA(At, 0, 1); PG8_STAGE(PG8_SB(0, 0), b2, voffB); PG8_STAGE(PG8_SB(0, 1), b2 + hstep, voffB); PG8_STAGE(PG8_SA(0, 0), a2, sA0);
            PG8_WAIT_V(8); PG8_WAIT_L(0); PG8_BAR; PG8_MMA(1, 0, At, B0); PG8_MMA(1, 1, At, B1); PG8_BAR; PG8_SCHED;
            PG8_LDB(B0, 1, 0); PG8_LDB(B1, 1, 1); PG8_SCHED; PG8_LDA(At, 1, 0); PG8_STAGE(PG8_SA(0, 1), a2, sA1);
            PG8_WAIT_V(8); PG8_WAIT_L(0); PG8_BAR; PG8_MMA(0, 0, At, B0); PG8_MMA(0, 1, At, B1); PG8_BAR; PG8_SCHED;
            PG8_LDA(At, 1, 1); PG8_STAGE(PG8_SB(1, 0), b3, voffB); PG8_STAGE(PG8_SB(1, 1), b3 + hstep, voffB); PG8_STAGE(PG8_SA(1, 0), a3, sA0);
            PG8_WAIT_V(8); PG8_WAIT_L(0); PG8_BAR; PG8_MMA(1, 0, At, B0); PG8_MMA(1, 1, At, B1); PG8_BAR; PG8_SCHED;
            } else {
            PG8_LDB(B0, 0, 0); PG8_SCHED; PG8_LDA(At, 0, 0); PG8_STAGE(PG8_SA(1, 1), a1 + hstep, voffA);
            PG8_WAIT_L(8); PG8_BAR; PG8_WAIT_L(0); PG8_MMA(0, 0, At, B0); PG8_BAR; PG8_SCHED;
            PG8_LDB(B1, 0, 1); PG8_STAGE(PG8_SB(0, 0), b2, voffB);
            PG8_BAR; PG8_WAIT_L(0); PG8_MMA(0, 1, At, B1); PG8_BAR;
            PG8_LDA(At, 0, 1); PG8_STAGE(PG8_SA(0, 0), a2, voffA);
            PG8_BAR; PG8_WAIT_L(0); PG8_MMA(1, 0, At, B0); PG8_BAR; PG8_SCHED;
            PG8_STAGE(PG8_SB(0, 1), b2 + hstep, voffB);
            PG8_WAIT_V(6); PG8_BAR; PG8_MMA(1, 1, At, B1); PG8_BAR;
            PG8_LDB(B0, 1, 0); PG8_SCHED; PG8_LDA(At, 1, 0); PG8_STAGE(PG8_SA(0, 1), a2 + hstep, voffA);
            PG8_WAIT_L(8); PG8_BAR; PG8_WAIT_L(0); PG8_MMA(0, 0, At, B0); PG8_BAR; PG8_SCHED;
            PG8_LDB(B1, 1, 1); PG8_STAGE(PG8_SB(1, 0), b3, voffB);
            PG8_BAR; PG8_WAIT_L(0); PG8_MMA(0, 1, At, B1); PG8_BAR;
            PG8_LDA(At, 1, 1); PG8_STAGE(PG8_SA(1, 0), a3, voffA);
            PG8_BAR; PG8_WAIT_L(0); PG8_MMA(1, 0, At, B0); PG8_BAR; PG8_SCHED;
            PG8_STAGE(PG8_SB(1, 1), b3 + hstep, voffB);
            PG8_WAIT_V(6); PG8_BAR; PG8_MMA(1, 1, At, B1); PG8_BAR;
            }
        }
        if constexpr (true) { if (wr == 0) PG8_BAR; }
        if constexpr (!Epi::AFTER_DRAIN) { E(acc, cur, wr, wc, fr, fq); S.done(cur); }
        if (!has_next) break;
#pragma unroll
        for (int a = 0; a < 2; ++a)
#pragma unroll
            for (int b = 0; b < 2; ++b)
#pragma unroll
                for (int m = 0; m < 4; ++m)
#pragma unroll
                    for (int n = 0; n < 2; ++n) acc[a][b][m][n] = (f32x4){0.f, 0.f, 0.f, 0.f};
        cur = nxt; cA = nA; cB = nB; ++ui; cvA0[0] = nvA0[0]; cvA0[1] = nvA0[1]; cvA1[0] = nvA1[0]; cvA1[1] = nvA1[1];
        if constexpr (true) { if (wr == 1) PG8_BAR; }
    }
    PG8_WAIT_V(0);
    if constexpr (false) { if (wr == 0) PG8_BAR; }
    PG8_BAR;
    if constexpr (Epi::AFTER_DRAIN) { E.fused(acc, cur, wr, wc, fr, fq, lds, wid, lane); S.done(cur); }
#undef PG8_GVA
#undef PG8_SA
#undef PG8_SB
#undef PG8_STAGE
#undef PG8_LDA
#undef PG8_LDB
#undef PG8_MMA
#undef PG8_WAIT_V
#undef PG8_WAIT_L
#undef PG8_BAR
#undef PG8_SCHED
}
}

#ifndef MK_LAUNCH_PER_PHASE
#define MK_LAUNCH_PER_PHASE 0
#endif
constexpr int D = 1024, SEQ = 16384, CTXL = 256, MTOT = SEQ + CTXL, GW = 64, GROWS = SEQ / GW;
constexpr int DR = 512, NH = 8, HD = 64, PA = 1920, WINC = 4992, NPAD = 5120;
constexpr int NEXP = 32, DEXP = 512;
constexpr float NORM_EPS = 1e-6f, GN_EPS = 64e-5f;
constexpr int NPHASE = 13;

constexpr size_t MiB = 1u << 20;
constexpr size_t WS_CTL = 0, CTL_ZERO_BYTES = 64 * 1024;
constexpr size_t WS_MOD = 1 * MiB;
constexpr size_t WS_ROWINFO = WS_MOD + 64 * 1024;
constexpr size_t WS_ROWW = WS_MOD + 256 * 1024;
constexpr size_t WS_ROUTE = WS_MOD + 512 * 1024;
constexpr size_t WS_WIN = 2 * MiB;
constexpr size_t WS_WA = 12 * MiB, WS_WB = 13 * MiB, WS_WOUT = 14 * MiB;
constexpr size_t WS_H = 16 * MiB;
constexpr size_t WS_ZA = 49 * MiB;
constexpr size_t WS_ZB = 114 * MiB;
constexpr size_t WS_ZG = 146 * MiB;
constexpr size_t WS_YB = 210 * MiB;
constexpr size_t WS_YA = 226 * MiB;
constexpr size_t WS_Y = 242 * MiB;
constexpr size_t WS_END = 306 * MiB;
constexpr size_t WS_WGU = 49 * MiB;
constexpr size_t WS_WD = 113 * MiB;
constexpr size_t WS_XG = 145 * MiB;
constexpr size_t WS_HMID = 225 * MiB;
constexpr size_t WS_WUPT = 512 * 1024, WS_AUPT = 640 * 1024, WS_GUPT = 768 * 1024;
constexpr size_t WS_PQ = 16 * MiB;
constexpr size_t WS_PQC = 33 * MiB;
constexpr size_t WS_S0 = 34 * MiB;
constexpr size_t WS_GY = 242 * MiB;
constexpr size_t WS_WRT = 48 * MiB + 512 * 1024;
constexpr size_t WS_SGW = 896 * 1024;
constexpr size_t WS_INVT = 145 * MiB, WS_INVW = 147 * MiB;
constexpr size_t WS_YBUF = 149 * MiB;
constexpr int ECAP = 16384;
constexpr int MAXTILES = 160;
constexpr int CW_TMO = 0, CW_BAR = 4096, CW_CNT = 8192;

constexpr int RING_BYTES = 131072, MISC_OFF = 159744, TAB_OFF = MISC_OFF + 256, LDS_BYTES = 163840;

#define GAS __attribute__((address_space(1)))
#define LAS __attribute__((address_space(3)))
typedef unsigned short bf16;
typedef float f32x4 __attribute__((ext_vector_type(4)));
typedef unsigned u32x4 __attribute__((ext_vector_type(4)));
typedef unsigned u32x2 __attribute__((ext_vector_type(2)));
typedef short bf16x8 __attribute__((ext_vector_type(8)));
#define LDS_WAIT() asm volatile("s_waitcnt lgkmcnt(0)" ::: "memory")
#define VM_WAIT() asm volatile("s_waitcnt vmcnt(0)" ::: "memory")

typedef __bf16 bf2_t __attribute__((ext_vector_type(2)));
__device__ __forceinline__ unsigned f2bf(float f) { return (unsigned)__builtin_bit_cast(unsigned short, (__bf16)f); }
__device__ __forceinline__ unsigned pk2(float lo, float hi) { bf2_t v; v.x = (__bf16)lo; v.y = (__bf16)hi; return __builtin_bit_cast(unsigned, v); }
__device__ __forceinline__ float bf2f(unsigned b) { return __builtin_bit_cast(float, b << 16); }
__device__ __forceinline__ float bflo(unsigned w) { return __builtin_bit_cast(float, w << 16); }
__device__ __forceinline__ float bfhi(unsigned w) { return __builtin_bit_cast(float, w & 0xffff0000u); }
__device__ __forceinline__ float sigmoidf_(float x) { return __builtin_amdgcn_rcpf(1.0f + __expf(-x)); }
__device__ __forceinline__ float siluf_(float x) { return x * __builtin_amdgcn_rcpf(1.0f + __expf(-x)); }
__device__ __forceinline__ float softplusf_(float x) { return fmaxf(x, 0.f) + log1pf(__expf(-fabsf(x))); }
__device__ __forceinline__ float gelu_tanh(float x) { const float u = 0.7978845608028654f * (x + 0.044715f * x * x * x); return x * __builtin_amdgcn_rcpf(1.0f + __expf(-2.0f * u)); }
__device__ __forceinline__ float wave_sum(float v) {
#pragma unroll
    for (int o = 1; o < 64; o <<= 1) v += __shfl_xor(v, o);
    return v;
}

#define XB_TMO      128
#define XB_XCNT(j)  (256  + 64 * (j))
#define XB_XSUB(j)  (1280 + 64 * (j))
#define XB_XGEN(j)  (2304 + 64 * (j))
#define XB_TOP      3328
#define XB_TOPGEN   3392
#define XCD_BAR_WORDS 3456
#define XB_SPIN_CAP (1u << 26)
#define LAS __attribute__((address_space(3)))

__device__ __forceinline__ unsigned xb_ld(unsigned* p)              { return __hip_atomic_load(p, __ATOMIC_RELAXED, __HIP_MEMORY_SCOPE_AGENT); }
__device__ __forceinline__ unsigned xb_add(unsigned* p, unsigned v) { return __hip_atomic_fetch_add(p, v, __ATOMIC_RELAXED, __HIP_MEMORY_SCOPE_AGENT); }
__device__ __forceinline__ unsigned xb_xcc_id() { return (unsigned)__builtin_amdgcn_s_getreg((3 << 11) | 20) & 0xFu; }
#define XB_SPIN(cond, bar) do { unsigned _sp = 0; while (cond) { __builtin_amdgcn_s_sleep(1); \
    if ((++_sp & 255u) == 0u) { if (xb_ld(&(bar)[XB_TMO])) break; if (_sp > XB_SPIN_CAP) { atomicAdd(&(bar)[XB_TMO], 1u); break; } } } } while (0)

struct XcdBarrier {
    unsigned* bar; unsigned x;
    volatile LAS unsigned* st;
};

__device__ __forceinline__ XcdBarrier xcd_barrier_post(unsigned* bar, volatile LAS unsigned* st) {
    XcdBarrier b; b.bar = bar; b.x = xb_xcc_id(); b.st = st;
    if (threadIdx.x == 0) (void)xb_add(&bar[XB_XCNT(b.x)], 1u);
    return b;
}
__device__ __forceinline__ void xcd_barrier_complete(unsigned* bar, unsigned x, unsigned& nloc, unsigned& nx) {
    const unsigned G = gridDim.x * gridDim.y * gridDim.z;
    unsigned sum, cnt, mine, sp = 0u;
    for (;;) {
        sum = 0u; cnt = 0u; mine = 0u;
#pragma unroll
        for (unsigned j = 0; j < 16; ++j) { const unsigned c = xb_ld(&bar[XB_XCNT(j)]); sum += c; cnt += (c > 0u) ? 1u : 0u; mine = (j == x) ? c : mine; }
        if (sum == G) break;
        __builtin_amdgcn_s_sleep(1);
        if ((++sp & 255u) == 0u) { if (xb_ld(&bar[XB_TMO])) break; if (sp > XB_SPIN_CAP) { atomicAdd(&bar[XB_TMO], 1u); break; } }
    }
    nloc = mine > 0u ? mine : 1u; nx = cnt > 0u ? cnt : 1u;
}

__device__ __forceinline__ void xcd_barrier(const XcdBarrier& b) {
    asm volatile("s_waitcnt vmcnt(0)" ::: "memory");
    __syncthreads();
    if (threadIdx.x == 0) {
        unsigned* bar = b.bar;
        __builtin_amdgcn_s_waitcnt(0);
        unsigned nloc = b.st[0], nx = b.st[1];
        if (nloc == 0u) { xcd_barrier_complete(bar, b.x, nloc, nx); b.st[0] = nloc; b.st[1] = nx; }
        const unsigned old = xb_add(&bar[XB_XSUB(b.x)], 1u);
        const unsigned gen = old / nloc;
        if (old + 1u == (gen + 1u) * nloc) {
            __builtin_amdgcn_fence(__ATOMIC_RELEASE, "agent");
            asm volatile("s_waitcnt vmcnt(0)" ::: "memory");
            const unsigned og = xb_add(&bar[XB_TOP], 1u);
            const unsigned tg = og / nx;
            if (og + 1u == (tg + 1u) * nx) xb_add(&bar[XB_TOPGEN], 1u);
            else XB_SPIN(xb_ld(&bar[XB_TOPGEN]) == tg, bar);
            __builtin_amdgcn_fence(__ATOMIC_ACQUIRE, "agent");
            xb_add(&bar[XB_XGEN(b.x)], 1u);
            asm volatile("s_waitcnt vmcnt(0)" ::: "memory");
        } else {
            XB_SPIN(xb_ld(&bar[XB_XGEN(b.x)]) == gen, bar);
            __builtin_amdgcn_fence(__ATOMIC_ACQUIRE, "agent");
            asm volatile("s_waitcnt vmcnt(0)" ::: "memory");
        }
    }
    __syncthreads();
}

struct Args { const float* in[35]; float* out; unsigned char* ws; int ph_lo, ph_hi; };

typedef const __attribute__((address_space(4))) unsigned char* kptr_t;
struct KArgs {
    kptr_t p;
    __device__ __forceinline__ const float* in(int i) const { return *(const float* const __attribute__((address_space(4)))*)(p + 8 * i); }
    __device__ __forceinline__ float* out() const { return *(float* const __attribute__((address_space(4)))*)(p + 280); }
    __device__ __forceinline__ unsigned char* ws() const { return *(unsigned char* const __attribute__((address_space(4)))*)(p + 288); }
};
#define FRESH_KA(name) KArgs name; { kptr_t q_ = (kptr_t)__builtin_amdgcn_kernarg_segment_ptr(); asm volatile("" : "+s"(q_)); name.p = q_; }
#define F_x (A.in(0))
#define F_c (A.in(1))
#define F_ctx (A.in(2))
#define F_cctx (A.in(3))
#define F_ada_w (A.in(4))
#define F_ada_b (A.in(5))
#define F_norm1_g (A.in(6))
#define F_norm2_g (A.in(7))
#define F_w_in (A.in(8))
#define F_mu (A.in(9))
#define F_w0 (A.in(10))
#define F_w_up (A.in(11))
#define F_a0 (A.in(12))
#define F_a_up (A.in(13))
#define F_g_up (A.in(14))
#define F_k_k (A.in(15))
#define F_k_a (A.in(16))
#define F_r_k (A.in(17))
#define F_ln_w (A.in(18))
#define F_ln_b (A.in(19))
#define F_w_ba (A.in(20))
#define F_sg_ln_w (A.in(21))
#define F_sg_ln_b (A.in(22))
#define F_sg_w (A.in(23))
#define F_sg_b (A.in(24))
#define F_w_bb (A.in(25))
#define F_w_out (A.in(26))
#define F_grp_w (A.in(27))
#define F_grp_b (A.in(28))
#define F_exp_w (A.in(29))
#define F_exp_b (A.in(30))
#define F_wg (A.in(31))
#define F_wu (A.in(32))
#define F_wd (A.in(33))
#define F_fin_g (A.in(34))
#define F_MOD ((float*)(A.ws() + WS_MOD))
#define F_rowinfo ((int*)(A.ws() + WS_ROWINFO))
#define F_roww ((float*)(A.ws() + WS_ROWW))
#define F_route ((unsigned*)(A.ws() + WS_ROUTE))
#define F_WinT ((bf16*)(A.ws() + WS_WIN))
#define F_WaT ((bf16*)(A.ws() + WS_WA))
#define F_WbT ((bf16*)(A.ws() + WS_WB))
#define F_WoutT ((bf16*)(A.ws() + WS_WOUT))
#define F_H ((bf16*)(A.ws() + WS_H))
#define F_ZA ((bf16*)(A.ws() + WS_ZA))
#define F_ZB ((bf16*)(A.ws() + WS_ZB))
#define F_ZG ((bf16*)(A.ws() + WS_ZG))
#define F_YB ((bf16*)(A.ws() + WS_YB))
#define F_YA ((bf16*)(A.ws() + WS_YA))
#define F_WguT ((bf16*)(A.ws() + WS_WGU))
#define F_WdT ((bf16*)(A.ws() + WS_WD))
#define F_XG ((bf16*)(A.ws() + WS_XG))
#define F_HMID ((bf16*)(A.ws() + WS_HMID))
#define F_YBUF ((bf16*)(A.ws() + WS_YBUF))
#define F_INVT ((int*)(A.ws() + WS_INVT))
#define F_INVW ((float*)(A.ws() + WS_INVW))
#define F_MG ((bf16*)(A.ws() + WS_ZB))
#define F_Y ((float*)(A.ws() + WS_Y))
#define F_out (A.out())
struct Frame {
    LAS unsigned char* lds;
    unsigned* ctl;
    unsigned char* ws;
    const float* const* in;
    int tid, lane, wave, G;
};


__device__ __forceinline__ void static_tile(int wgid, int nM, int nN, pg8::Unit& u) {
    const int nwg = nM * nN;
    { const int q = nwg / 8, r = nwg % 8, xcd = wgid % 8, off = wgid / 8; wgid = (xcd < r ? xcd * (q + 1) : r * (q + 1) + (xcd - r) * q) + off; }
    const int nig = 8 * nN, gid = wgid / nig, fm = gid * 8, gsz = (nM - fm) < 8 ? (nM - fm) : 8;
    u.pm = fm + ((wgid % nig) % gsz); u.pn = (wgid % nig) / gsz;
}

__device__ __forceinline__ void transpose_item(const float* W, int K, int N, int k0, int n0, bf16* WT, int dst_row0, LAS float* scr, int lane) {
#pragma unroll 8
    for (int i = 0; i < 32; ++i) { const int kk = 2 * i + (lane >> 5); scr[kk * 33 + (lane & 31)] = W[(size_t)(k0 + kk) * N + n0 + (lane & 31)]; }
    LDS_WAIT(); asm volatile("" ::: "memory");
    const int c = lane & 7;
#pragma unroll
    for (int j = 0; j < 4; ++j) { const int n = (lane >> 3) + 8 * j; const LAS float* s = scr + (8 * c) * 33 + n;
        u32x4 o; o.x = pk2(s[0 * 33], s[1 * 33]); o.y = pk2(s[2 * 33], s[3 * 33]); o.z = pk2(s[4 * 33], s[5 * 33]); o.w = pk2(s[6 * 33], s[7 * 33]);
        *(u32x4*)(WT + (size_t)(dst_row0 + n) * K + k0 + 8 * c) = o; }
    LDS_WAIT(); asm volatile("" ::: "memory");
}

__device__ __forceinline__ void transpose_item64(const float* W, int K, int N, int k0, int n0, bf16* WT, int dst_row0, LAS float* scr, int lane) {
    const int c16 = lane & 15, r4 = lane >> 4;
    f32x4 v[16];
#pragma unroll
    for (int i = 0; i < 16; ++i) v[i] = *(const f32x4*)(W + (size_t)(k0 + 4 * i + r4) * N + n0 + 4 * c16);
#pragma unroll
    for (int i = 0; i < 16; ++i) { LAS float* p = scr + (4 * c16) * 65 + 4 * i + r4; p[0] = v[i].x; p[65] = v[i].y; p[130] = v[i].z; p[195] = v[i].w; }
    LDS_WAIT(); asm volatile("" ::: "memory");
    const int c = lane & 7;
#pragma unroll
    for (int j = 0; j < 8; ++j) { const int n = (lane >> 3) + 8 * j; const LAS float* s = scr + n * 65 + 8 * c;
        u32x4 o; o.x = pk2(s[0], s[1]); o.y = pk2(s[2], s[3]); o.z = pk2(s[4], s[5]); o.w = pk2(s[6], s[7]);
        *(u32x4*)(WT + (size_t)(dst_row0 + n) * K + k0 + 8 * c) = o; }
    LDS_WAIT(); asm volatile("" ::: "memory");
}

__device__ __forceinline__ void p0_prologue(Frame& F, const KArgs& A) {
    {
        LAS float* red = (LAS float*)F.lds;
        const int cl = F.tid & 31, kg = F.tid >> 5;
        for (int cb = blockIdx.x; cb < 256; cb += F.G) {
            const int col = cb * 24 + cl; float a0 = 0.f, a1 = 0.f;
            if (cl < 24) for (int k = kg; k < D; k += 16) { const float w = F_ada_w[(size_t)k * 6144 + col]; a0 += siluf_(F_c[k]) * w; a1 += siluf_(F_cctx[k]) * w; }
            red[(kg * 32 + cl) * 2] = a0; red[(kg * 32 + cl) * 2 + 1] = a1;
            __syncthreads();
            if (F.tid < 48) { const int cc = F.tid % 24, i = F.tid / 24; float s = 0.f; for (int g = 0; g < 16; ++g) s += red[(g * 32 + cc) * 2 + i]; F_MOD[i * 6144 + cb * 24 + cc] = s + F_ada_b[cb * 24 + cc]; }
            __syncthreads();
        }
    }
    LAS float* scr = (LAS float*)(F.lds + F.wave * 16640);
    const int gw = blockIdx.x * 8 + F.wave, NGW = F.G * 8;
    constexpr int I_IN = 16 * 78, I_A = 8 * 16, I_B = 8 * 16, I_O = 16 * 16, NIT = I_IN + I_A + I_B + I_O;
    for (int it = gw; it < NIT; it += NGW) {
        int r = it;
        if (r < I_IN) { const int kb = r / 78, nb = r % 78, n0 = 64 * nb; transpose_item64(F_w_in, D, WINC, 64 * kb, n0, F_WinT, n0 + (n0 >= PA ? 128 : 0), scr, F.lane); continue; } r -= I_IN;
        if (r < I_A) { const int kb = r / 16, nb = r % 16; transpose_item64(F_w_ba, DR, D, 64 * kb, 64 * nb, F_WaT, 64 * nb, scr, F.lane); continue; } r -= I_A;
        if (r < I_B) { const int kb = r / 16, nb = r % 16; transpose_item64(F_w_bb, DR, D, 64 * kb, 64 * nb, F_WbT, 64 * nb, scr, F.lane); continue; } r -= I_B;
        { const int kb = r / 16, nb = r % 16; transpose_item64(F_w_out, D, D, 64 * kb, 64 * nb, F_WoutT, 64 * nb, scr, F.lane); }
    }
    for (int i = blockIdx.x * 512 + F.tid; i < 65536; i += F.G * 512) {
        const int ch = i >> 12, c = (i >> 6) & 63, r = i & 63, dd = ch >> 3, hh = ch & 7;
        ((bf16*)(A.ws() + WS_WUPT))[i] = (bf16)f2bf(F_w_up[(size_t)(dd * 64 + r) * DR + hh * 64 + c]);
        ((bf16*)(A.ws() + WS_AUPT))[i] = (bf16)f2bf(F_a_up[(size_t)(dd * 64 + r) * DR + hh * 64 + c]);
        const int hg = i >> 13, cg = (i >> 7) & 63, rg = i & 127;
        ((bf16*)(A.ws() + WS_GUPT))[i] = (bf16)f2bf(F_g_up[(size_t)rg * DR + hg * 64 + cg]);
    }
    for (int i = blockIdx.x * 512 + F.tid; i < 4 * 128 * 128; i += F.G * 512) ((bf16*)(A.ws() + WS_SGW))[i] = (bf16)f2bf(F_sg_w[i]);
    for (int i = blockIdx.x * 512 + F.tid; i < 36 * D; i += F.G * 512) { const int ee = i >> 10, k = i & 1023;
        ((float*)(A.ws() + WS_WRT))[i] = ee < 4 ? F_grp_w[k * 4 + ee] : F_exp_w[k * 32 + ee - 4]; }
    for (int i = blockIdx.x * 512 + F.tid; i < 16384; i += F.G * 512) ((u32x4*)(F_WinT + (size_t)PA * D))[i] = (u32x4){0u, 0u, 0u, 0u};
}

__device__ __forceinline__ void norm_row_bf16(const float* src, const float* g, const float* sh, const float* sc, bf16* dst, int lane) {
    f32x4 v[4]; float ss = 0.f;
#pragma unroll
    for (int j = 0; j < 4; ++j) { v[j] = ((const f32x4*)src)[lane + 64 * j]; ss += (v[j].x * v[j].x + v[j].y * v[j].y) + (v[j].z * v[j].z + v[j].w * v[j].w); }
    const float rinv = rsqrtf(wave_sum(ss) * (1.0f / D) + NORM_EPS);
#pragma unroll
    for (int j = 0; j < 4; ++j) {
        const f32x4 gg = ((const f32x4*)g)[lane + 64 * j], s1 = ((const f32x4*)sc)[lane + 64 * j], s0 = ((const f32x4*)sh)[lane + 64 * j];
        const f32x4 hv = (v[j] * rinv * gg) * (1.0f + s1) + s0;
        u32x2 o; o.x = pk2(hv.x, hv.y); o.y = pk2(hv.z, hv.w);
        ((u32x2*)dst)[lane + 64 * j] = o;
    }
}
__device__ __forceinline__ void p1_norm1(Frame& F, const KArgs& A) {
    const int gw = blockIdx.x * 8 + F.wave, NGW = F.G * 8;
    for (int row = gw; row < MTOT; row += NGW) {
        const bool isctx = row >= SEQ;
        const float* src = isctx ? F_ctx + (size_t)(row - SEQ) * D : F_x + (size_t)row * D;
        const float* mod = F_MOD + (isctx ? 6144 : 0);
        norm_row_bf16(src, F_norm1_g, mod, mod + 1024, F_H + (size_t)row * D, F.lane);
    }
}

struct Sched1 {
    int G, c;
    __device__ __forceinline__ bool next(int i, pg8::Unit& u) const {
        long L = (long)i * G + c; if (L < 8) { u.pm = 64; u.pn = (int)L; return true; }
        L -= 8; if (L >= 1280) return false; static_tile((int)L, 64, 20, u); return true;
    }
    __device__ __forceinline__ void a_ready(const pg8::Unit&) const {}
    __device__ __forceinline__ void done(const pg8::Unit&) const {}
};
struct EpiZ {
    static constexpr bool PERM = true, AFTER_DRAIN = false;
    bf16 *ZA, *ZB, *ZG;
    __device__ __forceinline__ void operator()(const pg8::f32x4 (&acc)[2][2][4][2], const pg8::Unit& u, int wr, int wc, int fr, int fq) const {
        const int row0 = u.pm * 256 + wr * 64 + fr;
        bf16* base; int ld, colt;
        if (u.pn < 8) { base = ZA; ld = 2048; colt = u.pn * 256; } else if (u.pn < 12) { base = ZB; ld = 1024; colt = (u.pn - 8) * 256; } else { base = ZG; ld = 2048; colt = (u.pn - 12) * 256; }
        const int col0 = colt + wc * 32 + 8 * fq;
#pragma unroll
        for (int ai = 0; ai < 2; ++ai)
#pragma unroll
            for (int m = 0; m < 4; ++m) { bf16* rowp = base + (size_t)(row0 + ai * 128 + m * 16) * ld + col0;
#pragma unroll
                for (int bj = 0; bj < 2; ++bj) { const pg8::f32x4 v0 = acc[ai][bj][m][0], v1 = acc[ai][bj][m][1];
                    u32x4 w; w.x = pg8::cvt_pk_bf16(v0[0], v0[1]); w.y = pg8::cvt_pk_bf16(v0[2], v0[3]); w.z = pg8::cvt_pk_bf16(v1[0], v1[1]); w.w = pg8::cvt_pk_bf16(v1[2], v1[3]);
                    *(u32x4*)(rowp + bj * 128) = w; } }
    }
};

__device__ __forceinline__ float mixed_val(const bf16* ZA, bool isctx, int t, int col, float mu) {
    const int row = isctx ? SEQ + t : t;
    const bf16* Z = ZA + (size_t)row * 2048;
    int dr; bool ok;
    if (isctx) { const bool ev = (col & 1) == 0; dr = ev ? -1 : 1; ok = ev ? (t > 0) : (t < CTXL - 1); }
    else { const int s = col & 3, gx = t & 63, gy = t >> 6;
        dr = (s == 0) ? -1 : (s == 1) ? 1 : (s == 2) ? -64 : 64;
        ok = (s == 0) ? (gx > 0) : (s == 1) ? (gx < 63) : (s == 2) ? (gy > 0) : (gy < GROWS - 1); }
    const int dsafe = ok ? dr : 0;
    const float z = bf2f(Z[col]);
    const float nbv = bf2f(Z[col + dsafe * 2048]);
    const float nb = ok ? nbv : 0.f;
    return z + mu * (nb - z);
}
__device__ __forceinline__ void mixed8(const bf16* ZA, int t, int col0, const float* mu, float (&o)[8]) {
    const bf16* Z = ZA + (size_t)t * 2048 + col0;
    const int gx = t & 63, gy = t >> 6;
    const u32x4 z = *(const u32x4*)Z;
    const u32x4 zero = (u32x4){0u, 0u, 0u, 0u};
    const u32x4 l = gx > 0 ? *(const u32x4*)(Z - 2048) : zero, r = gx < 63 ? *(const u32x4*)(Z + 2048) : zero;
    const u32x4 up = gy > 0 ? *(const u32x4*)(Z - 64 * 2048) : zero, dn = gy < GROWS - 1 ? *(const u32x4*)(Z + 64 * 2048) : zero;
    const f32x4 m0 = *(const f32x4*)(mu + col0), m1 = *(const f32x4*)(mu + col0 + 4);
    float zz[8], nn[8];
    zz[0] = bflo(z.x); zz[1] = bfhi(z.x); zz[2] = bflo(z.y); zz[3] = bfhi(z.y); zz[4] = bflo(z.z); zz[5] = bfhi(z.z); zz[6] = bflo(z.w); zz[7] = bfhi(z.w);
    nn[0] = bflo(l.x); nn[1] = bfhi(r.x); nn[2] = bflo(up.y); nn[3] = bfhi(dn.y); nn[4] = bflo(l.z); nn[5] = bfhi(r.z); nn[6] = bflo(up.w); nn[7] = bfhi(dn.w);
    const float mm[8] = {m0.x, m0.y, m0.z, m0.w, m1.x, m1.y, m1.z, m1.w};
#pragma unroll
    for (int i = 0; i < 8; ++i) o[i] = zz[i] + mm[i] * (nn[i] - zz[i]);
}

__device__ __forceinline__ void p3_scan_naive(Frame& F, const KArgs& A, int chain) {
    const int d = chain >> 3, h = chain & 7, j = F.lane, c = h * 64 + j, w = F.wave;
    float wup[64], aup[64];
#pragma unroll
    for (int r = 0; r < 64; ++r) { wup[r] = F_w_up[(size_t)(d * 64 + r) * DR + c]; aup[r] = F_a_up[(size_t)(d * 64 + r) * DR + c]; }
    const float w0 = F_w0[d * DR + c], a0 = F_a0[d * DR + c], kkc = F_k_k[c], kac = F_k_a[c];
    const int col_w = 1536 + d * 64 + j, col_a = 1664 + d * 64 + j;
    const float mu_r = F_mu[c], mu_k = F_mu[512 + c], mu_v = F_mu[1024 + c], mu_w = F_mu[col_w], mu_a = F_mu[col_a];
    float S[8];
#pragma unroll
    for (int i = 0; i < 8; ++i) S[i] = 0.f;
    float* Yd = F_Y + (size_t)d * SEQ * DR;
    const int NSTEP = CTXL + SEQ;
    float nr, nk, nv, nwd, nad;
    { const bool ic = true; const int t = d ? CTXL - 1 : 0;
      nr = mixed_val(F_ZA, ic, t, c, mu_r); nk = mixed_val(F_ZA, ic, t, 512 + c, mu_k); nv = mixed_val(F_ZA, ic, t, 1024 + c, mu_v); nwd = mixed_val(F_ZA, ic, t, col_w, mu_w); nad = mixed_val(F_ZA, ic, t, col_a, mu_a); }
    for (int step = 0; step < NSTEP; ++step) {
        const bool isctx = step < CTXL;
        const int t = isctx ? (d ? CTXL - 1 - step : step) : (d ? SEQ - 1 - (step - CTXL) : step - CTXL);
        const float r = nr, k = nk, v = nv, wd = nwd, ad = nad;
        if (step + 1 < NSTEP) { const int s2 = step + 1; const bool ic = s2 < CTXL; const int t2 = ic ? (d ? CTXL - 1 - s2 : s2) : (d ? SEQ - 1 - (s2 - CTXL) : s2 - CTXL);
            nr = mixed_val(F_ZA, ic, t2, c, mu_r); nk = mixed_val(F_ZA, ic, t2, 512 + c, mu_k); nv = mixed_val(F_ZA, ic, t2, 1024 + c, mu_v); nwd = mixed_val(F_ZA, ic, t2, col_w, mu_w); nad = mixed_val(F_ZA, ic, t2, col_a, mu_a); }
        const float twd = tanhf(wd);
        float wl = w0, al = a0;
#pragma unroll
        for (int rr = 0; rr < 64; ++rr) { const float tw = __builtin_bit_cast(float, __builtin_amdgcn_readlane(__builtin_bit_cast(int, twd), rr)); const float ta = __builtin_bit_cast(float, __builtin_amdgcn_readlane(__builtin_bit_cast(int, ad), rr));
            wl += tw * wup[rr]; al += ta * aup[rr]; }
        const float wv = -softplusf_(-wl) - 0.5f, dec = __expf(-__expf(wv)), a = sigmoidf_(al);
        float kk = k * kkc; const float n2 = wave_sum(kk * kk); kk = kk / fmaxf(sqrtf(n2), 1e-12f);
        const float kd = k * (1.0f + (a - 1.0f) * kac), kka = kk * a;
        float yv = 0.f;
#pragma unroll
        for (int i = 0; i < 8; ++i) {
            const float sa = wave_sum(S[i] * kk);
            const float vi = __builtin_bit_cast(float, __builtin_amdgcn_readlane(__builtin_bit_cast(int, v), 8 * w + i));
            S[i] = S[i] * dec - sa * kka + vi * kd;
            const float y = wave_sum(S[i] * r);
            yv = (j == i) ? y : yv;
        }
        if (!isctx && j < 8) Yd[(size_t)t * DR + h * 64 + 8 * w + j] = yv;
    }
}

__device__ __forceinline__ int mb_off(int row, int ch) { return row * 1024 + ((ch ^ (((row & 3) << 1) | (((row >> 3) & 1) << 3))) << 4); }
__device__ __forceinline__ void p3_mixer_b(Frame& F, const KArgs& A, int chunk) {
    const int tok0 = chunk * 128, lane = F.lane, w = F.wave, fr = lane & 15, fq = lane >> 4;
    LAS unsigned char* const L = F.lds;
    const bf16* ZB = F_ZB;
    bf16x8 wf[4][4];
    { const bf16* sw = (const bf16*)(A.ws() + WS_SGW);
#pragma unroll
      for (int g = 0; g < 4; ++g)
#pragma unroll
          for (int ks = 0; ks < 4; ++ks) wf[g][ks] = *(const bf16x8*)(sw + (size_t)(g * 128 + 16 * w + fr) * 128 + 32 * ks + 8 * fq); }
    {
        const f32x4 lw0 = *(const f32x4*)(F_sg_ln_w + 8 * lane), lw1 = *(const f32x4*)(F_sg_ln_w + 8 * lane + 4), lb0 = *(const f32x4*)(F_sg_ln_b + 8 * lane), lb1 = *(const f32x4*)(F_sg_ln_b + 8 * lane + 4);
        const float lwv[8] = {lw0.x, lw0.y, lw0.z, lw0.w, lw1.x, lw1.y, lw1.z, lw1.w}, lbv[8] = {lb0.x, lb0.y, lb0.z, lb0.w, lb1.x, lb1.y, lb1.z, lb1.w};
#pragma unroll 4
        for (int rr = 0; rr < 16; ++rr) {
            const int q = w * 16 + rr;
            const u32x4 raw = *(const u32x4*)(ZB + (size_t)(tok0 + q) * 1024 + 512 + 8 * lane);
            float g[8]; g[0] = gelu_tanh(bflo(raw.x)); g[1] = gelu_tanh(bfhi(raw.x)); g[2] = gelu_tanh(bflo(raw.y)); g[3] = gelu_tanh(bfhi(raw.y));
            g[4] = gelu_tanh(bflo(raw.z)); g[5] = gelu_tanh(bfhi(raw.z)); g[6] = gelu_tanh(bflo(raw.w)); g[7] = gelu_tanh(bfhi(raw.w));
            float s = 0.f;
#pragma unroll
            for (int i = 0; i < 8; ++i) s += g[i];
            const float mean = wave_sum(s) * (1.0f / 512.0f); float s2 = 0.f;
#pragma unroll
            for (int i = 0; i < 8; ++i) { g[i] -= mean; s2 += g[i] * g[i]; }
            const float rstd = rsqrtf(wave_sum(s2) * (1.0f / 512.0f) + 1e-5f);
#pragma unroll
            for (int i = 0; i < 8; ++i) g[i] = g[i] * rstd * lwv[i] + lbv[i];
            u32x4 o; o.x = pk2(g[0], g[1]); o.y = pk2(g[2], g[3]); o.z = pk2(g[4], g[5]); o.w = pk2(g[6], g[7]);
            *(LAS u32x4*)(L + mb_off(q, lane)) = o;
        }
    }
    __syncthreads();
    const int qq = fr >> 2, pp = fr & 3;
#pragma unroll
    for (int g = 0; g < 4; ++g) {
        const int p = 16 * w + fr; const float sb = F_sg_b[g * 128 + p];
#pragma unroll 2
        for (int ct = 0; ct < 8; ++ct) {
            u32x2 tr[4][2];
            { unsigned ad[4][2];
#pragma unroll
              for (int ks = 0; ks < 4; ++ks)
#pragma unroll
                  for (int t = 0; t < 2; ++t) ad[ks][t] = (unsigned)mb_off(32 * ks + 8 * fq + 4 * t + qq, g * 16 + 2 * ct + (pp >> 1)) + 8u * (pp & 1);
              asm volatile("ds_read_b64_tr_b16 %0, %8\n\tds_read_b64_tr_b16 %1, %9\n\tds_read_b64_tr_b16 %2, %10\n\tds_read_b64_tr_b16 %3, %11\n\t"
                           "ds_read_b64_tr_b16 %4, %12\n\tds_read_b64_tr_b16 %5, %13\n\tds_read_b64_tr_b16 %6, %14\n\tds_read_b64_tr_b16 %7, %15\n\ts_waitcnt lgkmcnt(0)"
                           : "=&v"(tr[0][0]), "=&v"(tr[0][1]), "=&v"(tr[1][0]), "=&v"(tr[1][1]), "=&v"(tr[2][0]), "=&v"(tr[2][1]), "=&v"(tr[3][0]), "=&v"(tr[3][1])
                           : "v"(ad[0][0]), "v"(ad[0][1]), "v"(ad[1][0]), "v"(ad[1][1]), "v"(ad[2][0]), "v"(ad[2][1]), "v"(ad[3][0]), "v"(ad[3][1]) : "memory"); }
            pg8::f32x4 acc = (pg8::f32x4){0.f, 0.f, 0.f, 0.f};
#pragma unroll
            for (int ks = 0; ks < 4; ++ks) { u32x4 a; a.x = tr[ks][0].x; a.y = tr[ks][0].y; a.z = tr[ks][1].x; a.w = tr[ks][1].y;
                acc = __builtin_amdgcn_mfma_f32_16x16x32_bf16(__builtin_bit_cast(bf16x8, a), wf[g][ks], acc, 0, 0, 0); }
            const int c0 = 16 * ct + 4 * fq;
            const u32x2 uraw = *(const u32x2*)(ZB + (size_t)(tok0 + p) * 1024 + g * 128 + c0);
            const float u0 = gelu_tanh(bflo(uraw.x)), u1 = gelu_tanh(bfhi(uraw.x)), u2 = gelu_tanh(bflo(uraw.y)), u3 = gelu_tanh(bfhi(uraw.y));
            u32x2 o; o.x = pk2(u0 * (acc[0] + sb), u1 * (acc[1] + sb)); o.y = pk2(u2 * (acc[2] + sb), u3 * (acc[3] + sb));
            *(u32x2*)(F_YB + (size_t)(tok0 + p) * DR + g * 128 + c0) = o;
        }
    }
    __syncthreads();
}

__device__ __forceinline__ void p4_rwkv_out(Frame& F, const KArgs& A) {
    const int gw = blockIdx.x * 8 + F.wave, NGW = F.G * 8, l = F.lane, h = l >> 3;
    for (int t = gw; t < SEQ; t += NGW) {
        float y[8];
        { const f32x4 a0 = *(const f32x4*)(F_Y + (size_t)t * DR + 8 * l), a1 = *(const f32x4*)(F_Y + (size_t)t * DR + 8 * l + 4);
          const f32x4 b0 = *(const f32x4*)(F_Y + (size_t)(SEQ + t) * DR + 8 * l), b1 = *(const f32x4*)(F_Y + (size_t)(SEQ + t) * DR + 8 * l + 4);
          y[0] = a0.x + b0.x; y[1] = a0.y + b0.y; y[2] = a0.z + b0.z; y[3] = a0.w + b0.w; y[4] = a1.x + b1.x; y[5] = a1.y + b1.y; y[6] = a1.z + b1.z; y[7] = a1.w + b1.w; }
        float s = 0.f;
#pragma unroll
        for (int i = 0; i < 8; ++i) s += y[i];
        s += __shfl_xor(s, 1); s += __shfl_xor(s, 2); s += __shfl_xor(s, 4);
        const float mean = s * (1.0f / 64.0f); float s2 = 0.f;
#pragma unroll
        for (int i = 0; i < 8; ++i) { const float dlt = y[i] - mean; s2 += dlt * dlt; }
        s2 += __shfl_xor(s2, 1); s2 += __shfl_xor(s2, 2); s2 += __shfl_xor(s2, 4);
        const float rstd = rsqrtf(s2 * (1.0f / 64.0f) + GN_EPS);
        float r[8], k[8], v[8];
        mixed8(F_ZA, t, 8 * l, F_mu, r); mixed8(F_ZA, t, 512 + 8 * l, F_mu, k); mixed8(F_ZA, t, 1024 + 8 * l, F_mu, v);
        float dp = 0.f;
#pragma unroll
        for (int i = 0; i < 8; ++i) dp += r[i] * k[i] * F_r_k[8 * l + i];
        dp += __shfl_xor(dp, 1); dp += __shfl_xor(dp, 2); dp += __shfl_xor(dp, 4);
        const float sg0 = sigmoidf_(mixed_val(F_ZA, false, t, 1792 + 2 * l, F_mu[1792 + 2 * l])), sg1 = sigmoidf_(mixed_val(F_ZA, false, t, 1793 + 2 * l, F_mu[1793 + 2 * l]));
        float g[8];
#pragma unroll
        for (int i = 0; i < 8; ++i) g[i] = 0.f;
        for (int rr = 0; rr < 64; ++rr) {
            const float s0 = __shfl(sg0, rr), s1 = __shfl(sg1, rr);
            const f32x4 u0 = *(const f32x4*)(F_g_up + (size_t)(2 * rr) * DR + 8 * l), u1 = *(const f32x4*)(F_g_up + (size_t)(2 * rr) * DR + 8 * l + 4);
            const f32x4 w0 = *(const f32x4*)(F_g_up + (size_t)(2 * rr + 1) * DR + 8 * l), w1 = *(const f32x4*)(F_g_up + (size_t)(2 * rr + 1) * DR + 8 * l + 4);
            g[0] += s0 * u0.x + s1 * w0.x; g[1] += s0 * u0.y + s1 * w0.y; g[2] += s0 * u0.z + s1 * w0.z; g[3] += s0 * u0.w + s1 * w0.w;
            g[4] += s0 * u1.x + s1 * w1.x; g[5] += s0 * u1.y + s1 * w1.y; g[6] += s0 * u1.z + s1 * w1.z; g[7] += s0 * u1.w + s1 * w1.w;
        }
        float o[8];
#pragma unroll
        for (int i = 0; i < 8; ++i) { const float yn = (y[i] - mean) * rstd * F_ln_w[8 * l + i] + F_ln_b[8 * l + i]; o[i] = (yn + dp * v[i]) * g[i]; }
        u32x4 pk; pk.x = pk2(o[0], o[1]); pk.y = pk2(o[2], o[3]); pk.z = pk2(o[4], o[5]); pk.w = pk2(o[6], o[7]);
        *(u32x4*)(F_YA + (size_t)t * DR + 8 * l) = pk;
        (void)h;
    }
}

struct SchedStd {
    int nM, nN, G, c;
    __device__ __forceinline__ bool next(int i, pg8::Unit& u) const { const long L = (long)i * G + c; if (L >= (long)nM * nN) return false; static_tile((int)L, nM, nN, u); return true; }
    __device__ __forceinline__ void a_ready(const pg8::Unit&) const {}
    __device__ __forceinline__ void done(const pg8::Unit&) const {}
};
__device__ __forceinline__ void sig8(const bf16* p, float (&o)[8]) {
    const u32x4 raw = *(const u32x4*)p;
    o[0] = sigmoidf_(bflo(raw.x)); o[1] = sigmoidf_(bfhi(raw.x)); o[2] = sigmoidf_(bflo(raw.y)); o[3] = sigmoidf_(bfhi(raw.y));
    o[4] = sigmoidf_(bflo(raw.z)); o[5] = sigmoidf_(bfhi(raw.z)); o[6] = sigmoidf_(bflo(raw.w)); o[7] = sigmoidf_(bfhi(raw.w));
}
struct EpiMergeA {
    static constexpr bool PERM = true, AFTER_DRAIN = false;
    bf16* RA;
    __device__ __forceinline__ void operator()(const pg8::f32x4 (&acc)[2][2][4][2], const pg8::Unit& u, int wr, int wc, int fr, int fq) const {
        const int row0 = u.pm * 256 + wr * 64 + fr, col0 = u.pn * 256 + wc * 32 + 8 * fq;
#pragma unroll
        for (int ai = 0; ai < 2; ++ai)
#pragma unroll
            for (int m = 0; m < 4; ++m) { const size_t row = (size_t)(row0 + ai * 128 + m * 16);
#pragma unroll
                for (int bj = 0; bj < 2; ++bj) { const int col = col0 + bj * 128; const pg8::f32x4 v0 = acc[ai][bj][m][0], v1 = acc[ai][bj][m][1];
                    u32x4 w; w.x = pk2(v0[0], v0[1]); w.y = pk2(v0[2], v0[3]); w.z = pk2(v1[0], v1[1]); w.w = pk2(v1[2], v1[3]);
                    *(u32x4*)(RA + row * D + col) = w; } }
    }
};
struct EpiMergeB {
    static constexpr bool PERM = true, AFTER_DRAIN = false;
    const bf16* RA; const bf16* ZG; bf16* MG;
    __device__ __forceinline__ void operator()(const pg8::f32x4 (&acc)[2][2][4][2], const pg8::Unit& u, int wr, int wc, int fr, int fq) const {
        const int row0 = u.pm * 256 + wr * 64 + fr, col0 = u.pn * 256 + wc * 32 + 8 * fq;
#pragma unroll
        for (int ai = 0; ai < 2; ++ai)
#pragma unroll
            for (int m = 0; m < 4; ++m) { const size_t row = (size_t)(row0 + ai * 128 + m * 16);
#pragma unroll
                for (int bj = 0; bj < 2; ++bj) { const int col = col0 + bj * 128; float ga[8], gb[8]; sig8(ZG + row * 2048 + col, ga); sig8(ZG + row * 2048 + 1024 + col, gb);
                    const pg8::f32x4 v0 = acc[ai][bj][m][0], v1 = acc[ai][bj][m][1];
                    const u32x4 ra = *(const u32x4*)(RA + row * D + col);
                    u32x4 w; w.x = pk2(ga[0] * bflo(ra.x) + gb[0] * v0[0], ga[1] * bfhi(ra.x) + gb[1] * v0[1]); w.y = pk2(ga[2] * bflo(ra.y) + gb[2] * v0[2], ga[3] * bfhi(ra.y) + gb[3] * v0[3]);
                    w.z = pk2(ga[4] * bflo(ra.z) + gb[4] * v1[0], ga[5] * bfhi(ra.z) + gb[5] * v1[1]); w.w = pk2(ga[6] * bflo(ra.w) + gb[6] * v1[2], ga[7] * bfhi(ra.w) + gb[7] * v1[3]);
                    *(u32x4*)(MG + row * D + col) = w; } }
    }
};
struct EpiX1 {
    static constexpr bool PERM = false, AFTER_DRAIN = false;
    const float* x; const float* gt1; float* out;
    __device__ __forceinline__ void operator()(const pg8::f32x4 (&acc)[2][2][4][2], const pg8::Unit& u, int wr, int wc, int fr, int fq) const {
        const int row0 = u.pm * 256 + wr * 64 + fr, col0 = u.pn * 256 + wc * 32 + 4 * fq;
#pragma unroll
        for (int ai = 0; ai < 2; ++ai)
#pragma unroll
            for (int m = 0; m < 4; ++m) { const size_t row = (size_t)(row0 + ai * 128 + m * 16);
#pragma unroll
                for (int bj = 0; bj < 2; ++bj)
#pragma unroll
                    for (int n = 0; n < 2; ++n) { const int col = col0 + bj * 128 + n * 16;
                        const f32x4 xv = *(const f32x4*)(x + row * D + col), gv = *(const f32x4*)(gt1 + col); const pg8::f32x4 a = acc[ai][bj][m][n];
                        *(f32x4*)(out + row * D + col) = (f32x4){xv.x + gv.x * a[0], xv.y + gv.y * a[1], xv.z + gv.z * a[2], xv.w + gv.w * a[3]}; } }
    }
};

__device__ __forceinline__ void route_decide(const float (&lg)[36], const float* grp_b, const float* exp_b, unsigned* ctl, int* invt, float* invw, int tok) {
    float gl[4]; int grp = 0;
#pragma unroll
    for (int q = 0; q < 4; ++q) gl[q] = lg[q] + grp_b[q];
#pragma unroll
    for (int q = 1; q < 4; ++q) if (gl[q] > gl[grp]) grp = q;
    float den = 0.f;
#pragma unroll
    for (int q = 0; q < 4; ++q) den += __expf(gl[q] - gl[grp]);
    const float pg = 1.0f / den;
    float el[8];
#pragma unroll
    for (int q = 0; q < 8; ++q) { float val = 0.f;
#pragma unroll
        for (int gq = 0; gq < 4; ++gq) val = (grp == gq) ? lg[4 + gq * 8 + q] + exp_b[gq * 8 + q] : val;
        el[q] = val; }
    int i1 = 0;
#pragma unroll
    for (int q = 1; q < 8; ++q) if (el[q] > el[i1]) i1 = q;
    int i2 = (i1 == 0) ? 1 : 0;
#pragma unroll
    for (int q = 0; q < 8; ++q) if (q != i1 && el[q] > el[i2]) i2 = q;
    const float v1 = el[i1], v2 = el[i2];
    const float e2 = __expf(v2 - v1), w1 = pg / (1.0f + e2), w2 = pg * e2 / (1.0f + e2);
    const int e1x = grp * 8 + i1, e2x = grp * 8 + i2;
    const unsigned p1 = atomicAdd(ctl + CW_CNT + 64 * e1x, 1u), p2 = atomicAdd(ctl + CW_CNT + 64 * e2x, 1u);
    invt[e1x * ECAP + (int)p1] = 2 * tok; invw[e1x * ECAP + (int)p1] = w1; invt[e2x * ECAP + (int)p2] = 2 * tok + 1; invw[e2x * ECAP + (int)p2] = w2;
}
__device__ __forceinline__ void p7_router(Frame& F, const KArgs& A) {
    const int gw = blockIdx.x * 8 + F.wave, NGW = F.G * 8, lane = F.lane;
    const float* mod = F_MOD;
    { const f32x4* src = (const f32x4*)(A.ws() + WS_WRT); LAS f32x4* dst = (LAS f32x4*)F.lds;
      for (int i = F.tid; i < 36 * D / 4; i += 512) dst[i] = src[i]; }
    __syncthreads();
    const LAS f32x4* wl = (const LAS f32x4*)F.lds;
#ifndef ROUTER_REPS
#define ROUTER_REPS 1
#endif
    for (int rrep = 0; rrep < ROUTER_REPS; ++rrep)
    for (int tp = gw; tp < SEQ / 2; tp += NGW) {
        const int t0 = 2 * tp;
        const float* src0 = F_out + (size_t)t0 * D; const float* src1 = src0 + D;
        f32x4 h0[4], h1[4]; float ss0 = 0.f, ss1 = 0.f;
#pragma unroll
        for (int j = 0; j < 4; ++j) { h0[j] = ((const f32x4*)src0)[lane + 64 * j]; h1[j] = ((const f32x4*)src1)[lane + 64 * j];
            ss0 += (h0[j].x * h0[j].x + h0[j].y * h0[j].y) + (h0[j].z * h0[j].z + h0[j].w * h0[j].w); ss1 += (h1[j].x * h1[j].x + h1[j].y * h1[j].y) + (h1[j].z * h1[j].z + h1[j].w * h1[j].w); }
        const float r0 = rsqrtf(wave_sum(ss0) * (1.0f / D) + NORM_EPS), r1 = rsqrtf(wave_sum(ss1) * (1.0f / D) + NORM_EPS);
#pragma unroll
        for (int j = 0; j < 4; ++j) {
            const f32x4 gg = ((const f32x4*)F_norm2_g)[lane + 64 * j], s1 = ((const f32x4*)(mod + 4096))[lane + 64 * j], s0 = ((const f32x4*)(mod + 3072))[lane + 64 * j];
            const f32x4 gs = gg * (1.0f + s1);
            h0[j] = (h0[j] * r0) * gs + s0; h1[j] = (h1[j] * r1) * gs + s0;
            u32x2 o; o.x = pk2(h0[j].x, h0[j].y); o.y = pk2(h0[j].z, h0[j].w); ((u32x2*)(F_H + (size_t)t0 * D))[lane + 64 * j] = o;
            o.x = pk2(h1[j].x, h1[j].y); o.y = pk2(h1[j].z, h1[j].w); ((u32x2*)(F_H + (size_t)(t0 + 1) * D))[lane + 64 * j] = o;
        }
        LAS float* lgs = (LAS float*)(F.lds + 147456 + F.wave * 512);
#pragma unroll 6
        for (int e = 0; e < 36; ++e) {
            float a0 = 0.f, a1 = 0.f;
#pragma unroll
            for (int j = 0; j < 4; ++j) { const f32x4 wv = wl[e * 256 + lane + 64 * j];
                a0 += (h0[j].x * wv.x + h0[j].y * wv.y) + (h0[j].z * wv.z + h0[j].w * wv.w); a1 += (h1[j].x * wv.x + h1[j].y * wv.y) + (h1[j].z * wv.z + h1[j].w * wv.w); }
            const bool lo = lane < 32; float xk = lo ? a0 : a1; const float yk = lo ? a1 : a0;
            xk += __shfl_xor(yk, 32);
            xk += __shfl_xor(xk, 16); xk += __shfl_xor(xk, 8); xk += __shfl_xor(xk, 4); xk += __shfl_xor(xk, 2); xk += __shfl_xor(xk, 1);
            if ((lane & 31) == 0) lgs[(lane >> 5) * 36 + e] = xk;
        }
        LDS_WAIT();
        float lg[36];
        if ((lane & 31) == 0) {
#pragma unroll
            for (int q = 0; q < 9; ++q) { const f32x4 v4 = *(const LAS f32x4*)(lgs + (lane >> 5) * 36 + 4 * q); lg[4 * q] = v4.x; lg[4 * q + 1] = v4.y; lg[4 * q + 2] = v4.z; lg[4 * q + 3] = v4.w; }
        }
        if ((lane & 31) == 0 && rrep == ROUTER_REPS - 1) route_decide(lg, F_grp_b, F_exp_b, F.ctl, F_INVT, F_INVW, t0 + (lane >> 5));
        if (rrep != ROUTER_REPS - 1) { float sink = 0.f; if ((lane & 31) == 0) { for (int q = 0; q < 36; ++q) sink += lg[q]; } asm volatile("" :: "v"(sink)); }
    }
    __syncthreads();
}
__device__ __forceinline__ void p7_moe_convert(Frame& F, const KArgs& A) {
    const int gw = blockIdx.x * 8 + F.wave, NGW = F.G * 8, lane = F.lane;
    {
    LAS float* scr = (LAS float*)(F.lds + F.wave * 16640);
    for (int it = gw; it < NEXP * 384; it += NGW) {
        const int e = it / 384; int r = it % 384;
        if (r < 256) { const bool up = r >= 128; r &= 127; const int kb = r >> 3, nb = r & 7, n0 = 64 * nb;
            const float* W = (up ? F_wu : F_wg) + (size_t)e * D * DEXP;
            transpose_item64(W, D, DEXP, 64 * kb, n0, F_WguT + (size_t)e * 1024 * D, 256 * (n0 >> 7) + (up ? 128 : 0) + (n0 & 127), scr, lane);
        } else { r -= 256; const int kb = r >> 4, nb = r & 15;
            transpose_item64(F_wd + (size_t)e * DEXP * D, DEXP, D, 64 * kb, 64 * nb, F_WdT + (size_t)e * 1024 * DEXP, 64 * nb, scr, lane); }
    }
    }
}

__device__ __forceinline__ int moe_tables(Frame& F, const KArgs& A) {
    LAS int* tab = (LAS int*)(F.lds + TAB_OFF);
    __syncthreads();
    if (F.tid < 64) {
        const int e = F.tid & 31;
        const int cnt = (int)__hip_atomic_load(F.ctl + CW_CNT + 64 * e, __ATOMIC_RELAXED, __HIP_MEMORY_SCOPE_AGENT);
        const int nt = (cnt + 255) >> 8;
        int incl = nt;
#pragma unroll
        for (int o = 1; o < 32; o <<= 1) { const int up = __shfl_up(incl, o); if (e >= o) incl += up; }
        const int off = incl - nt;
        if (F.tid < 32) { tab[e] = off * 256; tab[64 + e] = cnt; for (int q = 0; q < nt && off + q < MAXTILES; ++q) tab[128 + off + q] = e; if (e == 31) tab[32] = incl < MAXTILES ? incl : MAXTILES; }
    }
    __syncthreads();
    return tab[32];
}

__device__ __forceinline__ void p8_gather(Frame& F, const KArgs& A) {
    const int ntiles = moe_tables(F, A);
    LAS int* tab = (LAS int*)(F.lds + TAB_OFF);
    const int gw = blockIdx.x * 8 + F.wave, NGW = F.G * 8, lane = F.lane;
    for (int t = gw; t < SEQ; t += NGW) {
        const unsigned* rt = F_route + (size_t)t * 8;
        const u32x4 h0 = ((const u32x4*)(F_H + (size_t)t * D))[lane], h1 = ((const u32x4*)(F_H + (size_t)t * D))[lane + 64];
#pragma unroll
        for (int s = 0; s < 2; ++s) {
            const int e = (int)rt[3 * s], pos = (int)rt[3 * s + 1]; const int row = tab[e] + pos;
            if (row < MAXTILES * 256) {
                ((u32x4*)(F_XG + (size_t)row * D))[lane] = h0; ((u32x4*)(F_XG + (size_t)row * D))[lane + 64] = h1;
                if (lane == 0) { F_rowinfo[row] = 2 * t + s; F_roww[row] = __builtin_bit_cast(float, rt[3 * s + 2]); }
            }
        }
    }
    for (int e = blockIdx.x; e < NEXP; e += F.G) {
        const int cnt = tab[64 + e], r0 = tab[e] + cnt, r1 = tab[e] + (((cnt + 255) >> 8) << 8);
        for (int row = r0 + F.wave; row < r1 && row < MAXTILES * 256; row += 8) {
            ((u32x4*)(F_XG + (size_t)row * D))[lane] = (u32x4){0u, 0u, 0u, 0u}; ((u32x4*)(F_XG + (size_t)row * D))[lane + 64] = (u32x4){0u, 0u, 0u, 0u};
            if (lane == 0) { F_rowinfo[row] = -1; F_roww[row] = 0.f; }
        }
    }
    (void)ntiles;
}

struct MoeOrder {
    const LAS int* tab; const int* invt; int T4, G, c;
    __device__ __forceinline__ bool next(int i, pg8::Unit& u) const { const long L = (long)i * G + c; if (L >= T4) return false; const int rt = (int)(L >> 2), j = (int)(L & 3); u.pm = rt; u.pn = tab[128 + rt] * 4 + j; return true; }
    __device__ __forceinline__ int a_row(const pg8::Unit& u, int r) const { const int e = tab[128 + u.pm], pos = (u.pm - (tab[e] >> 8)) * 256 + r; return pos < tab[64 + e] ? (invt[e * ECAP + pos] >> 1) : 0; }
    __device__ __forceinline__ void a_ready(const pg8::Unit&) const {}
    __device__ __forceinline__ void done(const pg8::Unit&) const {}
};
struct EpiSwiGLU {
    static constexpr bool PERM = true, AFTER_DRAIN = false;
    bf16* HM;
    __device__ __forceinline__ void operator()(const pg8::f32x4 (&acc)[2][2][4][2], const pg8::Unit& u, int wr, int wc, int fr, int fq) const {
        const int row0 = u.pm * 256 + wr * 64 + fr, col0 = (u.pn & 3) * 128 + wc * 32 + 8 * fq;
#pragma unroll
        for (int ai = 0; ai < 2; ++ai)
#pragma unroll
            for (int m = 0; m < 4; ++m) { const size_t row = (size_t)(row0 + ai * 128 + m * 16);
                const pg8::f32x4 g0 = acc[ai][0][m][0], g1 = acc[ai][0][m][1], u0 = acc[ai][1][m][0], u1 = acc[ai][1][m][1];
                u32x4 w; w.x = pk2(siluf_(g0[0]) * u0[0], siluf_(g0[1]) * u0[1]); w.y = pk2(siluf_(g0[2]) * u0[2], siluf_(g0[3]) * u0[3]);
                w.z = pk2(siluf_(g1[0]) * u1[0], siluf_(g1[1]) * u1[1]); w.w = pk2(siluf_(g1[2]) * u1[2], siluf_(g1[3]) * u1[3]);
                *(u32x4*)(HM + row * DEXP + col0) = w; }
    }
};
struct EpiScatter {
    static constexpr bool PERM = true, AFTER_DRAIN = false;
    bf16* YBUF; const LAS int* tab; const int* invt; const float* invw;
    __device__ __forceinline__ void operator()(const pg8::f32x4 (&acc)[2][2][4][2], const pg8::Unit& u, int wr, int wc, int fr, int fq) const {
        const int e = tab[128 + u.pm], cnt = tab[64 + e], pos0 = (u.pm - (tab[e] >> 8)) * 256 + wr * 64 + fr, col0 = (u.pn & 3) * 256 + wc * 32 + 8 * fq;
#pragma unroll
        for (int ai = 0; ai < 2; ++ai)
#pragma unroll
            for (int m = 0; m < 4; ++m) { const int pos = pos0 + ai * 128 + m * 16;
                if (pos < cnt) { const int info = invt[e * ECAP + pos]; const float wt = invw[e * ECAP + pos];
#pragma unroll
                    for (int bj = 0; bj < 2; ++bj) { const pg8::f32x4 v0 = acc[ai][bj][m][0], v1 = acc[ai][bj][m][1];
                        u32x4 w; w.x = pk2(wt * v0[0], wt * v0[1]); w.y = pk2(wt * v0[2], wt * v0[3]); w.z = pk2(wt * v1[0], wt * v1[1]); w.w = pk2(wt * v1[2], wt * v1[3]);
                        *(u32x4*)(YBUF + (size_t)info * D + col0 + bj * 128) = w; } } }
    }
};

__device__ __forceinline__ void p11_final(Frame& F, const KArgs& A) {
    const int gw = blockIdx.x * 8 + F.wave, NGW = F.G * 8, lane = F.lane;
    const float* gt2 = F_MOD + 5120;
    for (int t = gw; t < SEQ; t += NGW) {
        float* row = F_out + (size_t)t * D;
        f32x4 v[4]; float ss = 0.f;
#pragma unroll
        for (int j = 0; j < 4; ++j) {
            const f32x4 x1 = ((const f32x4*)row)[lane + 64 * j], g2 = ((const f32x4*)gt2)[lane + 64 * j];
            const u32x2 y0 = ((const u32x2*)(F_YBUF + (size_t)(2 * t) * D))[lane + 64 * j], y1 = ((const u32x2*)(F_YBUF + (size_t)(2 * t + 1) * D))[lane + 64 * j];
            f32x4 ys; ys.x = bflo(y0.x) + bflo(y1.x); ys.y = bfhi(y0.x) + bfhi(y1.x); ys.z = bflo(y0.y) + bflo(y1.y); ys.w = bfhi(y0.y) + bfhi(y1.y);
            v[j] = x1 + g2 * ys;
            ss += (v[j].x * v[j].x + v[j].y * v[j].y) + (v[j].z * v[j].z + v[j].w * v[j].w);
        }
        const float rinv = rsqrtf(wave_sum(ss) * (1.0f / D) + NORM_EPS);
#pragma unroll
        for (int j = 0; j < 4; ++j) { const f32x4 fg = ((const f32x4*)F_fin_g)[lane + 64 * j]; ((f32x4*)row)[lane + 64 * j] = v[j] * rinv * fg; }
    }
}


constexpr int SL = 8192;
constexpr int SC_LBUF = 12 * SL;
constexpr int SC_MISC = 19 * SL;

__device__ __forceinline__ int sw_(int r) { return (r ^ (r >> 3)) & 7; }
__device__ __forceinline__ int m_off(int r, int c) { return r * 128 + (((c >> 3) ^ sw_(r)) << 4) + ((c & 7) << 1); }
__device__ __forceinline__ int frag_off(int r, int chunk) { return r * 128 + ((chunk ^ sw_(r)) << 4); }
__device__ __forceinline__ float tanh_fast(float x) { const float e = __expf(2.0f * x); return 1.0f - 2.0f * __builtin_amdgcn_rcpf(e + 1.0f); }

template <bool SWAP> __device__ __forceinline__ void mm_tiles(const LAS unsigned char* X, const LAS unsigned char* Y, int mt, int nt0, int fr, int fq, pg8::f32x4 (&acc)[2]) {
#pragma unroll
    for (int ks = 0; ks < 2; ++ks) {
        const bf16x8 xf = *(const LAS bf16x8*)(X + frag_off(16 * mt + fr, 4 * ks + fq));
#pragma unroll
        for (int n = 0; n < 2; ++n) {
            const bf16x8 yf = *(const LAS bf16x8*)(Y + frag_off(16 * (nt0 + n) + fr, 4 * ks + fq));
            acc[n] = SWAP ? __builtin_amdgcn_mfma_f32_16x16x32_bf16(yf, xf, acc[n], 0, 0, 0) : __builtin_amdgcn_mfma_f32_16x16x32_bf16(xf, yf, acc[n], 0, 0, 0);
        }
    }
}
__device__ __forceinline__ void st4(LAS unsigned char* slot, int r, int c, float a, float b, float cc, float d) { u32x2 o; o.x = pk2(a, b); o.y = pk2(cc, d); *(LAS u32x2*)(slot + m_off(r, c)) = o; }
__device__ __forceinline__ pg8::f32x4 ld4(const LAS unsigned char* slot, int r, int c) { const u32x2 w = *(const LAS u32x2*)(slot + m_off(r, c)); return (pg8::f32x4){bflo(w.x), bfhi(w.x), bflo(w.y), bfhi(w.y)}; }
__device__ __forceinline__ int opq(int x) { asm volatile("" : "+v"(x)); return x; }
struct LanePat { int x[2], y[2][2], nat[2], tr[2]; };
__device__ __forceinline__ void lane_pat(LanePat& P, int mt, int nt0, int fr, int fq) {
#pragma unroll
    for (int ks = 0; ks < 2; ++ks) { P.x[ks] = frag_off(16 * mt + fr, 4 * ks + fq);
#pragma unroll
        for (int n = 0; n < 2; ++n) P.y[n][ks] = frag_off(16 * (nt0 + n) + fr, 4 * ks + fq); }
#pragma unroll
    for (int n = 0; n < 2; ++n) { P.nat[n] = m_off(16 * mt + fr, 16 * (nt0 + n) + 4 * fq); P.tr[n] = m_off(16 * (nt0 + n) + fr, 16 * mt + 4 * fq); }
}
template <bool SWAP> __device__ __forceinline__ void mm_o(const LAS unsigned char* X, const LAS unsigned char* Y, const LanePat& P, pg8::f32x4 (&acc)[2]) {
#pragma unroll
    for (int ks = 0; ks < 2; ++ks) {
        const bf16x8 xf = *(const LAS bf16x8*)(X + P.x[ks]);
#pragma unroll
        for (int n = 0; n < 2; ++n) {
            const bf16x8 yf = *(const LAS bf16x8*)(Y + P.y[n][ks]);
            acc[n] = SWAP ? __builtin_amdgcn_mfma_f32_16x16x32_bf16(yf, xf, acc[n], 0, 0, 0) : __builtin_amdgcn_mfma_f32_16x16x32_bf16(xf, yf, acc[n], 0, 0, 0);
        }
    }
}
__device__ __forceinline__ void st4o(LAS unsigned char* slot, int off, float a, float b, float cc, float d) { u32x2 o; o.x = pk2(a, b); o.y = pk2(cc, d); *(LAS u32x2*)(slot + off) = o; }
__device__ __forceinline__ pg8::f32x4 ld4o(const LAS unsigned char* slot, int off) { const u32x2 w = *(const LAS u32x2*)(slot + off); return (pg8::f32x4){bflo(w.x), bfhi(w.x), bflo(w.y), bfhi(w.y)}; }
#ifndef P1REP
#define P1REP 0
#endif
#define P1R(b) for (int q_ = 0; q_ < (((P1REP >> (b)) & 1) ? 2 : 1); ++q_)
#define ZERO2(a) do { a[0] = (pg8::f32x4){0.f, 0.f, 0.f, 0.f}; a[1] = (pg8::f32x4){0.f, 0.f, 0.f, 0.f}; } while (0)

__device__ __forceinline__ void mix8(const bf16* Z, int col0, const float* mu, int dl, int dr, int du, int dd, bool okl, bool okr, bool oku, bool okd, float (&o)[8]) {
    const u32x4 z = *(const u32x4*)(Z + col0);
    const u32x4 l = *(const u32x4*)(Z + col0 + dl * 2048), r = *(const u32x4*)(Z + col0 + dr * 2048), up = *(const u32x4*)(Z + col0 + du * 2048), dn = *(const u32x4*)(Z + col0 + dd * 2048);
    const f32x4 m0 = *(const f32x4*)(mu + col0), m1 = *(const f32x4*)(mu + col0 + 4);
    float zz[8], nn[8];
    zz[0] = bflo(z.x); zz[1] = bfhi(z.x); zz[2] = bflo(z.y); zz[3] = bfhi(z.y); zz[4] = bflo(z.z); zz[5] = bfhi(z.z); zz[6] = bflo(z.w); zz[7] = bfhi(z.w);
    nn[0] = okl ? bflo(l.x) : 0.f; nn[1] = okr ? bfhi(r.x) : 0.f; nn[2] = oku ? bflo(up.y) : 0.f; nn[3] = okd ? bfhi(dn.y) : 0.f;
    nn[4] = okl ? bflo(l.z) : 0.f; nn[5] = okr ? bfhi(r.z) : 0.f; nn[6] = oku ? bflo(up.w) : 0.f; nn[7] = okd ? bfhi(dn.w) : 0.f;
    const float mm[8] = {m0.x, m0.y, m0.z, m0.w, m1.x, m1.y, m1.z, m1.w};
#pragma unroll
    for (int i = 0; i < 8; ++i) o[i] = zz[i] + mm[i] * (nn[i] - zz[i]);
}
__device__ __forceinline__ void mix4(const bf16* Z, int col0, const float* mu, int dl, int dr, int du, int dd, bool okl, bool okr, bool oku, bool okd, float (&o)[4]) {
    const u32x2 z = *(const u32x2*)(Z + col0);
    const u32x2 l = *(const u32x2*)(Z + col0 + dl * 2048), r = *(const u32x2*)(Z + col0 + dr * 2048), up = *(const u32x2*)(Z + col0 + du * 2048), dn = *(const u32x2*)(Z + col0 + dd * 2048);
    const f32x4 m0 = *(const f32x4*)(mu + col0);
    const float zz[4] = {bflo(z.x), bfhi(z.x), bflo(z.y), bfhi(z.y)};
    const float nn[4] = {okl ? bflo(l.x) : 0.f, okr ? bfhi(r.x) : 0.f, oku ? bflo(up.y) : 0.f, okd ? bfhi(dn.y) : 0.f};
    const float mm[4] = {m0.x, m0.y, m0.z, m0.w};
#pragma unroll
    for (int i = 0; i < 4; ++i) o[i] = zz[i] + mm[i] * (nn[i] - zz[i]);
}

struct P1Geo { const bf16* Z; int dl, dr, du, dd, tokchunk; bool okl, okr, oku, okd; };
__device__ __forceinline__ P1Geo p1_geo(const bf16* ZA, bool isctx, int d, int sc, int j, int x) {
    P1Geo g;
    if (isctx) { g.tokchunk = d ? 3 - j : j; const int tc = g.tokchunk * 64 + x; g.Z = ZA + (size_t)(SEQ + tc) * 2048; g.okl = tc > 0; g.okr = tc < CTXL - 1; g.oku = g.okl; g.okd = g.okr; g.dl = g.okl ? -1 : 0; g.dr = g.okr ? 1 : 0; g.du = g.dl; g.dd = g.dr; }
    else { g.tokchunk = d ? 255 - (4 * sc + j) : 4 * sc + j; const int tok = g.tokchunk * 64 + x; g.Z = ZA + (size_t)tok * 2048; g.okl = x > 0; g.okr = x < 63; g.oku = g.tokchunk > 0; g.okd = g.tokchunk < GROWS - 1; g.dl = g.okl ? -1 : 0; g.dr = g.okr ? 1 : 0; g.du = g.oku ? -64 : 0; g.dd = g.okd ? 64 : 0; }
    return g;
}
__device__ __forceinline__ void p1_rawload(const P1Geo& g, int col0, u32x4 (&q)[5]) {
    q[0] = *(const u32x4*)(g.Z + col0); q[1] = *(const u32x4*)(g.Z + col0 + g.dl * 2048); q[2] = *(const u32x4*)(g.Z + col0 + g.dr * 2048); q[3] = *(const u32x4*)(g.Z + col0 + g.du * 2048); q[4] = *(const u32x4*)(g.Z + col0 + g.dd * 2048);
}
__device__ __forceinline__ void p1_rawmix(const u32x4 (&q)[5], int col0, const float* mu, bool okl, bool okr, bool oku, bool okd, float (&o)[8]) {
    const u32x4 z = q[0], l = q[1], r = q[2], up = q[3], dn = q[4];
    const f32x4 m0 = *(const f32x4*)(mu + col0), m1 = *(const f32x4*)(mu + col0 + 4);
    float zz[8], nn[8];
    zz[0] = bflo(z.x); zz[1] = bfhi(z.x); zz[2] = bflo(z.y); zz[3] = bfhi(z.y); zz[4] = bflo(z.z); zz[5] = bfhi(z.z); zz[6] = bflo(z.w); zz[7] = bfhi(z.w);
    nn[0] = okl ? bflo(l.x) : 0.f; nn[1] = okr ? bfhi(r.x) : 0.f; nn[2] = oku ? bflo(up.y) : 0.f; nn[3] = okd ? bfhi(dn.y) : 0.f;
    nn[4] = okl ? bflo(l.z) : 0.f; nn[5] = okr ? bfhi(r.z) : 0.f; nn[6] = oku ? bflo(up.w) : 0.f; nn[7] = okd ? bfhi(dn.w) : 0.f;
    const float mm[8] = {m0.x, m0.y, m0.z, m0.w, m1.x, m1.y, m1.z, m1.w};
#pragma unroll
    for (int i = 0; i < 8; ++i) o[i] = zz[i] + mm[i] * (nn[i] - zz[i]);
}

__device__ __forceinline__ void scan_pass1_unit(Frame& F, const KArgs& A, int chain, int scidx, int cj) {
    const int d = chain >> 3, h = chain & 7, tid = F.tid, lane = F.lane, w = F.wave, fr = lane & 15, fq = lane >> 4, mt = w >> 1, nt0 = 2 * (w & 1);
    LAS unsigned char* const L = F.lds;
    LanePat P; lane_pat(P, mt, nt0, fr, fq);
#define S_(i) (L + opq((i) * SL))
    const bool isctx = (scidx == 0); const int sc = scidx - 1;
    const bf16* ZA = F_ZA; const float* mu = F_mu;
    { const int r = tid >> 3, ch = tid & 7; u32x4 idv = (u32x4){0u, 0u, 0u, 0u};
      if ((r >> 3) == ch) { const unsigned one = 0x3f80u; const int e = r & 7; if (e == 0) idv.x = one; else if (e == 1) idv.x = one << 16; else if (e == 2) idv.y = one; else if (e == 3) idv.y = one << 16; else if (e == 4) idv.z = one; else if (e == 5) idv.z = one << 16; else if (e == 6) idv.w = one; else idv.w = one << 16; }
      *(LAS u32x4*)(S_(14) + frag_off(r, ch)) = idv; *(LAS u32x4*)(S_(16) + frag_off(r, ch)) = (u32x4){0u, 0u, 0u, 0u}; }
    int ppc = 14, qpc = 16;
    const int jbeg = isctx ? cj : 0, jend = isctx ? cj + 1 : 4;
    const int t = tid >> 3, cg = tid & 7, x = d ? 63 - t : t;
    const int colb[5] = {h * 64 + 8 * cg, 512 + h * 64 + 8 * cg, 1024 + h * 64 + 8 * cg, 1536 + d * 64 + 8 * cg, 1664 + d * 64 + 8 * cg};
    u32x4 raw[3][5];
    P1Geo geo = p1_geo(ZA, isctx, d, sc, jbeg, x);
#pragma unroll
    for (int m = 0; m < 3; ++m) p1_rawload(geo, colb[m], raw[m]);
    u32x4 wstage, astage;
    { const bf16* wt = (const bf16*)(A.ws() + WS_WUPT) + (size_t)chain * 4096, *at = (const bf16*)(A.ws() + WS_AUPT) + (size_t)chain * 4096;
      wstage = *(const u32x4*)(wt + t * 64 + 8 * cg); astage = *(const u32x4*)(at + t * 64 + 8 * cg); }
    for (int j = jbeg; j < jend; ++j) {
        const int ppn = ppc ^ 1, qpn = qpc ^ 1;
        const int tokchunk = geo.tokchunk;
        float rv[8], kv[8];
        P1R(0) {
            float vv[8], wdv[8], adv[8];
            u32x4 rw[5], ra[5]; p1_rawload(geo, colb[3], rw); p1_rawload(geo, colb[4], ra);
            p1_rawmix(raw[0], colb[0], mu, geo.okl, geo.okr, geo.oku, geo.okd, rv);
            p1_rawmix(raw[1], colb[1], mu, geo.okl, geo.okr, geo.oku, geo.okd, kv);
            p1_rawmix(raw[2], colb[2], mu, geo.okl, geo.okr, geo.oku, geo.okd, vv);
            p1_rawmix(rw, colb[3], mu, geo.okl, geo.okr, geo.oku, geo.okd, wdv);
            p1_rawmix(ra, colb[4], mu, geo.okl, geo.okr, geo.oku, geo.okd, adv);
#pragma unroll
            for (int i = 0; i < 8; ++i) *(LAS bf16*)(S_(7) + m_off(8 * cg + i, t)) = (bf16)f2bf(vv[i]);
            u32x4 o; o.x = pk2(tanh_fast(wdv[0]), tanh_fast(wdv[1])); o.y = pk2(tanh_fast(wdv[2]), tanh_fast(wdv[3])); o.z = pk2(tanh_fast(wdv[4]), tanh_fast(wdv[5])); o.w = pk2(tanh_fast(wdv[6]), tanh_fast(wdv[7]));
            *(LAS u32x4*)(S_(8) + frag_off(t, cg)) = o;
            o.x = pk2(adv[0], adv[1]); o.y = pk2(adv[2], adv[3]); o.z = pk2(adv[4], adv[5]); o.w = pk2(adv[6], adv[7]);
            *(LAS u32x4*)(S_(9) + frag_off(t, cg)) = o;
            *(LAS u32x4*)(S_(10) + frag_off(t, cg)) = wstage;
            *(LAS u32x4*)(S_(11) + frag_off(t, cg)) = astage;
        }
        __syncthreads();
        P1R(1) {
            pg8::f32x4 acw[2], aca[2]; ZERO2(acw); ZERO2(aca);
            mm_o<false>(S_(8), S_(10), P, acw);
            mm_o<true>(S_(9), S_(11), P, aca);
            const int row = 16 * mt + fr;
            LAS float* lb = (LAS float*)(L + opq(SC_LBUF)); LAS float* tot = (LAS float*)(L + opq(SC_MISC));
#pragma unroll
            for (int n = 0; n < 2; ++n) {
                const int cc = 16 * (nt0 + n) + fr; const float w0c = F_w0[d * DR + h * 64 + cc];
                float p[4];
#pragma unroll
                for (int i = 0; i < 4; ++i) p[i] = -0.6065306597126334f * sigmoidf_(acw[n][i] + w0c);
                p[1] += p[0]; p[2] += p[1]; p[3] += p[2];
                float inc = p[3]; { const float u1 = __shfl_up(inc, 16); inc += (fq >= 1) ? u1 : 0.f; const float u2 = __shfl_up(inc, 32); inc += (fq >= 2) ? u2 : 0.f; }
                const float exc = inc - p[3];
#pragma unroll
                for (int i = 0; i < 4; ++i) lb[(16 * mt + 4 * fq + i) * 64 + cc] = p[i] + exc;
                if (fq == 3) tot[mt * 64 + cc] = inc;
                const int c0 = 16 * (nt0 + n) + 4 * fq; const f32x4 a0v = *(const f32x4*)(F_a0 + d * DR + h * 64 + c0);
                st4o(S_(18), P.nat[n], sigmoidf_(aca[n][0] + a0v[0]), sigmoidf_(aca[n][1] + a0v[1]), sigmoidf_(aca[n][2] + a0v[2]), sigmoidf_(aca[n][3] + a0v[3]));
            }
        }
        __syncthreads();
        P1R(2) {
            const LAS float* lb = (const LAS float*)(L + opq(SC_LBUF));
            float Lt[8], Lp[8], LC[8], av[8];
            { const LAS float* tot = (const LAS float*)(L + opq(SC_MISC));
              f32x4 tb[4][2];
#pragma unroll
              for (int m = 0; m < 4; ++m) { tb[m][0] = *(const LAS f32x4*)(tot + m * 64 + 8 * cg); tb[m][1] = *(const LAS f32x4*)(tot + m * 64 + 8 * cg + 4); }
              const int mtt = t >> 4;
              const f32x4 a0 = *(const LAS f32x4*)(lb + t * 64 + 8 * cg), a1 = *(const LAS f32x4*)(lb + t * 64 + 8 * cg + 4);
              const int tp = t > 0 ? t - 1 : 0; const f32x4 b0 = *(const LAS f32x4*)(lb + tp * 64 + 8 * cg), b1 = *(const LAS f32x4*)(lb + tp * 64 + 8 * cg + 4);
              const bool first = (t & 15) == 0;
#pragma unroll
              for (int i = 0; i < 4; ++i) {
                  const float o0 = (mtt > 0 ? tb[0][0][i] : 0.f) + (mtt > 1 ? tb[1][0][i] : 0.f) + (mtt > 2 ? tb[2][0][i] : 0.f), o1 = (mtt > 0 ? tb[0][1][i] : 0.f) + (mtt > 1 ? tb[1][1][i] : 0.f) + (mtt > 2 ? tb[2][1][i] : 0.f);
                  Lt[i] = a0[i] + o0; Lt[4 + i] = a1[i] + o1; Lp[i] = first ? o0 : b0[i] + o0; Lp[4 + i] = first ? o1 : b1[i] + o1;
                  LC[i] = (tb[0][0][i] + tb[1][0][i]) + (tb[2][0][i] + tb[3][0][i]); LC[4 + i] = (tb[0][1][i] + tb[1][1][i]) + (tb[2][1][i] + tb[3][1][i]); }
              const u32x4 aw = *(const LAS u32x4*)(S_(18) + frag_off(t, cg));
              av[0] = bflo(aw.x); av[1] = bfhi(aw.x); av[2] = bflo(aw.y); av[3] = bfhi(aw.y); av[4] = bflo(aw.z); av[5] = bfhi(aw.z); av[6] = bflo(aw.w); av[7] = bfhi(aw.w); }
            const int cb = h * 64 + 8 * cg;
            const f32x4 kk0 = *(const f32x4*)(F_k_k + cb), kk1 = *(const f32x4*)(F_k_k + cb + 4), ka0 = *(const f32x4*)(F_k_a + cb), ka1 = *(const f32x4*)(F_k_a + cb + 4);
            const float kkc[8] = {kk0.x, kk0.y, kk0.z, kk0.w, kk1.x, kk1.y, kk1.z, kk1.w}, kac[8] = {ka0.x, ka0.y, ka0.z, ka0.w, ka1.x, ka1.y, ka1.z, ka1.w};
            float kkv[8], n2 = 0.f;
#pragma unroll
            for (int i = 0; i < 8; ++i) { kkv[i] = kv[i] * kkc[i]; n2 += kkv[i] * kkv[i]; }
            n2 += __shfl_xor(n2, 1); n2 += __shfl_xor(n2, 2); n2 += __shfl_xor(n2, 4);
            const float inv = __builtin_amdgcn_rcpf(fmaxf(__builtin_amdgcn_sqrtf(n2), 1e-12f));
            float kb[8], rb[8], ah[8], kh[8], ahc[8], khc[8];
#pragma unroll
            for (int i = 0; i < 8; ++i) { const float kk = kkv[i] * inv, al = kk * av[i], kt = kv[i] * (1.0f + (av[i] - 1.0f) * kac[i]);
                const float ep = __expf(Lp[i]), et = __expf(Lt[i]), en = __expf(-Lt[i]), ec = __expf(LC[i] - Lt[i]);
                kb[i] = kk * ep; rb[i] = rv[i] * et; ah[i] = al * en; kh[i] = kt * en; ahc[i] = al * ec; khc[i] = kt * ec; }
            u32x4 o;
            o.x = pk2(kb[0], kb[1]); o.y = pk2(kb[2], kb[3]); o.z = pk2(kb[4], kb[5]); o.w = pk2(kb[6], kb[7]); *(LAS u32x4*)(S_(0) + frag_off(t, cg)) = o;
            o.x = pk2(rb[0], rb[1]); o.y = pk2(rb[2], rb[3]); o.z = pk2(rb[4], rb[5]); o.w = pk2(rb[6], rb[7]); *(LAS u32x4*)(S_(1) + frag_off(t, cg)) = o;
            o.x = pk2(ah[0], ah[1]); o.y = pk2(ah[2], ah[3]); o.z = pk2(ah[4], ah[5]); o.w = pk2(ah[6], ah[7]); *(LAS u32x4*)(S_(2) + frag_off(t, cg)) = o;
            o.x = pk2(kh[0], kh[1]); o.y = pk2(kh[2], kh[3]); o.z = pk2(kh[4], kh[5]); o.w = pk2(kh[6], kh[7]); *(LAS u32x4*)(S_(3) + frag_off(t, cg)) = o;
#pragma unroll
            for (int i = 0; i < 8; ++i) { *(LAS bf16*)(S_(4) + m_off(8 * cg + i, t)) = (bf16)f2bf(kb[i]); *(LAS bf16*)(S_(5) + m_off(8 * cg + i, t)) = (bf16)f2bf(ahc[i]); *(LAS bf16*)(S_(6) + m_off(8 * cg + i, t)) = (bf16)f2bf(khc[i]); }
            if (t == 0) { LAS float* gam = (LAS float*)(L + opq(SC_MISC) + 2048);
#pragma unroll
                for (int i = 0; i < 8; ++i) gam[8 * cg + i] = __expf(LC[i]); }
        }
        __syncthreads();
        P1R(3) {
            pg8::f32x4 a1[2], a2[2]; ZERO2(a1); ZERO2(a2);
            mm_o<true>(S_(0), S_(2), P, a1);
            mm_o<false>(S_(0), S_(2), P, a2);
#pragma unroll
            for (int n = 0; n < 2; ++n) {
                { const int tt = 16 * mt + fr, s0 = 16 * (nt0 + n) + 4 * fq; float m[4], t0[4];
#pragma unroll
                  for (int i = 0; i < 4; ++i) { m[i] = (s0 + i < tt) ? -a1[n][i] : 0.f; t0[i] = m[i] + ((s0 + i == tt) ? 1.0f : 0.f); }
                  st4o(S_(8), P.nat[n], m[0], m[1], m[2], m[3]); st4o(S_(18), P.nat[n], t0[0], t0[1], t0[2], t0[3]); }
                { const int t0r = 16 * mt + 4 * fq, ss = 16 * (nt0 + n) + fr; float m[4];
#pragma unroll
                  for (int i = 0; i < 4; ++i) m[i] = (ss < t0r + i) ? -a2[n][i] : 0.f;
                  st4o(S_(9), P.tr[n], m[0], m[1], m[2], m[3]); }
            }
            ZERO2(a1); ZERO2(a2);
            mm_o<true>(S_(0), S_(3), P, a1);
            mm_o<true>(S_(1), S_(2), P, a2);
            pg8::f32x4 a3[2]; ZERO2(a3);
            mm_o<true>(S_(1), S_(3), P, a3);
#pragma unroll
            for (int n = 0; n < 2; ++n) { const int tt = 16 * mt + fr, s0 = 16 * (nt0 + n) + 4 * fq; float u[4], v2[4], v3[4];
#pragma unroll
                for (int i = 0; i < 4; ++i) { u[i] = (s0 + i < tt) ? a1[n][i] : 0.f; v2[i] = (s0 + i <= tt) ? a2[n][i] : 0.f; v3[i] = (s0 + i <= tt) ? a3[n][i] : 0.f; }
                st4o(S_(10), P.nat[n], u[0], u[1], u[2], u[3]); st4o(S_(11), P.nat[n], v2[0], v2[1], v2[2], v2[3]); st4o(S_(12), P.nat[n], v3[0], v3[1], v3[2], v3[3]); }
        }
        __syncthreads();
        P1R(4) {
            pg8::f32x4 a1[2], a2[2], a3[2]; ZERO2(a1); ZERO2(a2); ZERO2(a3);
            mm_o<false>(S_(10), S_(7), P, a1);
            mm_o<true>(S_(8), S_(9), P, a2);
            mm_o<false>(S_(8), S_(9), P, a3);
#pragma unroll
            for (int n = 0; n < 2; ++n) {
                st4o(S_(13), P.tr[n], a1[n][0], a1[n][1], a1[n][2], a1[n][3]);
                st4o(S_(0), P.nat[n], a2[n][0], a2[n][1], a2[n][2], a2[n][3]);
                st4o(S_(2), P.tr[n], a3[n][0], a3[n][1], a3[n][2], a3[n][3]); }
        }
        __syncthreads();
#pragma unroll
        for (int k = 1; k <= 5; ++k) {
            const int pc = (k & 1) ? 0 : 8, pct = (k & 1) ? 2 : 9, pn = (k & 1) ? 8 : 0, pnt = (k & 1) ? 9 : 2, tc = (k & 1) ? 18 : 10, tn = (k & 1) ? 10 : 18;
            P1R(5) {
            pg8::f32x4 a1[2], a2[2], a3[2];
#pragma unroll
            for (int n = 0; n < 2; ++n) a1[n] = ld4o(S_(tc), P.nat[n]);
            mm_o<true>(S_(tc), S_(pct), P, a1);
            if (k < 5) { ZERO2(a2); ZERO2(a3); mm_o<true>(S_(pc), S_(pct), P, a2); mm_o<false>(S_(pc), S_(pct), P, a3); }
#pragma unroll
            for (int n = 0; n < 2; ++n) {
                st4o(S_(tn), P.nat[n], a1[n][0], a1[n][1], a1[n][2], a1[n][3]);
                if (k < 5) { st4o(S_(pn), P.nat[n], a2[n][0], a2[n][1], a2[n][2], a2[n][3]);
                             st4o(S_(pnt), P.tr[n], a3[n][0], a3[n][1], a3[n][2], a3[n][3]); } }
            __syncthreads();
            }
        }
        P1R(6) {
            pg8::f32x4 a1[2], a2[2]; ZERO2(a1); ZERO2(a2);
            mm_o<false>(S_(10), S_(4), P, a1);
            mm_o<false>(S_(10), S_(13), P, a2);
#pragma unroll
            for (int n = 0; n < 2; ++n) {
                st4o(S_(8), P.tr[n], -a1[n][0], -a1[n][1], -a1[n][2], -a1[n][3]);
                st4o(S_(9), P.tr[n], -a2[n][0], -a2[n][1], -a2[n][2], -a2[n][3]); }
        }
        __syncthreads();
        pg8::f32x4 accY[2];
        P1R(7) {
            pg8::f32x4 a1[2], a2[2], a3[2];
#pragma unroll
            for (int n = 0; n < 2; ++n) a1[n] = ld4o(S_(1), P.nat[n]);
            mm_o<true>(S_(11), S_(8), P, a1);
            ZERO2(accY); mm_o<true>(S_(12), S_(7), P, accY); mm_o<true>(S_(11), S_(9), P, accY);
            ZERO2(a2); mm_o<true>(S_(5), S_(8), P, a2);
            ZERO2(a3); mm_o<true>(S_(7), S_(6), P, a3); mm_o<true>(S_(9), S_(5), P, a3);
            const LAS float* gam = (const LAS float*)(L + opq(SC_MISC) + 2048);
#pragma unroll
            for (int n = 0; n < 2; ++n) { const int rr = 16 * mt + fr, c0 = 16 * (nt0 + n) + 4 * fq;
                st4o(S_(0), P.nat[n], a1[n][0], a1[n][1], a1[n][2], a1[n][3]);
                const float gj = gam[rr];
                st4o(S_(2), P.nat[n], a2[n][0] + (c0 + 0 == rr ? gj : 0.f), a2[n][1] + (c0 + 1 == rr ? gj : 0.f), a2[n][2] + (c0 + 2 == rr ? gj : 0.f), a2[n][3] + (c0 + 3 == rr ? gj : 0.f));
                st4o(S_(3), P.nat[n], a3[n][0], a3[n][1], a3[n][2], a3[n][3]); }
        }
        __syncthreads();
        if (j + 1 < jend) {
            geo = p1_geo(ZA, isctx, d, sc, j + 1, x);
#pragma unroll
            for (int m = 0; m < 3; ++m) p1_rawload(geo, colb[m], raw[m]);
        }
        {
            pg8::f32x4 a1[2], a2[2], a3[2]; ZERO2(a1);
            mm_o<true>(S_(0), S_(ppc), P, a1);
            mm_o<true>(S_(0), S_(qpc), P, accY);
            ZERO2(a2); mm_o<true>(S_(ppc), S_(2), P, a2);
#pragma unroll
            for (int n = 0; n < 2; ++n) a3[n] = ld4o(S_(3), P.nat[n]);
            mm_o<true>(S_(qpc), S_(2), P, a3);
            if (!isctx) {
                const int tt = 16 * mt + fr, xr = d ? 63 - tt : tt;
                bf16* gy = (bf16*)(A.ws() + WS_GY) + ((size_t)chain * 256 + tokchunk) * 8192;
#pragma unroll
                for (int n = 0; n < 2; ++n) { const int c0 = 16 * (nt0 + n) + 4 * fq; u32x2 o;
                    o.x = pk2(a1[n][0], a1[n][1]); o.y = pk2(a1[n][2], a1[n][3]); *(u32x2*)(gy + xr * 64 + c0) = o;
                    o.x = pk2(accY[n][0], accY[n][1]); o.y = pk2(accY[n][2], accY[n][3]); *(u32x2*)(gy + 4096 + xr * 64 + c0) = o; }
            }
            if (j < jend - 1) {
#pragma unroll
                for (int n = 0; n < 2; ++n) { const int rr = 16 * mt + fr, c0 = 16 * (nt0 + n) + 4 * fq;
                    st4o(S_(ppn), P.nat[n], a2[n][0], a2[n][1], a2[n][2], a2[n][3]); st4o(S_(qpn), P.nat[n], a3[n][0], a3[n][1], a3[n][2], a3[n][3]); }
            } else {
                pg8::f32x4 a4[2]; ZERO2(a4); mm_o<false>(S_(ppc), S_(2), P, a4);
                bf16* pq = isctx ? (bf16*)(A.ws() + WS_PQC) + ((size_t)chain * 4 + cj) * 8192 : (bf16*)(A.ws() + WS_PQ) + ((size_t)chain * 65 + scidx) * 8192;
#pragma unroll
                for (int n = 0; n < 2; ++n) { u32x2 o;
                    o.x = pk2(a4[n][0], a4[n][1]); o.y = pk2(a4[n][2], a4[n][3]); *(u32x2*)(pq + (16 * (nt0 + n) + fr) * 64 + 16 * mt + 4 * fq) = o;
                    o.x = pk2(a3[n][0], a3[n][1]); o.y = pk2(a3[n][2], a3[n][3]); *(u32x2*)(pq + 4096 + (16 * mt + fr) * 64 + 16 * (nt0 + n) + 4 * fq) = o; }
            }
        }
        __syncthreads();
        ppc = ppn; qpc = qpn;
    }
#undef S_
}

__device__ __forceinline__ void scan_chain(Frame& F, const KArgs& A, int chain) {
    const int w = F.wave, lane = F.lane, fr = lane & 15, fq = lane >> 4;
    const bf16* pq = (const bf16*)(A.ws() + WS_PQ) + (size_t)chain * 65 * 8192;
    const bf16* pqc = (const bf16*)(A.ws() + WS_PQC) + (size_t)chain * 4 * 8192;
    bf16* s0 = (bf16*)(A.ws() + WS_S0) + (size_t)chain * 64 * 4096;
    LAS unsigned char* const L = F.lds;
    const int vb = w & 3, v = 16 * vb + fr;
    pg8::f32x4 st[4];
#pragma unroll
    for (int it = 0; it < 4; ++it) st[it] = (pg8::f32x4){0.f, 0.f, 0.f, 0.f};
    if (w >= 4) {
        const bf16* src = pqc + (size_t)(w - 4) * 8192; LAS unsigned char* dst = L + (w - 4) * 16384;
#pragma unroll
        for (int i = 0; i < 16; ++i) { const int ci = i * 64 + lane, half = ci >> 9, row = (ci >> 3) & 63, ch = ci & 7;
            *(LAS u32x4*)(dst + half * 8192 + frag_off(row, ch)) = *(const u32x4*)(src + ci * 8); }
    }
    __syncthreads();
    for (int b = 0; b < 17; ++b) {
        if (w >= 4) {
            if (b + 1 < 17) { const bf16* src = pq + (size_t)(1 + 4 * b + (w - 4)) * 8192; LAS unsigned char* dst = L + ((b + 1) & 1) * 65536 + (w - 4) * 16384;
                u32x4 tmp[16];
#pragma unroll
                for (int i = 0; i < 16; ++i) tmp[i] = *(const u32x4*)(src + (i * 64 + lane) * 8);
#pragma unroll
                for (int i = 0; i < 16; ++i) { const int ci = i * 64 + lane, half = ci >> 9, row = (ci >> 3) & 63, ch = ci & 7; *(LAS u32x4*)(dst + half * 8192 + frag_off(row, ch)) = tmp[i]; } }
        } else {
#pragma unroll 1
            for (int s = 0; s < 4; ++s) {
                const int g = 4 * b + s, sc = g - 4;
                if (sc >= 0) {
#pragma unroll
                    for (int it = 0; it < 4; ++it) { u32x2 o; o.x = pk2(st[it][0], st[it][1]); o.y = pk2(st[it][2], st[it][3]); *(u32x2*)(s0 + (size_t)sc * 4096 + v * 64 + 16 * it + 4 * fq) = o; }
                }
                if (g < 67) {
                    const LAS unsigned char* P = L + (b & 1) * 65536 + s * 16384; const LAS unsigned char* Q = P + 8192;
                    bf16x8 bfrag[2];
#pragma unroll
                    for (int ks = 0; ks < 2; ++ks) { u32x4 bb; bb.x = pk2(st[2 * ks][0], st[2 * ks][1]); bb.y = pk2(st[2 * ks][2], st[2 * ks][3]); bb.z = pk2(st[2 * ks + 1][0], st[2 * ks + 1][1]); bb.w = pk2(st[2 * ks + 1][2], st[2 * ks + 1][3]); bfrag[ks] = __builtin_bit_cast(bf16x8, bb); }
                    pg8::f32x4 nw[4];
#pragma unroll
                    for (int jt = 0; jt < 4; ++jt) { nw[jt] = ld4(Q, v, 16 * jt + 4 * fq);
#pragma unroll
                        for (int ks = 0; ks < 2; ++ks) { const u32x2 a0 = *(const LAS u32x2*)(P + m_off(16 * jt + fr, 32 * ks + 4 * fq)), a1 = *(const LAS u32x2*)(P + m_off(16 * jt + fr, 32 * ks + 16 + 4 * fq));
                            u32x4 a; a.x = a0.x; a.y = a0.y; a.z = a1.x; a.w = a1.y;
                            nw[jt] = __builtin_amdgcn_mfma_f32_16x16x32_bf16(__builtin_bit_cast(bf16x8, a), bfrag[ks], nw[jt], 0, 0, 0); } }
#pragma unroll
                    for (int jt = 0; jt < 4; ++jt) st[jt] = nw[jt];
                }
            }
        }
        __syncthreads();
    }
}

__device__ __forceinline__ void scan_pass2_chunk(Frame& F, const KArgs& A, int c) {
    const int tid = F.tid, lane = F.lane, w = F.wave, fr = lane & 15, fq = lane >> 4;
    LAS unsigned char* const L = F.lds;
#define S_(i) (L + opq((i) * SL))
    const bf16* ZA = F_ZA; const float* mu = F_mu;
    const bf16* gy0 = (const bf16*)(A.ws() + WS_GY) + (size_t)c * 8192;
    const bf16* s0f0 = (const bf16*)(A.ws() + WS_S0) + (size_t)(c >> 2) * 4096;
    const bf16* s0b0 = (const bf16*)(A.ws() + WS_S0) + (size_t)(8 * 64 + ((255 - c) >> 2)) * 4096;
    const bf16* gut0 = (const bf16*)(A.ws() + WS_GUPT);
    const int r = tid >> 3, ch = tid & 7;
    {
        const int tok = c * 64 + r; const bf16* Z = ZA + (size_t)tok * 2048;
        const bool okl = r > 0, okr = r < 63, oku = c > 0, okd = c < GROWS - 1; const int dl = okl ? -1 : 0, dr = okr ? 1 : 0, du = oku ? -64 : 0, dd = okd ? 64 : 0;
#pragma unroll
        for (int half = 0; half < 2; ++half) { float g8[8]; const int col = 16 * ch + 8 * half; mix8(Z, 1792 + col, mu, dl, dr, du, dd, okl, okr, oku, okd, g8);
            u32x4 o; o.x = pk2(sigmoidf_(g8[0]), sigmoidf_(g8[1])); o.y = pk2(sigmoidf_(g8[2]), sigmoidf_(g8[3])); o.z = pk2(sigmoidf_(g8[4]), sigmoidf_(g8[5])); o.w = pk2(sigmoidf_(g8[6]), sigmoidf_(g8[7]));
            *(LAS u32x4*)(S_(6 + (col >> 6)) + frag_off(r, (col & 63) >> 3)) = o; }
    }
    u32x4 pf[6];
#define P2_LOAD(hh) do { const bf16* gf = gy0 + (size_t)(hh) * 256 * 8192, *gb = gy0 + (size_t)(8 + (hh)) * 256 * 8192; \
        pf[0] = *(const u32x4*)(gf + r * 64 + 8 * ch); pf[1] = *(const u32x4*)(gb + r * 64 + 8 * ch); \
        pf[2] = *(const u32x4*)(s0f0 + (size_t)(hh) * 64 * 4096 + r * 64 + 8 * ch); pf[3] = *(const u32x4*)(s0b0 + (size_t)(hh) * 64 * 4096 + r * 64 + 8 * ch); \
        pf[4] = *(const u32x4*)(gut0 + (size_t)(hh) * 8192 + r * 128 + 8 * ch); pf[5] = *(const u32x4*)(gut0 + (size_t)(hh) * 8192 + r * 128 + 64 + 8 * ch); } while (0)
    P2_LOAD(0);
    const int mt2 = w & 3, tt = 16 * mt2 + fr, tok = c * 64 + tt;
#pragma unroll 1
    for (int h = 0; h < 8; ++h) {
#pragma unroll
        for (int i = 0; i < 6; ++i) *(LAS u32x4*)(S_(i) + frag_off(r, ch)) = pf[i];
        __syncthreads();
        if (h < 7) P2_LOAD(h + 1);
        pg8::f32x4 y[4];
        if (w >= 4) {
            const int mt = w - 4;
#pragma unroll
            for (int np = 0; np < 2; ++np) { pg8::f32x4 g[2]; ZERO2(g);
                mm_tiles<true>(S_(6), S_(4), mt, 2 * np, fr, fq, g); mm_tiles<true>(S_(7), S_(5), mt, 2 * np, fr, fq, g);
#pragma unroll
                for (int n = 0; n < 2; ++n) *(LAS f32x4*)(L + opq(8 * SL) + ((16 * mt + fr) * 64 + 16 * (2 * np + n) + 4 * fq) * 4) = (f32x4){g[n][0], g[n][1], g[n][2], g[n][3]}; }
            const int t2 = tid - 256, tq = t2 >> 2, qc = t2 & 3, tk = c * 64 + tq; const bf16* Z = ZA + (size_t)tk * 2048;
            const bool okl = tq > 0, okr = tq < 63, oku = c > 0, okd = c < GROWS - 1; const int dl = okl ? -1 : 0, dr = okr ? 1 : 0, du = oku ? -64 : 0, dd = okd ? 64 : 0;
            float dp = 0.f;
#pragma unroll
            for (int half = 0; half < 2; ++half) { const int cc = h * 64 + 16 * qc + 8 * half; float r8[8], k8[8], v8[8];
                mix8(Z, cc, mu, dl, dr, du, dd, okl, okr, oku, okd, r8); mix8(Z, 512 + cc, mu, dl, dr, du, dd, okl, okr, oku, okd, k8); mix8(Z, 1024 + cc, mu, dl, dr, du, dd, okl, okr, oku, okd, v8);
                const f32x4 rk0 = *(const f32x4*)(F_r_k + cc), rk1 = *(const f32x4*)(F_r_k + cc + 4);
                dp += r8[0] * k8[0] * rk0.x + r8[1] * k8[1] * rk0.y + r8[2] * k8[2] * rk0.z + r8[3] * k8[3] * rk0.w + r8[4] * k8[4] * rk1.x + r8[5] * k8[5] * rk1.y + r8[6] * k8[6] * rk1.z + r8[7] * k8[7] * rk1.w;
                u32x4 o; o.x = pk2(v8[0], v8[1]); o.y = pk2(v8[2], v8[3]); o.z = pk2(v8[4], v8[5]); o.w = pk2(v8[6], v8[7]);
                *(LAS u32x4*)(S_(10) + frag_off(tq, 2 * qc + half)) = o; }
            dp += __shfl_xor(dp, 1); dp += __shfl_xor(dp, 2);
            if (qc == 0) ((LAS float*)(L + opq(SC_MISC)))[tq] = dp;
        } else {
            const bf16* gyf = gy0 + (size_t)h * 256 * 8192, *gyb = gy0 + (size_t)(8 + h) * 256 * 8192;
#pragma unroll
            for (int np = 0; np < 2; ++np) { pg8::f32x4 a[2];
#pragma unroll
                for (int n = 0; n < 2; ++n) { const int c0 = 16 * (2 * np + n) + 4 * fq; const u32x2 yf = *(const u32x2*)(gyf + 4096 + tt * 64 + c0), yb = *(const u32x2*)(gyb + 4096 + tt * 64 + c0);
                    a[n] = (pg8::f32x4){bflo(yf.x) + bflo(yb.x), bfhi(yf.x) + bfhi(yb.x), bflo(yf.y) + bflo(yb.y), bfhi(yf.y) + bfhi(yb.y)}; }
                mm_tiles<true>(S_(0), S_(2), mt2, 2 * np, fr, fq, a); mm_tiles<true>(S_(1), S_(3), mt2, 2 * np, fr, fq, a);
                y[2 * np] = a[0]; y[2 * np + 1] = a[1]; }
        }
        __syncthreads();
        if (w < 4) {
            float s = 0.f;
#pragma unroll
            for (int n = 0; n < 4; ++n) s += (y[n][0] + y[n][1]) + (y[n][2] + y[n][3]);
            s += __shfl_xor(s, 16); s += __shfl_xor(s, 32);
            const float mean = s * (1.0f / 64.0f); float s2 = 0.f;
#pragma unroll
            for (int n = 0; n < 4; ++n)
#pragma unroll
                for (int i = 0; i < 4; ++i) { const float dlt = y[n][i] - mean; s2 += dlt * dlt; }
            s2 += __shfl_xor(s2, 16); s2 += __shfl_xor(s2, 32);
            const float rstd = rsqrtf(s2 * (1.0f / 64.0f) + GN_EPS);
            const float dp = ((const LAS float*)(L + opq(SC_MISC)))[tt];
#pragma unroll
            for (int n = 0; n < 4; ++n) { const int cl = 16 * n + 4 * fq, cc = h * 64 + cl;
                const f32x4 lw = *(const f32x4*)(F_ln_w + cc), lb = *(const f32x4*)(F_ln_b + cc);
                const f32x4 g = *(const LAS f32x4*)(L + opq(8 * SL) + (tt * 64 + cl) * 4);
                const pg8::f32x4 vv = ld4(S_(10), tt, cl);
                float o[4];
#pragma unroll
                for (int i = 0; i < 4; ++i) { const float yn = (y[n][i] - mean) * rstd * lw[i] + lb[i]; o[i] = (yn + dp * vv[i]) * g[i]; }
                u32x2 pk; pk.x = pk2(o[0], o[1]); pk.y = pk2(o[2], o[3]);
                *(u32x2*)(F_YA + (size_t)tok * DR + cc) = pk; }
        }
    }
    __syncthreads();
#undef P2_LOAD
#undef S_
}

__global__ void __launch_bounds__(512, 2) fwd(Args AA) {
    extern __shared__ __attribute__((aligned(16))) unsigned char lds_raw[];
    Frame F;
    F.lds = (LAS unsigned char*)lds_raw;
    F.tid = threadIdx.x; F.lane = F.tid & 63; F.wave = __builtin_amdgcn_readfirstlane(F.tid >> 6); F.G = gridDim.x;
    F.ws = AA.ws; F.in = nullptr; F.ctl = (unsigned*)(AA.ws + WS_CTL);

    for (int u = F.tid; u < (LDS_BYTES - MISC_OFF) / 4; u += 512) ((LAS unsigned*)(F.lds + MISC_OFF))[u] = 0u;
    __syncthreads();
    XcdBarrier bar; bar.bar = F.ctl + CW_BAR; bar.x = 0; bar.st = nullptr;
    if (!MK_LAUNCH_PER_PHASE) bar = xcd_barrier_post(F.ctl + CW_BAR, (volatile LAS unsigned*)(F.lds + MISC_OFF));
    const int lo = AA.ph_lo, hi = AA.ph_hi;
#ifndef ONLY_PHASE
#define ONLY_PHASE -1
#endif
#define IN(k) ((ONLY_PHASE < 0 || ONLY_PHASE == (k)) && lo <= (k) && (k) < hi)
#define FRESH() do { int t_ = threadIdx.x; asm volatile("" : "+v"(t_)); F.tid = t_; F.lane = t_ & 63; } while (0)
#ifndef REP_MASK
#define REP_MASK 0
#endif
#define REPS(k) (((REP_MASK >> (k)) & 1) ? 2 : 1)
#define SEAM(k) do { if (!MK_LAUNCH_PER_PHASE && IN(k) && IN((k) + 1)) xcd_barrier(bar); } while (0)

    if (IN(0)) for (int rep_ = 0; rep_ < REPS(0); ++rep_) { FRESH(); FRESH_KA(A); p0_prologue(F, A); } SEAM(0);
    if (IN(1)) for (int rep_ = 0; rep_ < REPS(1); ++rep_) { FRESH(); FRESH_KA(A); p1_norm1(F, A); } SEAM(1);
    if (IN(2)) for (int rep_ = 0; rep_ < REPS(2); ++rep_) { FRESH(); FRESH_KA(A);
        pg8::Gemm g{F_H, F_WinT, MTOT, NPAD, D}; Sched1 S{F.G, (int)blockIdx.x}; EpiZ E{F_ZA, F_ZB, F_ZG};
        pg8::gemm_phase<EpiZ, Sched1, true, true>(F.lds, g, S, E);
    } SEAM(2);
#ifndef SCAN_NAIVE
#define SCAN_NAIVE 0
#endif
    if (IN(3)) for (int rep_ = 0; rep_ < REPS(3); ++rep_) { FRESH(); FRESH_KA(A);
#if SCAN_NAIVE
        if (blockIdx.x < 16) p3_scan_naive(F, A, (int)blockIdx.x);
        else for (int ch = (int)blockIdx.x - 16; ch < SEQ / 128; ch += F.G - 16) p3_mixer_b(F, A, ch);
#else
        if (F.G == 256) {
            const int xcd = (int)blockIdx.x & 7, slot = (int)blockIdx.x >> 3, chain = slot & 15;
            for (int r = 0; r < 4; ++r) { const int tsc = 16 * r + 2 * xcd + (slot >> 4); scan_pass1_unit(F, A, chain, 1 + ((chain >> 3) ? 63 - tsc : tsc), -1); }
        } else for (int u = (int)blockIdx.x; u < 16 * 64; u += F.G) scan_pass1_unit(F, A, u & 15, 1 + (u >> 4), -1);
        if (blockIdx.x >= F.G - 64) { const int u = (int)blockIdx.x - (F.G - 64); scan_pass1_unit(F, A, u & 15, 0, u >> 4); }
#endif
    } SEAM(3);
    if (IN(4)) for (int rep_ = 0; rep_ < REPS(4); ++rep_) { FRESH(); FRESH_KA(A);
#if !SCAN_NAIVE
#ifndef P4REP
#define P4REP 0
#endif
        if (blockIdx.x < 16) {
            for (int q_ = 0; q_ < ((P4REP & 1) ? 2 : 1); ++q_) scan_chain(F, A, (int)blockIdx.x); }
        else for (int q_ = 0; q_ < ((P4REP & 2) ? 2 : 1); ++q_) for (int ch = (int)blockIdx.x - 16; ch < SEQ / 128; ch += F.G - 16) p3_mixer_b(F, A, ch);
#endif
    } SEAM(4);
    if (IN(5)) for (int rep_ = 0; rep_ < REPS(5); ++rep_) { FRESH(); FRESH_KA(A);
#if SCAN_NAIVE
        p4_rwkv_out(F, A);
#else
        for (int c = (int)blockIdx.x; c < 256; c += F.G) scan_pass2_chunk(F, A, c);
#endif
    } SEAM(5);
    if (IN(6)) for (int rep_ = 0; rep_ < REPS(6); ++rep_) { FRESH(); FRESH_KA(A);
        SchedStd S{64, 4, F.G, (int)blockIdx.x};
        { pg8::Gemm g{F_YA, F_WaT, SEQ, D, DR}; EpiMergeA E{(bf16*)F_Y}; pg8::gemm_phase<EpiMergeA, SchedStd, true, true>(F.lds, g, S, E); }
        __syncthreads();
        { pg8::Gemm g{F_YB, F_WbT, SEQ, D, DR}; EpiMergeB E{(const bf16*)F_Y, F_ZG, F_MG}; pg8::gemm_phase<EpiMergeB, SchedStd, true, true>(F.lds, g, S, E); }
    } SEAM(6);
    if (IN(7)) for (int rep_ = 0; rep_ < REPS(7); ++rep_) { FRESH(); FRESH_KA(A);
        SchedStd S{64, 4, F.G, (int)blockIdx.x};
        pg8::Gemm g{F_MG, F_WoutT, SEQ, D, D}; EpiX1 E{F_x, F_MOD + 2048, F_out}; pg8::gemm_phase<EpiX1, SchedStd, true, true>(F.lds, g, S, E);
    } SEAM(7);
#ifndef CONV_REPS
#define CONV_REPS 1
#endif
    if (IN(8)) { FRESH(); FRESH_KA(A); p7_router(F, A); for (int rep_ = 0; rep_ < CONV_REPS; ++rep_) { p7_moe_convert(F, A); __syncthreads(); } } do { if (!MK_LAUNCH_PER_PHASE && IN(8) && IN(10)) xcd_barrier(bar); } while (0);
    if (IN(10)) for (int rep_ = 0; rep_ < REPS(10); ++rep_) { FRESH(); FRESH_KA(A);
        const int ntiles = moe_tables(F, A);
        MoeOrder S{(const LAS int*)(F.lds + TAB_OFF), F_INVT, ntiles * 4, F.G, (int)blockIdx.x};
        pg8::Gemm g{F_H, F_WguT, SEQ, NEXP * 1024, D}; EpiSwiGLU E{F_HMID};
        pg8::gemm_phase_g<EpiSwiGLU, MoeOrder>(F.lds, g, S, E);
    } SEAM(10);
    if (IN(11)) for (int rep_ = 0; rep_ < REPS(11); ++rep_) { FRESH(); FRESH_KA(A);
        const int ntiles = moe_tables(F, A);
        MoeOrder S{(const LAS int*)(F.lds + TAB_OFF), F_INVT, ntiles * 4, F.G, (int)blockIdx.x};
        pg8::Gemm g{F_HMID, F_WdT, MAXTILES * 256, NEXP * 1024, DEXP}; EpiScatter E{F_YBUF, (const LAS int*)(F.lds + TAB_OFF), F_INVT, F_INVW};
        pg8::gemm_phase<EpiScatter, MoeOrder, true, true>(F.lds, g, S, E);
    } SEAM(11);
    if (IN(12)) for (int rep_ = 0; rep_ < REPS(12); ++rep_) { FRESH(); FRESH_KA(A); p11_final(F, A); }
#undef IN
#undef SEAM
}

extern "C" void kernel_launch(void* const* d_in, const int* in_sizes, int n_in, void* d_out, int out_size, void* d_ws, size_t ws_size, hipStream_t stream) {
    static int grid = 0;
    if (grid == 0) {
        if (n_in != 35 || in_sizes[0] != SEQ * D || out_size != SEQ * D || ws_size < WS_END) {
            fprintf(stderr, "kernel_launch: unexpected shapes: n_in %d in0 %d out %d ws %zu (need %zu); nothing launched\n", n_in, n_in > 0 ? in_sizes[0] : -1, out_size, ws_size, (size_t)WS_END); grid = -1; return; }
        int dev = 0, cus = 0, per_cu = 0;
        if (hipGetDevice(&dev) != hipSuccess || hipDeviceGetAttribute(&cus, hipDeviceAttributeMultiprocessorCount, dev) != hipSuccess) { grid = -1; return; }
        if (hipFuncSetAttribute((const void*)fwd, hipFuncAttributeMaxDynamicSharedMemorySize, LDS_BYTES) != hipSuccess) { fprintf(stderr, "kernel_launch: hipFuncSetAttribute failed\n"); grid = -1; return; }
        if (hipOccupancyMaxActiveBlocksPerMultiprocessor(&per_cu, (const void*)fwd, 512, LDS_BYTES) != hipSuccess || per_cu < 1) fprintf(stderr, "kernel_launch: occupancy query says %d\n", per_cu);
        (void)hipGetLastError();
        grid = cus;
    }
    if (grid < 0) return;
    if (hipMemsetAsync((char*)d_ws + WS_CTL, 0, CTL_ZERO_BYTES, stream) != hipSuccess) return;
    Args a{};
    for (int i = 0; i < 35; ++i) a.in[i] = (const float*)d_in[i];
    a.out = (float*)d_out; a.ws = (unsigned char*)d_ws;
#if MK_LAUNCH_PER_PHASE
    for (int p = 0; p < NPHASE; ++p) { a.ph_lo = p; a.ph_hi = p + 1; hipLaunchKernelGGL(fwd, dim3(grid), dim3(512), LDS_BYTES, stream, a); }
#else
#ifndef MK_PH_HI
#define MK_PH_HI NPHASE
#endif
    a.ph_lo = 0; a.ph_hi = MK_PH_HI;
    hipLaunchKernelGGL(fwd, dim3(grid), dim3(512), LDS_BYTES, stream, a);
#endif
}
```
